# Optimizing an MI355X kernel written in HIP

```python
import jax
import jax.numpy as jnp
from jax import lax
import numpy as np

D_MODEL = 1024
BATCH = 4
SEQ = 4096
DEPTH = 2
DEC_BATCH = 32
DEC_SEQ = 8
PAST_LEN = 8192
PAGE_SIZE = 128

HEAD_DIM = 64
A_HEADS = D_MODEL // (2 * HEAD_DIM)
DIL_PAIRS = ((128, 1), (512, 4), (2048, 16))
DIL_MAX = 2048
RNN_WIDTH = D_MODEL // 2
RNN_BLOCKS = RNN_WIDTH // HEAD_DIM
CONV_W = 4
LRU_C = 8.0
C_HEADS = D_MODEL // HEAD_DIM
C_KV_HEADS = C_HEADS // 4
CMP_LEN = 32
CMP_STRIDE = 16
SEL_BLOCK = 64
SEL_TOP = 16
WIN = 512
FFN_HIDDEN = -(-8 * D_MODEL // (3 * 256)) * 256
N_EVEN = (DEPTH + 1) // 2
N_ODD = DEPTH // 2
A_WIDTH = A_HEADS * HEAD_DIM
AB_IN = 3 * A_WIDTH + 2 * RNN_WIDTH
AB_MIX = A_WIDTH + RNN_WIDTH
C_Q = C_HEADS * HEAD_DIM
C_KV = 2 * C_KV_HEADS * HEAD_DIM
C_IN = C_Q + 3 * C_KV + 3 * C_HEADS
DIL_Q_BLOCK = 128
SEL_Q_BLOCK = 64
WIN_Q_BLOCK = 128
NEG = -1e30
FORCE_BONUS = 1e3
EPS = 1e-6

kernel_name = 'hybrid_dilated_rglru_nsa_step'


def _rms_norm(x, g):
    xf = x.astype(jnp.float32)
    y = xf * lax.rsqrt(jnp.mean(xf * xf, axis=-1, keepdims=True) + EPS) * g.astype(jnp.float32)
    return y.astype(x.dtype)


def _alibi_slopes(n):
    return 2.0 ** (-8.0 * jnp.arange(1, n + 1, dtype=jnp.float32) / n)


def _masked_softmax(s, mask):
    s = jnp.where(mask, s, NEG)
    m = jnp.max(s, axis=-1, keepdims=True)
    p = jnp.where(mask, jnp.exp(s - m), 0.0)
    return p / jnp.maximum(jnp.sum(p, axis=-1, keepdims=True), 1e-30)


def _blocked_map(fn, q, pos, block):
    b, t = q.shape[0], q.shape[1]
    if t <= block or t % block:
        return fn((q, pos))
    nb = t // block
    qb = jnp.moveaxis(q.reshape((b, nb, block) + q.shape[2:]), 1, 0)
    out = lax.map(fn, (qb, pos.reshape(nb, block)))

    def unblock(o):
        o = jnp.moveaxis(o, 0, 1)
        return o.reshape((b, t) + o.shape[3:])
    return jax.tree_util.tree_map(unblock, out)


def _gather_pages(pool, page_table):
    rows = pool[page_table]
    return rows.reshape((page_table.shape[0], -1) + pool.shape[2:])


def _dilated_attention(q, kv_ctx, q_off):
    slopes = _alibi_slopes(A_HEADS)
    scale = HEAD_DIM ** -0.5

    def block_fn(args):
        qb, qc = args
        lses, outs = [], []
        for window, dil in DIL_PAIRS:
            dist = jnp.arange(window // dil + 1) * dil
            idx = qc[:, None] - dist[None, :]
            kvg = jnp.take(kv_ctx, jnp.maximum(idx, 0), axis=1)
            s = jnp.einsum('bthd,btkhd->bhtk', qb, kvg[:, :, :, 0], preferred_element_type=jnp.float32) * scale
            s = s - slopes[:, None, None] * dist.astype(jnp.float32)
            s = jnp.where(idx >= 0, s, NEG)
            m = jnp.max(s, axis=-1, keepdims=True)
            p = jnp.exp(s - m)
            l = jnp.sum(p, axis=-1, keepdims=True)
            outs.append(jnp.einsum('bhtk,btkhd->bthd', p / l, kvg[:, :, :, 1].astype(jnp.float32)))
            lses.append(jnp.swapaxes((m + jnp.log(l))[..., 0], 1, 2))
        wts = jax.nn.softmax(jnp.stack(lses), axis=0)[..., None]
        return jnp.sum(wts * jnp.stack(outs), axis=0).astype(qb.dtype)

    pos = q_off + jnp.arange(q.shape[1])
    return _blocked_map(block_fn, q, pos, DIL_Q_BLOCK)


def _rg_lru(xr, gate, conv_prev, h_prev, conv_w, conv_b, gate_a_w, gate_a_b, gate_x_w, gate_x_b, lru_lambda):
    b, t, _ = xr.shape
    xin = jnp.concatenate([conv_prev.astype(xr.dtype), xr], axis=1)
    xc = conv_b + sum(xin[:, k:k + t] * conv_w[k] for k in range(CONV_W))
    xb = xc.reshape(b, t, RNN_BLOCKS, RNN_WIDTH // RNN_BLOCKS)
    rg = jax.nn.sigmoid((jnp.einsum('btni,nij->btnj', xb, gate_a_w).reshape(b, t, RNN_WIDTH) + gate_a_b).astype(jnp.float32))
    ig = jax.nn.sigmoid((jnp.einsum('btni,nij->btnj', xb, gate_x_w).reshape(b, t, RNN_WIDTH) + gate_x_b).astype(jnp.float32))
    log_a = -LRU_C * rg * jax.nn.softplus(-lru_lambda.astype(jnp.float32))
    a = jnp.exp(log_a)
    u = jnp.sqrt(-jnp.expm1(2.0 * log_a)) * ig * xc.astype(jnp.float32)

    def step(hc, au):
        hc = au[0] * hc + au[1]
        return hc, hc
    h_last, hs = lax.scan(step, h_prev.astype(jnp.float32), (jnp.swapaxes(a, 0, 1), jnp.swapaxes(u, 0, 1)))
    y = jnp.swapaxes(hs, 0, 1) * jax.nn.gelu(gate.astype(jnp.float32))
    return y.astype(xr.dtype), xin[:, t:], h_last.astype(h_prev.dtype)


def _mixer_ab(h, w_in, w_out, conv_w, conv_b, gate_a_w, gate_a_b, gate_x_w, gate_x_b, lru_lambda, kv_buf, conv_prev, h_prev):
    b, t, _ = h.shape
    proj = h @ w_in
    q = proj[..., :A_WIDTH].reshape(b, t, A_HEADS, HEAD_DIM)
    kv = proj[..., A_WIDTH:3 * A_WIDTH].reshape(b, t, 2, A_HEADS, HEAD_DIM)
    xr = proj[..., 3 * A_WIDTH:3 * A_WIDTH + RNN_WIDTH]
    gate = proj[..., 3 * A_WIDTH + RNN_WIDTH:]
    if kv_buf is None:
        ctx, keep = kv, min(DIL_MAX, t)
    else:
        ctx, keep = jnp.concatenate([kv_buf.astype(kv.dtype), kv], axis=1), kv_buf.shape[1]
    o_att = _dilated_attention(q, ctx, ctx.shape[1] - t)
    o_rnn, new_conv, new_h = _rg_lru(xr, gate, conv_prev, h_prev, conv_w, conv_b, gate_a_w, gate_a_b, gate_x_w, gate_x_b, lru_lambda)
    y = jnp.concatenate([o_att.reshape(b, t, A_WIDTH), o_rnn], axis=-1) @ w_out
    return y, ctx[:, ctx.shape[1] - keep:], new_conv, new_h


def _compress(ctx, w_cmp, pe_cmp):
    b, tc = ctx.shape[:2]
    n_r = CMP_LEN // CMP_STRIDE
    n_ch = tc // CMP_STRIDE
    n_c = n_ch - n_r + 1
    chunks = ctx[:, :n_ch * CMP_STRIDE].reshape((b, n_ch, CMP_STRIDE) + ctx.shape[2:])
    w = w_cmp.reshape(n_r, CMP_STRIDE, 2, HEAD_DIM, HEAD_DIM)
    out = jnp.einsum('lcd,lcde->ce', pe_cmp, w_cmp)[None, None, :, None, :]
    for i in range(n_r):
        out = out + jnp.einsum('bnscgd,scde->bncge', chunks[:, i:i + n_c], w[i])
    end = jnp.arange(n_c) * CMP_STRIDE + CMP_LEN - 1
    return out.astype(ctx.dtype), end


def _cmp_to_sel(n_c, n_sel):
    cs = jnp.arange(n_c)[:, None] * CMP_STRIDE
    ss = jnp.arange(n_sel)[None, :] * SEL_BLOCK
    ov = jnp.minimum(cs + CMP_LEN, ss + SEL_BLOCK) - jnp.maximum(cs, ss)
    return jnp.maximum(ov, 0).astype(jnp.float32) / CMP_STRIDE


def _band_attention(q, kv_ctx, q_off, slopes):
    scale = HEAD_DIM ** -0.5
    kv_pad = jnp.pad(kv_ctx, ((0, 0), (WIN, 0), (0, 0), (0, 0), (0, 0)))

    def block_fn(args):
        qb, qc = args
        tb = qb.shape[1]
        kvb = lax.dynamic_slice_in_dim(kv_pad, qc[0], tb + WIN, axis=1)
        kc = qc[0] - WIN + jnp.arange(tb + WIN)
        dist = qc[:, None] - kc[None, :]
        ok = (dist >= 0) & (dist <= WIN) & (kc >= 0)[None, :]
        s = jnp.einsum('btgrd,bsgd->bgrts', qb, kvb[:, :, 0], preferred_element_type=jnp.float32) * scale
        s = s - slopes[:, :, None, None] * dist.astype(jnp.float32)
        p = _masked_softmax(s, ok)
        return jnp.einsum('bgrts,bsgd->btgrd', p, kvb[:, :, 1])

    pos = q_off + jnp.arange(q.shape[1])
    return _blocked_map(block_fn, q, pos, WIN_Q_BLOCK)


def _mixer_nsa(h, w_in, w_out, w_cmp, pe_cmp, past_cmp, past_sel, win_buf):
    b, t, _ = h.shape
    g, r = C_KV_HEADS, C_HEADS // C_KV_HEADS
    scale = HEAD_DIM ** -0.5
    slopes = _alibi_slopes(C_HEADS).reshape(g, r)
    proj = h @ w_in
    q = proj[..., :C_Q].reshape(b, t, g, r, HEAD_DIM)
    kv_cmp, kv_sel, kv_win = [proj[..., C_Q + i * C_KV:C_Q + (i + 1) * C_KV].reshape(b, t, 2, g, HEAD_DIM) for i in range(3)]
    gates = jax.nn.sigmoid(proj[..., C_Q + 3 * C_KV:].astype(jnp.float32)).reshape(b, t, g, r, 3)
    if past_cmp is None:
        ctx_cmp, ctx_sel = kv_cmp, kv_sel
    else:
        ctx_cmp = jnp.concatenate([past_cmp.astype(kv_cmp.dtype), kv_cmp], axis=1)
        ctx_sel = jnp.concatenate([past_sel.astype(kv_sel.dtype), kv_sel], axis=1)
    if win_buf is None:
        ctx_win, keep = kv_win, min(WIN, t)
    else:
        ctx_win, keep = jnp.concatenate([win_buf.astype(kv_win.dtype), kv_win], axis=1), win_buf.shape[1]
    tc = ctx_cmp.shape[1]
    pos = (tc - t) + jnp.arange(t)
    kvc, cmp_end = _compress(ctx_cmp, w_cmp, pe_cmp)
    kc, vc = kvc[:, :, 0], kvc[:, :, 1]
    n_c = kvc.shape[1]
    n_sel = -(-tc // SEL_BLOCK)
    n_top = min(SEL_TOP, n_sel)
    sel_blocks = jnp.pad(ctx_sel, ((0, 0), (0, n_sel * SEL_BLOCK - tc), (0, 0), (0, 0), (0, 0)))
    sel_blocks = sel_blocks.reshape(b, n_sel, SEL_BLOCK, 2, g, HEAD_DIM).transpose(0, 4, 1, 2, 3, 5)
    cmp2sel = _cmp_to_sel(n_c, n_sel)
    bi = jnp.arange(b)[:, None, None, None]
    gi = jnp.arange(g)[None, :, None, None]
    blk = jnp.arange(n_sel)
    tok_off = jnp.arange(SEL_BLOCK)

    def block_fn(args):
        qb, qp = args
        tb = qb.shape[1]
        s = jnp.einsum('btgrd,bngd->bgrtn', qb, kc, preferred_element_type=jnp.float32) * scale
        s = s - slopes[:, :, None, None] * (qp[:, None] - cmp_end[None, :]).astype(jnp.float32)
        p = _masked_softmax(s, cmp_end[None, :] <= qp[:, None])
        o_cmp = jnp.einsum('bgrtn,bngd->btgrd', p, vc)
        imp = jnp.einsum('bgrtn,nj->bgtj', p, cmp2sel)
        cb = qp // SEL_BLOCK
        blk_ok = blk[None, :] <= cb[:, None]
        forced = (blk[None, :] == 0) | (blk[None, :] == cb[:, None]) | (blk[None, :] == cb[:, None] - 1)
        score = jnp.where(blk_ok, imp + FORCE_BONUS * forced.astype(jnp.float32), NEG)
        top_s, top_i = lax.top_k(score, n_top)
        kvs = sel_blocks[bi, gi, top_i]
        tok = top_i[..., None] * SEL_BLOCK + tok_off
        ok = (top_s > 0.5 * NEG)[..., None] & (tok <= qp[None, None, :, None, None])
        ks = kvs[..., 0, :].reshape(b, g, tb, n_top * SEL_BLOCK, HEAD_DIM)
        vs = kvs[..., 1, :].reshape(b, g, tb, n_top * SEL_BLOCK, HEAD_DIM)
        dist = (qp[None, None, :, None, None] - tok).reshape(b, g, tb, n_top * SEL_BLOCK)
        s2 = jnp.einsum('btgrd,bgtkd->bgrtk', qb, ks, preferred_element_type=jnp.float32) * scale
        s2 = s2 - slopes[None, :, :, None, None] * dist[:, :, None].astype(jnp.float32)
        p2 = _masked_softmax(s2, ok.reshape(b, g, tb, n_top * SEL_BLOCK)[:, :, None])
        o_sel = jnp.einsum('bgrtk,bgtkd->btgrd', p2, vs)
        return o_cmp, o_sel

    o_cmp, o_sel = _blocked_map(block_fn, q, pos, SEL_Q_BLOCK)
    o_win = _band_attention(q, ctx_win, ctx_win.shape[1] - t, slopes)
    o = gates[..., 0:1] * o_cmp + gates[..., 1:2] * o_sel + gates[..., 2:3] * o_win
    y = o.astype(h.dtype).reshape(b, t, C_Q) @ w_out
    return y, kv_cmp, kv_sel, ctx_win[:, ctx_win.shape[1] - keep:]


def _swiglu(h, w1, w3, w2):
    return (jax.nn.silu(h @ w1) * (h @ w3)) @ w2


def setup_inputs(seed: int = 0) -> dict:
    key = jax.random.key(seed)
    ks = iter(jax.random.split(key, 40))

    def nrm(shape, s):
        return s * jax.random.normal(next(ks), shape, jnp.float32)
    n_pages = PAST_LEN // PAGE_SIZE
    n_used = DEC_BATCH * n_pages
    n_phys = n_used + n_used // 4
    l_dil = min(DIL_MAX, PAST_LEN)
    l_win = min(WIN, PAST_LEN)
    bw = RNN_WIDTH // RNN_BLOCKS
    a0 = jax.random.uniform(next(ks), (N_EVEN, RNN_WIDTH), jnp.float32, 0.9, 0.999) ** (1.0 / LRU_C)
    page_table = jax.random.permutation(next(ks), n_phys)[:n_used].reshape(DEC_BATCH, n_pages).astype(jnp.int32)
    return {
        'x_prompt': nrm((BATCH, SEQ, D_MODEL), 1.0),
        'x_sample': nrm((DEC_BATCH, DEC_SEQ, D_MODEL), 1.0),
        'cache_dil_kv': nrm((N_EVEN, DEC_BATCH, l_dil, 2, A_HEADS, HEAD_DIM), 1.0),
        'state_conv': nrm((N_EVEN, DEC_BATCH, CONV_W - 1, RNN_WIDTH), 1.0),
        'state_rnn': nrm((N_EVEN, DEC_BATCH, RNN_WIDTH), 0.5),
        'cache_win_kv': nrm((N_ODD, DEC_BATCH, l_win, 2, C_KV_HEADS, HEAD_DIM), 1.0),
        'cache_cmp_kv': nrm((N_ODD, n_phys, PAGE_SIZE, 2, C_KV_HEADS, HEAD_DIM), 1.0),
        'cache_sel_kv': nrm((N_ODD, n_phys, PAGE_SIZE, 2, C_KV_HEADS, HEAD_DIM), 1.0),
        'page_table': page_table,
        'norm_mix': 1.0 + nrm((DEPTH, D_MODEL), 0.1),
        'norm_ffn': 1.0 + nrm((DEPTH, D_MODEL), 0.1),
        'norm_out': 1.0 + nrm((D_MODEL,), 0.1),
        'w_in_ab': nrm((N_EVEN, D_MODEL, AB_IN), D_MODEL ** -0.5),
        'w_out_ab': nrm((N_EVEN, AB_MIX, D_MODEL), AB_MIX ** -0.5),
        'conv_w': nrm((N_EVEN, CONV_W, RNN_WIDTH), CONV_W ** -0.5),
        'conv_b': nrm((N_EVEN, RNN_WIDTH), 0.1),
        'gate_a_w': nrm((N_EVEN, RNN_BLOCKS, bw, bw), bw ** -0.5),
        'gate_a_b': nrm((N_EVEN, RNN_WIDTH), 0.1),
        'gate_x_w': nrm((N_EVEN, RNN_BLOCKS, bw, bw), bw ** -0.5),
        'gate_x_b': nrm((N_EVEN, RNN_WIDTH), 0.1),
        'lru_lambda': jnp.log(a0) - jnp.log1p(-a0),
        'w_in_c': nrm((N_ODD, D_MODEL, C_IN), D_MODEL ** -0.5),
        'w_out_c': nrm((N_ODD, C_Q, D_MODEL), C_Q ** -0.5),
        'w_cmp': nrm((N_ODD, CMP_LEN, 2, HEAD_DIM, HEAD_DIM), (CMP_LEN * HEAD_DIM) ** -0.5),
        'pe_cmp': nrm((N_ODD, CMP_LEN, 2, HEAD_DIM), 0.1),
        'ffn_w1': nrm((DEPTH, D_MODEL, FFN_HIDDEN), D_MODEL ** -0.5),
        'ffn_w3': nrm((DEPTH, D_MODEL, FFN_HIDDEN), D_MODEL ** -0.5),
        'ffn_w2': nrm((DEPTH, FFN_HIDDEN, D_MODEL), FFN_HIDDEN ** -0.5),
    }


def reference(x_prompt, x_sample, cache_dil_kv, state_conv, state_rnn, cache_win_kv, cache_cmp_kv, cache_sel_kv, page_table, norm_mix, norm_ffn, norm_out, w_in_ab, w_out_ab, conv_w, conv_b, gate_a_w, gate_a_b, gate_x_w, gate_x_b, lru_lambda, w_in_c, w_out_c, w_cmp, pe_cmp, ffn_w1, ffn_w3, ffn_w2):
    yp, ys = x_prompt, x_sample
    bp = x_prompt.shape[0]
    dil_p, dil_s, conv_p, conv_s, rnn_p, rnn_s = [], [], [], [], [], []
    win_p, win_s, cmp_p, cmp_s, sel_p, sel_s = [], [], [], [], [], []
    for layer in range(DEPTH):
        hp = _rms_norm(yp, norm_mix[layer])
        hs = _rms_norm(ys, norm_mix[layer])
        li = layer // 2
        if layer % 2 == 0:
            wts = (w_in_ab[li], w_out_ab[li], conv_w[li], conv_b[li], gate_a_w[li], gate_a_b[li], gate_x_w[li], gate_x_b[li], lru_lambda[li])
            zc = jnp.zeros((bp, CONV_W - 1, RNN_WIDTH), x_prompt.dtype)
            zh = jnp.zeros((bp, RNN_WIDTH), x_prompt.dtype)
            op, kvp, cvp, hpn = _mixer_ab(hp, *wts, None, zc, zh)
            osm, kvs, cvs, hsn = _mixer_ab(hs, *wts, cache_dil_kv[li], state_conv[li], state_rnn[li])
            dil_p.append(kvp)
            dil_s.append(kvs)
            conv_p.append(cvp)
            conv_s.append(cvs)
            rnn_p.append(hpn)
            rnn_s.append(hsn)
        else:
            wts = (w_in_c[li], w_out_c[li], w_cmp[li], pe_cmp[li])
            op, cp, sp, wp = _mixer_nsa(hp, *wts, None, None, None)
            past_cmp = _gather_pages(cache_cmp_kv[li], page_table)
            past_sel = _gather_pages(cache_sel_kv[li], page_table)
            osm, cs, ss, wsn = _mixer_nsa(hs, *wts, past_cmp, past_sel, cache_win_kv[li])
            cmp_p.append(cp)
            cmp_s.append(cs)
            sel_p.append(sp)
            sel_s.append(ss)
            win_p.append(wp)
            win_s.append(wsn)
        yp = yp + op
        ys = ys + osm
        yp = yp + _swiglu(_rms_norm(yp, norm_ffn[layer]), ffn_w1[layer], ffn_w3[layer], ffn_w2[layer])
        ys = ys + _swiglu(_rms_norm(ys, norm_ffn[layer]), ffn_w1[layer], ffn_w3[layer], ffn_w2[layer])
    y_prompt = _rms_norm(yp, norm_out)
    y_sample = _rms_norm(ys, norm_out)
    dil_kv_p = jnp.stack(dil_p)
    dil_kv_s = jnp.stack(dil_s)
    conv_pr = jnp.stack(conv_p)
    conv_sa = jnp.stack(conv_s)
    rnn_pr = jnp.stack(rnn_p)
    rnn_sa = jnp.stack(rnn_s)
    win_kv_p = jnp.stack(win_p)
    win_kv_s = jnp.stack(win_s)
    cmp_kv_p = jnp.stack(cmp_p)
    cmp_kv_s = jnp.stack(cmp_s)
    sel_kv_p = jnp.stack(sel_p)
    sel_kv_s = jnp.stack(sel_s)
    return (y_prompt, y_sample, dil_kv_p, dil_kv_s, conv_pr, conv_sa, rnn_pr, rnn_sa, win_kv_p, win_kv_s, cmp_kv_p, cmp_kv_s, sel_kv_p, sel_kv_s)
```

```cpp
#include <hip/hip_runtime.h>
#include <cstdio>
#include <cstdint>
#include <type_traits>

#define LAS __attribute__((address_space(3)))
#define GAS __attribute__((address_space(1)))
typedef unsigned short bf16_t;
typedef short bf16x8 __attribute__((ext_vector_type(8)));
typedef short s16x4 __attribute__((ext_vector_type(4)));
typedef float f32x2 __attribute__((ext_vector_type(2)));
typedef float f32x4 __attribute__((ext_vector_type(4)));
typedef float f32x16 __attribute__((ext_vector_type(16)));
typedef unsigned u32x2 __attribute__((ext_vector_type(2)));
typedef unsigned u32x4 __attribute__((ext_vector_type(4)));
typedef __bf16 bf16x2_t __attribute__((ext_vector_type(2)));

constexpr int D = 1024, BP = 4, SEQ = 4096, MP = BP * SEQ, BS = 32, TS = 8, MS = BS * TS, M = MP + MS;
constexpr int PAST = 8192, PAGE = 128, NPG = PAST / PAGE;
constexpr int AB_IN = 2560, C_IN = 2608, C_IN_PAD = 2816, FF = 2816, FF2 = 2 * FF;
constexpr int DIL_KEEP = 2048, WIN = 512;
constexpr int NCP = 255, NCS = 511;
constexpr float EPS = 1e-6f;
constexpr float LOG2E = 1.4426950408889634f;
constexpr float C_SCALE2 = 0.125f * LOG2E;

constexpr size_t O_YP = 0, O_YS = O_YP + (size_t)MP * D, O_DILP = O_YS + (size_t)MS * D, O_DILS = O_DILP + (size_t)BP * 2048 * 1024,
                 O_CONVP = O_DILS + (size_t)BS * 2048 * 1024, O_CONVS = O_CONVP + (size_t)BP * 3 * 512, O_RNNP = O_CONVS + (size_t)BS * 3 * 512,
                 O_RNNS = O_RNNP + (size_t)BP * 512, O_WINP = O_RNNS + (size_t)BS * 512, O_WINS = O_WINP + (size_t)BP * 512 * 512,
                 O_CMPP = O_WINS + (size_t)BS * 512 * 512, O_CMPS = O_CMPP + (size_t)BP * SEQ * 512, O_SELP = O_CMPS + (size_t)BS * TS * 512,
                 O_SELS = O_SELP + (size_t)BP * SEQ * 512, O_END = O_SELS + (size_t)BS * TS * 512;
static_assert(O_END == 119087104, "output size");

constexpr size_t al256(size_t x) { return (x + 255) & ~(size_t)255; }
constexpr size_t WS_CTL = 0, CTL_ZERO_BYTES = 1u << 16;
constexpr size_t WS_WIN0 = CTL_ZERO_BYTES;
constexpr size_t WS_WOUT0 = WS_WIN0 + (size_t)AB_IN * D * 2;
constexpr size_t WS_W13_0 = WS_WOUT0 + (size_t)D * D * 2;
constexpr size_t WS_W2_0 = WS_W13_0 + (size_t)FF2 * D * 2;
constexpr size_t WS_WIN1 = WS_W2_0 + (size_t)D * FF * 2;
constexpr size_t WS_WOUT1 = WS_WIN1 + (size_t)C_IN_PAD * D * 2;
constexpr size_t WS_W13_1 = WS_WOUT1 + (size_t)D * D * 2;
constexpr size_t WS_W2_1 = WS_W13_1 + (size_t)FF2 * D * 2;
constexpr size_t WS_WG = WS_W2_1 + (size_t)D * FF * 2;
constexpr size_t WS_WCT = WS_WG + (size_t)2 * 8 * 64 * 64 * 2;
constexpr size_t WS_PET = WS_WCT + (size_t)2 * 64 * 2048 * 2;
constexpr size_t WS_C8 = WS_PET + 512;
constexpr size_t WS_XN = al256(WS_C8 + 2048);
constexpr size_t WS_QD = WS_XN + (size_t)M * D * 2;
constexpr size_t WS_KVD = WS_QD + (size_t)M * 512 * 2;
constexpr size_t WS_XR = WS_KVD + (size_t)M * 1024 * 2;
constexpr size_t WS_GT = WS_XR + (size_t)M * 512 * 4;
constexpr size_t WS_AU = WS_GT + (size_t)M * 512 * 2;
constexpr size_t WS_AGG = WS_AU + (size_t)M * 1024 * 4;
constexpr size_t WS_O = WS_AGG + (size_t)4 * 128 * 1024 * 4;
constexpr size_t WS_H = WS_O + (size_t)M * D * 2;
constexpr size_t WS_SSP = WS_H + (size_t)M * FF * 2;
constexpr size_t WS_Q1 = WS_SSP + (size_t)M * 16 * 4;
constexpr size_t WS_KVSEL = WS_Q1 + (size_t)M * D * 2;
constexpr size_t WS_KVWIN = WS_KVSEL + (size_t)MP * 512 * 2;
constexpr size_t WS_G1 = WS_KVWIN + (size_t)MP * 512 * 2;
constexpr size_t WS_KCP = al256(WS_G1 + (size_t)M * 48 * 4);
constexpr size_t WS_KCS = WS_KCP + (size_t)BP * 256 * 512 * 2;
constexpr size_t WS_SLAB = WS_KCS + (size_t)BS * 512 * 512 * 2;
constexpr size_t WS_XSL = WS_SLAB + (size_t)11 * MS * D * 4;
constexpr size_t WS_PETP = WS_XSL + (size_t)MP * 4 * 4;
constexpr size_t WS_END = WS_PETP + (size_t)2 * 32 * 64 * 4;

constexpr int CW_BAR = 4096;
constexpr int CW_Q2 = 8192, CW_Q9 = 8192 + 1024;
constexpr int CW_PN = 8192 + 2048;
constexpr int CW_SR = 8192 + 2048 + 4096;
constexpr int CW_QBG = 8192 + 2048, CW_DONE = 8192 + 3072;

constexpr int RING_BYTES = 131072;
constexpr int WSCR = 18432;
constexpr int MISC_OFF = 8 * WSCR;
constexpr int LDS_BYTES = MISC_OFF + 1024;

__device__ __forceinline__ unsigned cvtpk(float lo, float hi) { f32x2 v = {lo, hi}; bf16x2_t b = __builtin_convertvector(v, bf16x2_t); return __builtin_bit_cast(unsigned, b); }
__device__ __forceinline__ float bf2f(unsigned short h) { return __uint_as_float((unsigned)h << 16); }
__device__ __forceinline__ bf16x8 pack8(f32x4 a, f32x4 b) { u32x4 w; w.x = cvtpk(a[0], a[1]); w.y = cvtpk(a[2], a[3]); w.z = cvtpk(b[0], b[1]); w.w = cvtpk(b[2], b[3]); return __builtin_bit_cast(bf16x8, w); }
__device__ __forceinline__ float wave_sum(float v) {
#pragma unroll
    for (int o = 1; o < 64; o <<= 1) v += __shfl_xor(v, o);
    return v;
}
#define LDS_WAIT() asm volatile("s_waitcnt lgkmcnt(0)" ::: "memory")
#define VM_WAIT() asm volatile("s_waitcnt vmcnt(0)" ::: "memory")

namespace pg8 {
#define PG8_LAS __attribute__((address_space(3)))
constexpr int BM = 256, BK = 64, HALF = 128, HTB = HALF * BK * 2, STAGE_BYTES = 8 * HTB, NXCD = 8, WGM = 8;
__host__ __device__ __forceinline__ int lds_byte(int r, int c) { const int st = (r >> 4) * 2 + (c >> 5), rr = r & 15, cc = c & 31, ob = rr * 64 + cc * 2; return st * 1024 + (ob ^ (((ob >> 9) & 1) << 5)); }
__host__ __device__ __forceinline__ void stage_rc(int b, int& R, int& C) { const int st = b / 1024, sb = b % 1024, swz = sb ^ (((sb >> 9) & 1) << 5); R = (st >> 1) * 16 + swz / 64; C = (st & 1) * 32 + (swz % 64) / 2; }
__host__ __device__ __forceinline__ int perm32(int rho) { const int n = rho >> 4, i = rho & 15; return 8 * (i >> 2) + 4 * n + (i & 3); }
struct Unit { int pm, pn; };
struct Gemm { const bf16_t* A; const bf16_t* Bt; int M, N, K, ld; };
struct StaticOrder {
    int nM, nN, nwg, G, c;
    __host__ __device__ void init(int M_, int N_, int G_, int c_) { nM = M_ / BM; nN = N_ / BM; nwg = nM * nN; G = G_; c = c_; }
    __host__ __device__ bool next(int i, Unit& u) const {
        const long L = (long)i * G + c; if (L >= nwg) return false;
        int wgid = (int)L; { const int q = nwg / NXCD, r = nwg % NXCD, xcd = wgid % NXCD, off = wgid / NXCD; wgid = (xcd < r ? xcd * (q + 1) : r * (q + 1) + (xcd - r) * q) + off; }
        const int nig = WGM * nN, gid = wgid / nig, fm = gid * WGM, gsz = (nM - fm) < WGM ? (nM - fm) : WGM;
        u.pm = fm + ((wgid % nig) % gsz); u.pn = (wgid % nig) / gsz; return true;
    }
    __device__ __forceinline__ void a_ready(const Unit&) const {}
    __device__ __forceinline__ void done(const Unit&) const {}
};

struct CountingOrder : StaticOrder {
    unsigned* cnt; int lane;
    __device__ __forceinline__ void done(const Unit&) const { if (lane == 0) __hip_atomic_fetch_add(cnt, 1u, __ATOMIC_RELAXED, __HIP_MEMORY_SCOPE_AGENT); }
};
struct OneUnit {
    int pm, pn;
    __host__ __device__ bool next(int i, Unit& u) const { if (i) return false; u.pm = pm; u.pn = pn; return true; }
    __device__ __forceinline__ void a_ready(const Unit&) const {}
    __device__ __forceinline__ void done(const Unit&) const {}
};
template <class Epi, class Sched, bool ALIGN_EPI = false, bool SP2 = false>
__device__ __forceinline__ void gemm_phase(PG8_LAS unsigned char* lds, const Gemm g, const Sched& S, const Epi& E) {
    const int tid = threadIdx.x, wid = __builtin_amdgcn_readfirstlane(tid >> 6), lane = tid & 63, wr = wid >> 2, wc = wid & 3, fr = lane & 15, fq = lane >> 4;
    const int K = g.K, nt = K / BK, LD = g.ld;
    unsigned voffA[2], voffB[2];
#pragma unroll
    for (int i = 0; i < 2; ++i) { int R, C; stage_rc(tid * 16 + i * 8192, R, C); const int Rb = Epi::PERM ? ((R & ~31) + perm32(R & 31)) : R;
        voffA[i] = (unsigned)(R * LD + C) * 2u; voffB[i] = (unsigned)(Rb * LD + C) * 2u; }
    const size_t kstep = (size_t)(BK * 2);
    const size_t hstep = (size_t)HALF * LD * 2;
    const size_t tstep = 2 * hstep;
    const unsigned ldsw = (unsigned)wid * 1024u;
    const int aoff = lds_byte(wr * 64 + fr, fq * 8), boff = lds_byte(wc * 32 + fr, fq * 8);
#define PG8_SA(b, h) (((b) * 2 + (h)) * HTB)
#define PG8_SB(b, h) ((4 + (b) * 2 + (h)) * HTB)
#define PG8_STAGE(bufoff, gbase, voff) do { _Pragma("unroll") for (int _i = 0; _i < 2; ++_i) \
        __builtin_amdgcn_global_load_lds((const unsigned*)((const char*)(gbase) + (voff)[_i]), (PG8_LAS unsigned*)(lds + (bufoff) + ldsw + _i * 8192), 16, 0, 0); } while (0)
#define PG8_LDA(dst, b, h) do { _Pragma("unroll") for (int m = 0; m < 4; ++m) _Pragma("unroll") for (int k = 0; k < 2; ++k) dst[m][k] = *(const PG8_LAS bf16x8*)(lds + PG8_SA(b, h) + aoff + m * 2048 + k * 1024); } while (0)
#define PG8_LDB(dst, b, h) do { _Pragma("unroll") for (int n = 0; n < 2; ++n) _Pragma("unroll") for (int k = 0; k < 2; ++k) dst[n][k] = *(const PG8_LAS bf16x8*)(lds + PG8_SB(b, h) + boff + n * 2048 + k * 1024); } while (0)
#define PG8_MMA(ai, bj, At, Bt) do { __builtin_amdgcn_s_setprio(1); _Pragma("unroll") for (int m = 0; m < 4; ++m) _Pragma("unroll") for (int n = 0; n < 2; ++n) _Pragma("unroll") for (int k = 0; k < 2; ++k) \
        acc[ai][bj][m][n] = __builtin_amdgcn_mfma_f32_16x16x32_bf16(Bt[n][k], At[m][k], acc[ai][bj][m][n], 0, 0, 0); __builtin_amdgcn_s_setprio(0); } while (0)
#define PG8_WAIT_V(n) asm volatile("s_waitcnt vmcnt(" #n ")" ::: "memory")
#define PG8_WAIT_L(n) asm volatile("s_waitcnt lgkmcnt(" #n ")" ::: "memory")
#define PG8_BAR __builtin_amdgcn_s_barrier()
#define PG8_SCHED __builtin_amdgcn_sched_barrier(0)
    Unit cur, nxt; int ui = 0;
    if (!S.next(0, cur)) return;
    f32x4 acc[2][2][4][2];
#pragma unroll
    for (int a = 0; a < 2; ++a)
#pragma unroll
        for (int b = 0; b < 2; ++b)
#pragma unroll
            for (int m = 0; m < 4; ++m)
#pragma unroll
                for (int n = 0; n < 2; ++n) acc[a][b][m][n] = (f32x4){0.f, 0.f, 0.f, 0.f};
    bf16x8 At[4][2], B0[2][2], B1[2][2];
    const char* cA = (const char*)g.A + (size_t)cur.pm * tstep; const char* cB = (const char*)g.Bt + (size_t)cur.pn * tstep;
    S.a_ready(cur);
    if constexpr (SP2) {
        PG8_STAGE(PG8_SB(0, 0), cB, voffB); PG8_STAGE(PG8_SB(0, 1), cB + hstep, voffB); PG8_STAGE(PG8_SA(0, 0), cA, voffA); PG8_STAGE(PG8_SA(0, 1), cA + hstep, voffA);
        if (wr == 1) PG8_BAR;
        PG8_WAIT_V(2); PG8_BAR;
        PG8_STAGE(PG8_SB(1, 0), cB + kstep, voffB); PG8_STAGE(PG8_SA(1, 0), cA + kstep, voffA); PG8_STAGE(PG8_SB(1, 1), cB + hstep + kstep, voffB);
        PG8_WAIT_V(6); PG8_BAR;
    } else {
        PG8_STAGE(PG8_SB(0, 0), cB, voffB); PG8_STAGE(PG8_SA(0, 0), cA, voffA); PG8_STAGE(PG8_SB(0, 1), cB + hstep, voffB); PG8_STAGE(PG8_SA(0, 1), cA + hstep, voffA);
        if (wr == 1) PG8_BAR;
        PG8_WAIT_V(4); PG8_BAR;
        PG8_STAGE(PG8_SB(1, 0), cB + kstep, voffB); PG8_STAGE(PG8_SA(1, 0), cA + kstep, voffA); PG8_STAGE(PG8_SB(1, 1), cB + hstep + kstep, voffB);
        PG8_WAIT_V(6); PG8_BAR;
    }
    for (;;) {
        const bool has_next = S.next(ui + 1, nxt);
        const char* nA = has_next ? (const char*)g.A + (size_t)nxt.pm * tstep : cA; const char* nB = has_next ? (const char*)g.Bt + (size_t)nxt.pn * tstep : cB;
        for (int t = 0; t < nt; t += 2) {
            const bool last = (t == nt - 2);
            const char* a1 = cA + (size_t)(t + 1) * kstep;
            const char* a2 = last ? nA : cA + (size_t)(t + 2) * kstep; const char* b2 = last ? nB : cB + (size_t)(t + 2) * kstep;
            const char* a3 = a2 + kstep; const char* b3 = b2 + kstep;
            if (last && has_next) S.a_ready(nxt);
            if constexpr (SP2) {
            PG8_LDB(B0, 0, 0); PG8_LDB(B1, 0, 1); PG8_SCHED; PG8_LDA(At, 0, 0); PG8_STAGE(PG8_SA(1, 1), a1 + hstep, voffA);
            PG8_WAIT_V(8); PG8_WAIT_L(0); PG8_BAR; PG8_MMA(0, 0, At, B0); PG8_MMA(0, 1, At, B1); PG8_BAR; PG8_SCHED;
            PG8_LDA(At, 0, 1); PG8_STAGE(PG8_SB(0, 0), b2, voffB); PG8_STAGE(PG8_SB(0, 1), b2 + hstep, voffB); PG8_STAGE(PG8_SA(0, 0), a2, voffA);
            PG8_WAIT_V(8); PG8_WAIT_L(0); PG8_BAR; PG8_MMA(1, 0, At, B0); PG8_MMA(1, 1, At, B1); PG8_BAR; PG8_SCHED;
            PG8_LDB(B0, 1, 0); PG8_LDB(B1, 1, 1); PG8_SCHED; PG8_LDA(At, 1, 0); PG8_STAGE(PG8_SA(0, 1), a2 + hstep, voffA);
            PG8_WAIT_V(8); PG8_WAIT_L(0); PG8_BAR; PG8_MMA(0, 0, At, B0); PG8_MMA(0, 1, At, B1); PG8_BAR; PG8_SCHED;
            PG8_LDA(At, 1, 1); PG8_STAGE(PG8_SB(1, 0), b3, voffB); PG8_STAGE(PG8_SB(1, 1), b3 + hstep, voffB); PG8_STAGE(PG8_SA(1, 0), a3, voffA);
            PG8_WAIT_V(8); PG8_WAIT_L(0); PG8_BAR; PG8_MMA(1, 0, At, B0); PG8_MMA(1, 1, At, B1); PG8_BAR; PG8_SCHED;
            } else {
            PG8_LDB(B0, 0, 0); PG8_SCHED; PG8_LDA(At, 0, 0); PG8_STAGE(PG8_SA(1, 1), a1 + hstep, voffA);
            PG8_WAIT_L(8); PG8_BAR; PG8_WAIT_L(0); PG8_MMA(0, 0, At, B0); PG8_BAR; PG8_SCHED;
            PG8_LDB(B1, 0, 1); PG8_STAGE(PG8_SB(0, 0), b2, voffB);
            PG8_BAR; PG8_WAIT_L(0); PG8_MMA(0, 1, At, B1); PG8_BAR;
            PG8_LDA(At, 0, 1); PG8_STAGE(PG8_SA(0, 0), a2, voffA);
            PG8_BAR; PG8_WAIT_L(0); PG8_MMA(1, 0, At, B0); PG8_BAR; PG8_SCHED;
            PG8_STAGE(PG8_SB(0, 1), b2 + hstep, voffB);
            PG8_WAIT_V(6); PG8_BAR; PG8_MMA(1, 1, At, B1); PG8_BAR;
            PG8_LDB(B0, 1, 0); PG8_SCHED; PG8_LDA(At, 1, 0); PG8_STAGE(PG8_SA(0, 1), a2 + hstep, voffA);
            PG8_WAIT_L(8); PG8_BAR; PG8_WAIT_L(0); PG8_MMA(0, 0, At, B0); PG8_BAR; PG8_SCHED;
            PG8_LDB(B1, 1, 1); PG8_STAGE(PG8_SB(1, 0), b3, voffB);
            PG8_BAR; PG8_WAIT_L(0); PG8_MMA(0, 1, At, B1); PG8_BAR;
            PG8_LDA(At, 1, 1); PG8_STAGE(PG8_SA(1, 0), a3, voffA);
            PG8_BAR; PG8_WAIT_L(0); PG8_MMA(1, 0, At, B0); PG8_BAR; PG8_SCHED;
            PG8_STAGE(PG8_SB(1, 1), b3 + hstep, voffB);
            PG8_WAIT_V(6); PG8_BAR; PG8_MMA(1, 1, At, B1); PG8_BAR;
            }
        }
        if constexpr (ALIGN_EPI) { if (wr == 0) PG8_BAR; }
        if constexpr (!Epi::AFTER_DRAIN) { E(acc, cur, wr, wc, fr, fq); S.done(cur); }
        if (!has_next) break;
#pragma unroll
        for (int a = 0; a < 2; ++a)
#pragma unroll
            for (int b = 0; b < 2; ++b)
#pragma unroll
                for (int m = 0; m < 4; ++m)
#pragma unroll
                    for (int n = 0; n < 2; ++n) acc[a][b][m][n] = (f32x4){0.f, 0.f, 0.f, 0.f};
        cur = nxt; cA = nA; cB = nB; ++ui;
        if constexpr (ALIGN_EPI) { if (wr == 1) PG8_BAR; }
    }
    PG8_WAIT_V(0);
    if constexpr (!ALIGN_EPI) { if (wr == 0) PG8_BAR; }
    PG8_BAR;
    if constexpr (Epi::AFTER_DRAIN) { E.fused(acc, cur, wr, wc, fr, fq, lds, wid, lane, tid); S.done(cur); }
#undef PG8_SA
#undef PG8_SB
#undef PG8_STAGE
#undef PG8_LDA
#undef PG8_LDB
#undef PG8_MMA
#undef PG8_WAIT_V
#undef PG8_WAIT_L
#undef PG8_BAR
#undef PG8_SCHED
}

typedef f32x4 Acc[2][2][4][2];

struct EpiIn0 {
    static constexpr bool PERM = true, AFTER_DRAIN = false;
    bf16_t* QD; bf16_t* KVD; float* XR; bf16_t* GT; float* out;
    __device__ __forceinline__ void operator()(const Acc& acc, const Unit& u, int wr, int wc, int fr, int fq) const {
        const int region = u.pn >> 1, cb = (u.pn & 1) * 256 + wc * 32 + 8 * fq;
#pragma unroll
        for (int ai = 0; ai < 2; ++ai)
#pragma unroll
            for (int m = 0; m < 4; ++m) {
                const int row = u.pm * BM + ai * HALF + wr * 64 + m * 16 + fr;
                const bool smp = row >= MP; const int b = smp ? (row - MP) >> 3 : row >> 12, t = smp ? (row - MP) & 7 : row & 4095;
#pragma unroll
                for (int bj = 0; bj < 2; ++bj) {
                    const int col = cb + bj * HALF; const f32x4 v0 = acc[ai][bj][m][0], v1 = acc[ai][bj][m][1];
                    if (region == 0) { *(bf16x8*)(QD + (size_t)row * 512 + col) = pack8(v0 * C_SCALE2, v1 * C_SCALE2); }
                    else if (region <= 2) { const int c = region - 1;
                        *(bf16x8*)(KVD + (size_t)row * 1024 + c * 512 + col) = pack8(v0, v1);
                        float* o = nullptr;
                        if (smp) o = out + O_DILS + ((size_t)(b * 2048 + 2040 + t) * 2 + c) * 512 + col;
                        else if (t >= 2048) o = out + O_DILP + ((size_t)(b * 2048 + t - 2048) * 2 + c) * 512 + col;
                        if (o) { *(f32x4*)o = v0; *(f32x4*)(o + 4) = v1; } }
                    else if (region == 3) { float* x = XR + (size_t)row * 512 + col; *(f32x4*)x = v0; *(f32x4*)(x + 4) = v1;
                        float* o = nullptr;
                        if (smp) { if (t >= 5) o = out + O_CONVS + (size_t)(b * 3 + t - 5) * 512 + col; }
                        else if (t >= SEQ - 3) o = out + O_CONVP + (size_t)(b * 3 + t - (SEQ - 3)) * 512 + col;
                        if (o) { *(f32x4*)o = v0; *(f32x4*)(o + 4) = v1; } }
                    else { *(bf16x8*)(GT + (size_t)row * 512 + col) = pack8(v0, v1); }
                }
            }
    }
};
}

#define XB_TMO      128
#define XB_XCNT(j)  (256  + 64 * (j))
#define XB_XSUB(j)  (1280 + 64 * (j))
#define XB_XGEN(j)  (2304 + 64 * (j))
#define XB_TOP      3328
#define XB_TOPGEN   3392
#define XCD_BAR_WORDS 3456
#define XB_SPIN_CAP (1u << 18)
__device__ __forceinline__ unsigned xb_ld(unsigned* p)              { return __hip_atomic_load(p, __ATOMIC_RELAXED, __HIP_MEMORY_SCOPE_AGENT); }
__device__ __forceinline__ unsigned xb_add(unsigned* p, unsigned v) { return __hip_atomic_fetch_add(p, v, __ATOMIC_RELAXED, __HIP_MEMORY_SCOPE_AGENT); }
__device__ __forceinline__ unsigned xb_xcc_id() { return (unsigned)__builtin_amdgcn_s_getreg((3 << 11) | 20) & 0xFu; }
#define XB_SPIN(cond, bar) do { unsigned _sp = 0; while (cond) { __builtin_amdgcn_s_sleep(1); \
    if ((++_sp & 255u) == 0u) { if (xb_ld(&(bar)[XB_TMO])) break; if (_sp > XB_SPIN_CAP) { atomicAdd(&(bar)[XB_TMO], 1u); break; } } } } while (0)
struct XcdBarrier { unsigned* bar; unsigned x; volatile LAS unsigned* st; };
__device__ __forceinline__ XcdBarrier xcd_barrier_post(unsigned* bar, volatile LAS unsigned* st) {
    XcdBarrier b; b.bar = bar; b.x = xb_xcc_id(); b.st = st;
    if (threadIdx.x == 0) (void)xb_add(&bar[XB_XCNT(b.x)], 1u);
    return b;
}
__device__ __forceinline__ void xcd_barrier_complete(unsigned* bar, unsigned x, unsigned& nloc, unsigned& nx) {
    const unsigned G = gridDim.x * gridDim.y * gridDim.z;
    unsigned sum, cnt, mine, sp = 0u;
    for (;;) {
        sum = 0u; cnt = 0u; mine = 0u;
#pragma unroll
        for (unsigned j = 0; j < 16; ++j) { const unsigned c = xb_ld(&bar[XB_XCNT(j)]); sum += c; cnt += (c > 0u) ? 1u : 0u; mine = (j == x) ? c : mine; }
        if (sum == G) break;
        __builtin_amdgcn_s_sleep(1);
        if ((++sp & 255u) == 0u) { if (xb_ld(&bar[XB_TMO])) break; if (sp > XB_SPIN_CAP) { atomicAdd(&bar[XB_TMO], 1u); break; } }
    }
    nloc = mine > 0u ? mine : 1u; nx = cnt > 0u ? cnt : 1u;
}
__device__ __forceinline__ void xcd_barrier(const XcdBarrier& b) {
    asm volatile("s_waitcnt vmcnt(0)" ::: "memory");
    __syncthreads();
    if (threadIdx.x == 0) {
        unsigned* bar = b.bar;
        __builtin_amdgcn_s_waitcnt(0);
        unsigned nloc = b.st[0], nx = b.st[1];
        if (nloc == 0u) { xcd_barrier_complete(bar, b.x, nloc, nx); b.st[0] = nloc; b.st[1] = nx; }
        const unsigned old = xb_add(&bar[XB_XSUB(b.x)], 1u);
        const unsigned gen = old / nloc;
        if (old + 1u == (gen + 1u) * nloc) {
            __builtin_amdgcn_fence(__ATOMIC_RELEASE, "agent");
            asm volatile("s_waitcnt vmcnt(0)" ::: "memory");
            const unsigned og = xb_add(&bar[XB_TOP], 1u);
            const unsigned tg = og / nx;
            if (og + 1u == (tg + 1u) * nx) xb_add(&bar[XB_TOPGEN], 1u);
            else XB_SPIN(xb_ld(&bar[XB_TOPGEN]) == tg, bar);
            __builtin_amdgcn_fence(__ATOMIC_ACQUIRE, "agent");
            xb_add(&bar[XB_XGEN(b.x)], 1u);
            asm volatile("s_waitcnt vmcnt(0)" ::: "memory");
        } else {
            XB_SPIN(xb_ld(&bar[XB_XGEN(b.x)]) == gen, bar);
            __builtin_amdgcn_fence(__ATOMIC_ACQUIRE, "agent");
            asm volatile("s_waitcnt vmcnt(0)" ::: "memory");
        }
    }
    __syncthreads();
}

__device__ __forceinline__ void subgrid_rendezvous(unsigned* cnt, unsigned n, unsigned* bar) {
    asm volatile("s_waitcnt vmcnt(0)" ::: "memory");
    __syncthreads();
    if (threadIdx.x == 0) {
        __builtin_amdgcn_fence(__ATOMIC_RELEASE, "agent");
        asm volatile("s_waitcnt vmcnt(0)" ::: "memory");
        (void)xb_add(cnt, 1u);
        XB_SPIN(xb_ld(cnt) < n, bar);
        __builtin_amdgcn_fence(__ATOMIC_ACQUIRE, "agent");
        asm volatile("s_waitcnt vmcnt(0)" ::: "memory");
    }
    __syncthreads();
}

struct Args { const void* in[28]; float* out; unsigned char* ws; int ph_lo, ph_hi; };
constexpr int NWAVES = 8;

struct Frame {
    LAS unsigned char* lds; LAS unsigned char* wscr;
    int tid, lane, wave, gw, NGW, G;
    unsigned char* ws; float* out; const Args* a;
};

__device__ __forceinline__ void transpose_item(const float* W, int K, int Nsrc, int Npad, bf16_t* WT, int mode, LAS float* scr, int item, int lane, const float* gk = nullptr) {
    const int nblk = Npad / 32, kb = item / nblk, nb = item % nblk, k0 = 64 * kb, n0 = 32 * nb;
    const int nn = n0 + (lane & 31);
    float v[32];
#pragma unroll
    for (int i = 0; i < 32; ++i) { const int kk = 2 * i + (lane >> 5); v[i] = nn < Nsrc ? __builtin_nontemporal_load(W + (size_t)(k0 + kk) * Nsrc + nn) : 0.f; }
#pragma unroll
    for (int i = 0; i < 32; ++i) { const int kk = 2 * i + (lane >> 5); scr[kk * 33 + (lane & 31)] = v[i]; }
    LDS_WAIT();
    const int c = lane & 7;
    f32x4 ga = {1.f, 1.f, 1.f, 1.f}, gb = ga;
    if (gk) { ga = *(const f32x4*)(gk + k0 + 8 * c); gb = *(const f32x4*)(gk + k0 + 8 * c + 4); }
#pragma unroll
    for (int j = 0; j < 4; ++j) { const int n = (lane >> 3) + 8 * j; const LAS float* s = scr + (8 * c) * 33 + n;
        u32x4 o; o.x = cvtpk(s[0 * 33] * ga.x, s[1 * 33] * ga.y); o.y = cvtpk(s[2 * 33] * ga.z, s[3 * 33] * ga.w); o.z = cvtpk(s[4 * 33] * gb.x, s[5 * 33] * gb.y); o.w = cvtpk(s[6 * 33] * gb.z, s[7 * 33] * gb.w);
        const int ng = n0 + n; const int drow = mode == 0 ? ng : ((ng >> 7) * 256 + (ng & 127) + (mode == 2 ? 128 : 0));
        *(u32x4*)(WT + (size_t)drow * K + k0 + 8 * c) = o; }
    LDS_WAIT();
}
__device__ __forceinline__ void rms_row_to_bf16(const float* xrow, const float* g, bf16_t* orow, int lane) {
    const f32x4* xr = (const f32x4*)xrow + lane; const f32x4* gr = (const f32x4*)g + lane;
    f32x4 v[4]; float s = 0.f;
#pragma unroll
    for (int j = 0; j < 4; ++j) { v[j] = __builtin_nontemporal_load(xr + 64 * j); s += (v[j].x * v[j].x + v[j].y * v[j].y) + (v[j].z * v[j].z + v[j].w * v[j].w); }
    const float rstd = 1.f / sqrtf(wave_sum(s) * (1.f / D) + EPS);
    u32x2* o8 = (u32x2*)orow + lane;
#pragma unroll
    for (int j = 0; j < 4; ++j) { const f32x4 gg = gr[64 * j]; u32x2 w; w.x = cvtpk(v[j].x * rstd * gg.x, v[j].y * rstd * gg.y); w.y = cvtpk(v[j].z * rstd * gg.z, v[j].w * rstd * gg.w); o8[64 * j] = w; }
}

__device__ __forceinline__ void rms_rows4_to_bf16(const float* x0, const float* x1, const float* x2, const float* x3, const float* g, bf16_t* o0, bf16_t* o1, bf16_t* o2, bf16_t* o3, int lane) {
    const float* xs[4] = {x0, x1, x2, x3}; bf16_t* os[4] = {o0, o1, o2, o3};
    f32x4 v[4][4]; float s[4];
#pragma unroll
    for (int q = 0; q < 4; ++q)
#pragma unroll
        for (int j = 0; j < 4; ++j) v[q][j] = __builtin_nontemporal_load((const f32x4*)xs[q] + lane + 64 * j);
    f32x4 gg[4];
#pragma unroll
    for (int j = 0; j < 4; ++j) gg[j] = *((const f32x4*)g + lane + 64 * j);
#pragma unroll
    for (int q = 0; q < 4; ++q) { float t = 0.f;
#pragma unroll
        for (int j = 0; j < 4; ++j) t += (v[q][j].x * v[q][j].x + v[q][j].y * v[q][j].y) + (v[q][j].z * v[q][j].z + v[q][j].w * v[q][j].w);
        s[q] = 1.f / sqrtf(wave_sum(t) * (1.f / D) + EPS); }
#pragma unroll
    for (int q = 0; q < 4; ++q)
#pragma unroll
        for (int j = 0; j < 4; ++j) { const float rstd = s[q]; u32x2 w; w.x = cvtpk(v[q][j].x * rstd * gg[j].x, v[q][j].y * rstd * gg[j].y); w.y = cvtpk(v[q][j].z * rstd * gg[j].z, v[q][j].w * rstd * gg[j].w);
            *((u32x2*)os[q] + lane + 64 * j) = w; }
}

constexpr int WT_IN0 = 16 * (AB_IN / 32), WT_O = 16 * (D / 32), WT_F = 16 * (FF / 32), WT_2 = (FF / 64) * (D / 32), WT_IN1 = 16 * (C_IN_PAD / 32);
constexpr int WT_T0 = WT_IN0, WT_T1 = WT_T0 + WT_O, WT_T2 = WT_T1 + WT_F, WT_T3 = WT_T2 + WT_F, WT_T4 = WT_T3 + WT_2, WT_T5 = WT_T4 + WT_IN1, WT_T6 = WT_T5 + WT_O, WT_T7 = WT_T6 + WT_F, WT_T8 = WT_T7 + WT_F, WT_T9 = WT_T8 + WT_2;
__device__ __forceinline__ void weight_transpose_item(const Frame& F, int it) {
    const Args& A = *F.a; LAS float* scr = (LAS float*)F.wscr; unsigned char* ws = F.ws; const int lane = F.lane;
    constexpr int T0 = WT_T0, T1 = WT_T1, T2 = WT_T2, T3 = WT_T3, T4 = WT_T4, T5 = WT_T5, T6 = WT_T6, T7 = WT_T7, T8 = WT_T8;
    {
        {
            const float* w1_0 = (const float*)A.in[25]; const float* w3_0 = (const float*)A.in[26]; const float* w2_0 = (const float*)A.in[27];
            if (it < T0) transpose_item((const float*)A.in[12], D, AB_IN, AB_IN, (bf16_t*)(ws + WS_WIN0), 0, scr, it, lane);
            else if (it < T1) transpose_item((const float*)A.in[13], D, D, D, (bf16_t*)(ws + WS_WOUT0), 0, scr, it - T0, lane);
            else if (it < T2) transpose_item(w1_0, D, FF, FF, (bf16_t*)(ws + WS_W13_0), 1, scr, it - T1, lane, (const float*)A.in[10]);
            else if (it < T3) transpose_item(w3_0, D, FF, FF, (bf16_t*)(ws + WS_W13_0), 2, scr, it - T2, lane, (const float*)A.in[10]);
            else if (it < T4) transpose_item(w2_0, FF, D, D, (bf16_t*)(ws + WS_W2_0), 0, scr, it - T3, lane);
            else if (it < T5) transpose_item((const float*)A.in[21], D, C_IN, C_IN_PAD, (bf16_t*)(ws + WS_WIN1), 0, scr, it - T4, lane, (const float*)A.in[9] + D);
            else if (it < T6) transpose_item((const float*)A.in[22], D, D, D, (bf16_t*)(ws + WS_WOUT1), 0, scr, it - T5, lane);
            else if (it < T7) transpose_item(w1_0 + (size_t)D * FF, D, FF, FF, (bf16_t*)(ws + WS_W13_1), 1, scr, it - T6, lane, (const float*)A.in[10] + D);
            else if (it < T8) transpose_item(w3_0 + (size_t)D * FF, D, FF, FF, (bf16_t*)(ws + WS_W13_1), 2, scr, it - T7, lane, (const float*)A.in[10] + D);
            else transpose_item(w2_0 + (size_t)FF * D, FF, D, D, (bf16_t*)(ws + WS_W2_1), 0, scr, it - T8, lane);
        }
    }
}
__device__ __forceinline__ void p0_prologue(const Frame& F) {
    const Args& A = *F.a;
    unsigned char* ws = F.ws;
    const int lane = F.lane;
    constexpr int X0 = WT_T4;
    constexpr int NMISC = 16 + 64 + 1;
    constexpr int R0 = X0 + NMISC;
    constexpr int NITEMS = R0 + M;
    for (int it = F.gw; it < NITEMS; it += F.NGW) {
        if (it < WT_T4) { weight_transpose_item(F, it);
        } else if (it < R0) {
            const int mi = it - X0;
            if (mi < 16) {
                const int mat = mi >> 3, n = mi & 7; const float* W = (const float*)A.in[mat ? 18 : 16] + (size_t)n * 4096;
                bf16_t* dst = (bf16_t*)(ws + WS_WG) + ((size_t)(mat * 8 + n) * 64 + lane) * 64;
#pragma unroll
                for (int k8 = 0; k8 < 8; ++k8) { const int d0 = k8 >> 1, h = k8 & 1; float v[8];
#pragma unroll
                    for (int jj = 0; jj < 8; ++jj) { const int i = 16 * d0 + 8 * (jj >> 2) + 4 * h + (jj & 3); v[jj] = W[i * 64 + lane]; }
                    u32x4 o; o.x = cvtpk(v[0], v[1]); o.y = cvtpk(v[2], v[3]); o.z = cvtpk(v[4], v[5]); o.w = cvtpk(v[6], v[7]);
                    *(u32x4*)(dst + 8 * k8) = o; }
            } else if (mi < 16 + 64) {
                const int lc = mi - 16, l = lc >> 1, c = lc & 1; const float* W = (const float*)A.in[23] + (size_t)(l * 2 + c) * 4096;
                bf16_t* dst = (bf16_t*)(ws + WS_WCT) + ((size_t)(c * 32 + l) * 4 * 2) * 512 + lane * 8;
                const int r32 = lane & 31, hi = lane >> 5;
                const float* P = (const float*)A.in[24] + (size_t)(l * 2 + c) * 64 + 8 * hi;
                float pt0 = 0.f, pt1 = 0.f;
#pragma unroll
                for (int k4 = 0; k4 < 4; ++k4) {
                    const f32x4 pa = *(const f32x4*)(P + 16 * k4), pb = *(const f32x4*)(P + 16 * k4 + 4);
#pragma unroll
                    for (int eh = 0; eh < 2; ++eh) { float v[8];
#pragma unroll
                        for (int j = 0; j < 8; ++j) v[j] = W[(16 * k4 + 8 * hi + j) * 64 + r32 + 32 * eh];
                        u32x4 o; o.x = cvtpk(v[0], v[1]); o.y = cvtpk(v[2], v[3]); o.z = cvtpk(v[4], v[5]); o.w = cvtpk(v[6], v[7]);
                        *(u32x4*)(dst + (size_t)(k4 * 2 + eh) * 512) = o;
                        const float t = ((pa.x * v[0] + pa.y * v[1]) + (pa.z * v[2] + pa.w * v[3])) + ((pb.x * v[4] + pb.y * v[5]) + (pb.z * v[6] + pb.w * v[7]));
                        if (eh) pt1 += t; else pt0 += t; }
                }
                pt0 += __shfl_xor(pt0, 32); pt1 += __shfl_xor(pt1, 32);
                ((float*)(ws + WS_PETP))[(size_t)(c * 32 + l) * 64 + lane] = hi ? pt1 : pt0;
            } else {
                const float* L = (const float*)A.in[20];
#pragma unroll
                for (int j = 0; j < 8; ++j) { const float z = -L[j * 64 + lane]; ((float*)(ws + WS_C8))[j * 64 + lane] = 8.f * (fmaxf(z, 0.f) + log1pf(expf(-fabsf(z)))); }
            }
        } else {
            const int r = it - R0;
#define XROW(r_) ((r_) < MP ? (const float*)A.in[0] + (size_t)(r_) * D : (const float*)A.in[1] + (size_t)((r_) - MP) * D)
#define OROW(r_) ((bf16_t*)(ws + WS_XN) + (size_t)(r_) * D)
            if (r + 3 * F.NGW < M) {
                rms_rows4_to_bf16(XROW(r), XROW(r + F.NGW), XROW(r + 2 * F.NGW), XROW(r + 3 * F.NGW), (const float*)A.in[9], OROW(r), OROW(r + F.NGW), OROW(r + 2 * F.NGW), OROW(r + 3 * F.NGW), lane);
                it += 3 * F.NGW;
            } else rms_row_to_bf16(XROW(r), (const float*)A.in[9], OROW(r), lane);
#undef XROW
#undef OROW
        }
    }
}
constexpr int NDC = BS * 255, NWC = BS * 32;
__device__ __forceinline__ void copy_item(const Frame& F, int ci) {
    const float* src; float* dst; const int lane = F.lane; bool half2 = true;
    if (ci < NDC) { const int b = ci / 255, ch = ci % 255; src = (const float*)F.a->in[2] + ((size_t)b * 2048 + 8) * 1024 + (size_t)ch * 8192; dst = F.out + O_DILS + (size_t)b * 2048 * 1024 + (size_t)ch * 8192; }
    else { const int c2 = ci - NDC, b = c2 >> 5, ch = c2 & 31; src = (const float*)F.a->in[5] + ((size_t)b * 512 + 8) * 512 + (size_t)ch * 8192; dst = F.out + O_WINS + (size_t)b * 512 * 512 + (size_t)ch * 8192; half2 = ch < 31; }
    f32x4 v[32];
#pragma unroll
    for (int j = 0; j < 16; ++j) v[j] = __builtin_nontemporal_load((const f32x4*)src + j * 64 + lane);
    if (half2) {
#pragma unroll
        for (int j = 16; j < 32; ++j) v[j] = __builtin_nontemporal_load((const f32x4*)src + j * 64 + lane); }
#pragma unroll
    for (int j = 0; j < 16; ++j) __builtin_nontemporal_store(v[j], (f32x4*)dst + j * 64 + lane);
    if (half2) {
#pragma unroll
        for (int j = 16; j < 32; ++j) __builtin_nontemporal_store(v[j], (f32x4*)dst + j * 64 + lane); }
}

namespace pg8 {
struct GatedOrder : StaticOrder {
    unsigned* flag; unsigned need; unsigned* bar;
    __device__ __forceinline__ void a_ready(const Unit& u) const {
        if (u.pm == MP / BM) {
            XB_SPIN(xb_ld(flag) < need, bar);
            __builtin_amdgcn_fence(__ATOMIC_ACQUIRE, "agent");
            asm volatile("s_waitcnt vmcnt(0)" ::: "memory");
        }
    }
};
__device__ __forceinline__ float row_rstd(const float* ssp, int row) {
    const f32x4* p = (const f32x4*)(ssp + (size_t)row * 16);
    const f32x4 a = p[0], b = p[1], c = p[2], d = p[3];
    const float s = ((a.x + a.y) + (a.z + a.w)) + ((b.x + b.y) + (b.z + b.w)) + ((c.x + c.y) + (c.z + c.w)) + ((d.x + d.y) + (d.z + d.w));
    return __builtin_amdgcn_rsqf(s * (1.f / D) + EPS);
}
__device__ __forceinline__ void unpack8(const bf16x8& v, f32x4& a, f32x4& b) {
    const u32x4 w = __builtin_bit_cast(u32x4, v);
    a = (f32x4){__uint_as_float(w.x << 16), __uint_as_float(w.x & 0xffff0000u), __uint_as_float(w.y << 16), __uint_as_float(w.y & 0xffff0000u)};
    b = (f32x4){__uint_as_float(w.z << 16), __uint_as_float(w.z & 0xffff0000u), __uint_as_float(w.w << 16), __uint_as_float(w.w & 0xffff0000u)};
}
template <bool RES_BF16, bool OUT_F32 = false>
struct EpiRes {
    static constexpr bool PERM = true, AFTER_DRAIN = false;
    const float* resF; bf16_t* Yb; float* Yf; float* ssp;
    __device__ __forceinline__ void operator()(const Acc& acc, const Unit& u, int wr, int wc, int fr, int fq) const {
        const int cb = u.pn * BM + wc * 32 + 8 * fq;
#pragma unroll
        for (int ai = 0; ai < 2; ++ai)
#pragma unroll
            for (int m = 0; m < 4; ++m) {
                const int row = u.pm * BM + ai * HALF + wr * 64 + m * 16 + fr;
                float ss = 0.f;
#pragma unroll
                for (int bj = 0; bj < 2; ++bj) {
                    const int col = cb + bj * HALF;
                    f32x4 r0, r1;
                    if (RES_BF16) unpack8(*(const bf16x8*)(Yb + (size_t)row * D + col), r0, r1);
                    else { r0 = *(const f32x4*)(resF + (size_t)row * D + col); r1 = *(const f32x4*)(resF + (size_t)row * D + col + 4); }
                    const f32x4 y0 = acc[ai][bj][m][0] + r0, y1 = acc[ai][bj][m][1] + r1;
                    if (OUT_F32) { float* yp = Yf + (size_t)row * D + col; *(f32x4*)yp = y0; *(f32x4*)(yp + 4) = y1; }
                    else *(bf16x8*)(Yb + (size_t)row * D + col) = pack8(y0, y1);
                    ss += (y0.x * y0.x + y0.y * y0.y) + (y0.z * y0.z + y0.w * y0.w) + (y1.x * y1.x + y1.y * y1.y) + (y1.z * y1.z + y1.w * y1.w);
                }
                ss += __shfl_xor(ss, 16); ss += __shfl_xor(ss, 32);
                if (fq == 0) ssp[(size_t)row * 16 + u.pn * 4 + wc] = ss;
            }
    }
};
struct EpiResNorm {
    static constexpr bool PERM = true, AFTER_DRAIN = true;
    const bf16_t* res; float* out; const float* gain; float* xslot; unsigned* cnt; unsigned* tmo;
    __device__ __forceinline__ void fused(Acc& acc, const Unit& u, int wr, int wc, int fr, int fq, PG8_LAS unsigned char* lds, int wid, int lane, int tid) const {
        PG8_LAS float* P = (PG8_LAS float*)lds;
        PG8_LAS float* S = (PG8_LAS float*)(lds + 4096);
        const int cb = u.pn * BM + wc * 32 + 8 * fq;
#pragma unroll
        for (int am = 0; am < 4; ++am) {
            const int ai = am >> 1, m0 = (am & 1) * 2;
            f32x4 r[2][2][2];
#pragma unroll
            for (int mm = 0; mm < 2; ++mm) { const bf16_t* rp = res + (size_t)(u.pm * BM + ai * HALF + wr * 64 + (m0 + mm) * 16 + fr) * D;
#pragma unroll
                for (int bj = 0; bj < 2; ++bj) unpack8(*(const bf16x8*)(rp + cb + bj * HALF), r[mm][bj][0], r[mm][bj][1]); }
#pragma unroll
            for (int mm = 0; mm < 2; ++mm) { const int m = m0 + mm; float ss = 0.f;
#pragma unroll
                for (int bj = 0; bj < 2; ++bj)
#pragma unroll
                    for (int n = 0; n < 2; ++n) { const f32x4 y = acc[ai][bj][m][n] + r[mm][bj][n]; acc[ai][bj][m][n] = y; ss += (y.x * y.x + y.y * y.y) + (y.z * y.z + y.w * y.w); }
                ss += __shfl_xor(ss, 16); ss += __shfl_xor(ss, 32);
                if (fq == 0) P[(ai * HALF + wr * 64 + m * 16 + fr) * 4 + wc] = ss; }
        }
        asm volatile("s_waitcnt lgkmcnt(0)" ::: "memory"); __builtin_amdgcn_s_barrier(); asm volatile("" ::: "memory");
        if (tid < 256) { const float t = (P[tid * 4 + 0] + P[tid * 4 + 1]) + (P[tid * 4 + 2] + P[tid * 4 + 3]);
            __hip_atomic_store((unsigned*)xslot + ((size_t)(u.pm * BM + tid) * 4 + u.pn), __float_as_uint(t), __ATOMIC_RELAXED, __HIP_MEMORY_SCOPE_AGENT); }
        asm volatile("s_waitcnt vmcnt(0)" ::: "memory");
        if (lane == 0) __hip_atomic_fetch_add(cnt + 64 * u.pm, 1u, __ATOMIC_RELAXED, __HIP_MEMORY_SCOPE_AGENT);
        if (wid == 0) {
            unsigned spins = 0;
            while ((unsigned)__builtin_amdgcn_readfirstlane(__hip_atomic_load(cnt + 64 * u.pm, __ATOMIC_RELAXED, __HIP_MEMORY_SCOPE_AGENT)) < 32u) {
                __builtin_amdgcn_s_sleep(2); if (++spins > (1u << 22)) { if (lane == 0) atomicAdd(tmo, 1u); break; } }
            __builtin_amdgcn_fence(__ATOMIC_ACQUIRE, "agent");
        }
        asm volatile("s_waitcnt vmcnt(0) lgkmcnt(0)" ::: "memory"); __builtin_amdgcn_s_barrier(); asm volatile("" ::: "memory");
        if (tid < 256) { const unsigned* sl = (const unsigned*)xslot + (size_t)(u.pm * BM + tid) * 4; float t = 0.f;
#pragma unroll
            for (int k = 0; k < 4; ++k) t += __uint_as_float(__hip_atomic_load(sl + k, __ATOMIC_RELAXED, __HIP_MEMORY_SCOPE_AGENT));
            S[tid] = __builtin_amdgcn_rsqf(t * (1.f / D) + EPS); }
        asm volatile("s_waitcnt lgkmcnt(0)" ::: "memory"); __builtin_amdgcn_s_barrier(); asm volatile("" ::: "memory");
        f32x4 g[2][2];
#pragma unroll
        for (int bj = 0; bj < 2; ++bj) { g[bj][0] = *(const f32x4*)(gain + cb + bj * HALF); g[bj][1] = *(const f32x4*)(gain + cb + bj * HALF + 4); }
#pragma unroll
        for (int ai = 0; ai < 2; ++ai)
#pragma unroll
            for (int m = 0; m < 4; ++m) { const int rl = ai * HALF + wr * 64 + m * 16 + fr; const float rs = S[rl]; float* op = out + (size_t)(u.pm * BM + rl) * D + cb;
#pragma unroll
                for (int bj = 0; bj < 2; ++bj) { *(f32x4*)(op + bj * HALF) = acc[ai][bj][m][0] * rs * g[bj][0]; *(f32x4*)(op + bj * HALF + 4) = acc[ai][bj][m][1] * rs * g[bj][1]; } }
        asm volatile("s_waitcnt lgkmcnt(0)" ::: "memory"); __builtin_amdgcn_s_barrier(); asm volatile("" ::: "memory");
    }
};
struct EpiSlab {
    static constexpr bool PERM = true, AFTER_DRAIN = false;
    float* slab;
    __device__ __forceinline__ void operator()(const Acc& acc, const Unit& u, int wr, int wc, int fr, int fq) const {
        const int cb = u.pn * BM + wc * 32 + 8 * fq;
#pragma unroll
        for (int ai = 0; ai < 2; ++ai)
#pragma unroll
            for (int m = 0; m < 4; ++m) { float* rp = slab + (size_t)(ai * HALF + wr * 64 + m * 16 + fr) * D;
#pragma unroll
                for (int bj = 0; bj < 2; ++bj) { *(f32x4*)(rp + cb + bj * HALF) = acc[ai][bj][m][0]; *(f32x4*)(rp + cb + bj * HALF + 4) = acc[ai][bj][m][1]; } }
    }
};
struct EpiUp {
    static constexpr bool PERM = true, AFTER_DRAIN = false;
    const float* ssp; bf16_t* H;
    __device__ __forceinline__ void operator()(const Acc& acc, const Unit& u, int wr, int wc, int fr, int fq) const {
        const int col = u.pn * HALF + wc * 32 + 8 * fq;
#pragma unroll
        for (int ai = 0; ai < 2; ++ai)
#pragma unroll
            for (int m = 0; m < 4; ++m) {
                const int row = u.pm * BM + ai * HALF + wr * 64 + m * 16 + fr;
                const float rs = row_rstd(ssp, row);
                f32x4 h[2];
#pragma unroll
                for (int n = 0; n < 2; ++n) {
                    const f32x4 a = acc[ai][0][m][n] * rs, b = acc[ai][1][m][n] * rs;
#pragma unroll
                    for (int e = 0; e < 4; ++e) h[n][e] = a[e] * b[e] * __builtin_amdgcn_rcpf(1.f + __expf(-a[e]));
                }
                *(bf16x8*)(H + (size_t)row * FF + col) = pack8(h[0], h[1]);
            }
    }
};
struct EpiIn1 {
    static constexpr bool PERM = true, AFTER_DRAIN = false;
    const float* ssp; bf16_t* Q1; bf16_t* KVSEL; bf16_t* KVWIN; float* G1; float* out;
    __device__ __forceinline__ void operator()(const Acc& acc, const Unit& u, int wr, int wc, int fr, int fq) const {
        const int pn = u.pn;
#pragma unroll
        for (int ai = 0; ai < 2; ++ai)
#pragma unroll
            for (int m = 0; m < 4; ++m) {
                const int row = u.pm * BM + ai * HALF + wr * 64 + m * 16 + fr;
                const float rs = row_rstd(ssp, row);
                const bool smp = row >= MP; const int b = smp ? (row - MP) >> 3 : row >> 12, t = smp ? (row - MP) & 7 : row & 4095;
#pragma unroll
                for (int bj = 0; bj < 2; ++bj) {
                    const int lc = bj * HALF + wc * 32 + 8 * fq;
                    const f32x4 v0 = acc[ai][bj][m][0] * rs, v1 = acc[ai][bj][m][1] * rs;
                    if (pn < 4) { *(bf16x8*)(Q1 + (size_t)row * D + pn * 256 + lc) = pack8(v0 * C_SCALE2, v1 * C_SCALE2); }
                    else if (pn < 6) { const int col = (pn - 4) * 256 + lc;
                        float* o = smp ? out + O_CMPS + (size_t)(row - MP) * 512 + col : out + O_CMPP + (size_t)row * 512 + col;
                        *(f32x4*)o = v0; *(f32x4*)(o + 4) = v1; }
                    else if (pn < 8) { const int col = (pn - 6) * 256 + lc;
                        float* o = smp ? out + O_SELS + (size_t)(row - MP) * 512 + col : out + O_SELP + (size_t)row * 512 + col;
                        *(f32x4*)o = v0; *(f32x4*)(o + 4) = v1;
                        if (!smp) *(bf16x8*)(KVSEL + (size_t)row * 512 + col) = pack8(v0, v1); }
                    else if (pn < 10) { const int col = (pn - 8) * 256 + lc;
                        if (!smp) *(bf16x8*)(KVWIN + (size_t)row * 512 + col) = pack8(v0, v1);
                        float* o = nullptr;
                        if (smp) o = out + O_WINS + (size_t)(b * 512 + 504 + t) * 512 + col;
                        else if (t >= SEQ - WIN) o = out + O_WINP + (size_t)(b * 512 + t - (SEQ - WIN)) * 512 + col;
                        if (o) { *(f32x4*)o = v0; *(f32x4*)(o + 4) = v1; } }
                    else { if (lc < 48) { f32x4 s0, s1;
#pragma unroll
                            for (int e = 0; e < 4; ++e) { s0[e] = __builtin_amdgcn_rcpf(1.f + __expf(-v0[e])); s1[e] = __builtin_amdgcn_rcpf(1.f + __expf(-v1[e])); }
                            float* o = G1 + (size_t)row * 48 + lc; *(f32x4*)o = s0; *(f32x4*)(o + 4) = s1; } }
                }
            }
    }
};
}

template <typename T> struct Src;
template <> struct Src<bf16_t> { typedef bf16x8 raw;
    static __device__ __forceinline__ raw ld(const bf16_t* p) { return *(const bf16x8*)p; }
    static __device__ __forceinline__ bf16x8 cv(const raw& r) { return r; } };
template <> struct Src<float> { struct raw { f32x4 a, b; };
    static __device__ __forceinline__ raw ld(const float* p) { raw r; r.a = *(const f32x4*)p; r.b = *(const f32x4*)(p + 4); return r; }
    static __device__ __forceinline__ bf16x8 cv(const raw& r) { return pack8(r.a, r.b); } };

constexpr int VT_MT = 2112;
constexpr float NEG_INF = -__builtin_inff();
struct AttnAcc { f32x16 o0, o1; float m, l; };
__device__ __forceinline__ void acc_init(AttnAcc& A) {
#pragma unroll
    for (int r = 0; r < 16; ++r) { A.o0[r] = 0.f; A.o1[r] = 0.f; }
    A.m = NEG_INF; A.l = 0.f;
}
__device__ __forceinline__ float swap32_max(float v) { auto rr = __builtin_amdgcn_permlane32_swap(__float_as_uint(v), __float_as_uint(v), false, false); return fmaxf(__uint_as_float(rr[0]), __uint_as_float(rr[1])); }
__device__ __forceinline__ float swap32_sum(float v) { auto rr = __builtin_amdgcn_permlane32_swap(__float_as_uint(v), __float_as_uint(v), false, false); return __uint_as_float(rr[0]) + __uint_as_float(rr[1]); }
__device__ __forceinline__ int crow(int r, int hi) { return (r & 3) + 8 * (r >> 2) + 4 * hi; }
typedef short v4i16_t __attribute__((ext_vector_type(4)));
__device__ __forceinline__ s16x4 vtr(const LAS unsigned char* p) { return __builtin_bit_cast(s16x4, __builtin_amdgcn_ds_read_tr16_b64_v4i16((LAS v4i16_t*)p)); }

struct VFrag { s16x4 lo[4], hh[4]; };
__device__ __forceinline__ void vt_read(VFrag& f, const LAS unsigned char* vb) {
#pragma unroll
    for (int mt = 0; mt < 2; ++mt)
#pragma unroll
        for (int ks = 0; ks < 2; ++ks) { f.lo[mt * 2 + ks] = vtr(vb + mt * VT_MT + ks * 1024); f.hh[mt * 2 + ks] = vtr(vb + mt * VT_MT + ks * 1024 + 512); }
}
__device__ __forceinline__ void pv_tile(f32x16& o0, f32x16& o1, const VFrag& f, bf16x8 pf0, bf16x8 pf1) {
#define VFR(i) (bf16x8){f.lo[i][0], f.lo[i][1], f.lo[i][2], f.lo[i][3], f.hh[i][0], f.hh[i][1], f.hh[i][2], f.hh[i][3]}
    __builtin_amdgcn_s_setprio(1);
    o0 = __builtin_amdgcn_mfma_f32_32x32x16_bf16(VFR(0), pf0, o0, 0, 0, 0);
    o0 = __builtin_amdgcn_mfma_f32_32x32x16_bf16(VFR(1), pf1, o0, 0, 0, 0);
    o1 = __builtin_amdgcn_mfma_f32_32x32x16_bf16(VFR(2), pf0, o1, 0, 0, 0);
    o1 = __builtin_amdgcn_mfma_f32_32x32x16_bf16(VFR(3), pf1, o1, 0, 0, 0);
    __builtin_amdgcn_s_setprio(0);
#undef VFR
}
__device__ __forceinline__ bf16x8 pack_p(const f32x16& p, int base) {
    u32x4 w; w.x = cvtpk(p[base + 0], p[base + 1]); w.y = cvtpk(p[base + 2], p[base + 3]); w.z = cvtpk(p[base + 4], p[base + 5]); w.w = cvtpk(p[base + 6], p[base + 7]);
    return __builtin_bit_cast(bf16x8, w);
}

constexpr float RESC_THR = 6.f;
constexpr int KT_OFF = 4352;
struct NoHook { __device__ __forceinline__ void operator()(int, const f32x16&) const {} };
template <typename T, int MODE, int VOFF, int PFD = 1, class RP, class MK, class HK = NoHook>
__device__ __forceinline__ void attn_run(AttnAcc& A, const bf16x8 (&qf)[4], int t_begin, int t_end, LAS unsigned char* vt, int lane, RP rp, MK mk, HK hk = HK()) {
    if (t_begin >= t_end) return;
    const int r32 = lane & 31, hi = lane >> 5, vkey = lane >> 3, vch = lane & 7;
    LAS unsigned char* vdst = vt + (vch >> 2) * VT_MT + vkey * 64 + (vch & 3) * 16;
    const LAS unsigned char* vb = vt + ((lane >> 4) & 1) * 32 + (lane & 3) * 8 + (4 * hi + ((lane & 15) >> 2)) * 64;
    LAS unsigned char* kt = vt + KT_OFF;
    const int kswz_w = (vkey >> 1) & 3;
    const LAS unsigned char* krd = kt + r32 * 128; const int kswz_r = (r32 >> 1) & 7;
    typedef typename Src<T>::raw raw_t;
    auto loads = [&](raw_t (&kr)[4], raw_t (&vr)[4], int tt) {
#pragma unroll
        for (int i = 0; i < 4; ++i) { const T* p_ = rp(tt, vkey + 8 * i) + 8 * vch; kr[i] = Src<T>::ld(p_); if (MODE != 1) vr[i] = Src<T>::ld(p_ + VOFF); } };
    auto tile = [&](int t, raw_t (&kr)[4], raw_t (&vr)[4], int tnext) {
        asm volatile("" ::: "memory");
#pragma unroll
        for (int i = 0; i < 4; ++i) {
            *(LAS bf16x8*)(kt + (vkey + 8 * i) * 128 + ((vch ^ (kswz_w | ((i & 1) << 2))) * 16)) = Src<T>::cv(kr[i]);
            if (MODE != 1) *(LAS bf16x8*)(vdst + i * 512) = Src<T>::cv(vr[i]);
        }
        if (tnext >= t_begin) loads(kr, vr, tnext);
        asm volatile("s_waitcnt lgkmcnt(0)" ::: "memory");
        bf16x8 kf[4];
#pragma unroll
        for (int d0 = 0; d0 < 4; ++d0) kf[d0] = *(const LAS bf16x8*)(krd + (((2 * d0 + hi) ^ kswz_r) * 16));
        VFrag vf;
        if (MODE != 1) { vt_read(vf, vb); __builtin_amdgcn_sched_barrier(0); }
        f32x16 s;
#pragma unroll
        for (int r = 0; r < 16; ++r) s[r] = 0.f;
        __builtin_amdgcn_s_setprio(1);
#pragma unroll
        for (int d0 = 0; d0 < 4; ++d0) s = __builtin_amdgcn_mfma_f32_32x32x16_bf16(kf[d0], qf[d0], s, 0, 0, 0);
        __builtin_amdgcn_s_setprio(0);
        if (MODE == 2) {
            mk(t, s, -A.m);
#pragma unroll
            for (int r = 0; r < 16; ++r) s[r] = __builtin_amdgcn_exp2f(s[r]) * A.l;
            hk(t, s);
        } else {
            const bool first = A.m == NEG_INF;
            mk(t, s, first ? 0.f : -A.m);
            float tm = fmaxf(fmaxf(s[0], s[1]), fmaxf(s[2], s[3]));
#pragma unroll
            for (int r = 4; r < 16; r += 4) tm = fmaxf(tm, fmaxf(fmaxf(s[r], s[r + 1]), fmaxf(s[r + 2], s[r + 3])));
            tm = swap32_max(tm);
            if (__any(first ? tm > NEG_INF : tm > RESC_THR)) {
                const float up = first ? tm : fmaxf(tm, 0.f);
                const float alpha = first ? 0.f : __builtin_amdgcn_exp2f(-up);
                A.l *= alpha; A.m = first ? up : A.m + up;
                const float sh = (up == NEG_INF) ? 0.f : up;
#pragma unroll
                for (int r = 0; r < 16; ++r) s[r] -= sh;
                if (MODE == 0) {
#pragma unroll
                    for (int r = 0; r < 16; ++r) { A.o0[r] *= alpha; A.o1[r] *= alpha; } }
            }
            float ps = 0.f;
#pragma unroll
            for (int r = 0; r < 16; ++r) { s[r] = __builtin_amdgcn_exp2f(s[r]); ps += s[r]; }
            A.l += swap32_sum(ps);
        }
        if (MODE != 1) {
            const bf16x8 pf0 = pack_p(s, 0), pf1 = pack_p(s, 8);
            pv_tile(A.o0, A.o1, vf, pf0, pf1);
        }
        asm volatile("" ::: "memory");
    };
    raw_t krA[4], vrA[4];
    int t = t_end - 1;
    loads(krA, vrA, t);
    if (PFD == 2) {
        raw_t krB[4], vrB[4];
        if (t - 1 >= t_begin) loads(krB, vrB, t - 1);
        while (t >= t_begin) {
            tile(t, krA, vrA, t - 2);
            if (t - 1 < t_begin) break;
            tile(t - 1, krB, vrB, t - 3);
            t -= 2;
        }
    } else {
        for (; t >= t_begin; --t) tile(t, krA, vrA, t - 1);
    }
}
template <int KS, bool CHECK>
__device__ __forceinline__ void bias_mask(f32x16& s, float dq, float nslope2, float lo, float hi_, int hi, float base = 0.f) {
    const float dq2 = dq - (float)(KS * 4 * hi);
#pragma unroll
    for (int r = 0; r < 16; ++r) {
        const float d = dq2 - (float)(KS * ((r & 3) + 8 * (r >> 2)));
        float x = __builtin_fmaf(d, nslope2, s[r] + base);
        asm volatile("" : "+v"(x));
        if (CHECK) { const bool ok = (d >= lo) & (d <= hi_); s[r] = ok ? x : NEG_INF; } else s[r] = x;
    }
}

__device__ __forceinline__ void store_o(bf16_t* orow, const f32x16& o0, const f32x16& o1, float sc, int hi) {
#pragma unroll
    for (int i = 0; i < 4; ++i) {
        u32x2 w; w.x = cvtpk(o0[4 * i] * sc, o0[4 * i + 1] * sc); w.y = cvtpk(o0[4 * i + 2] * sc, o0[4 * i + 3] * sc); *(u32x2*)(orow + 8 * i + 4 * hi) = w;
        u32x2 x; x.x = cvtpk(o1[4 * i] * sc, o1[4 * i + 1] * sc); x.y = cvtpk(o1[4 * i + 2] * sc, o1[4 * i + 3] * sc); *(u32x2*)(orow + 32 + 8 * i + 4 * hi) = x;
    }
}

__device__ __forceinline__ void dil_item_prompt(const Frame& F, int item) {
    const int lane = F.lane, r32 = lane & 31, hi = lane >> 5;
    const int j = item & 7, blk = (item >> 3) & 15, h = (item >> 7) & 7, b = item >> 10;
    const int q0 = blk * 256 + j, q = q0 + 8 * r32;
    const bf16_t* QD = (const bf16_t*)(F.ws + WS_QD); const bf16_t* KVD = (const bf16_t*)(F.ws + WS_KVD);
    const size_t rb = (size_t)b * SEQ;
    bf16x8 qf[4];
#pragma unroll
    for (int d0 = 0; d0 < 4; ++d0) qf[d0] = *(const bf16x8*)(QD + (rb + q) * 512 + h * 64 + 16 * d0 + 8 * hi);
    const float nslope2 = -__builtin_amdgcn_exp2f(-(float)(h + 1)) * LOG2E; const bool par = (r32 & 1) != 0;
    const bf16_t* Kb = KVD + rb * 1024 + h * 64;
    AttnAcc A; acc_init(A);
    LAS unsigned char* vt = F.wscr;
#define DIL_BRANCH(ST, K0, NT, WINDOW, PAR) do { \
        const int need_ = -(K0) - 31 - q0 / (ST); const int tb_ = need_ <= 0 ? 0 : (need_ + 31) >> 5; \
        auto rp = [&](int t, int key) -> const bf16_t* { int pos = q0 + (ST) * ((K0) + 32 * t + key); pos = pos < 0 ? 0 : (pos > SEQ - 1 ? SEQ - 1 : pos); return Kb + (size_t)pos * 1024; }; \
        auto mk = [&](int t, f32x16& s, float sh) { \
            const int tb = q0 + (ST) * ((K0) + 32 * t);                      \
            const float dq = (float)(q - tb); const float lim = fminf((float)(WINDOW), (float)q); \
            bias_mask<(ST), true>(s, dq, nslope2, 0.f, lim, hi, sh); \
            if (PAR) { _Pragma("unroll") for (int r = 0; r < 16; ++r) { const bool keep = (r & 1) ? par : !par; s[r] = keep ? s[r] : NEG_INF; } } }; \
        attn_run<bf16_t, 0, 512, 2>(A, qf, tb_, (NT), vt, lane, rp, mk); } while (0)
    DIL_BRANCH(1, -128, 12, 128, false);
    DIL_BRANCH(4, -128, 6, 512, false);
    DIL_BRANCH(8, -256, 9, 2048, true);
#undef DIL_BRANCH
    const float inv = 1.f / fmaxf(A.l, 1e-30f);
    store_o((bf16_t*)(F.ws + WS_O) + (rb + q) * D + h * 64, A.o0, A.o1, inv, hi);
}
__device__ __forceinline__ void dil_item_sample(const Frame& F, int item) {
    const int lane = F.lane, hi = lane >> 5, qi = lane & 7;
    const int h = item & 7, b = item >> 3;
    const size_t row = (size_t)MP + b * 8 + qi;
    const bf16_t* QD = (const bf16_t*)(F.ws + WS_QD);
    bf16x8 qf[4];
#pragma unroll
    for (int d0 = 0; d0 < 4; ++d0) qf[d0] = *(const bf16x8*)(QD + row * 512 + h * 64 + 16 * d0 + 8 * hi);
    const float slope2 = __builtin_amdgcn_exp2f(-(float)(h + 1)) * LOG2E;
    const float* cache = (const float*)F.a->in[2] + (size_t)b * 2048 * 1024 + h * 64;
    const float* newr = F.out + O_DILS + (size_t)b * 2048 * 1024 + h * 64;
    AttnAcc A; acc_init(A);
    LAS unsigned char* vt = F.wscr;
    auto geom = [&](int t, int& sh, int& pos0, int& tt, int& cls) { if (t < 5) { sh = 0; cls = 0; tt = t; pos0 = 1920; } else if (t < 25) { sh = 2; cls = (t - 5) / 5; tt = (t - 5) - 5 * cls; pos0 = 1536 + cls; } else { sh = 4; cls = (t - 25) / 5; tt = (t - 25) - 5 * cls; pos0 = cls; } };
    auto rowp = [&](int t, int key) -> const float* { int sh, pos0, tt, cls; geom(t, sh, pos0, tt, cls); int c = pos0 + ((32 * tt + key) << sh); c = c > 2055 ? 2055 : c; return c < 2048 ? cache + (size_t)c * 1024 : newr + (size_t)(c - 8) * 1024; };
    auto mk = [&](int t, f32x16& s, float shf) {
        int sh, pos0, tt, cls; geom(t, sh, pos0, tt, cls);
        const bool ok2 = sh == 0 ? true : (sh == 2 ? (qi & 3) == cls : qi == cls);
        const float dq = (float)(((2048 + qi - pos0) >> sh) - 32 * tt);
        bias_mask<1, true>(s, dq, -slope2 * (float)(1 << sh), 0.f, 128.f, hi, ok2 ? shf : NEG_INF); };
    attn_run<float, 0, 512>(A, qf, 0, 65, vt, lane, rowp, mk);
    const float inv = 1.f / fmaxf(A.l, 1e-30f);
    if ((lane & 31) < 8) store_o((bf16_t*)(F.ws + WS_O) + row * D + h * 64, A.o0, A.o1, inv, hi);
}

template <bool SAMPLE>
__device__ __forceinline__ void rglru_gates_item(const Frame& F, int item) {
    const int lane = F.lane, r32 = lane & 31, hi = lane >> 5;
    const int n = item & 7, tile = item >> 3;
    const int b = SAMPLE ? tile : tile >> 7, t = SAMPLE ? (r32 < 8 ? r32 : 7) : ((tile & 127) * 32 + r32);
    const size_t rowbase = SAMPLE ? (size_t)MP + b * 8 : (size_t)b * SEQ;
    const float* XR = (const float*)(F.ws + WS_XR);
    const float* cw = (const float*)F.a->in[14]; const float* cbias = (const float*)F.a->in[15];
    const float* sconv = (const float*)F.a->in[3] + (size_t)b * 3 * 512;
    const int ch0 = 64 * n + 4 * hi;
    f32x4 xc[8];
#pragma unroll
    for (int a = 0; a < 8; ++a) {
        const int ch = ch0 + 8 * a;
        f32x4 acc = *(const f32x4*)(cbias + ch);
#pragma unroll
        for (int k = 0; k < 4; ++k) {
            const int tau = t + k - 3;
            const float* xp = XR + (rowbase + (tau >= 0 ? tau : 0)) * 512 + ch;
            if (SAMPLE) xp = tau >= 0 ? xp : sconv + (3 + tau) * 512 + ch;
            f32x4 x = *(const f32x4*)xp;
            const float keep = (SAMPLE || tau >= 0) ? 1.f : 0.f;
            acc += x * (*(const f32x4*)(cw + k * 512 + ch) * keep);
        }
        xc[a] = acc;
        if (a & 1) __builtin_amdgcn_sched_barrier(0);
    }
    bf16x8 xb[4];
#pragma unroll
    for (int d0 = 0; d0 < 4; ++d0) xb[d0] = pack8(xc[2 * d0], xc[2 * d0 + 1]);
    const bf16_t* WG = (const bf16_t*)(F.ws + WS_WG);
    const float* ba = (const float*)F.a->in[17]; const float* bx = (const float*)F.a->in[19]; const float* c8 = (const float*)(F.ws + WS_C8);
    float* AU = (float*)(F.ws + WS_AU) + (rowbase + t) * 1024;
    const bool valid = !SAMPLE || r32 < 8;
#pragma unroll
    for (int mt = 0; mt < 2; ++mt) {
        f32x16 ga, gx;
#pragma unroll
        for (int r = 0; r < 16; ++r) { ga[r] = 0.f; gx[r] = 0.f; }
#pragma unroll
        for (int d0 = 0; d0 < 4; ++d0) {
            const bf16x8 wa = *(const bf16x8*)(WG + ((size_t)(0 * 8 + n) * 64 + r32 + 32 * mt) * 64 + 16 * d0 + 8 * hi);
            const bf16x8 wx = *(const bf16x8*)(WG + ((size_t)(1 * 8 + n) * 64 + r32 + 32 * mt) * 64 + 16 * d0 + 8 * hi);
            ga = __builtin_amdgcn_mfma_f32_32x32x16_bf16(wa, xb[d0], ga, 0, 0, 0);
            gx = __builtin_amdgcn_mfma_f32_32x32x16_bf16(wx, xb[d0], gx, 0, 0, 0);
        }
#pragma unroll
        for (int a4 = 0; a4 < 4; ++a4) {
            const int a = 4 * mt + a4, ch = ch0 + 8 * a, rb = a4 * 4;
            const f32x4 vba = *(const f32x4*)(ba + ch), vbx = *(const f32x4*)(bx + ch), vc8 = *(const f32x4*)(c8 + ch);
            f32x4 av, uv;
#pragma unroll
            for (int e = 0; e < 4; ++e) {
                const float rg = __builtin_amdgcn_rcpf(1.f + __expf(-(ga[rb + e] + vba[e])));
                const float ig = __builtin_amdgcn_rcpf(1.f + __expf(-(gx[rb + e] + vbx[e])));
                const float la = -rg * vc8[e];
                av[e] = __expf(la);
                uv[e] = __builtin_amdgcn_sqrtf(fmaxf(1.f - av[e] * av[e], 0.f)) * ig * xc[a][e];
            }
            if (valid) { *(f32x4*)(AU + ch) = av; *(f32x4*)(AU + 512 + ch) = uv; }
            if (!SAMPLE) {
#pragma unroll
                for (int sft = 1; sft < 32; sft <<= 1) {
                    const bool upper = (r32 & sft) != 0;
#pragma unroll
                    for (int e = 0; e < 4; ++e) {
                        const float pa = __shfl_xor(av[e], sft), pu = __shfl_xor(uv[e], sft);
                        const float nu = upper ? av[e] * pu + uv[e] : pa * uv[e] + pu;
                        av[e] = av[e] * pa; uv[e] = nu;
                    }
                }
                if (r32 == 0) { float* ag = (float*)(F.ws + WS_AGG) + (size_t)tile * 1024; *(f32x4*)(ag + ch) = av; *(f32x4*)(ag + 512 + ch) = uv; }
            }
            __builtin_amdgcn_sched_barrier(0);
        }
    }
}
__device__ __forceinline__ float gelu_tanh(float x) { const float z = 0.7978845608028654f * (x + 0.044715f * x * x * x); const float e = __expf(2.f * z); return 0.5f * x * (2.f - 2.f * __builtin_amdgcn_rcpf(e + 1.f)); }
template <bool SAMPLE>
__device__ __forceinline__ void rglru_scan_item(const Frame& F, int item) {
    const int lane = F.lane, n = item & 7, tile = item >> 3;
    const int b = SAMPLE ? tile : tile >> 7, tt = SAMPLE ? 0 : tile & 127;
    const int ch = 64 * n + lane;
    constexpr int NT = SAMPLE ? 8 : 32;
    const size_t row0 = SAMPLE ? (size_t)MP + b * 8 : (size_t)b * SEQ + tt * 32;
    const float* AU = (const float*)(F.ws + WS_AU) + row0 * 1024 + ch; const bf16_t* GT = (const bf16_t*)(F.ws + WS_GT) + row0 * 512 + ch;
    bf16_t* O = (bf16_t*)(F.ws + WS_O) + row0 * D + 512 + ch;
    float av[NT], uv[NT], gv[NT];
#pragma unroll
    for (int i = 0; i < NT; ++i) { av[i] = AU[(size_t)i * 1024]; uv[i] = AU[(size_t)i * 1024 + 512]; gv[i] = bf2f(GT[(size_t)i * 512]); }
    float h;
    if (SAMPLE) h = ((const float*)F.a->in[4])[b * 512 + ch];
    else { h = 0.f; const float* ag = (const float*)(F.ws + WS_AGG) + (size_t)(b * 128) * 1024 + ch;
        int c = 0;
        for (; c + 32 <= tt; c += 32) { float pa[32], ph[32];
#pragma unroll
            for (int k = 0; k < 32; ++k) { pa[k] = ag[(size_t)(c + k) * 1024]; ph[k] = ag[(size_t)(c + k) * 1024 + 512]; }
#pragma unroll
            for (int k = 0; k < 32; ++k) h = pa[k] * h + ph[k]; }
        if (c < tt) { float pa[32], ph[32];
#pragma unroll
            for (int k = 0; k < 32; ++k) { const int cc = c + k < tt ? c + k : 0; pa[k] = ag[(size_t)cc * 1024]; ph[k] = ag[(size_t)cc * 1024 + 512]; }
#pragma unroll
            for (int k = 0; k < 32; ++k) { const bool on = c + k < tt; h = on ? pa[k] * h + ph[k] : h; } }
    }
    float y[NT];
#pragma unroll
    for (int i = 0; i < NT; ++i) { h = av[i] * h + uv[i]; y[i] = h * gelu_tanh(gv[i]); }
#pragma unroll
    for (int i = 0; i < NT; ++i) O[(size_t)i * D] = (bf16_t)(cvtpk(y[i], 0.f) & 0xffffu);
    if (SAMPLE) F.out[O_RNNS + b * 512 + ch] = h;
    else if (tt == 127) F.out[O_RNNP + b * 512 + ch] = h;
}

template <bool SAMPLE, bool SPLIT = false>
__device__ __forceinline__ void compress_item(const Frame& F, int item) {
    const int lane = F.lane, r32 = lane & 31, hi = lane >> 5;
    constexpr int NTL = SAMPLE ? 64 : 32, NC = SAMPLE ? NCS : NCP;
    const int c = item & 1, nt = (item >> 1) % NTL, b = (item >> 1) / NTL;
    const int lg = lane >> 4, lch = lane & 15;
    const int* pt = (const int*)F.a->in[8] + b * NPG;
    const float* rbase[9];
#pragma unroll
    for (int j = 0; j < 9; ++j) { int ch = nt * 8 + j; ch = ch < NC ? ch : NC;
        if (SAMPLE) { const int pg = pt[ch >> 3]; rbase[j] = (const float*)F.a->in[6] + ((size_t)pg * PAGE + (ch & 7) * 16) * 512 + c * 256 + lane * 4; }
        else rbase[j] = F.out + O_CMPP + ((size_t)b * SEQ + ch * 16) * 512 + c * 256 + lane * 4; }
    const bf16_t* WF = (const bf16_t*)(F.ws + WS_WCT) + (size_t)c * 32 * 4 * 2 * 512 + lane * 8;
    LAS unsigned char* xt = F.wscr;
    f32x4 xr[9], xq[9];
#define CMP_LOAD(X, l_) do { _Pragma("unroll") for (int j = 0; j < 9; ++j) X[j] = SAMPLE ? __builtin_nontemporal_load((const f32x4*)(rbase[j] + (size_t)(l_) * 512)) : *(const f32x4*)(rbase[j] + (size_t)(l_) * 512); } while (0)
#define CMP_STEP(X, l_, NEXT_OK, lnext_) do { \
        LAS unsigned char* img = xt + ((l_) & 1) * 4608; \
        _Pragma("unroll") for (int j = 0; j < 9; ++j) { const int q = 4 * j + lg; u32x2 w; w.x = cvtpk(X[j][0], X[j][1]); w.y = cvtpk(X[j][2], X[j][3]); \
            *(LAS u32x2*)(img + q * 128 + (((lch >> 1) ^ ((q >> 1) & 7)) * 16) + (lch & 1) * 8) = w; } \
        if (NEXT_OK) CMP_LOAD(X, lnext_); \
        asm volatile("s_waitcnt lgkmcnt(0)" ::: "memory"); \
        _Pragma("unroll") for (int k4 = 0; k4 < 4; ++k4) { \
            const bf16x8 x0 = *(const LAS bf16x8*)(img + r32 * 128 + (((2 * k4 + hi) ^ ((r32 >> 1) & 7)) * 16)); \
            const bf16x8 x1 = *(const LAS bf16x8*)(img + (r32 + 4) * 128 + (((2 * k4 + hi) ^ (((r32 + 4) >> 1) & 7)) * 16)); \
            const bf16x8 w0 = *(const bf16x8*)(WF + (size_t)(((l_) * 4 + k4) * 2 + 0) * 512), w1 = *(const bf16x8*)(WF + (size_t)(((l_) * 4 + k4) * 2 + 1) * 512); \
            const bf16x8 w2 = *(const bf16x8*)(WF + (size_t)((((l_) + 16) * 4 + k4) * 2 + 0) * 512), w3 = *(const bf16x8*)(WF + (size_t)((((l_) + 16) * 4 + k4) * 2 + 1) * 512); \
            a0 = __builtin_amdgcn_mfma_f32_32x32x16_bf16(w0, x0, a0, 0, 0, 0); \
            a1 = __builtin_amdgcn_mfma_f32_32x32x16_bf16(w1, x0, a1, 0, 0, 0); \
            a0 = __builtin_amdgcn_mfma_f32_32x32x16_bf16(w2, x1, a0, 0, 0, 0); \
            a1 = __builtin_amdgcn_mfma_f32_32x32x16_bf16(w3, x1, a1, 0, 0, 0); } \
        asm volatile("" ::: "memory"); } while (0)
    f32x16 a0, a1;
#pragma unroll
    for (int r = 0; r < 16; ++r) { a0[r] = 0.f; a1[r] = 0.f; }
    const int l0 = SPLIT ? 2 * F.wave : 0, l1 = SPLIT ? l0 + 2 : 16;
    CMP_LOAD(xr, l0); CMP_LOAD(xq, l0 + 1);
    for (int l = l0; l < l1; l += 2) {
        CMP_STEP(xr, l, l + 2 < l1, l + 2);
        CMP_STEP(xq, l + 1, l + 3 < l1, l + 3);
    }
#undef CMP_STEP
#undef CMP_LOAD
    if (SPLIT) {
        constexpr int PART = 9216;
        LAS f32x4* mine = (LAS f32x4*)(F.wscr + PART);
#pragma unroll
        for (int i = 0; i < 4; ++i) { mine[i * 64 + lane] = (f32x4){a0[4 * i], a0[4 * i + 1], a0[4 * i + 2], a0[4 * i + 3]}; mine[(4 + i) * 64 + lane] = (f32x4){a1[4 * i], a1[4 * i + 1], a1[4 * i + 2], a1[4 * i + 3]}; }
        __syncthreads();
        {
            const int me = F.wave;
            for (int w = 0; w < NWAVES; ++w) { if (w == me) continue; const LAS f32x4* p = (const LAS f32x4*)(F.lds + w * WSCR + PART);
#pragma unroll
                for (int i = 0; i < 4; ++i) { const f32x4 u = p[i * 64 + lane], v = p[(4 + i) * 64 + lane];
                    a0[4 * i] += u.x; a0[4 * i + 1] += u.y; a0[4 * i + 2] += u.z; a0[4 * i + 3] += u.w; a1[4 * i] += v.x; a1[4 * i + 1] += v.y; a1[4 * i + 2] += v.z; a1[4 * i + 3] += v.w; } }
        }
        __syncthreads();
    }
    const int n = nt * 8 + (r32 >> 2), g = r32 & 3;
    if (n < NC && (!SPLIT || F.wave == 0)) {
        const float* pe = (const float*)(F.ws + WS_PET) + c * 64;
        bf16_t* o = SAMPLE ? (bf16_t*)(F.ws + WS_KCS) + ((size_t)(b * 512 + n) * 2 + c) * 256 + g * 64 : (bf16_t*)(F.ws + WS_KCP) + ((size_t)(b * 256 + n) * 2 + c) * 256 + g * 64;
#pragma unroll
        for (int i = 0; i < 4; ++i) {
            const int e0 = 8 * i + 4 * hi; const f32x4 p0 = *(const f32x4*)(pe + e0), p1 = *(const f32x4*)(pe + 32 + e0);
            u32x2 w; w.x = cvtpk(a0[4 * i] + p0.x, a0[4 * i + 1] + p0.y); w.y = cvtpk(a0[4 * i + 2] + p0.z, a0[4 * i + 3] + p0.w); *(u32x2*)(o + e0) = w;
            u32x2 x; x.x = cvtpk(a1[4 * i] + p1.x, a1[4 * i + 1] + p1.y); x.y = cvtpk(a1[4 * i + 2] + p1.z, a1[4 * i + 3] + p1.w); *(u32x2*)(o + 32 + e0) = x;
        }
    }
}

constexpr int WS_IMP = 8448, WS_SELM = WS_IMP + 8 * 132 * 4, WS_BLIST = WS_SELM + 8 * 4 * 8, WS_OT = 13568, WS_PT = WS_OT + 4096;
static_assert(KT_OFF + 4096 <= WS_IMP && WS_BLIST + 132 * 4 <= WS_OT && WS_PT + 256 <= WSCR, "per-wave scratch map");
template <bool SAMPLE>
__device__ __forceinline__ void nsa_item(const Frame& F, int item) {
    typedef typename std::conditional<SAMPLE, float, bf16_t>::type KT;
    const int lane = F.lane, r32 = lane & 31, hi = lane >> 5, qi = r32 >> 2, r = r32 & 3;
    const int g = item & 3, qt = SAMPLE ? 0 : (item >> 2) & 511, b = SAMPLE ? item >> 2 : item >> 11;
    const int t0 = 8 * qt, qp = SAMPLE ? PAST + qi : t0 + qi, qp_max = SAMPLE ? PAST + 7 : t0 + 7;
    const size_t row = SAMPLE ? (size_t)MP + b * 8 + qi : (size_t)b * SEQ + t0 + qi;
    const int head = 4 * g + r;
    const float nslope2 = -__builtin_amdgcn_exp2f(-0.5f * (float)(head + 1)) * LOG2E;
    const bf16_t* Q1 = (const bf16_t*)(F.ws + WS_Q1);
    bf16x8 qf[4];
#pragma unroll
    for (int d0 = 0; d0 < 4; ++d0) qf[d0] = *(const bf16x8*)(Q1 + row * D + head * 64 + 16 * d0 + 8 * hi);
    const float* gp = (const float*)(F.ws + WS_G1) + row * 48 + head * 3;
    const float g_cmp = gp[0], g_sel = gp[1], g_win = gp[2];
    LAS unsigned char* vt = F.wscr;
    LAS float* imp = (LAS float*)(F.wscr + WS_IMP);
    LAS unsigned long long* selm = (LAS unsigned long long*)(F.wscr + WS_SELM);
    LAS int* blist = (LAS int*)(F.wscr + WS_BLIST);
    constexpr int NC = SAMPLE ? NCS : NCP, NCH = SAMPLE ? 3 : 1;
    LAS u32x2* otl = (LAS u32x2*)(F.wscr + WS_OT) + lane;
    for (int i = lane; i < 8 * 132; i += 64) imp[i] = 0.f;

    const bf16_t* KC = SAMPLE ? (const bf16_t*)(F.ws + WS_KCS) + (size_t)b * 512 * 512 + g * 64 : (const bf16_t*)(F.ws + WS_KCP) + (size_t)b * 256 * 512 + g * 64;
    const int ncv = qp_max >= 31 ? (((qp_max - 31) >> 4) + 1 < NC ? ((qp_max - 31) >> 4) + 1 : NC) : 0;
    const int nct = (ncv + 31) >> 5;
    auto rpc = [&](int t, int key) -> const bf16_t* { int n = 32 * t + key; n = n < NC ? n : NC - 1; return KC + (size_t)n * 512; };
    auto mkc = [&](int t, f32x16& s, float sh) { bias_mask<16, true>(s, (float)(qp - 31 - 512 * t), nslope2, 0.f, 1e30f, hi, sh); };
    AttnAcc A; acc_init(A);
    attn_run<bf16_t, 1, 256>(A, qf, 0, nct, vt, lane, rpc, mkc);
    {
        A.m = (A.m == NEG_INF) ? 0.f : A.m; A.l = A.l > 0.f ? 1.f / A.l : 0.f;
        auto hkc = [&](int t, const f32x16& p) {
#pragma unroll
            for (int i = 0; i < 4; ++i) {
                float p3 = p[4 * i + 3]; float a = 2.f * ((p[4 * i] + p[4 * i + 1]) + p[4 * i + 2]) + p3;
                a += __shfl_xor(a, 1); a += __shfl_xor(a, 2); p3 += __shfl_xor(p3, 1); p3 += __shfl_xor(p3, 2);
                if (r == 0) { const int J = 8 * t + 2 * i + hi; __hip_atomic_fetch_add(&imp[J * 8 + qi], a, __ATOMIC_RELAXED, __HIP_MEMORY_SCOPE_WORKGROUP); __hip_atomic_fetch_add(&imp[(J + 1) * 8 + qi], p3, __ATOMIC_RELAXED, __HIP_MEMORY_SCOPE_WORKGROUP); }
            } };
        attn_run<bf16_t, 2, 256>(A, qf, 0, nct, vt, lane, rpc, mkc, hkc);
#pragma unroll
        for (int j = 0; j < 4; ++j) {
            u32x2 w; w.x = cvtpk(A.o0[4 * j] * g_cmp, A.o0[4 * j + 1] * g_cmp); w.y = cvtpk(A.o0[4 * j + 2] * g_cmp, A.o0[4 * j + 3] * g_cmp); otl[64 * j] = w;
            u32x2 x; x.x = cvtpk(A.o1[4 * j] * g_cmp, A.o1[4 * j + 1] * g_cmp); x.y = cvtpk(A.o1[4 * j + 2] * g_cmp, A.o1[4 * j + 3] * g_cmp); otl[64 * (4 + j)] = x; }
    }
    asm volatile("s_waitcnt lgkmcnt(0)" ::: "memory");
    const int cb = qp_max >> 6;
    for (int idx = lane; idx < 8 * (cb + 1); idx += 64) { const int j = idx >> 3; if (j == 0 || j >= cb - 1) imp[idx] += 1000.f; }
    asm volatile("s_waitcnt lgkmcnt(0)" ::: "memory");
    {
        f32x4 sj[NCH][2]; int rank[NCH][8];
#pragma unroll
        for (int c2 = 0; c2 < NCH; ++c2) { int j = lane + 64 * c2; j = j <= cb ? j : cb; sj[c2][0] = *(const LAS f32x4*)(imp + j * 8); sj[c2][1] = *(const LAS f32x4*)(imp + j * 8 + 4);
#pragma unroll
            for (int q = 0; q < 8; ++q) rank[c2][q] = 0; }
#pragma unroll 2
        for (int i = 0; i <= cb; ++i) {
            const f32x4 v0 = *(const LAS f32x4*)(imp + i * 8), v1 = *(const LAS f32x4*)(imp + i * 8 + 4);
#pragma unroll
            for (int c2 = 0; c2 < NCH; ++c2) { const bool lower = i < lane + 64 * c2;
#pragma unroll
                for (int q = 0; q < 8; ++q) { const float vi = q < 4 ? v0[q & 3] : v1[q & 3], vj = q < 4 ? sj[c2][0][q & 3] : sj[c2][1][q & 3];
                    rank[c2][q] += ((vi > vj) | ((vi == vj) & lower)) ? 1 : 0; } }
        }
#pragma unroll
        for (int c2 = 0; c2 < NCH; ++c2) { const bool cand = lane + 64 * c2 <= cb;
#pragma unroll
            for (int q = 0; q < 8; ++q) { const unsigned long long mask = __ballot(cand && rank[c2][q] < 16); if (lane == 0) selm[q * 4 + c2] = mask; } }
    }
    asm volatile("s_waitcnt lgkmcnt(0)" ::: "memory");
    unsigned long long mym0 = 0ull, mym1 = 0ull, mym2 = 0ull; int nblk = 0;
#pragma unroll
    for (int c2 = 0; c2 < NCH; ++c2) { const unsigned long long mine = selm[qi * 4 + c2]; unsigned long long u = 0;
        if (c2 == 0) mym0 = mine; else if (c2 == 1) mym1 = mine; else mym2 = mine;
#pragma unroll
        for (int q = 0; q < 8; ++q) u |= selm[q * 4 + c2];
        const int j = lane + 64 * c2; const bool in = (u >> lane) & 1ull;
        const int pos = nblk + __popcll(u & ((1ull << lane) - 1ull));
        if (in) blist[pos] = j;
        nblk += __popcll(u); }
    asm volatile("s_waitcnt lgkmcnt(0)" ::: "memory");
    nblk = __builtin_amdgcn_readfirstlane(nblk);
    {
        const KT* sbase; LAS int* pt = (LAS int*)(F.wscr + WS_PT);
        if constexpr (SAMPLE) { pt[lane] = ((const int*)F.a->in[8])[b * NPG + lane]; asm volatile("s_waitcnt lgkmcnt(0)" ::: "memory"); }
        if constexpr (SAMPLE) sbase = (const float*)F.a->in[7] + g * 64; else sbase = (const bf16_t*)(F.ws + WS_KVSEL) + (size_t)b * SEQ * 512 + g * 64;
        const float* snew = F.out + O_SELS + (size_t)b * 8 * 512 + g * 64;
        auto rps = [&](int t, int key) -> const KT* {
            const int J = blist[t >> 1]; const int tok = 64 * J + 32 * (t & 1) + key;
            if constexpr (SAMPLE) { const int tk = tok < PAST ? tok : PAST - 1; const int pg = pt[tk >> 7]; const KT* p0 = sbase + ((size_t)pg * PAGE + (tk & 127)) * 512;
                int i2 = tok - PAST; i2 = i2 < 0 ? 0 : (i2 > 7 ? 7 : i2); const KT* p1 = (const KT*)(snew + (size_t)i2 * 512); return tok < PAST ? p0 : p1; }
            else return sbase + (size_t)tok * 512; };
        auto mks = [&](int t, f32x16& s, float sh) {
            const int J = blist[t >> 1]; bool sel = (mym0 >> (J & 63)) & 1ull; if constexpr (SAMPLE) { const bool s1 = (mym1 >> (J & 63)) & 1ull, s2 = (mym2 >> (J & 63)) & 1ull; sel = J < 64 ? sel : (J < 128 ? s1 : s2); } const int tb = 64 * J + 32 * (t & 1);
            const float base = sel ? sh : NEG_INF, dq = (float)(qp - tb);
            if (J < cb) bias_mask<1, false>(s, dq, nslope2, 0.f, 0.f, hi, base);
            else bias_mask<1, true>(s, dq, nslope2, 0.f, 1e30f, hi, base); };
        acc_init(A);
        attn_run<KT, 0, 256, SAMPLE ? 1 : 2>(A, qf, 0, 2 * nblk, vt, lane, rps, mks);
        const float sc = g_sel / fmaxf(A.l, 1e-30f);
#pragma unroll
        for (int j = 0; j < 4; ++j) {
            const u32x2 a = otl[64 * j], c = otl[64 * (4 + j)];
            u32x2 w; w.x = cvtpk(A.o0[4 * j] * sc + __uint_as_float(a.x << 16), A.o0[4 * j + 1] * sc + __uint_as_float(a.x & 0xffff0000u)); w.y = cvtpk(A.o0[4 * j + 2] * sc + __uint_as_float(a.y << 16), A.o0[4 * j + 3] * sc + __uint_as_float(a.y & 0xffff0000u)); otl[64 * j] = w;
            u32x2 x; x.x = cvtpk(A.o1[4 * j] * sc + __uint_as_float(c.x << 16), A.o1[4 * j + 1] * sc + __uint_as_float(c.x & 0xffff0000u)); x.y = cvtpk(A.o1[4 * j + 2] * sc + __uint_as_float(c.y << 16), A.o1[4 * j + 3] * sc + __uint_as_float(c.y & 0xffff0000u)); otl[64 * (4 + j)] = x; }
    }
    {
        acc_init(A);
        if constexpr (SAMPLE) {
            const float* wc = (const float*)F.a->in[5] + (size_t)b * 512 * 512 + g * 64; const float* wn = F.out + O_WINS + (size_t)b * 512 * 512 + g * 64;
            auto rpw = [&](int t, int key) -> const float* { int c = 32 * t + key; c = c > 519 ? 519 : c; return c < 512 ? wc + (size_t)c * 512 : wn + (size_t)(c - 8) * 512; };
            auto mkw = [&](int t, f32x16& s, float sh) { bias_mask<1, true>(s, (float)(512 + qi - 32 * t), nslope2, 0.f, (float)WIN, hi, sh); };
            attn_run<float, 0, 256>(A, qf, 0, 17, vt, lane, rpw, mkw);
        } else {
            const bf16_t* wb = (const bf16_t*)(F.ws + WS_KVWIN) + (size_t)b * SEQ * 512 + g * 64;
            const int tlo = (t0 - WIN > 0 ? t0 - WIN : 0) >> 5, thi = (t0 + 7) >> 5;
            auto rpw = [&](int t, int key) -> const bf16_t* { return wb + (size_t)(32 * t + key) * 512; };
            auto mkw = [&](int t, f32x16& s, float sh) { const float dq = (float)(qp - 32 * t);
                if (32 * t + 31 <= t0 && 32 * t >= t0 + 7 - WIN) bias_mask<1, false>(s, dq, nslope2, 0.f, 0.f, hi, sh);
                else bias_mask<1, true>(s, dq, nslope2, 0.f, (float)WIN, hi, sh); };
            attn_run<bf16_t, 0, 256, 2>(A, qf, tlo, thi + 1, vt, lane, rpw, mkw);
        }
        const float sc = g_win / fmaxf(A.l, 1e-30f);
#pragma unroll
        for (int j = 0; j < 4; ++j) { const u32x2 a = otl[64 * j], c = otl[64 * (4 + j)];
            A.o0[4 * j] = A.o0[4 * j] * sc + __uint_as_float(a.x << 16); A.o0[4 * j + 1] = A.o0[4 * j + 1] * sc + __uint_as_float(a.x & 0xffff0000u);
            A.o0[4 * j + 2] = A.o0[4 * j + 2] * sc + __uint_as_float(a.y << 16); A.o0[4 * j + 3] = A.o0[4 * j + 3] * sc + __uint_as_float(a.y & 0xffff0000u);
            A.o1[4 * j] = A.o1[4 * j] * sc + __uint_as_float(c.x << 16); A.o1[4 * j + 1] = A.o1[4 * j + 1] * sc + __uint_as_float(c.x & 0xffff0000u);
            A.o1[4 * j + 2] = A.o1[4 * j + 2] * sc + __uint_as_float(c.y << 16); A.o1[4 * j + 3] = A.o1[4 * j + 3] * sc + __uint_as_float(c.y & 0xffff0000u); }
    }
    store_o((bf16_t*)(F.ws + WS_O) + row * D + head * 64, A.o0, A.o1, 1.f, hi);
}

__device__ __forceinline__ void final_norm_row(float* y, const float* ssp, const float* g, int row, int lane) {
    const float rs = pg8::row_rstd(ssp, row);
    f32x4* yr = (f32x4*)(y + (size_t)row * D) + lane; const f32x4* gr = (const f32x4*)g + lane;
#pragma unroll
    for (int j = 0; j < 4; ++j) { const f32x4 v = yr[64 * j], gg = gr[64 * j]; yr[64 * j] = v * rs * gg; }
}

template <bool FINAL>
__device__ __forceinline__ void sample_finalize_row(const float* slab, int ns, const float* res, float* Y, bf16_t* Aout, const float* gain, float* ssp, int r, int lane) {
    f32x4 y[4]; float ss = 0.f;
#pragma unroll
    for (int j = 0; j < 4; ++j) y[j] = *((const f32x4*)(res + (size_t)r * D) + lane + 64 * j);
    for (int sl = 0; sl < ns; ++sl) {
#pragma unroll
        for (int j = 0; j < 4; ++j) y[j] += *((const f32x4*)(slab + ((size_t)sl * MS + r) * D) + lane + 64 * j); }
#pragma unroll
    for (int j = 0; j < 4; ++j) ss += (y[j].x * y[j].x + y[j].y * y[j].y) + (y[j].z * y[j].z + y[j].w * y[j].w);
    ss = wave_sum(ss);
    if (FINAL) { const float rs = 1.f / sqrtf(ss * (1.f / D) + EPS);
#pragma unroll
        for (int j = 0; j < 4; ++j) *((f32x4*)(Y + (size_t)r * D) + lane + 64 * j) = y[j] * rs * *((const f32x4*)gain + lane + 64 * j); }
    else {
#pragma unroll
        for (int j = 0; j < 4; ++j) { *((f32x4*)(Y + (size_t)r * D) + lane + 64 * j) = y[j];
            u32x2 w; w.x = cvtpk(y[j].x, y[j].y); w.y = cvtpk(y[j].z, y[j].w); *((u32x2*)(Aout + (size_t)r * D) + lane + 64 * j) = w; }
        if (lane < 16) ssp[(size_t)(MP + r) * 16 + lane] = lane == 0 ? ss : 0.f; }
}
__device__ __forceinline__ unsigned q_issue(unsigned* ctr, int lane) { unsigned v = 0u; if (lane == 0) v = __hip_atomic_fetch_add(ctr, 1u, __ATOMIC_RELAXED, __HIP_MEMORY_SCOPE_AGENT); return v; }
__device__ __forceinline__ int q_item(unsigned tk, int shard) { return (int)__builtin_amdgcn_readfirstlane(tk) * 8 + shard; }
constexpr int N_PHASES = 17;
#ifndef ONE_LAUNCH
#define ONE_LAUNCH 1
#endif
#define PH_BEGIN \
    const Args* ap_ = &args; size_t z_ = 0; asm volatile("" : "+s"(z_)); \
    Frame F; F.lds = (LAS unsigned char*)lds_raw; F.tid = threadIdx.x; F.lane = F.tid & 63; F.wave = __builtin_amdgcn_readfirstlane(F.tid >> 6); \
    F.G = gridDim.x; { const int vcu_ = (F.G % 8 == 0) ? ((int)blockIdx.x % 8) * (F.G / 8) + (int)blockIdx.x / 8 : (int)blockIdx.x; F.gw = vcu_ * NWAVES + F.wave; } F.NGW = F.G * NWAVES; \
    F.wscr = F.lds + F.wave * WSCR; F.ws = ap_->ws + z_; F.out = ap_->out + z_; F.a = ap_; \
    unsigned char* ws = F.ws; float* out = F.out; unsigned* ctl = (unsigned*)(ws + WS_CTL); float* ssp = (float*)(ws + WS_SSP); \
    const float* norm_mix = (const float*)ap_->in[9] + z_; const float* norm_ffn = (const float*)ap_->in[10] + z_; const float* norm_out = (const float*)ap_->in[11] + z_; \
    (void)ctl; (void)ssp; (void)norm_mix; (void)norm_ffn; (void)norm_out; (void)out;
__global__ void __launch_bounds__(NWAVES * 64, 2) fwd(Args args) {
    extern __shared__ __attribute__((aligned(16))) unsigned char lds_raw[];
    volatile LAS unsigned* MISC = (volatile LAS unsigned*)((LAS unsigned char*)lds_raw + MISC_OFF);
    if (threadIdx.x < 16) MISC[threadIdx.x] = 0u;
    __syncthreads();
    const int lo = args.ph_lo, hi = args.ph_hi;
    const bool multi = (hi - lo) > 1;
    if (multi) (void)xcd_barrier_post((unsigned*)(args.ws + WS_CTL) + CW_BAR, MISC);
#ifndef ONLY_PHASE
#define ONLY_PHASE -1
#endif
#define IN(k) ((ONLY_PHASE < 0 || ONLY_PHASE == (k)) && lo <= (k) && (k) < hi)
#define SEAM(k) do { if (IN(k) && IN((k) + 1)) { XcdBarrier bar_; bar_.bar = (unsigned*)(args.ws + WS_CTL) + CW_BAR; bar_.x = xb_xcc_id(); bar_.st = MISC; xcd_barrier(bar_); } } while (0)

#define GEMM_N1024(Aptr, Wptr, KFULL, RESF, RBF16) do { \
        { pg8::Gemm g{(const bf16_t*)(Aptr), (const bf16_t*)(Wptr), MP, D, (KFULL), (KFULL)}; \
          pg8::StaticOrder S; S.init(MP, D, F.G, (int)blockIdx.x); \
          pg8::EpiRes<RBF16> E{(RESF), (bf16_t*)(ws + WS_XN), nullptr, ssp}; \
          pg8::gemm_phase<pg8::EpiRes<RBF16>, pg8::StaticOrder, true, true>(F.lds, g, S, E); } } while (0)
#define DEFERRED_SAMPLE(Aptr, Wptr, KFULL, RESS, AOUT, GAIN, INST) do { \
        constexpr int ns_ = (KFULL) / 256; const int mu = (int)blockIdx.x - (F.G - 4 * ns_); \
        if (mu >= 0) { const int sl = mu >> 2; int ks_ = 256; asm volatile("" : "+s"(ks_)); \
          pg8::Gemm g{(const bf16_t*)(Aptr) + sl * 256, (const bf16_t*)(Wptr) + sl * 256, M, D, ks_, (KFULL)}; \
          pg8::OneUnit S{MP / 256, mu & 3}; \
          pg8::EpiSlab E{(float*)(ws + WS_SLAB) + (size_t)sl * MS * D}; \
          pg8::gemm_phase<pg8::EpiSlab, pg8::OneUnit, true, true>(F.lds, g, S, E); \
          subgrid_rendezvous(ctl + CW_SR + 64 * (INST), 4 * ns_, ctl + CW_BAR); \
          for (int r = mu * NWAVES + F.wave; r < MS; r += 4 * ns_ * NWAVES) \
              sample_finalize_row<false>((const float*)(ws + WS_SLAB), ns_, (RESS), out + O_YS, (AOUT) + (size_t)MP * D, (GAIN), ssp, r, F.lane); \
          asm volatile("s_waitcnt vmcnt(0)" ::: "memory"); \
          __syncthreads(); \
          if (threadIdx.x == 0) { __builtin_amdgcn_fence(__ATOMIC_RELEASE, "agent"); asm volatile("s_waitcnt vmcnt(0)" ::: "memory"); (void)xb_add(ctl + CW_SR + 64 * (4 + (INST)), 1u); } } } while (0)
#define GATED_ORDER(S, MROWS, NCOLS, KFULL, INST) pg8::GatedOrder S; S.init((MROWS), (NCOLS), F.G, (int)blockIdx.x); S.flag = ctl + CW_SR + 64 * (4 + (INST)); S.need = 4 * ((KFULL) / 256); S.bar = ctl + CW_BAR

    if (IN(0)) { PH_BEGIN p0_prologue(F); }
    SEAM(0);
    if (IN(1)) { PH_BEGIN
        pg8::Gemm g{(const bf16_t*)(ws + WS_XN), (const bf16_t*)(ws + WS_WIN0), M, AB_IN, D, D};
        pg8::StaticOrder S; S.init(M, AB_IN, F.G, (int)blockIdx.x);
        pg8::EpiIn0 E{(bf16_t*)(ws + WS_QD), (bf16_t*)(ws + WS_KVD), (float*)(ws + WS_XR), (bf16_t*)(ws + WS_GT), out};
        pg8::gemm_phase<pg8::EpiIn0, pg8::StaticOrder, true, true>(F.lds, g, S, E);
        {
            constexpr int units = (M / 256) * (AB_IN / 256); const int nfull = units % F.G, nbg = nfull ? F.G - nfull : F.G;
            const int me = (int)blockIdx.x - (F.G - nbg);
            if (me >= 0) { __syncthreads(); for (int it = WT_T4 + me * NWAVES + F.wave; it < WT_T9; it += nbg * NWAVES) weight_transpose_item(F, it); }
        }
        if ((int)blockIdx.x == F.G - 1 && F.wave < 2) {
            const float* pp = (const float*)(ws + WS_PETP) + (size_t)F.wave * 32 * 64 + F.lane; float acc = 0.f;
#pragma unroll
            for (int l = 0; l < 32; ++l) acc += pp[l * 64];
            ((float*)(ws + WS_PET))[F.wave * 64 + F.lane] = acc;
        }
    }
    SEAM(1);
    if (IN(2)) { PH_BEGIN
        constexpr int ND = 32, NGL = 256, NL = ND + NGL * 6 + 32;
        unsigned* qc = ctl + CW_Q2 + 64 * ((int)blockIdx.x & 7); const int shard = (int)blockIdx.x & 7;
        for (int k = (int)__builtin_amdgcn_readfirstlane(q_issue(qc, F.lane)); k < NL; ) {
            const unsigned tk = q_issue(qc, F.lane);
            Frame Fi = F; { size_t zz = 0; asm volatile("" : "+s"(zz)); Fi.ws += zz; Fi.out += zz; }
            if (k < ND) dil_item_sample(Fi, k * 8 + shard);
            else if (k >= ND + NGL * 6) rglru_gates_item<true>(Fi, (k - ND - NGL * 6) * 8 + shard);
            else { const int i2 = k - ND, gl = i2 / 6, slot = i2 - gl * 6;
                if (slot < 2) compress_item<true>(Fi, (2 * gl + slot) * 8 + shard);
                else { const int kd = 2 * gl + (slot & 1);
                    const int item = (((kd >> 3) * 8 + shard) << 3) | (kd & 7);
                    if (slot < 4) dil_item_prompt(Fi, item); else rglru_gates_item<false>(Fi, item); } }
            k = (int)__builtin_amdgcn_readfirstlane(tk);
        }
    }
    SEAM(2);
    if (IN(3)) { PH_BEGIN
        for (int it = F.gw; it < 4096 + 256; it += F.NGW) {
            if (it < 2048) rglru_scan_item<false>(F, it);
            else if (it < 4096) { const int tile = it >> 3; rglru_scan_item<false>(F, ((((tile >> 7) << 7) | (127 - (tile & 127))) << 3) | (it & 7)); }
            else rglru_scan_item<true>(F, it - 4096); }
    }
    SEAM(3);
    if (IN(4)) { PH_BEGIN GEMM_N1024(ws + WS_O, ws + WS_WOUT0, D, (const float*)args.in[0], false); }
    SEAM(4);
    if (IN(6)) { PH_BEGIN
        DEFERRED_SAMPLE(ws + WS_O, ws + WS_WOUT0, D, (const float*)args.in[1], (bf16_t*)(ws + WS_XN), norm_ffn, 0);
        pg8::Gemm g{(const bf16_t*)(ws + WS_XN), (const bf16_t*)(ws + WS_W13_0), M, FF2, D, D};
        GATED_ORDER(S, M, FF2, D, 0);
        pg8::EpiUp E{ssp, (bf16_t*)(ws + WS_H)};
        pg8::gemm_phase<pg8::EpiUp, pg8::GatedOrder, true, true>(F.lds, g, S, E);
    }
    SEAM(6);
    if (IN(7)) { PH_BEGIN GEMM_N1024(ws + WS_H, ws + WS_W2_0, FF, nullptr, true); }
    SEAM(7);
    if (IN(9)) { PH_BEGIN
        DEFERRED_SAMPLE(ws + WS_H, ws + WS_W2_0, FF, out + O_YS, (bf16_t*)(ws + WS_XN), norm_mix + D, 1);
        pg8::Gemm g{(const bf16_t*)(ws + WS_XN), (const bf16_t*)(ws + WS_WIN1), M, C_IN_PAD, D, D};
        GATED_ORDER(S, M, C_IN_PAD, FF, 1);
        pg8::EpiIn1 E{ssp, (bf16_t*)(ws + WS_Q1), (bf16_t*)(ws + WS_KVSEL), (bf16_t*)(ws + WS_KVWIN), (float*)(ws + WS_G1), out};
        pg8::gemm_phase<pg8::EpiIn1, pg8::GatedOrder, true, true>(F.lds, g, S, E);
    }
    SEAM(9);
    if (IN(10)) { PH_BEGIN
        for (int it = (int)blockIdx.x; it < 4 * 8 * 8; it += F.G) compress_item<false, true>(F, it);
    }
    SEAM(10);
    if (IN(11)) { PH_BEGIN
        unsigned* qc = ctl + CW_Q9 + 64 * ((int)blockIdx.x & 7); const int shard = (int)blockIdx.x & 7;
        if (F.wave >= 6) for (int it = (int)blockIdx.x * 2 + (F.wave - 6); it < NDC + NWC; it += 2 * F.G) copy_item(F, it);
        for (int it = q_item(q_issue(qc, F.lane), shard); it < 128 + 8192; ) {
            const unsigned tk = q_issue(qc, F.lane);
            if (it < 128) nsa_item<true>(F, it);
            else { const int p = it - 128, qt = 511 - (p >> 4), bg = p & 15; nsa_item<false>(F, ((bg >> 2) << 11) | (qt << 2) | (bg & 3)); }
            it = q_item(tk, shard);
        }
    }
    SEAM(11);
    if (IN(12)) { PH_BEGIN GEMM_N1024(ws + WS_O, ws + WS_WOUT1, D, nullptr, true); }
    SEAM(12);
    if (IN(14)) { PH_BEGIN
        DEFERRED_SAMPLE(ws + WS_O, ws + WS_WOUT1, D, out + O_YS, (bf16_t*)(ws + WS_XN), norm_ffn + D, 2);
        pg8::Gemm g{(const bf16_t*)(ws + WS_XN), (const bf16_t*)(ws + WS_W13_1), M, FF2, D, D};
        GATED_ORDER(S, M, FF2, D, 2);
        pg8::EpiUp E{ssp, (bf16_t*)(ws + WS_H)};
        pg8::gemm_phase<pg8::EpiUp, pg8::GatedOrder, true, true>(F.lds, g, S, E);
    }
    SEAM(14);
    if (IN(15)) { PH_BEGIN
        if (F.G == MP / 256 * 4) {
            pg8::Gemm g{(const bf16_t*)(ws + WS_H), (const bf16_t*)(ws + WS_W2_1), MP, D, FF, FF};
            pg8::StaticOrder S; S.init(MP, D, F.G, (int)blockIdx.x);
            pg8::EpiResNorm E{(const bf16_t*)(ws + WS_XN), out + O_YP, norm_out, (float*)(ws + WS_XSL), ctl + CW_PN, ctl + CW_BAR + XB_TMO};
            pg8::gemm_phase<pg8::EpiResNorm, pg8::StaticOrder, true, true>(F.lds, g, S, E);
        } else {
            pg8::Gemm g{(const bf16_t*)(ws + WS_H), (const bf16_t*)(ws + WS_W2_1), MP, D, FF, FF};
            pg8::StaticOrder S; S.init(MP, D, F.G, (int)blockIdx.x);
            pg8::EpiRes<true, true> E{nullptr, (bf16_t*)(ws + WS_XN), out + O_YP, ssp};
            pg8::gemm_phase<pg8::EpiRes<true, true>, pg8::StaticOrder, true, true>(F.lds, g, S, E);
        }
        if ((int)blockIdx.x < 4 * (FF / 256)) { const int mu = (int)blockIdx.x; const int sl = mu >> 2;
            pg8::Gemm g{(const bf16_t*)(ws + WS_H) + sl * 256, (const bf16_t*)(ws + WS_W2_1) + sl * 256, M, D, 256, FF};
            pg8::OneUnit S{MP / 256, mu & 3};
            pg8::EpiSlab E{(float*)(ws + WS_SLAB) + (size_t)sl * MS * D};
            pg8::gemm_phase<pg8::EpiSlab, pg8::OneUnit, true, true>(F.lds, g, S, E);
            subgrid_rendezvous(ctl + CW_SR + 64 * 3, 4 * (FF / 256), ctl + CW_BAR);
            for (int r = mu * NWAVES + F.wave; r < MS; r += 4 * (FF / 256) * NWAVES)
                sample_finalize_row<true>((const float*)(ws + WS_SLAB), FF / 256, out + O_YS, out + O_YS, nullptr, norm_out, ssp, r, F.lane); }
    }
    if (gridDim.x != MP / 256 * 4) {
        SEAM(15);
        if (IN(16)) { PH_BEGIN
            for (int r = F.gw; r < MP; r += F.NGW) final_norm_row(out, ssp, norm_out, r, F.lane);
        }
    }
#undef GEMM_N1024
#undef DEFERRED_SAMPLE
#undef GATED_ORDER
#undef IN
#undef SEAM
}

extern "C" void kernel_launch(void* const* d_in, const int* in_sizes, int n_in, void* d_out, int out_size, void* d_ws, size_t ws_size, hipStream_t stream) {
    static int grid = 0;
    if (grid == 0) {
        if (n_in != 28 || (size_t)out_size != O_END || ws_size < WS_END) { fprintf(stderr, "kernel_launch: unexpected shapes (n_in %d out %d ws %zu need %zu)\n", n_in, out_size, ws_size, (size_t)WS_END); grid = -1; return; }
        int dev = 0, cus = 0, per_cu = 0;
        if (hipGetDevice(&dev) != hipSuccess || hipDeviceGetAttribute(&cus, hipDeviceAttributeMultiprocessorCount, dev) != hipSuccess) { grid = -1; return; }
        if (hipFuncSetAttribute((const void*)fwd, hipFuncAttributeMaxDynamicSharedMemorySize, LDS_BYTES) != hipSuccess) { fprintf(stderr, "kernel_launch: hipFuncSetAttribute failed\n"); grid = -1; return; }
        if (hipOccupancyMaxActiveBlocksPerMultiprocessor(&per_cu, (const void*)fwd, NWAVES * 64, LDS_BYTES) != hipSuccess || per_cu < 1) { fprintf(stderr, "kernel_launch: occupancy query says %d\n", per_cu); }
        (void)hipGetLastError();
        grid = cus;
    }
    if (grid < 0) return;
    (void)hipMemsetAsync((char*)d_ws + WS_CTL, 0, CTL_ZERO_BYTES, stream);
    Args a{};
    for (int i = 0; i < 28; ++i) a.in[i] = d_in[i];
    a.out = (float*)d_out; a.ws = (unsigned char*)d_ws;
#if ONE_LAUNCH
    a.ph_lo = 0; a.ph_hi = N_PHASES; hipLaunchKernelGGL(fwd, dim3(grid), dim3(NWAVES * 64), LDS_BYTES, stream, a);
#else
    for (int p = 0; p < N_PHASES; ++p) { a.ph_lo = p; a.ph_hi = p + 1; hipLaunchKernelGGL(fwd, dim3(grid), dim3(NWAVES * 64), LDS_BYTES, stream, a); }
#endif
}
```

```cpp
#include <hip/hip_runtime.h>
#include <cstdio>
#include <cstdint>
#include <type_traits>

#define LAS __attribute__((address_space(3)))
#define GAS __attribute__((address_space(1)))
typedef unsigned short bf16_t;
typedef short bf16x8 __attribute__((ext_vector_type(8)));
typedef short s16x4 __attribute__((ext_vector_type(4)));
typedef float f32x2 __attribute__((ext_vector_type(2)));
typedef float f32x4 __attribute__((ext_vector_type(4)));
typedef float f32x16 __attribute__((ext_vector_type(16)));
typedef unsigned u32x2 __attribute__((ext_vector_type(2)));
typedef unsigned u32x4 __attribute__((ext_vector_type(4)));
typedef __bf16 bf16x2_t __attribute__((ext_vector_type(2)));

constexpr int D = 1024, BP = 4, SEQ = 4096, MP = BP * SEQ, BS = 32, TS = 8, MS = BS * TS, M = MP + MS;
constexpr int PAST = 8192, PAGE = 128, NPG = PAST / PAGE;
constexpr int AB_IN = 2560, C_IN = 2608, C_IN_PAD = 2816, FF = 2816, FF2 = 2 * FF;
constexpr int DIL_KEEP = 2048, WIN = 512;
constexpr int NCP = 255, NCS = 511;
constexpr float EPS = 1e-6f;
constexpr float LOG2E = 1.4426950408889634f;
constexpr float C_SCALE2 = 0.125f * LOG2E;

constexpr size_t O_YP = 0, O_YS = O_YP + (size_t)MP * D, O_DILP = O_YS + (size_t)MS * D, O_DILS = O_DILP + (size_t)BP * 2048 * 1024,
                 O_CONVP = O_DILS + (size_t)BS * 2048 * 1024, O_CONVS = O_CONVP + (size_t)BP * 3 * 512, O_RNNP = O_CONVS + (size_t)BS * 3 * 512,
                 O_RNNS = O_RNNP + (size_t)BP * 512, O_WINP = O_RNNS + (size_t)BS * 512, O_WINS = O_WINP + (size_t)BP * 512 * 512,
                 O_CMPP = O_WINS + (size_t)BS * 512 * 512, O_CMPS = O_CMPP + (size_t)BP * SEQ * 512, O_SELP = O_CMPS + (size_t)BS * TS * 512,
                 O_SELS = O_SELP + (size_t)BP * SEQ * 512, O_END = O_SELS + (size_t)BS * TS * 512;
static_assert(O_END == 119087104, "output size");

constexpr size_t al256(size_t x) { return (x + 255) & ~(size_t)255; }
constexpr size_t WS_CTL = 0, CTL_ZERO_BYTES = 1u << 16;
constexpr size_t WS_WIN0 = CTL_ZERO_BYTES;
constexpr size_t WS_WOUT0 = WS_WIN0 + (size_t)AB_IN * D * 2;
constexpr size_t WS_W13_0 = WS_WOUT0 + (size_t)D * D * 2;
constexpr size_t WS_W2_0 = WS_W13_0 + (size_t)FF2 * D * 2;
constexpr size_t WS_WIN1 = WS_W2_0 + (size_t)D * FF * 2;
constexpr size_t WS_WOUT1 = WS_WIN1 + (size_t)C_IN_PAD * D * 2;
constexpr size_t WS_W13_1 = WS_WOUT1 + (size_t)D * D * 2;
constexpr size_t WS_W2_1 = WS_W13_1 + (size_t)FF2 * D * 2;
constexpr size_t WS_WG = WS_W2_1 + (size_t)D * FF * 2;
constexpr size_t WS_WCT = WS_WG + (size_t)2 * 8 * 64 * 64 * 2;
constexpr size_t WS_PET = WS_WCT + (size_t)2 * 64 * 2048 * 2;
constexpr size_t WS_C8 = WS_PET + 512;
constexpr size_t WS_XN = al256(WS_C8 + 2048);
constexpr size_t WS_QD = WS_XN + (size_t)M * D * 2;
constexpr size_t WS_KVD = WS_QD + (size_t)M * 512 * 2;
constexpr size_t WS_XR = WS_KVD + (size_t)M * 1024 * 2;
constexpr size_t WS_GT = WS_XR + (size_t)M * 512 * 4;
constexpr size_t WS_AU = WS_GT + (size_t)M * 512 * 2;
constexpr size_t WS_AGG = WS_AU + (size_t)M * 1024 * 4;
constexpr size_t WS_O = WS_AGG + (size_t)4 * 128 * 1024 * 4;
constexpr size_t WS_H = WS_O + (size_t)M * D * 2;
constexpr size_t WS_SSP = WS_H + (size_t)M * FF * 2;
constexpr size_t WS_Q1 = WS_SSP + (size_t)M * 16 * 4;
constexpr size_t WS_KVSEL = WS_Q1 + (size_t)M * D * 2;
constexpr size_t WS_KVWIN = WS_KVSEL + (size_t)MP * 512 * 2;
constexpr size_t WS_G1 = WS_KVWIN + (size_t)MP * 512 * 2;
constexpr size_t WS_KCP = al256(WS_G1 + (size_t)M * 48 * 4);
constexpr size_t WS_KCS = WS_KCP + (size_t)BP * 256 * 512 * 2;
constexpr size_t WS_SLAB = WS_KCS + (size_t)BS * 512 * 512 * 2;
constexpr size_t WS_XSL = WS_SLAB + (size_t)11 * MS * D * 4;
constexpr size_t WS_PETP = WS_XSL + (size_t)MP * 4 * 4;
constexpr size_t WS_END = WS_PETP + (size_t)2 * 32 * 64 * 4;

constexpr int CW_BAR = 4096;
constexpr int CW_Q2 = 8192, CW_Q9 = 8192 + 1024;
constexpr int CW_PN = 8192 + 2048;
constexpr int CW_SR = 8192 + 2048 + 4096;
constexpr int CW_QBG = 8192 + 2048, CW_DONE = 8192 + 3072;

constexpr int RING_BYTES = 131072;
constexpr int WSCR = 18432;
constexpr int MISC_OFF = 8 * WSCR;
constexpr int LDS_BYTES = MISC_OFF + 1024;

__device__ __forceinline__ unsigned cvtpk(float lo, float hi) { f32x2 v = {lo, hi}; bf16x2_t b = __builtin_convertvector(v, bf16x2_t); return __builtin_bit_cast(unsigned, b); }
__device__ __forceinline__ float bf2f(unsigned short h) { return __uint_as_float((unsigned)h << 16); }
__device__ __forceinline__ bf16x8 pack8(f32x4 a, f32x4 b) { u32x4 w; w.x = cvtpk(a[0], a[1]); w.y = cvtpk(a[2], a[3]); w.z = cvtpk(b[0], b[1]); w.w = cvtpk(b[2], b[3]); return __builtin_bit_cast(bf16x8, w); }
__device__ __forceinline__ float wave_sum(float v) {
#pragma unroll
    for (int o = 1; o < 64; o <<= 1) v += __shfl_xor(v, o);
    return v;
}
#define LDS_WAIT() asm volatile("s_waitcnt lgkmcnt(0)" ::: "memory")
#define VM_WAIT() asm volatile("s_waitcnt vmcnt(0)" ::: "memory")

namespace pg8 {
#define PG8_LAS __attribute__((address_space(3)))
constexpr int BM = 256, BK = 64, HALF = 128, HTB = HALF * BK * 2, STAGE_BYTES = 8 * HTB, NXCD = 8, WGM = 8;
__host__ __device__ __forceinline__ int lds_byte(int r, int c) { const int st = (r >> 4) * 2 + (c >> 5), rr = r & 15, cc = c & 31, ob = rr * 64 + cc * 2; return st * 1024 + (ob ^ (((ob >> 9) & 1) << 5)); }
__host__ __device__ __forceinline__ void stage_rc(int b, int& R, int& C) { const int st = b / 1024, sb = b % 1024, swz = sb ^ (((sb >> 9) & 1) << 5); R = (st >> 1) * 16 + swz / 64; C = (st & 1) * 32 + (swz % 64) / 2; }
__host__ __device__ __forceinline__ int perm32(int rho) { const int n = rho >> 4, i = rho & 15; return 8 * (i >> 2) + 4 * n + (i & 3); }
struct Unit { int pm, pn; };
struct Gemm { const bf16_t* A; const bf16_t* Bt; int M, N, K, ld; };
struct StaticOrder {
    int nM, nN, nwg, G, c;
    __host__ __device__ void init(int M_, int N_, int G_, int c_) { nM = M_ / BM; nN = N_ / BM; nwg = nM * nN; G = G_; c = c_; }
    __host__ __device__ bool next(int i, Unit& u) const {
        const long L = (long)i * G + c; if (L >= nwg) return false;
        int wgid = (int)L; { const int q = nwg / NXCD, r = nwg % NXCD, xcd = wgid % NXCD, off = wgid / NXCD; wgid = (xcd < r ? xcd * (q + 1) : r * (q + 1) + (xcd - r) * q) + off; }
        const int nig = WGM * nN, gid = wgid / nig, fm = gid * WGM, gsz = (nM - fm) < WGM ? (nM - fm) : WGM;
        u.pm = fm + ((wgid % nig) % gsz); u.pn = (wgid % nig) / gsz; return true;
    }
    __device__ __forceinline__ void a_ready(const Unit&) const {}
    __device__ __forceinline__ void done(const Unit&) const {}
};

struct CountingOrder : StaticOrder {
    unsigned* cnt; int lane;
    __device__ __forceinline__ void done(const Unit&) const { if (lane == 0) __hip_atomic_fetch_add(cnt, 1u, __ATOMIC_RELAXED, __HIP_MEMORY_SCOPE_AGENT); }
};
struct OneUnit {
    int pm, pn;
    __host__ __device__ bool next(int i, Unit& u) const { if (i) return false; u.pm = pm; u.pn = pn; return true; }
    __device__ __forceinline__ void a_ready(const Unit&) const {}
    __device__ __forceinline__ void done(const Unit&) const {}
};
template <class Epi, class Sched, bool ALIGN_EPI = false, bool SP2 = false>
__device__ __forceinline__ void gemm_phase(PG8_LAS unsigned char* lds, const Gemm g, const Sched& S, const Epi& E) {
    const int tid = threadIdx.x, wid = __builtin_amdgcn_readfirstlane(tid >> 6), lane = tid & 63, wr = wid >> 2, wc = wid & 3, fr = lane & 15, fq = lane >> 4;
    const int K = g.K, nt = K / BK, LD = g.ld;
    unsigned voffA[2], voffB[2];
#pragma unroll
    for (int i = 0; i < 2; ++i) { int R, C; stage_rc(tid * 16 + i * 8192, R, C); const int Rb = Epi::PERM ? ((R & ~31) + perm32(R & 31)) : R;
        voffA[i] = (unsigned)(R * LD + C) * 2u; voffB[i] = (unsigned)(Rb * LD + C) * 2u; }
    const size_t kstep = (size_t)(BK * 2);
    const size_t hstep = (size_t)HALF * LD * 2;
    const size_t tstep = 2 * hstep;
    const unsigned ldsw = (unsigned)wid * 1024u;
    const int aoff = lds_byte(wr * 64 + fr, fq * 8), boff = lds_byte(wc * 32 + fr, fq * 8);
#define PG8_SA(b, h) (((b) * 2 + (h)) * HTB)
#define PG8_SB(b, h) ((4 + (b) * 2 + (h)) * HTB)
#define PG8_STAGE(bufoff, gbase, voff) do { _Pragma("unroll") for (int _i = 0; _i < 2; ++_i) \
        __builtin_amdgcn_global_load_lds((const unsigned*)((const char*)(gbase) + (voff)[_i]), (PG8_LAS unsigned*)(lds + (bufoff) + ldsw + _i * 8192), 16, 0, 0); } while (0)
#define PG8_LDA(dst, b, h) do { _Pragma("unroll") for (int m = 0; m < 4; ++m) _Pragma("unroll") for (int k = 0; k < 2; ++k) dst[m][k] = *(const PG8_LAS bf16x8*)(lds + PG8_SA(b, h) + aoff + m * 2048 + k * 1024); } while (0)
#define PG8_LDB(dst, b, h) do { _Pragma("unroll") for (int n = 0; n < 2; ++n) _Pragma("unroll") for (int k = 0; k < 2; ++k) dst[n][k] = *(const PG8_LAS bf16x8*)(lds + PG8_SB(b, h) + boff + n * 2048 + k * 1024); } while (0)
#define PG8_MMA(ai, bj, At, Bt) do { __builtin_amdgcn_s_setprio(1); _Pragma("unroll") for (int m = 0; m < 4; ++m) _Pragma("unroll") for (int n = 0; n < 2; ++n) _Pragma("unroll") for (int k = 0; k < 2; ++k) \
        acc[ai][bj][m][n] = __builtin_amdgcn_mfma_f32_16x16x32_bf16(Bt[n][k], At[m][k], acc[ai][bj][m][n], 0, 0, 0); __builtin_amdgcn_s_setprio(0); } while (0)
#define PG8_WAIT_V(n) asm volatile("s_waitcnt vmcnt(" #n ")" ::: "memory")
#define PG8_WAIT_L(n) asm volatile("s_waitcnt lgkmcnt(" #n ")" ::: "memory")
#define PG8_BAR __builtin_amdgcn_s_barrier()
#define PG8_SCHED __builtin_amdgcn_sched_barrier(0)
    Unit cur, nxt; int ui = 0;
    if (!S.next(0, cur)) return;
    f32x4 acc[2][2][4][2];
#pragma unroll
    for (int a = 0; a < 2; ++a)
#pragma unroll
        for (int b = 0; b < 2; ++b)
#pragma unroll
            for (int m = 0; m < 4; ++m)
#pragma unroll
                for (int n = 0; n < 2; ++n) acc[a][b][m][n] = (f32x4){0.f, 0.f, 0.f, 0.f};
    bf16x8 At[4][2], B0[2][2], B1[2][2];
    const char* cA = (const char*)g.A + (size_t)cur.pm * tstep; const char* cB = (const char*)g.Bt + (size_t)cur.pn * tstep;
    S.a_ready(cur);
    if constexpr (SP2) {
        PG8_STAGE(PG8_SB(0, 0), cB, voffB); PG8_STAGE(PG8_SB(0, 1), cB + hstep, voffB); PG8_STAGE(PG8_SA(0, 0), cA, voffA); PG8_STAGE(PG8_SA(0, 1), cA + hstep, voffA);
        if (wr == 1) PG8_BAR;
        PG8_WAIT_V(2); PG8_BAR;
        PG8_STAGE(PG8_SB(1, 0), cB + kstep, voffB); PG8_STAGE(PG8_SA(1, 0), cA + kstep, voffA); PG8_STAGE(PG8_SB(1, 1), cB + hstep + kstep, voffB);
        PG8_WAIT_V(6); PG8_BAR;
    } else {
        PG8_STAGE(PG8_SB(0, 0), cB, voffB); PG8_STAGE(PG8_SA(0, 0), cA, voffA); PG8_STAGE(PG8_SB(0, 1), cB + hstep, voffB); PG8_STAGE(PG8_SA(0, 1), cA + hstep, voffA);
        if (wr == 1) PG8_BAR;
        PG8_WAIT_V(4); PG8_BAR;
        PG8_STAGE(PG8_SB(1, 0), cB + kstep, voffB); PG8_STAGE(PG8_SA(1, 0), cA + kstep, voffA); PG8_STAGE(PG8_SB(1, 1), cB + hstep + kstep, voffB);
        PG8_WAIT_V(6); PG8_BAR;
    }
    for (;;) {
        const bool has_next = S.next(ui + 1, nxt);
        const char* nA = has_next ? (const char*)g.A + (size_t)nxt.pm * tstep : cA; const char* nB = has_next ? (const char*)g.Bt + (size_t)nxt.pn * tstep : cB;
        for (int t = 0; t < nt; t += 2) {
            const bool last = (t == nt - 2);
            const char* a1 = cA + (size_t)(t + 1) * kstep;
            const char* a2 = last ? nA : cA + (size_t)(t + 2) * kstep; const char* b2 = last ? nB : cB + (size_t)(t + 2) * kstep;
            const char* a3 = a2 + kstep; const char* b3 = b2 + kstep;
            if (last && has_next) S.a_ready(nxt);
            if constexpr (SP2) {
            PG8_LDB(B0, 0, 0); PG8_LDB(B1, 0, 1); PG8_SCHED; PG8_LDA(At, 0, 0); PG8_STAGE(PG8_SA(1, 1), a1 + hstep, voffA);
            PG8_WAIT_V(8); PG8_WAIT_L(0); PG8_BAR; PG8_MMA(0, 0, At, B0); PG8_MMA(0, 1, At, B1); PG8_BAR; PG8_SCHED;
            PG8_LDA(At, 0, 1); PG8_STAGE(PG8_SB(0, 0), b2, voffB); PG8_STAGE(PG8_SB(0, 1), b2 + hstep, voffB); PG8_STAGE(PG8_SA(0, 0), a2, voffA);
            PG8_WAIT_V(8); PG8_WAIT_L(0); PG8_BAR; PG8_MMA(1, 0, At, B0); PG8_MMA(1, 1, At, B1); PG8_BAR; PG8_SCHED;
            PG8_LDB(B0, 1, 0); PG8_LDB(B1, 1, 1); PG8_SCHED; PG8_LDA(At, 1, 0); PG8_STAGE(PG8_SA(0, 1), a2 + hstep, voffA);
            PG8_WAIT_V(8); PG8_WAIT_L(0); PG8_BAR; PG8_MMA(0, 0, At, B0); PG8_MMA(0, 1, At, B1); PG8_BAR; PG8_SCHED;
            PG8_LDA(At, 1, 1); PG8_STAGE(PG8_SB(1, 0), b3, voffB); PG8_STAGE(PG8_SB(1, 1), b3 + hstep, voffB); PG8_STAGE(PG8_SA(1, 0), a3, voffA);
            PG8_WAIT_V(8); PG8_WAIT_L(0); PG8_BAR; PG8_MMA(1, 0, At, B0); PG8_MMA(1, 1, At, B1); PG8_BAR; PG8_SCHED;
            } else {
            PG8_LDB(B0, 0, 0); PG8_SCHED; PG8_LDA(At, 0, 0); PG8_STAGE(PG8_SA(1, 1), a1 + hstep, voffA);
            PG8_WAIT_L(8); PG8_BAR; PG8_WAIT_L(0); PG8_MMA(0, 0, At, B0); PG8_BAR; PG8_SCHED;
            PG8_LDB(B1, 0, 1); PG8_STAGE(PG8_SB(0, 0), b2, voffB);
            PG8_BAR; PG8_WAIT_L(0); PG8_MMA(0, 1, At, B1); PG8_BAR;
            PG8_LDA(At, 0, 1); PG8_STAGE(PG8_SA(0, 0), a2, voffA);
            PG8_BAR; PG8_WAIT_L(0); PG8_MMA(1, 0, At, B0); PG8_BAR; PG8_SCHED;
            PG8_STAGE(PG8_SB(0, 1), b2 + hstep, voffB);
            PG8_WAIT_V(6); PG8_BAR; PG8_MMA(1, 1, At, B1); PG8_BAR;
            PG8_LDB(B0, 1, 0); PG8_SCHED; PG8_LDA(At, 1, 0); PG8_STAGE(PG8_SA(0, 1), a2 + hstep, voffA);
            PG8_WAIT_L(8); PG8_BAR; PG8_WAIT_L(0); PG8_MMA(0, 0, At, B0); PG8_BAR; PG8_SCHED;
            PG8_LDB(B1, 1, 1); PG8_STAGE(PG8_SB(1, 0), b3, voffB);
            PG8_BAR; PG8_WAIT_L(0); PG8_MMA(0, 1, At, B1); PG8_BAR;
            PG8_LDA(At, 1, 1); PG8_STAGE(PG8_SA(1, 0), a3, voffA);
            PG8_BAR; PG8_WAIT_L(0); PG8_MMA(1, 0, At, B0); PG8_BAR; PG8_SCHED;
            PG8_STAGE(PG8_SB(1, 1), b3 + hstep, voffB);
            PG8_WAIT_V(6); PG8_BAR; PG8_MMA(1, 1, At, B1); PG8_BAR;
            }
        }
        if constexpr (ALIGN_EPI) { if (wr == 0) PG8_BAR; }
        if constexpr (!Epi::AFTER_DRAIN) { E(acc, cur, wr, wc, fr, fq); S.done(cur); }
        if (!has_next) break;
#pragma unroll
        for (int a = 0; a < 2; ++a)
#pragma unroll
            for (int b = 0; b < 2; ++b)
#pragma unroll
                for (int m = 0; m < 4; ++m)
#pragma unroll
                    for (int n = 0; n < 2; ++n) acc[a][b][m][n] = (f32x4){0.f, 0.f, 0.f, 0.f};
        cur = nxt; cA = nA; cB = nB; ++ui;
        if constexpr (ALIGN_EPI) { if (wr == 1) PG8_BAR; }
    }
    PG8_WAIT_V(0);
    if constexpr (!ALIGN_EPI) { if (wr == 0) PG8_BAR; }
    PG8_BAR;
    if constexpr (Epi::AFTER_DRAIN) { E.fused(acc, cur, wr, wc, fr, fq, lds, wid, lane, tid); S.done(cur); }
#undef PG8_SA
#undef PG8_SB
#undef PG8_STAGE
#undef PG8_LDA
#undef PG8_LDB
#undef PG8_MMA
#undef PG8_WAIT_V
#undef PG8_WAIT_L
#undef PG8_BAR
#undef PG8_SCHED
}

typedef f32x4 Acc[2][2][4][2];

struct EpiIn0 {
    static constexpr bool PERM = true, AFTER_DRAIN = false;
    bf16_t* QD; bf16_t* KVD; float* XR; bf16_t* GT; float* out;
    __device__ __forceinline__ void operator()(const Acc& acc, const Unit& u, int wr, int wc, int fr, int fq) const {
        const int region = u.pn >> 1, cb = (u.pn & 1) * 256 + wc * 32 + 8 * fq;
#pragma unroll
        for (int ai = 0; ai < 2; ++ai)
#pragma unroll
            for (int m = 0; m < 4; ++m) {
                const int row = u.pm * BM + ai * HALF + wr * 64 + m * 16 + fr;
                const bool smp = row >= MP; const int b = smp ? (row - MP) >> 3 : row >> 12, t = smp ? (row - MP) & 7 : row & 4095;
#pragma unroll
                for (int bj = 0; bj < 2; ++bj) {
                    const int col = cb + bj * HALF; const f32x4 v0 = acc[ai][bj][m][0], v1 = acc[ai][bj][m][1];
                    if (region == 0) { *(bf16x8*)(QD + (size_t)row * 512 + col) = pack8(v0 * C_SCALE2, v1 * C_SCALE2); }
                    else if (region <= 2) { const int c = region - 1;
                        *(bf16x8*)(KVD + (size_t)row * 1024 + c * 512 + col) = pack8(v0, v1);
                        float* o = nullptr;
                        if (smp) o = out + O_DILS + ((size_t)(b * 2048 + 2040 + t) * 2 + c) * 512 + col;
                        else if (t >= 2048) o = out + O_DILP + ((size_t)(b * 2048 + t - 2048) * 2 + c) * 512 + col;
                        if (o) { *(f32x4*)o = v0; *(f32x4*)(o + 4) = v1; } }
                    else if (region == 3) { float* x = XR + (size_t)row * 512 + col; *(f32x4*)x = v0; *(f32x4*)(x + 4) = v1;
                        float* o = nullptr;
                        if (smp) { if (t >= 5) o = out + O_CONVS + (size_t)(b * 3 + t - 5) * 512 + col; }
                        else if (t >= SEQ - 3) o = out + O_CONVP + (size_t)(b * 3 + t - (SEQ - 3)) * 512 + col;
                        if (o) { *(f32x4*)o = v0; *(f32x4*)(o + 4) = v1; } }
                    else { *(bf16x8*)(GT + (size_t)row * 512 + col) = pack8(v0, v1); }
                }
            }
    }
};
}

#define XB_TMO      128
#define XB_XCNT(j)  (256  + 64 * (j))
#define XB_XSUB(j)  (1280 + 64 * (j))
#define XB_XGEN(j)  (2304 + 64 * (j))
#define XB_TOP      3328
#define XB_TOPGEN   3392
#define XCD_BAR_WORDS 3456
#define XB_SPIN_CAP (1u << 18)
__device__ __forceinline__ unsigned xb_ld(unsigned* p)              { return __hip_atomic_load(p, __ATOMIC_RELAXED, __HIP_MEMORY_SCOPE_AGENT); }
__device__ __forceinline__ unsigned xb_add(unsigned* p, unsigned v) { return __hip_atomic_fetch_add(p, v, __ATOMIC_RELAXED, __HIP_MEMORY_SCOPE_AGENT); }
__device__ __forceinline__ unsigned xb_xcc_id() { return (unsigned)__builtin_amdgcn_s_getreg((3 << 11) | 20) & 0xFu; }
#define XB_SPIN(cond, bar) do { unsigned _sp = 0; while (cond) { __builtin_amdgcn_s_sleep(1); \
    if ((++_sp & 255u) == 0u) { if (xb_ld(&(bar)[XB_TMO])) break; if (_sp > XB_SPIN_CAP) { atomicAdd(&(bar)[XB_TMO], 1u); break; } } } } while (0)
struct XcdBarrier { unsigned* bar; unsigned x; volatile LAS unsigned* st; };
__device__ __forceinline__ XcdBarrier xcd_barrier_post(unsigned* bar, volatile LAS unsigned* st) {
    XcdBarrier b; b.bar = bar; b.x = xb_xcc_id(); b.st = st;
    if (threadIdx.x == 0) (void)xb_add(&bar[XB_XCNT(b.x)], 1u);
    return b;
}
__device__ __forceinline__ void xcd_barrier_complete(unsigned* bar, unsigned x, unsigned& nloc, unsigned& nx) {
    const unsigned G = gridDim.x * gridDim.y * gridDim.z;
    unsigned sum, cnt, mine, sp = 0u;
    for (;;) {
        sum = 0u; cnt = 0u; mine = 0u;
#pragma unroll
        for (unsigned j = 0; j < 16; ++j) { const unsigned c = xb_ld(&bar[XB_XCNT(j)]); sum += c; cnt += (c > 0u) ? 1u : 0u; mine = (j == x) ? c : mine; }
        if (sum == G) break;
        __builtin_amdgcn_s_sleep(1);
        if ((++sp & 255u) == 0u) { if (xb_ld(&bar[XB_TMO])) break; if (sp > XB_SPIN_CAP) { atomicAdd(&bar[XB_TMO], 1u); break; } }
    }
    nloc = mine > 0u ? mine : 1u; nx = cnt > 0u ? cnt : 1u;
}
__device__ __forceinline__ void xcd_barrier(const XcdBarrier& b) {
    asm volatile("s_waitcnt vmcnt(0)" ::: "memory");
    __syncthreads();
    if (threadIdx.x == 0) {
        unsigned* bar = b.bar;
        __builtin_amdgcn_s_waitcnt(0);
        unsigned nloc = b.st[0], nx = b.st[1];
        if (nloc == 0u) { xcd_barrier_complete(bar, b.x, nloc, nx); b.st[0] = nloc; b.st[1] = nx; }
        const unsigned old = xb_add(&bar[XB_XSUB(b.x)], 1u);
        const unsigned gen = old / nloc;
        if (old + 1u == (gen + 1u) * nloc) {
            __builtin_amdgcn_fence(__ATOMIC_RELEASE, "agent");
            asm volatile("s_waitcnt vmcnt(0)" ::: "memory");
            const unsigned og = xb_add(&bar[XB_TOP], 1u);
            const unsigned tg = og / nx;
            if (og + 1u == (tg + 1u) * nx) xb_add(&bar[XB_TOPGEN], 1u);
            else XB_SPIN(xb_ld(&bar[XB_TOPGEN]) == tg, bar);
            __builtin_amdgcn_fence(__ATOMIC_ACQUIRE, "agent");
            xb_add(&bar[XB_XGEN(b.x)], 1u);
            asm volatile("s_waitcnt vmcnt(0)" ::: "memory");
        } else {
            XB_SPIN(xb_ld(&bar[XB_XGEN(b.x)]) == gen, bar);
            __builtin_amdgcn_fence(__ATOMIC_ACQUIRE, "agent");
            asm volatile("s_waitcnt vmcnt(0)" ::: "memory");
        }
    }
    __syncthreads();
}

__device__ __forceinline__ void subgrid_rendezvous(unsigned* cnt, unsigned n, unsigned* bar) {
    asm volatile("s_waitcnt vmcnt(0)" ::: "memory");
    __syncthreads();
    if (threadIdx.x == 0) {
        __builtin_amdgcn_fence(__ATOMIC_RELEASE, "agent");
        asm volatile("s_waitcnt vmcnt(0)" ::: "memory");
        (void)xb_add(cnt, 1u);
        XB_SPIN(xb_ld(cnt) < n, bar);
        __builtin_amdgcn_fence(__ATOMIC_ACQUIRE, "agent");
        asm volatile("s_waitcnt vmcnt(0)" ::: "memory");
    }
    __syncthreads();
}

struct Args { const void* in[28]; float* out; unsigned char* ws; int ph_lo, ph_hi; };
constexpr int NWAVES = 8;

struct Frame {
    LAS unsigned char* lds; LAS unsigned char* wscr;
    int tid, lane, wave, gw, NGW, G;
    unsigned char* ws; float* out; const Args* a;
};

__device__ __forceinline__ void transpose_item(const float* W, int K, int Nsrc, int Npad, bf16_t* WT, int mode, LAS float* scr, int item, int lane, const float* gk = nullptr) {
    const int nblk = Npad / 32, kb = item / nblk, nb = item % nblk, k0 = 64 * kb, n0 = 32 * nb;
    const int nn = n0 + (lane & 31);
    float v[32];
#pragma unroll
    for (int i = 0; i < 32; ++i) { const int kk = 2 * i + (lane >> 5); v[i] = nn < Nsrc ? __builtin_nontemporal_load(W + (size_t)(k0 + kk) * Nsrc + nn) : 0.f; }
#pragma unroll
    for (int i = 0; i < 32; ++i) { const int kk = 2 * i + (lane >> 5); scr[kk * 33 + (lane & 31)] = v[i]; }
    LDS_WAIT();
    const int c = lane & 7;
    f32x4 ga = {1.f, 1.f, 1.f, 1.f}, gb = ga;
    if (gk) { ga = *(const f32x4*)(gk + k0 + 8 * c); gb = *(const f32x4*)(gk + k0 + 8 * c + 4); }
#pragma unroll
    for (int j = 0; j < 4; ++j) { const int n = (lane >> 3) + 8 * j; const LAS float* s = scr + (8 * c) * 33 + n;
        u32x4 o; o.x = cvtpk(s[0 * 33] * ga.x, s[1 * 33] * ga.y); o.y = cvtpk(s[2 * 33] * ga.z, s[3 * 33] * ga.w); o.z = cvtpk(s[4 * 33] * gb.x, s[5 * 33] * gb.y); o.w = cvtpk(s[6 * 33] * gb.z, s[7 * 33] * gb.w);
        const int ng = n0 + n; const int drow = mode == 0 ? ng : ((ng >> 7) * 256 + (ng & 127) + (mode == 2 ? 128 : 0));
        *(u32x4*)(WT + (size_t)drow * K + k0 + 8 * c) = o; }
    LDS_WAIT();
}
__device__ __forceinline__ void rms_row_to_bf16(const float* xrow, const float* g, bf16_t* orow, int lane) {
    const f32x4* xr = (const f32x4*)xrow + lane; const f32x4* gr = (const f32x4*)g + lane;
    f32x4 v[4]; float s = 0.f;
#pragma unroll
    for (int j = 0; j < 4; ++j) { v[j] = __builtin_nontemporal_load(xr + 64 * j); s += (v[j].x * v[j].x + v[j].y * v[j].y) + (v[j].z * v[j].z + v[j].w * v[j].w); }
    const float rstd = 1.f / sqrtf(wave_sum(s) * (1.f / D) + EPS);
    u32x2* o8 = (u32x2*)orow + lane;
#pragma unroll
    for (int j = 0; j < 4; ++j) { const f32x4 gg = gr[64 * j]; u32x2 w; w.x = cvtpk(v[j].x * rstd * gg.x, v[j].y * rstd * gg.y); w.y = cvtpk(v[j].z * rstd * gg.z, v[j].w * rstd * gg.w); o8[64 * j] = w; }
}

__device__ __forceinline__ void rms_rows4_to_bf16(const float* x0, const float* x1, const float* x2, const float* x3, const float* g, bf16_t* o0, bf16_t* o1, bf16_t* o2, bf16_t* o3, int lane) {
    const float* xs[4] = {x0, x1, x2, x3}; bf16_t* os[4] = {o0, o1, o2, o3};
    f32x4 v[4][4]; float s[4];
#pragma unroll
    for (int q = 0; q < 4; ++q)
#pragma unroll
        for (int j = 0; j < 4; ++j) v[q][j] = __builtin_nontemporal_load((const f32x4*)xs[q] + lane + 64 * j);
    f32x4 gg[4];
#pragma unroll
    for (int j = 0; j < 4; ++j) gg[j] = *((const f32x4*)g + lane + 64 * j);
#pragma unroll
    for (int q = 0; q < 4; ++q) { float t = 0.f;
#pragma unroll
        for (int j = 0; j < 4; ++j) t += (v[q][j].x * v[q][j].x + v[q][j].y * v[q][j].y) + (v[q][j].z * v[q][j].z + v[q][j].w * v[q][j].w);
        s[q] = 1.f / sqrtf(wave_sum(t) * (1.f / D) + EPS); }
#pragma unroll
    for (int q = 0; q < 4; ++q)
#pragma unroll
        for (int j = 0; j < 4; ++j) { const float rstd = s[q]; u32x2 w; w.x = cvtpk(v[q][j].x * rstd * gg[j].x, v[q][j].y * rstd * gg[j].y); w.y = cvtpk(v[q][j].z * rstd * gg[j].z, v[q][j].w * rstd * gg[j].w);
            *((u32x2*)os[q] + lane + 64 * j) = w; }
}

constexpr int WT_IN0 = 16 * (AB_IN / 32), WT_O = 16 * (D / 32), WT_F = 16 * (FF / 32), WT_2 = (FF / 64) * (D / 32), WT_IN1 = 16 * (C_IN_PAD / 32);
constexpr int WT_T0 = WT_IN0, WT_T1 = WT_T0 + WT_O, WT_T2 = WT_T1 + WT_F, WT_T3 = WT_T2 + WT_F, WT_T4 = WT_T3 + WT_2, WT_T5 = WT_T4 + WT_IN1, WT_T6 = WT_T5 + WT_O, WT_T7 = WT_T6 + WT_F, WT_T8 = WT_T7 + WT_F, WT_T9 = WT_T8 + WT_2;
__device__ __forceinline__ void weight_transpose_item(const Frame& F, int it) {
    const Args& A = *F.a; LAS float* scr = (LAS float*)F.wscr; unsigned char* ws = F.ws; const int lane = F.lane;
    constexpr int T0 = WT_T0, T1 = WT_T1, T2 = WT_T2, T3 = WT_T3, T4 = WT_T4, T5 = WT_T5, T6 = WT_T6, T7 = WT_T7, T8 = WT_T8;
    {
        {
            const float* w1_0 = (const float*)A.in[25]; const float* w3_0 = (const float*)A.in[26]; const float* w2_0 = (const float*)A.in[27];
            if (it < T0) transpose_item((const float*)A.in[12], D, AB_IN, AB_IN, (bf16_t*)(ws + WS_WIN0), 0, scr, it, lane);
            else if (it < T1) transpose_item((const float*)A.in[13], D, D, D, (bf16_t*)(ws + WS_WOUT0), 0, scr, it - T0, lane);
            else if (it < T2) transpose_item(w1_0, D, FF, FF, (bf16_t*)(ws + WS_W13_0), 1, scr, it - T1, lane, (const float*)A.in[10]);
            else if (it < T3) transpose_item(w3_0, D, FF, FF, (bf16_t*)(ws + WS_W13_0), 2, scr, it - T2, lane, (const float*)A.in[10]);
            else if (it < T4) transpose_item(w2_0, FF, D, D, (bf16_t*)(ws + WS_W2_0), 0, scr, it - T3, lane);
            else if (it < T5) transpose_item((const float*)A.in[21], D, C_IN, C_IN_PAD, (bf16_t*)(ws + WS_WIN1), 0, scr, it - T4, lane, (const float*)A.in[9] + D);
            else if (it < T6) transpose_item((const float*)A.in[22], D, D, D, (bf16_t*)(ws + WS_WOUT1), 0, scr, it - T5, lane);
            else if (it < T7) transpose_item(w1_0 + (size_t)D * FF, D, FF, FF, (bf16_t*)(ws + WS_W13_1), 1, scr, it - T6, lane, (const float*)A.in[10] + D);
            else if (it < T8) transpose_item(w3_0 + (size_t)D * FF, D, FF, FF, (bf16_t*)(ws + WS_W13_1), 2, scr, it - T7, lane, (const float*)A.in[10] + D);
            else transpose_item(w2_0 + (size_t)FF * D, FF, D, D, (bf16_t*)(ws + WS_W2_1), 0, scr, it - T8, lane);
        }
    }
}
__device__ __forceinline__ void p0_prologue(const Frame& F) {
    const Args& A = *F.a;
    unsigned char* ws = F.ws;
    const int lane = F.lane;
    constexpr int X0 = WT_T4;
    constexpr int NMISC = 16 + 64 + 1;
    constexpr int R0 = X0 + NMISC;
    constexpr int NITEMS = R0 + M;
    for (int it = F.gw; it < NITEMS; it += F.NGW) {
        if (it < WT_T4) { weight_transpose_item(F, it);
        } else if (it < R0) {
            const int mi = it - X0;
            if (mi < 16) {
                const int mat = mi >> 3, n = mi & 7; const float* W = (const float*)A.in[mat ? 18 : 16] + (size_t)n * 4096;
                bf16_t* dst = (bf16_t*)(ws + WS_WG) + ((size_t)(mat * 8 + n) * 64 + lane) * 64;
#pragma unroll
                for (int k8 = 0; k8 < 8; ++k8) { const int d0 = k8 >> 1, h = k8 & 1; float v[8];
#pragma unroll
                    for (int jj = 0; jj < 8; ++jj) { const int i = 16 * d0 + 8 * (jj >> 2) + 4 * h + (jj & 3); v[jj] = W[i * 64 + lane]; }
                    u32x4 o; o.x = cvtpk(v[0], v[1]); o.y = cvtpk(v[2], v[3]); o.z = cvtpk(v[4], v[5]); o.w = cvtpk(v[6], v[7]);
                    *(u32x4*)(dst + 8 * k8) = o; }
            } else if (mi < 16 + 64) {
                const int lc = mi - 16, l = lc >> 1, c = lc & 1; const float* W = (const float*)A.in[23] + (size_t)(l * 2 + c) * 4096;
                bf16_t* dst = (bf16_t*)(ws + WS_WCT) + ((size_t)(c * 32 + l) * 4 * 2) * 512 + lane * 8;
                const int r32 = lane & 31, hi = lane >> 5;
                const float* P = (const float*)A.in[24] + (size_t)(l * 2 + c) * 64 + 8 * hi;
                float pt0 = 0.f, pt1 = 0.f;
#pragma unroll
                for (int k4 = 0; k4 < 4; ++k4) {
                    const f32x4 pa = *(const f32x4*)(P + 16 * k4), pb = *(const f32x4*)(P + 16 * k4 + 4);
#pragma unroll
                    for (int eh = 0; eh < 2; ++eh) { float v[8];
#pragma unroll
                        for (int j = 0; j < 8; ++j) v[j] = W[(16 * k4 + 8 * hi + j) * 64 + r32 + 32 * eh];
                        u32x4 o; o.x = cvtpk(v[0], v[1]); o.y = cvtpk(v[2], v[3]); o.z = cvtpk(v[4], v[5]); o.w = cvtpk(v[6], v[7]);
                        *(u32x4*)(dst + (size_t)(k4 * 2 + eh) * 512) = o;
                        const float t = ((pa.x * v[0] + pa.y * v[1]) + (pa.z * v[2] + pa.w * v[3])) + ((pb.x * v[4] + pb.y * v[5]) + (pb.z * v[6] + pb.w * v[7]));
                        if (eh) pt1 += t; else pt0 += t; }
                }
                pt0 += __shfl_xor(pt0, 32); pt1 += __shfl_xor(pt1, 32);
                ((float*)(ws + WS_PETP))[(size_t)(c * 32 + l) * 64 + lane] = hi ? pt1 : pt0;
            } else {
                const float* L = (const float*)A.in[20];
#pragma unroll
                for (int j = 0; j < 8; ++j) { const float z = -L[j * 64 + lane]; ((float*)(ws + WS_C8))[j * 64 + lane] = 8.f * (fmaxf(z, 0.f) + log1pf(expf(-fabsf(z)))); }
            }
        } else {
            const int r = it - R0;
#define XROW(r_) ((r_) < MP ? (const float*)A.in[0] + (size_t)(r_) * D : (const float*)A.in[1] + (size_t)((r_) - MP) * D)
#define OROW(r_) ((bf16_t*)(ws + WS_XN) + (size_t)(r_) * D)
            if (r + 3 * F.NGW < M) {
                rms_rows4_to_bf16(XROW(r), XROW(r + F.NGW), XROW(r + 2 * F.NGW), XROW(r + 3 * F.NGW), (const float*)A.in[9], OROW(r), OROW(r + F.NGW), OROW(r + 2 * F.NGW), OROW(r + 3 * F.NGW), lane);
                it += 3 * F.NGW;
            } else rms_row_to_bf16(XROW(r), (const float*)A.in[9], OROW(r), lane);
#undef XROW
#undef OROW
        }
    }
}
constexpr int NDC = BS * 255, NWC = BS * 32;
__device__ __forceinline__ void copy_item(const Frame& F, int ci) {
    const float* src; float* dst; const int lane = F.lane; bool half2 = true;
    if (ci < NDC) { const int b = ci / 255, ch = ci % 255; src = (const float*)F.a->in[2] + ((size_t)b * 2048 + 8) * 1024 + (size_t)ch * 8192; dst = F.out + O_DILS + (size_t)b * 2048 * 1024 + (size_t)ch * 8192; }
    else { const int c2 = ci - NDC, b = c2 >> 5, ch = c2 & 31; src = (const float*)F.a->in[5] + ((size_t)b * 512 + 8) * 512 + (size_t)ch * 8192; dst = F.out + O_WINS + (size_t)b * 512 * 512 + (size_t)ch * 8192; half2 = ch < 31; }
    f32x4 v[32];
#pragma unroll
    for (int j = 0; j < 16; ++j) v[j] = __builtin_nontemporal_load((const f32x4*)src + j * 64 + lane);
    if (half2) {
#pragma unroll
        for (int j = 16; j < 32; ++j) v[j] = __builtin_nontemporal_load((const f32x4*)src + j * 64 + lane); }
#pragma unroll
    for (int j = 0; j < 16; ++j) __builtin_nontemporal_store(v[j], (f32x4*)dst + j * 64 + lane);
    if (half2) {
#pragma unroll
        for (int j = 16; j < 32; ++j) __builtin_nontemporal_store(v[j], (f32x4*)dst + j * 64 + lane); }
}

namespace pg8 {
struct GatedOrder : StaticOrder {
    unsigned* flag; unsigned need; unsigned* bar;
    __device__ __forceinline__ void a_ready(const Unit& u) const {
        if (u.pm == MP / BM) {
            XB_SPIN(xb_ld(flag) < need, bar);
            __builtin_amdgcn_fence(__ATOMIC_ACQUIRE, "agent");
            asm volatile("s_waitcnt vmcnt(0)" ::: "memory");
        }
    }
};
__device__ __forceinline__ float row_rstd_q(const float* ssp, int row, int fq) {
    const f32x4 a = *(const f32x4*)(ssp + (size_t)row * 16 + fq * 4);
    float t = (a.x + a.y) + (a.z + a.w);
    { auto rr = __builtin_amdgcn_permlane16_swap(__float_as_uint(t), __float_as_uint(t), false, false); t = __uint_as_float(rr[0]) + __uint_as_float(rr[1]); }
    { auto rr = __builtin_amdgcn_permlane32_swap(__float_as_uint(t), __float_as_uint(t), false, false); t = __uint_as_float(rr[0]) + __uint_as_float(rr[1]); }
    return __builtin_amdgcn_rsqf(t * (1.f / D) + EPS);
}
__device__ __forceinline__ float row_rstd(const float* ssp, int row) {
    const f32x4* p = (const f32x4*)(ssp + (size_t)row * 16);
    const f32x4 a = p[0], b = p[1], c = p[2], d = p[3];
    const float s = ((a.x + a.y) + (a.z + a.w)) + ((b.x + b.y) + (b.z + b.w)) + ((c.x + c.y) + (c.z + c.w)) + ((d.x + d.y) + (d.z + d.w));
    return __builtin_amdgcn_rsqf(s * (1.f / D) + EPS);
}
__device__ __forceinline__ void unpack8(const bf16x8& v, f32x4& a, f32x4& b) {
    const u32x4 w = __builtin_bit_cast(u32x4, v);
    a = (f32x4){__uint_as_float(w.x << 16), __uint_as_float(w.x & 0xffff0000u), __uint_as_float(w.y << 16), __uint_as_float(w.y & 0xffff0000u)};
    b = (f32x4){__uint_as_float(w.z << 16), __uint_as_float(w.z & 0xffff0000u), __uint_as_float(w.w << 16), __uint_as_float(w.w & 0xffff0000u)};
}
template <bool RES_BF16, bool OUT_F32 = false>
struct EpiRes {
    static constexpr bool PERM = true, AFTER_DRAIN = false;
    const float* resF; bf16_t* Yb; float* Yf; float* ssp;
    __device__ __forceinline__ void operator()(const Acc& acc, const Unit& u, int wr, int wc, int fr, int fq) const {
        const int cb = u.pn * BM + wc * 32 + 8 * fq;
#pragma unroll
        for (int ai = 0; ai < 2; ++ai)
#pragma unroll
            for (int m = 0; m < 4; ++m) {
                const int row = u.pm * BM + ai * HALF + wr * 64 + m * 16 + fr;
                float ss = 0.f;
#pragma unroll
                for (int bj = 0; bj < 2; ++bj) {
                    const int col = cb + bj * HALF;
                    f32x4 r0, r1;
                    if (RES_BF16) unpack8(*(const bf16x8*)(Yb + (size_t)row * D + col), r0, r1);
                    else { r0 = *(const f32x4*)(resF + (size_t)row * D + col); r1 = *(const f32x4*)(resF + (size_t)row * D + col + 4); }
                    const f32x4 y0 = acc[ai][bj][m][0] + r0, y1 = acc[ai][bj][m][1] + r1;
                    if (OUT_F32) { float* yp = Yf + (size_t)row * D + col; *(f32x4*)yp = y0; *(f32x4*)(yp + 4) = y1; }
                    else *(bf16x8*)(Yb + (size_t)row * D + col) = pack8(y0, y1);
                    ss += (y0.x * y0.x + y0.y * y0.y) + (y0.z * y0.z + y0.w * y0.w) + (y1.x * y1.x + y1.y * y1.y) + (y1.z * y1.z + y1.w * y1.w);
                }
                ss += __shfl_xor(ss, 16); ss += __shfl_xor(ss, 32);
                if (fq == 0) ssp[(size_t)row * 16 + u.pn * 4 + wc] = ss;
            }
    }
};
struct EpiResNorm {
    static constexpr bool PERM = true, AFTER_DRAIN = true;
    const bf16_t* res; float* out; const float* gain; float* xslot; unsigned* cnt; unsigned* tmo;
    __device__ __forceinline__ void fused(Acc& acc, const Unit& u, int wr, int wc, int fr, int fq, PG8_LAS unsigned char* lds, int wid, int lane, int tid) const {
        PG8_LAS float* P = (PG8_LAS float*)lds;
        PG8_LAS float* S = (PG8_LAS float*)(lds + 4096);
        const int cb = u.pn * BM + wc * 32 + 8 * fq;
#pragma unroll
        for (int am = 0; am < 4; ++am) {
            const int ai = am >> 1, m0 = (am & 1) * 2;
            f32x4 r[2][2][2];
#pragma unroll
            for (int mm = 0; mm < 2; ++mm) { const bf16_t* rp = res + (size_t)(u.pm * BM + ai * HALF + wr * 64 + (m0 + mm) * 16 + fr) * D;
#pragma unroll
                for (int bj = 0; bj < 2; ++bj) unpack8(*(const bf16x8*)(rp + cb + bj * HALF), r[mm][bj][0], r[mm][bj][1]); }
#pragma unroll
            for (int mm = 0; mm < 2; ++mm) { const int m = m0 + mm; float ss = 0.f;
#pragma unroll
                for (int bj = 0; bj < 2; ++bj)
#pragma unroll
                    for (int n = 0; n < 2; ++n) { const f32x4 y = acc[ai][bj][m][n] + r[mm][bj][n]; acc[ai][bj][m][n] = y; ss += (y.x * y.x + y.y * y.y) + (y.z * y.z + y.w * y.w); }
                ss += __shfl_xor(ss, 16); ss += __shfl_xor(ss, 32);
                if (fq == 0) P[(ai * HALF + wr * 64 + m * 16 + fr) * 4 + wc] = ss; }
        }
        asm volatile("s_waitcnt lgkmcnt(0)" ::: "memory"); __builtin_amdgcn_s_barrier(); asm volatile("" ::: "memory");
        if (tid < 256) { const float t = (P[tid * 4 + 0] + P[tid * 4 + 1]) + (P[tid * 4 + 2] + P[tid * 4 + 3]);
            __hip_atomic_store((unsigned*)xslot + ((size_t)(u.pm * BM + tid) * 4 + u.pn), __float_as_uint(t), __ATOMIC_RELAXED, __HIP_MEMORY_SCOPE_AGENT); }
        asm volatile("s_waitcnt vmcnt(0)" ::: "memory");
        if (lane == 0) __hip_atomic_fetch_add(cnt + 64 * u.pm, 1u, __ATOMIC_RELAXED, __HIP_MEMORY_SCOPE_AGENT);
        if (wid == 0) {
            unsigned spins = 0;
            while ((unsigned)__builtin_amdgcn_readfirstlane(__hip_atomic_load(cnt + 64 * u.pm, __ATOMIC_RELAXED, __HIP_MEMORY_SCOPE_AGENT)) < 32u) {
                __builtin_amdgcn_s_sleep(2); if (++spins > (1u << 22)) { if (lane == 0) atomicAdd(tmo, 1u); break; } }
            __builtin_amdgcn_fence(__ATOMIC_ACQUIRE, "agent");
        }
        asm volatile("s_waitcnt vmcnt(0) lgkmcnt(0)" ::: "memory"); __builtin_amdgcn_s_barrier(); asm volatile("" ::: "memory");
        if (tid < 256) { const unsigned* sl = (const unsigned*)xslot + (size_t)(u.pm * BM + tid) * 4; float t = 0.f;
#pragma unroll
            for (int k = 0; k < 4; ++k) t += __uint_as_float(__hip_atomic_load(sl + k, __ATOMIC_RELAXED, __HIP_MEMORY_SCOPE_AGENT));
            S[tid] = __builtin_amdgcn_rsqf(t * (1.f / D) + EPS); }
        asm volatile("s_waitcnt lgkmcnt(0)" ::: "memory"); __builtin_amdgcn_s_barrier(); asm volatile("" ::: "memory");
        f32x4 g[2][2];
#pragma unroll
        for (int bj = 0; bj < 2; ++bj) { g[bj][0] = *(const f32x4*)(gain + cb + bj * HALF); g[bj][1] = *(const f32x4*)(gain + cb + bj * HALF + 4); }
#pragma unroll
        for (int ai = 0; ai < 2; ++ai)
#pragma unroll
            for (int m = 0; m < 4; ++m) { const int rl = ai * HALF + wr * 64 + m * 16 + fr; const float rs = S[rl]; float* op = out + (size_t)(u.pm * BM + rl) * D + cb;
#pragma unroll
                for (int bj = 0; bj < 2; ++bj) { *(f32x4*)(op + bj * HALF) = acc[ai][bj][m][0] * rs * g[bj][0]; *(f32x4*)(op + bj * HALF + 4) = acc[ai][bj][m][1] * rs * g[bj][1]; } }
        asm volatile("s_waitcnt lgkmcnt(0)" ::: "memory"); __builtin_amdgcn_s_barrier(); asm volatile("" ::: "memory");
    }
};
struct EpiSlab {
    static constexpr bool PERM = true, AFTER_DRAIN = false;
    float* slab;
    __device__ __forceinline__ void operator()(const Acc& acc, const Unit& u, int wr, int wc, int fr, int fq) const {
        const int cb = u.pn * BM + wc * 32 + 8 * fq;
#pragma unroll
        for (int ai = 0; ai < 2; ++ai)
#pragma unroll
            for (int m = 0; m < 4; ++m) { float* rp = slab + (size_t)(ai * HALF + wr * 64 + m * 16 + fr) * D;
#pragma unroll
                for (int bj = 0; bj < 2; ++bj) { *(f32x4*)(rp + cb + bj * HALF) = acc[ai][bj][m][0]; *(f32x4*)(rp + cb + bj * HALF + 4) = acc[ai][bj][m][1]; } }
    }
};
struct EpiUp {
    static constexpr bool PERM = true, AFTER_DRAIN = false;
    const float* ssp; bf16_t* H;
    __device__ __forceinline__ void operator()(const Acc& acc, const Unit& u, int wr, int wc, int fr, int fq) const {
        const int col = u.pn * HALF + wc * 32 + 8 * fq;
#pragma unroll
        for (int ai = 0; ai < 2; ++ai)
#pragma unroll
            for (int m = 0; m < 4; ++m) {
                const int row = u.pm * BM + ai * HALF + wr * 64 + m * 16 + fr;
                const float rs = row_rstd_q(ssp, row, fq);
                f32x4 h[2];
#pragma unroll
                for (int n = 0; n < 2; ++n) {
                    const f32x4 a = acc[ai][0][m][n] * rs, b = acc[ai][1][m][n] * rs;
#pragma unroll
                    for (int e = 0; e < 4; ++e) h[n][e] = a[e] * b[e] * __builtin_amdgcn_rcpf(1.f + __expf(-a[e]));
                }
                *(bf16x8*)(H + (size_t)row * FF + col) = pack8(h[0], h[1]);
            }
    }
};
struct EpiIn1 {
    static constexpr bool PERM = true, AFTER_DRAIN = false;
    const float* ssp; bf16_t* Q1; bf16_t* KVSEL; bf16_t* KVWIN; float* G1; float* out;
    __device__ __forceinline__ void operator()(const Acc& acc, const Unit& u, int wr, int wc, int fr, int fq) const {
        const int pn = u.pn;
#pragma unroll
        for (int ai = 0; ai < 2; ++ai)
#pragma unroll
            for (int m = 0; m < 4; ++m) {
                const int row = u.pm * BM + ai * HALF + wr * 64 + m * 16 + fr;
                const float rs = row_rstd_q(ssp, row, fq);
                const bool smp = row >= MP; const int b = smp ? (row - MP) >> 3 : row >> 12, t = smp ? (row - MP) & 7 : row & 4095;
#pragma unroll
                for (int bj = 0; bj < 2; ++bj) {
                    const int lc = bj * HALF + wc * 32 + 8 * fq;
                    const f32x4 v0 = acc[ai][bj][m][0] * rs, v1 = acc[ai][bj][m][1] * rs;
                    if (pn < 4) { *(bf16x8*)(Q1 + (size_t)row * D + pn * 256 + lc) = pack8(v0 * C_SCALE2, v1 * C_SCALE2); }
                    else if (pn < 6) { const int col = (pn - 4) * 256 + lc;
                        float* o = smp ? out + O_CMPS + (size_t)(row - MP) * 512 + col : out + O_CMPP + (size_t)row * 512 + col;
                        *(f32x4*)o = v0; *(f32x4*)(o + 4) = v1; }
                    else if (pn < 8) { const int col = (pn - 6) * 256 + lc;
                        float* o = smp ? out + O_SELS + (size_t)(row - MP) * 512 + col : out + O_SELP + (size_t)row * 512 + col;
                        *(f32x4*)o = v0; *(f32x4*)(o + 4) = v1;
                        if (!smp) *(bf16x8*)(KVSEL + (size_t)row * 512 + col) = pack8(v0, v1); }
                    else if (pn < 10) { const int col = (pn - 8) * 256 + lc;
                        if (!smp) *(bf16x8*)(KVWIN + (size_t)row * 512 + col) = pack8(v0, v1);
                        float* o = nullptr;
                        if (smp) o = out + O_WINS + (size_t)(b * 512 + 504 + t) * 512 + col;
                        else if (t >= SEQ - WIN) o = out + O_WINP + (size_t)(b * 512 + t - (SEQ - WIN)) * 512 + col;
                        if (o) { *(f32x4*)o = v0; *(f32x4*)(o + 4) = v1; } }
                    else { if (lc < 48) { f32x4 s0, s1;
#pragma unroll
                            for (int e = 0; e < 4; ++e) { s0[e] = __builtin_amdgcn_rcpf(1.f + __expf(-v0[e])); s1[e] = __builtin_amdgcn_rcpf(1.f + __expf(-v1[e])); }
                            float* o = G1 + (size_t)row * 48 + lc; *(f32x4*)o = s0; *(f32x4*)(o + 4) = s1; } }
                }
            }
    }
};
}

template <typename T> struct Src;
template <> struct Src<bf16_t> { typedef bf16x8 raw;
    static __device__ __forceinline__ raw ld(const bf16_t* p) { return *(const bf16x8*)p; }
    static __device__ __forceinline__ bf16x8 cv(const raw& r) { return r; } };
template <> struct Src<float> { struct raw { f32x4 a, b; };
    static __device__ __forceinline__ raw ld(const float* p) { raw r; r.a = *(const f32x4*)p; r.b = *(const f32x4*)(p + 4); return r; }
    static __device__ __forceinline__ bf16x8 cv(const raw& r) { return pack8(r.a, r.b); } };

constexpr int VT_MT = 2112;
constexpr float NEG_INF = -__builtin_inff();
struct AttnAcc { f32x16 o0, o1; float m, l; };
__device__ __forceinline__ void acc_init(AttnAcc& A) {
#pragma unroll
    for (int r = 0; r < 16; ++r) { A.o0[r] = 0.f; A.o1[r] = 0.f; }
    A.m = NEG_INF; A.l = 0.f;
}
__device__ __forceinline__ float swap32_max(float v) { auto rr = __builtin_amdgcn_permlane32_swap(__float_as_uint(v), __float_as_uint(v), false, false); return fmaxf(__uint_as_float(rr[0]), __uint_as_float(rr[1])); }
__device__ __forceinline__ float swap32_sum(float v) { auto rr = __builtin_amdgcn_permlane32_swap(__float_as_uint(v), __float_as_uint(v), false, false); return __uint_as_float(rr[0]) + __uint_as_float(rr[1]); }
__device__ __forceinline__ int crow(int r, int hi) { return (r & 3) + 8 * (r >> 2) + 4 * hi; }
typedef short v4i16_t __attribute__((ext_vector_type(4)));
__device__ __forceinline__ s16x4 vtr(const LAS unsigned char* p) { return __builtin_bit_cast(s16x4, __builtin_amdgcn_ds_read_tr16_b64_v4i16((LAS v4i16_t*)p)); }

struct VFrag { s16x4 lo[4], hh[4]; };
__device__ __forceinline__ void vt_read(VFrag& f, const LAS unsigned char* vb) {
#pragma unroll
    for (int mt = 0; mt < 2; ++mt)
#pragma unroll
        for (int ks = 0; ks < 2; ++ks) { f.lo[mt * 2 + ks] = vtr(vb + mt * VT_MT + ks * 1024); f.hh[mt * 2 + ks] = vtr(vb + mt * VT_MT + ks * 1024 + 512); }
}
__device__ __forceinline__ void pv_tile(f32x16& o0, f32x16& o1, const VFrag& f, bf16x8 pf0, bf16x8 pf1) {
#define VFR(i) (bf16x8){f.lo[i][0], f.lo[i][1], f.lo[i][2], f.lo[i][3], f.hh[i][0], f.hh[i][1], f.hh[i][2], f.hh[i][3]}
    __builtin_amdgcn_s_setprio(1);
    o0 = __builtin_amdgcn_mfma_f32_32x32x16_bf16(VFR(0), pf0, o0, 0, 0, 0);
    o0 = __builtin_amdgcn_mfma_f32_32x32x16_bf16(VFR(1), pf1, o0, 0, 0, 0);
    o1 = __builtin_amdgcn_mfma_f32_32x32x16_bf16(VFR(2), pf0, o1, 0, 0, 0);
    o1 = __builtin_amdgcn_mfma_f32_32x32x16_bf16(VFR(3), pf1, o1, 0, 0, 0);
    __builtin_amdgcn_s_setprio(0);
#undef VFR
}
__device__ __forceinline__ bf16x8 pack_p(const f32x16& p, int base) {
    u32x4 w; w.x = cvtpk(p[base + 0], p[base + 1]); w.y = cvtpk(p[base + 2], p[base + 3]); w.z = cvtpk(p[base + 4], p[base + 5]); w.w = cvtpk(p[base + 6], p[base + 7]);
    return __builtin_bit_cast(bf16x8, w);
}

constexpr float RESC_THR = 6.f;
constexpr int KT_OFF = 4352;
struct NoHook { __device__ __forceinline__ void operator()(int, const f32x16&) const {} };
template <typename T, int MODE, int VOFF, int PFD = 1, class RP, class MK, class HK = NoHook>
__device__ __forceinline__ void attn_run(AttnAcc& A, const bf16x8 (&qf)[4], int t_begin, int t_end, LAS unsigned char* vt, int lane, RP rp, MK mk, HK hk = HK()) {
    if (t_begin >= t_end) return;
    const int r32 = lane & 31, hi = lane >> 5, vkey = lane >> 3, vch = lane & 7;
    LAS unsigned char* vdst = vt + (vch >> 2) * VT_MT + vkey * 64 + (vch & 3) * 16;
    const LAS unsigned char* vb = vt + ((lane >> 4) & 1) * 32 + (lane & 3) * 8 + (4 * hi + ((lane & 15) >> 2)) * 64;
    LAS unsigned char* kt = vt + KT_OFF;
    const int kswz_w = (vkey >> 1) & 3;
    const LAS unsigned char* krd = kt + r32 * 128; const int kswz_r = (r32 >> 1) & 7;
    typedef typename Src<T>::raw raw_t;
    auto loads = [&](raw_t (&kr)[4], raw_t (&vr)[4], int tt) {
#pragma unroll
        for (int i = 0; i < 4; ++i) { const T* p_ = rp(tt, vkey + 8 * i) + 8 * vch; kr[i] = Src<T>::ld(p_); if (MODE != 1) vr[i] = Src<T>::ld(p_ + VOFF); } };
    auto tile = [&](int t, raw_t (&kr)[4], raw_t (&vr)[4], int tnext) {
        asm volatile("" ::: "memory");
#pragma unroll
        for (int i = 0; i < 4; ++i) {
            *(LAS bf16x8*)(kt + (vkey + 8 * i) * 128 + ((vch ^ (kswz_w | ((i & 1) << 2))) * 16)) = Src<T>::cv(kr[i]);
            if (MODE != 1) *(LAS bf16x8*)(vdst + i * 512) = Src<T>::cv(vr[i]);
        }
        if (tnext >= t_begin) loads(kr, vr, tnext);
        asm volatile("s_waitcnt lgkmcnt(0)" ::: "memory");
        bf16x8 kf[4];
#pragma unroll
        for (int d0 = 0; d0 < 4; ++d0) kf[d0] = *(const LAS bf16x8*)(krd + (((2 * d0 + hi) ^ kswz_r) * 16));
        VFrag vf;
        if (MODE != 1) { vt_read(vf, vb); __builtin_amdgcn_sched_barrier(0); }
        f32x16 s;
#pragma unroll
        for (int r = 0; r < 16; ++r) s[r] = 0.f;
        __builtin_amdgcn_s_setprio(1);
#pragma unroll
        for (int d0 = 0; d0 < 4; ++d0) s = __builtin_amdgcn_mfma_f32_32x32x16_bf16(kf[d0], qf[d0], s, 0, 0, 0);
        __builtin_amdgcn_s_setprio(0);
        if (MODE == 2) {
            mk(t, s, -A.m);
#pragma unroll
            for (int r = 0; r < 16; ++r) s[r] = __builtin_amdgcn_exp2f(s[r]) * A.l;
            hk(t, s);
        } else {
            const bool first = A.m == NEG_INF;
            mk(t, s, first ? 0.f : -A.m);
            float tm = fmaxf(fmaxf(s[0], s[1]), fmaxf(s[2], s[3]));
#pragma unroll
            for (int r = 4; r < 16; r += 4) tm = fmaxf(tm, fmaxf(fmaxf(s[r], s[r + 1]), fmaxf(s[r + 2], s[r + 3])));
            tm = swap32_max(tm);
            if (__any(first ? tm > NEG_INF : tm > RESC_THR)) {
                const float up = first ? tm : fmaxf(tm, 0.f);
                const float alpha = first ? 0.f : __builtin_amdgcn_exp2f(-up);
                A.l *= alpha; A.m = first ? up : A.m + up;
                const float sh = (up == NEG_INF) ? 0.f : up;
#pragma unroll
                for (int r = 0; r < 16; ++r) s[r] -= sh;
                if (MODE == 0) {
#pragma unroll
                    for (int r = 0; r < 16; ++r) { A.o0[r] *= alpha; A.o1[r] *= alpha; } }
            }
            float ps = 0.f;
#pragma unroll
            for (int r = 0; r < 16; ++r) { s[r] = __builtin_amdgcn_exp2f(s[r]); ps += s[r]; }
            A.l += swap32_sum(ps);
        }
        if (MODE != 1) {
            const bf16x8 pf0 = pack_p(s, 0), pf1 = pack_p(s, 8);
            pv_tile(A.o0, A.o1, vf, pf0, pf1);
        }
        asm volatile("" ::: "memory");
    };
    raw_t krA[4], vrA[4];
    int t = t_end - 1;
    loads(krA, vrA, t);
    if (PFD == 2) {
        raw_t krB[4], vrB[4];
        if (t - 1 >= t_begin) loads(krB, vrB, t - 1);
        while (t >= t_begin) {
            tile(t, krA, vrA, t - 2);
            if (t - 1 < t_begin) break;
            tile(t - 1, krB, vrB, t - 3);
            t -= 2;
        }
    } else {
        for (; t >= t_begin; --t) tile(t, krA, vrA, t - 1);
    }
}
template <int KS, int CHECK>
__device__ __forceinline__ void bias_mask(f32x16& s, float dq, float nslope2, float lo, float hi_, int hi, float base = 0.f) {
    const float dq2 = dq - (float)(KS * 4 * hi);
#pragma unroll
    for (int r = 0; r < 16; ++r) {
        const float d = dq2 - (float)(KS * ((r & 3) + 8 * (r >> 2)));
        float x = __builtin_fmaf(d, nslope2, s[r] + base);
        asm volatile("" : "+v"(x));
        if (CHECK == 1) { const bool ok = (d >= lo) & (d <= hi_); s[r] = ok ? x : NEG_INF; } else if (CHECK == 2) { s[r] = d >= lo ? x : NEG_INF; } else s[r] = x;
    }
}

__device__ __forceinline__ void store_o(bf16_t* orow, const f32x16& o0, const f32x16& o1, float sc, int hi) {
#pragma unroll
    for (int i = 0; i < 4; ++i) {
        u32x2 w; w.x = cvtpk(o0[4 * i] * sc, o0[4 * i + 1] * sc); w.y = cvtpk(o0[4 * i + 2] * sc, o0[4 * i + 3] * sc); *(u32x2*)(orow + 8 * i + 4 * hi) = w;
        u32x2 x; x.x = cvtpk(o1[4 * i] * sc, o1[4 * i + 1] * sc); x.y = cvtpk(o1[4 * i + 2] * sc, o1[4 * i + 3] * sc); *(u32x2*)(orow + 32 + 8 * i + 4 * hi) = x;
    }
}

__device__ __forceinline__ void dil_item_prompt(const Frame& F, int item) {
    const int lane = F.lane, r32 = lane & 31, hi = lane >> 5;
    const int j = item & 7, blk = (item >> 3) & 15, h = (item >> 7) & 7, b = item >> 10;
    const int q0 = blk * 256 + j, q = q0 + 8 * r32;
    const bf16_t* QD = (const bf16_t*)(F.ws + WS_QD); const bf16_t* KVD = (const bf16_t*)(F.ws + WS_KVD);
    const size_t rb = (size_t)b * SEQ;
    bf16x8 qf[4];
#pragma unroll
    for (int d0 = 0; d0 < 4; ++d0) qf[d0] = *(const bf16x8*)(QD + (rb + q) * 512 + h * 64 + 16 * d0 + 8 * hi);
    const float nslope2 = -__builtin_amdgcn_exp2f(-(float)(h + 1)) * LOG2E; const bool par = (r32 & 1) != 0;
    const bf16_t* Kb = KVD + rb * 1024 + h * 64;
    AttnAcc A; acc_init(A);
    LAS unsigned char* vt = F.wscr;
#define DIL_BRANCH(ST, K0, NT, WINDOW, PAR) do { \
        const int need_ = -(K0) - 31 - q0 / (ST); const int tb_ = need_ <= 0 ? 0 : (need_ + 31) >> 5; \
        auto rp = [&](int t, int key) -> const bf16_t* { int pos = q0 + (ST) * ((K0) + 32 * t + key); pos = pos < 0 ? 0 : (pos > SEQ - 1 ? SEQ - 1 : pos); return Kb + (size_t)pos * 1024; }; \
        auto mk = [&](int t, f32x16& s, float sh) { \
            const int tb = q0 + (ST) * ((K0) + 32 * t);                      \
            const float dq = (float)(q - tb); const float lim = fminf((float)(WINDOW), (float)q); \
            bias_mask<(ST), true>(s, dq, nslope2, 0.f, lim, hi, sh); \
            if (PAR) { _Pragma("unroll") for (int r = 0; r < 16; ++r) { const bool keep = (r & 1) ? par : !par; s[r] = keep ? s[r] : NEG_INF; } } }; \
        attn_run<bf16_t, 0, 512, 2>(A, qf, tb_, (NT), vt, lane, rp, mk); } while (0)
    DIL_BRANCH(1, -128, 12, 128, false);
    DIL_BRANCH(4, -128, 6, 512, false);
    DIL_BRANCH(8, -256, 9, 2048, true);
#undef DIL_BRANCH
    const float inv = 1.f / fmaxf(A.l, 1e-30f);
    store_o((bf16_t*)(F.ws + WS_O) + (rb + q) * D + h * 64, A.o0, A.o1, inv, hi);
}
__device__ __forceinline__ void dil_item_sample(const Frame& F, int item) {
    const int lane = F.lane, hi = lane >> 5, qi = lane & 7;
    const int h = item & 7, b = item >> 3;
    const size_t row = (size_t)MP + b * 8 + qi;
    const bf16_t* QD = (const bf16_t*)(F.ws + WS_QD);
    bf16x8 qf[4];
#pragma unroll
    for (int d0 = 0; d0 < 4; ++d0) qf[d0] = *(const bf16x8*)(QD + row * 512 + h * 64 + 16 * d0 + 8 * hi);
    const float slope2 = __builtin_amdgcn_exp2f(-(float)(h + 1)) * LOG2E;
    const float* cache = (const float*)F.a->in[2] + (size_t)b * 2048 * 1024 + h * 64;
    const float* newr = F.out + O_DILS + (size_t)b * 2048 * 1024 + h * 64;
    AttnAcc A; acc_init(A);
    LAS unsigned char* vt = F.wscr;
    auto geom = [&](int t, int& sh, int& pos0, int& tt, int& cls) { if (t < 5) { sh = 0; cls = 0; tt = t; pos0 = 1920; } else if (t < 25) { sh = 2; cls = (t - 5) / 5; tt = (t - 5) - 5 * cls; pos0 = 1536 + cls; } else { sh = 4; cls = (t - 25) / 5; tt = (t - 25) - 5 * cls; pos0 = cls; } };
    auto rowp = [&](int t, int key) -> const float* { int sh, pos0, tt, cls; geom(t, sh, pos0, tt, cls); int c = pos0 + ((32 * tt + key) << sh); c = c > 2055 ? 2055 : c; return c < 2048 ? cache + (size_t)c * 1024 : newr + (size_t)(c - 8) * 1024; };
    auto mk = [&](int t, f32x16& s, float shf) {
        int sh, pos0, tt, cls; geom(t, sh, pos0, tt, cls);
        const bool ok2 = sh == 0 ? true : (sh == 2 ? (qi & 3) == cls : qi == cls);
        const float dq = (float)(((2048 + qi - pos0) >> sh) - 32 * tt);
        bias_mask<1, true>(s, dq, -slope2 * (float)(1 << sh), 0.f, 128.f, hi, ok2 ? shf : NEG_INF); };
    attn_run<float, 0, 512>(A, qf, 0, 65, vt, lane, rowp, mk);
    const float inv = 1.f / fmaxf(A.l, 1e-30f);
    if ((lane & 31) < 8) store_o((bf16_t*)(F.ws + WS_O) + row * D + h * 64, A.o0, A.o1, inv, hi);
}

template <bool SAMPLE>
__device__ __forceinline__ void rglru_gates_item(const Frame& F, int item) {
    const int lane = F.lane, r32 = lane & 31, hi = lane >> 5;
    const int n = item & 7, tile = item >> 3;
    const int b = SAMPLE ? tile : tile >> 7, t = SAMPLE ? (r32 < 8 ? r32 : 7) : ((tile & 127) * 32 + r32);
    const size_t rowbase = SAMPLE ? (size_t)MP + b * 8 : (size_t)b * SEQ;
    const float* XR = (const float*)(F.ws + WS_XR);
    const float* cw = (const float*)F.a->in[14]; const float* cbias = (const float*)F.a->in[15];
    const float* sconv = (const float*)F.a->in[3] + (size_t)b * 3 * 512;
    const int ch0 = 64 * n + 4 * hi;
    f32x4 xc[8];
#pragma unroll
    for (int a = 0; a < 8; ++a) {
        const int ch = ch0 + 8 * a;
        f32x4 acc = *(const f32x4*)(cbias + ch);
#pragma unroll
        for (int k = 0; k < 4; ++k) {
            const int tau = t + k - 3;
            const float* xp = XR + (rowbase + (tau >= 0 ? tau : 0)) * 512 + ch;
            if (SAMPLE) xp = tau >= 0 ? xp : sconv + (3 + tau) * 512 + ch;
            f32x4 x = *(const f32x4*)xp;
            const float keep = (SAMPLE || tau >= 0) ? 1.f : 0.f;
            acc += x * (*(const f32x4*)(cw + k * 512 + ch) * keep);
        }
        xc[a] = acc;
        if (a & 1) __builtin_amdgcn_sched_barrier(0);
    }
    bf16x8 xb[4];
#pragma unroll
    for (int d0 = 0; d0 < 4; ++d0) xb[d0] = pack8(xc[2 * d0], xc[2 * d0 + 1]);
    const bf16_t* WG = (const bf16_t*)(F.ws + WS_WG);
    const float* ba = (const float*)F.a->in[17]; const float* bx = (const float*)F.a->in[19]; const float* c8 = (const float*)(F.ws + WS_C8);
    float* AU = (float*)(F.ws + WS_AU) + (rowbase + t) * 1024;
    const bool valid = !SAMPLE || r32 < 8;
#pragma unroll
    for (int mt = 0; mt < 2; ++mt) {
        f32x16 ga, gx;
#pragma unroll
        for (int r = 0; r < 16; ++r) { ga[r] = 0.f; gx[r] = 0.f; }
#pragma unroll
        for (int d0 = 0; d0 < 4; ++d0) {
            const bf16x8 wa = *(const bf16x8*)(WG + ((size_t)(0 * 8 + n) * 64 + r32 + 32 * mt) * 64 + 16 * d0 + 8 * hi);
            const bf16x8 wx = *(const bf16x8*)(WG + ((size_t)(1 * 8 + n) * 64 + r32 + 32 * mt) * 64 + 16 * d0 + 8 * hi);
            ga = __builtin_amdgcn_mfma_f32_32x32x16_bf16(wa, xb[d0], ga, 0, 0, 0);
            gx = __builtin_amdgcn_mfma_f32_32x32x16_bf16(wx, xb[d0], gx, 0, 0, 0);
        }
#pragma unroll
        for (int a4 = 0; a4 < 4; ++a4) {
            const int a = 4 * mt + a4, ch = ch0 + 8 * a, rb = a4 * 4;
            const f32x4 vba = *(const f32x4*)(ba + ch), vbx = *(const f32x4*)(bx + ch), vc8 = *(const f32x4*)(c8 + ch);
            f32x4 av, uv;
#pragma unroll
            for (int e = 0; e < 4; ++e) {
                const float rg = __builtin_amdgcn_rcpf(1.f + __expf(-(ga[rb + e] + vba[e])));
                const float ig = __builtin_amdgcn_rcpf(1.f + __expf(-(gx[rb + e] + vbx[e])));
                const float la = -rg * vc8[e];
                av[e] = __expf(la);
                uv[e] = __builtin_amdgcn_sqrtf(fmaxf(1.f - av[e] * av[e], 0.f)) * ig * xc[a][e];
            }
            if (valid) { *(f32x4*)(AU + ch) = av; *(f32x4*)(AU + 512 + ch) = uv; }
            if (!SAMPLE) {
#pragma unroll
                for (int sft = 1; sft < 32; sft <<= 1) {
                    const bool upper = (r32 & sft) != 0;
#pragma unroll
                    for (int e = 0; e < 4; ++e) {
                        const float pa = __shfl_xor(av[e], sft), pu = __shfl_xor(uv[e], sft);
                        const float nu = upper ? av[e] * pu + uv[e] : pa * uv[e] + pu;
                        av[e] = av[e] * pa; uv[e] = nu;
                    }
                }
                if (r32 == 0) { float* ag = (float*)(F.ws + WS_AGG) + (size_t)tile * 1024; *(f32x4*)(ag + ch) = av; *(f32x4*)(ag + 512 + ch) = uv; }
            }
            __builtin_amdgcn_sched_barrier(0);
        }
    }
}
__device__ __forceinline__ float gelu_tanh(float x) { const float z = 0.7978845608028654f * (x + 0.044715f * x * x * x); const float e = __expf(2.f * z); return 0.5f * x * (2.f - 2.f * __builtin_amdgcn_rcpf(e + 1.f)); }
template <bool SAMPLE>
__device__ __forceinline__ void rglru_scan_item(const Frame& F, int item) {
    const int lane = F.lane, n = item & 7, tile = item >> 3;
    const int b = SAMPLE ? tile : tile >> 6, tt = SAMPLE ? 0 : 2 * (tile & 63);
    const int ch = 64 * n + lane;
    constexpr int NT = SAMPLE ? 8 : 32;
    const size_t row0 = SAMPLE ? (size_t)MP + b * 8 : (size_t)b * SEQ + tt * 32;
    const float* AU = (const float*)(F.ws + WS_AU) + row0 * 1024 + ch; const bf16_t* GT = (const bf16_t*)(F.ws + WS_GT) + row0 * 512 + ch;
    bf16_t* O = (bf16_t*)(F.ws + WS_O) + row0 * D + 512 + ch;
    float av[NT], uv[NT], gv[NT];
#pragma unroll
    for (int i = 0; i < NT; ++i) { av[i] = AU[(size_t)i * 1024]; uv[i] = AU[(size_t)i * 1024 + 512]; gv[i] = bf2f(GT[(size_t)i * 512]); }
    float h;
    if (SAMPLE) h = ((const float*)F.a->in[4])[b * 512 + ch];
    else { h = 0.f; const float* ag = (const float*)(F.ws + WS_AGG) + (size_t)(b * 128) * 1024 + ch;
        int c = 0;
        for (; c + 32 <= tt; c += 32) { float pa[32], ph[32];
#pragma unroll
            for (int k = 0; k < 32; ++k) { pa[k] = ag[(size_t)(c + k) * 1024]; ph[k] = ag[(size_t)(c + k) * 1024 + 512]; }
#pragma unroll
            for (int k = 0; k < 32; ++k) h = pa[k] * h + ph[k]; }
        if (c < tt) { float pa[32], ph[32];
#pragma unroll
            for (int k = 0; k < 32; ++k) { const int cc = c + k < tt ? c + k : 0; pa[k] = ag[(size_t)cc * 1024]; ph[k] = ag[(size_t)cc * 1024 + 512]; }
#pragma unroll
            for (int k = 0; k < 32; ++k) { const bool on = c + k < tt; h = on ? pa[k] * h + ph[k] : h; } }
    }
    float y[NT];
#pragma unroll
    for (int i = 0; i < NT; ++i) { h = av[i] * h + uv[i]; y[i] = h * gelu_tanh(gv[i]); }
    if (!SAMPLE) {
        const float* AU2 = AU + (size_t)32 * 1024; const bf16_t* GT2 = GT + (size_t)32 * 512;
#pragma unroll
        for (int i = 0; i < NT; ++i) { av[i] = AU2[(size_t)i * 1024]; uv[i] = AU2[(size_t)i * 1024 + 512]; gv[i] = bf2f(GT2[(size_t)i * 512]); }
#pragma unroll
        for (int i = 0; i < NT; ++i) O[(size_t)i * D] = (bf16_t)(cvtpk(y[i], 0.f) & 0xffffu);
#pragma unroll
        for (int i = 0; i < NT; ++i) { h = av[i] * h + uv[i]; y[i] = h * gelu_tanh(gv[i]); }
        O += (size_t)32 * D;
    }
#pragma unroll
    for (int i = 0; i < NT; ++i) O[(size_t)i * D] = (bf16_t)(cvtpk(y[i], 0.f) & 0xffffu);
    if (SAMPLE) F.out[O_RNNS + b * 512 + ch] = h;
    else if (tt == 126) F.out[O_RNNP + b * 512 + ch] = h;
}

template <bool SAMPLE, bool SPLIT = false>
__device__ __forceinline__ void compress_item(const Frame& F, int item) {
    const int lane = F.lane, r32 = lane & 31, hi = lane >> 5;
    constexpr int NTL = SAMPLE ? 64 : 32, NC = SAMPLE ? NCS : NCP;
    const int c = item & 1, nt = (item >> 1) % NTL, b = (item >> 1) / NTL;
    const int lg = lane >> 4, lch = lane & 15;
    const int* pt = (const int*)F.a->in[8] + b * NPG;
    const float* rbase[9];
#pragma unroll
    for (int j = 0; j < 9; ++j) { int ch = nt * 8 + j; ch = ch < NC ? ch : NC;
        if (SAMPLE) { const int pg = pt[ch >> 3]; rbase[j] = (const float*)F.a->in[6] + ((size_t)pg * PAGE + (ch & 7) * 16) * 512 + c * 256 + lane * 4; }
        else rbase[j] = F.out + O_CMPP + ((size_t)b * SEQ + ch * 16) * 512 + c * 256 + lane * 4; }
    const bf16_t* WF = (const bf16_t*)(F.ws + WS_WCT) + (size_t)c * 32 * 4 * 2 * 512 + lane * 8;
    LAS unsigned char* xt = F.wscr;
    f32x4 xr[9], xq[9];
#define CMP_LOAD(X, l_) do { _Pragma("unroll") for (int j = 0; j < 9; ++j) X[j] = SAMPLE ? __builtin_nontemporal_load((const f32x4*)(rbase[j] + (size_t)(l_) * 512)) : *(const f32x4*)(rbase[j] + (size_t)(l_) * 512); } while (0)
#define CMP_STEP(X, l_, NEXT_OK, lnext_) do { \
        LAS unsigned char* img = xt + ((l_) & 1) * 4608; \
        _Pragma("unroll") for (int j = 0; j < 9; ++j) { const int q = 4 * j + lg; u32x2 w; w.x = cvtpk(X[j][0], X[j][1]); w.y = cvtpk(X[j][2], X[j][3]); \
            *(LAS u32x2*)(img + q * 128 + (((lch >> 1) ^ ((q >> 1) & 7)) * 16) + (lch & 1) * 8) = w; } \
        if (NEXT_OK) CMP_LOAD(X, lnext_); \
        asm volatile("s_waitcnt lgkmcnt(0)" ::: "memory"); \
        _Pragma("unroll") for (int k4 = 0; k4 < 4; ++k4) { \
            const bf16x8 x0 = *(const LAS bf16x8*)(img + r32 * 128 + (((2 * k4 + hi) ^ ((r32 >> 1) & 7)) * 16)); \
            const bf16x8 x1 = *(const LAS bf16x8*)(img + (r32 + 4) * 128 + (((2 * k4 + hi) ^ (((r32 + 4) >> 1) & 7)) * 16)); \
            const bf16x8 w0 = *(const bf16x8*)(WF + (size_t)(((l_) * 4 + k4) * 2 + 0) * 512), w1 = *(const bf16x8*)(WF + (size_t)(((l_) * 4 + k4) * 2 + 1) * 512); \
            const bf16x8 w2 = *(const bf16x8*)(WF + (size_t)((((l_) + 16) * 4 + k4) * 2 + 0) * 512), w3 = *(const bf16x8*)(WF + (size_t)((((l_) + 16) * 4 + k4) * 2 + 1) * 512); \
            a0 = __builtin_amdgcn_mfma_f32_32x32x16_bf16(w0, x0, a0, 0, 0, 0); \
            a1 = __builtin_amdgcn_mfma_f32_32x32x16_bf16(w1, x0, a1, 0, 0, 0); \
            a0 = __builtin_amdgcn_mfma_f32_32x32x16_bf16(w2, x1, a0, 0, 0, 0); \
            a1 = __builtin_amdgcn_mfma_f32_32x32x16_bf16(w3, x1, a1, 0, 0, 0); } \
        asm volatile("" ::: "memory"); } while (0)
    f32x16 a0, a1;
#pragma unroll
    for (int r = 0; r < 16; ++r) { a0[r] = 0.f; a1[r] = 0.f; }
    const int l0 = SPLIT ? 2 * F.wave : 0, l1 = SPLIT ? l0 + 2 : 16;
    CMP_LOAD(xr, l0); CMP_LOAD(xq, l0 + 1);
    for (int l = l0; l < l1; l += 2) {
        CMP_STEP(xr, l, l + 2 < l1, l + 2);
        CMP_STEP(xq, l + 1, l + 3 < l1, l + 3);
    }
#undef CMP_STEP
#undef CMP_LOAD
    if (SPLIT) {
        constexpr int PART = 9216;
        LAS f32x4* mine = (LAS f32x4*)(F.wscr + PART);
#pragma unroll
        for (int i = 0; i < 4; ++i) { mine[i * 64 + lane] = (f32x4){a0[4 * i], a0[4 * i + 1], a0[4 * i + 2], a0[4 * i + 3]}; mine[(4 + i) * 64 + lane] = (f32x4){a1[4 * i], a1[4 * i + 1], a1[4 * i + 2], a1[4 * i + 3]}; }
        __syncthreads();
        {
            const int me = F.wave;
            for (int w = 0; w < NWAVES; ++w) { if (w == me) continue; const LAS f32x4* p = (const LAS f32x4*)(F.lds + w * WSCR + PART);
#pragma unroll
                for (int i = 0; i < 4; ++i) { const f32x4 u = p[i * 64 + lane], v = p[(4 + i) * 64 + lane];
                    a0[4 * i] += u.x; a0[4 * i + 1] += u.y; a0[4 * i + 2] += u.z; a0[4 * i + 3] += u.w; a1[4 * i] += v.x; a1[4 * i + 1] += v.y; a1[4 * i + 2] += v.z; a1[4 * i + 3] += v.w; } }
        }
        __syncthreads();
    }
    const int n = nt * 8 + (r32 >> 2), g = r32 & 3;
    if (n < NC && (!SPLIT || F.wave == 0)) {
        const float* pe = (const float*)(F.ws + WS_PET) + c * 64;
        bf16_t* o = SAMPLE ? (bf16_t*)(F.ws + WS_KCS) + ((size_t)(b * 512 + n) * 2 + c) * 256 + g * 64 : (bf16_t*)(F.ws + WS_KCP) + ((size_t)(b * 256 + n) * 2 + c) * 256 + g * 64;
#pragma unroll
        for (int i = 0; i < 4; ++i) {
            const int e0 = 8 * i + 4 * hi; const f32x4 p0 = *(const f32x4*)(pe + e0), p1 = *(const f32x4*)(pe + 32 + e0);
            u32x2 w; w.x = cvtpk(a0[4 * i] + p0.x, a0[4 * i + 1] + p0.y); w.y = cvtpk(a0[4 * i + 2] + p0.z, a0[4 * i + 3] + p0.w); *(u32x2*)(o + e0) = w;
            u32x2 x; x.x = cvtpk(a1[4 * i] + p1.x, a1[4 * i + 1] + p1.y); x.y = cvtpk(a1[4 * i + 2] + p1.z, a1[4 * i + 3] + p1.w); *(u32x2*)(o + 32 + e0) = x;
        }
    }
}

constexpr int WS_IMP = 8448, WS_SELM = WS_IMP + 8 * 132 * 4, WS_BLIST = WS_SELM + 8 * 4 * 8, WS_OT = 13568, WS_PT = WS_OT + 4096;
static_assert(KT_OFF + 4096 <= WS_IMP && WS_BLIST + 132 * 4 <= WS_OT && WS_PT + 256 <= WSCR, "per-wave scratch map");
template <bool SAMPLE>
__device__ __forceinline__ void nsa_item(const Frame& F, int item) {
    typedef typename std::conditional<SAMPLE, float, bf16_t>::type KT;
    const int lane = F.lane, r32 = lane & 31, hi = lane >> 5, qi = r32 >> 2, r = r32 & 3;
    const int g = item & 3, qt = SAMPLE ? 0 : (item >> 2) & 511, b = SAMPLE ? item >> 2 : item >> 11;
    const int t0 = 8 * qt, qp = SAMPLE ? PAST + qi : t0 + qi, qp_max = SAMPLE ? PAST + 7 : t0 + 7;
    const size_t row = SAMPLE ? (size_t)MP + b * 8 + qi : (size_t)b * SEQ + t0 + qi;
    const int head = 4 * g + r;
    const float nslope2 = -__builtin_amdgcn_exp2f(-0.5f * (float)(head + 1)) * LOG2E;
    const bf16_t* Q1 = (const bf16_t*)(F.ws + WS_Q1);
    bf16x8 qf[4];
#pragma unroll
    for (int d0 = 0; d0 < 4; ++d0) qf[d0] = *(const bf16x8*)(Q1 + row * D + head * 64 + 16 * d0 + 8 * hi);
    const float* gp = (const float*)(F.ws + WS_G1) + row * 48 + head * 3;
    const float g_cmp = gp[0], g_sel = gp[1], g_win = gp[2];
    LAS unsigned char* vt = F.wscr;
    LAS float* imp = (LAS float*)(F.wscr + WS_IMP);
    LAS unsigned long long* selm = (LAS unsigned long long*)(F.wscr + WS_SELM);
    LAS int* blist = (LAS int*)(F.wscr + WS_BLIST);
    constexpr int NC = SAMPLE ? NCS : NCP, NCH = SAMPLE ? 3 : 1;
    LAS u32x2* otl = (LAS u32x2*)(F.wscr + WS_OT) + lane;
    for (int i = lane; i < 8 * 132; i += 64) imp[i] = 0.f;

    const bf16_t* KC = SAMPLE ? (const bf16_t*)(F.ws + WS_KCS) + (size_t)b * 512 * 512 + g * 64 : (const bf16_t*)(F.ws + WS_KCP) + (size_t)b * 256 * 512 + g * 64;
    const int ncv = qp_max >= 31 ? (((qp_max - 31) >> 4) + 1 < NC ? ((qp_max - 31) >> 4) + 1 : NC) : 0;
    const int nct = (ncv + 31) >> 5;
    auto rpc = [&](int t, int key) -> const bf16_t* { int n = 32 * t + key; n = n < NC ? n : NC - 1; return KC + (size_t)n * 512; };
    auto mkc = [&](int t, f32x16& s, float sh) { bias_mask<16, 2>(s, (float)(qp - 31 - 512 * t), nslope2, 0.f, 1e30f, hi, sh); };
    AttnAcc A; acc_init(A);
    attn_run<bf16_t, 1, 256>(A, qf, 0, nct, vt, lane, rpc, mkc);
    {
        A.m = (A.m == NEG_INF) ? 0.f : A.m; A.l = A.l > 0.f ? 1.f / A.l : 0.f;
        auto hkc = [&](int t, const f32x16& p) {
#pragma unroll
            for (int i = 0; i < 4; ++i) {
                float p3 = p[4 * i + 3]; float a = 2.f * ((p[4 * i] + p[4 * i + 1]) + p[4 * i + 2]) + p3;
                a += __shfl_xor(a, 1); a += __shfl_xor(a, 2); p3 += __shfl_xor(p3, 1); p3 += __shfl_xor(p3, 2);
                if (r == 0) { const int J = 8 * t + 2 * i + hi; __hip_atomic_fetch_add(&imp[J * 8 + qi], a, __ATOMIC_RELAXED, __HIP_MEMORY_SCOPE_WORKGROUP); __hip_atomic_fetch_add(&imp[(J + 1) * 8 + qi], p3, __ATOMIC_RELAXED, __HIP_MEMORY_SCOPE_WORKGROUP); }
            } };
        attn_run<bf16_t, 2, 256>(A, qf, 0, nct, vt, lane, rpc, mkc, hkc);
#pragma unroll
        for (int j = 0; j < 4; ++j) {
            u32x2 w; w.x = cvtpk(A.o0[4 * j] * g_cmp, A.o0[4 * j + 1] * g_cmp); w.y = cvtpk(A.o0[4 * j + 2] * g_cmp, A.o0[4 * j + 3] * g_cmp); otl[64 * j] = w;
            u32x2 x; x.x = cvtpk(A.o1[4 * j] * g_cmp, A.o1[4 * j + 1] * g_cmp); x.y = cvtpk(A.o1[4 * j + 2] * g_cmp, A.o1[4 * j + 3] * g_cmp); otl[64 * (4 + j)] = x; }
    }
    asm volatile("s_waitcnt lgkmcnt(0)" ::: "memory");
    const int cb = qp_max >> 6;
    for (int idx = lane; idx < 8 * (cb + 1); idx += 64) { const int j = idx >> 3; if (j == 0 || j >= cb - 1) imp[idx] += 1000.f; }
    asm volatile("s_waitcnt lgkmcnt(0)" ::: "memory");
    {
        f32x4 sj[NCH][2]; int rank[NCH][8];
#pragma unroll
        for (int c2 = 0; c2 < NCH; ++c2) { int j = lane + 64 * c2; j = j <= cb ? j : cb; sj[c2][0] = *(const LAS f32x4*)(imp + j * 8); sj[c2][1] = *(const LAS f32x4*)(imp + j * 8 + 4);
#pragma unroll
            for (int q = 0; q < 8; ++q) rank[c2][q] = 0; }
#pragma unroll 2
        for (int i = 0; i <= cb; ++i) {
            const f32x4 v0 = *(const LAS f32x4*)(imp + i * 8), v1 = *(const LAS f32x4*)(imp + i * 8 + 4);
#pragma unroll
            for (int c2 = 0; c2 < NCH; ++c2) { const bool lower = i < lane + 64 * c2;
#pragma unroll
                for (int q = 0; q < 8; ++q) { const float vi = q < 4 ? v0[q & 3] : v1[q & 3], vj = q < 4 ? sj[c2][0][q & 3] : sj[c2][1][q & 3];
                    rank[c2][q] += ((vi > vj) | ((vi == vj) & lower)) ? 1 : 0; } }
        }
#pragma unroll
        for (int c2 = 0; c2 < NCH; ++c2) { const bool cand = lane + 64 * c2 <= cb;
#pragma unroll
            for (int q = 0; q < 8; ++q) { const unsigned long long mask = __ballot(cand && rank[c2][q] < 16); if (lane == 0) selm[q * 4 + c2] = mask; } }
    }
    asm volatile("s_waitcnt lgkmcnt(0)" ::: "memory");
    unsigned long long mym0 = 0ull, mym1 = 0ull, mym2 = 0ull; int nblk = 0;
#pragma unroll
    for (int c2 = 0; c2 < NCH; ++c2) { const unsigned long long mine = selm[qi * 4 + c2]; unsigned long long u = 0;
        if (c2 == 0) mym0 = mine; else if (c2 == 1) mym1 = mine; else mym2 = mine;
#pragma unroll
        for (int q = 0; q < 8; ++q) u |= selm[q * 4 + c2];
        const int j = lane + 64 * c2; const bool in = (u >> lane) & 1ull;
        const int pos = nblk + __popcll(u & ((1ull << lane) - 1ull));
        if (in) blist[pos] = j;
        nblk += __popcll(u); }
    asm volatile("s_waitcnt lgkmcnt(0)" ::: "memory");
    nblk = __builtin_amdgcn_readfirstlane(nblk);
    {
        const KT* sbase; LAS int* pt = (LAS int*)(F.wscr + WS_PT);
        if constexpr (SAMPLE) { pt[lane] = ((const int*)F.a->in[8])[b * NPG + lane]; asm volatile("s_waitcnt lgkmcnt(0)" ::: "memory"); }
        if constexpr (SAMPLE) sbase = (const float*)F.a->in[7] + g * 64; else sbase = (const bf16_t*)(F.ws + WS_KVSEL) + (size_t)b * SEQ * 512 + g * 64;
        const float* snew = F.out + O_SELS + (size_t)b * 8 * 512 + g * 64;
        auto rps = [&](int t, int key) -> const KT* {
            const int J = blist[t >> 1]; const int tok = 64 * J + 32 * (t & 1) + key;
            if constexpr (SAMPLE) { const int tk = tok < PAST ? tok : PAST - 1; const int pg = pt[tk >> 7]; const KT* p0 = sbase + ((size_t)pg * PAGE + (tk & 127)) * 512;
                int i2 = tok - PAST; i2 = i2 < 0 ? 0 : (i2 > 7 ? 7 : i2); const KT* p1 = (const KT*)(snew + (size_t)i2 * 512); return tok < PAST ? p0 : p1; }
            else return sbase + (size_t)tok * 512; };
        auto mks = [&](int t, f32x16& s, float sh) {
            const int J = blist[t >> 1]; bool sel = (mym0 >> (J & 63)) & 1ull; if constexpr (SAMPLE) { const bool s1 = (mym1 >> (J & 63)) & 1ull, s2 = (mym2 >> (J & 63)) & 1ull; sel = J < 64 ? sel : (J < 128 ? s1 : s2); } const int tb = 64 * J + 32 * (t & 1);
            const float base = sel ? sh : NEG_INF, dq = (float)(qp - tb);
            if (J < cb) bias_mask<1, false>(s, dq, nslope2, 0.f, 0.f, hi, base);
            else bias_mask<1, 2>(s, dq, nslope2, 0.f, 1e30f, hi, base); };
        acc_init(A);
        attn_run<KT, 0, 256, SAMPLE ? 1 : 2>(A, qf, 0, 2 * nblk, vt, lane, rps, mks);
        const float sc = g_sel / fmaxf(A.l, 1e-30f);
#pragma unroll
        for (int j = 0; j < 4; ++j) {
            const u32x2 a = otl[64 * j], c = otl[64 * (4 + j)];
            u32x2 w; w.x = cvtpk(A.o0[4 * j] * sc + __uint_as_float(a.x << 16), A.o0[4 * j + 1] * sc + __uint_as_float(a.x & 0xffff0000u)); w.y = cvtpk(A.o0[4 * j + 2] * sc + __uint_as_float(a.y << 16), A.o0[4 * j + 3] * sc + __uint_as_float(a.y & 0xffff0000u)); otl[64 * j] = w;
            u32x2 x; x.x = cvtpk(A.o1[4 * j] * sc + __uint_as_float(c.x << 16), A.o1[4 * j + 1] * sc + __uint_as_float(c.x & 0xffff0000u)); x.y = cvtpk(A.o1[4 * j + 2] * sc + __uint_as_float(c.y << 16), A.o1[4 * j + 3] * sc + __uint_as_float(c.y & 0xffff0000u)); otl[64 * (4 + j)] = x; }
    }
    {
        acc_init(A);
        if constexpr (SAMPLE) {
            const float* wc = (const float*)F.a->in[5] + (size_t)b * 512 * 512 + g * 64; const float* wn = F.out + O_WINS + (size_t)b * 512 * 512 + g * 64;
            auto rpw = [&](int t, int key) -> const float* { int c = 32 * t + key; c = c > 519 ? 519 : c; return c < 512 ? wc + (size_t)c * 512 : wn + (size_t)(c - 8) * 512; };
            auto mkw = [&](int t, f32x16& s, float sh) { bias_mask<1, true>(s, (float)(512 + qi - 32 * t), nslope2, 0.f, (float)WIN, hi, sh); };
            attn_run<float, 0, 256>(A, qf, 0, 17, vt, lane, rpw, mkw);
        } else {
            const bf16_t* wb = (const bf16_t*)(F.ws + WS_KVWIN) + (size_t)b * SEQ * 512 + g * 64;
            const int tlo = (t0 - WIN > 0 ? t0 - WIN : 0) >> 5, thi = (t0 + 7) >> 5;
            auto rpw = [&](int t, int key) -> const bf16_t* { return wb + (size_t)(32 * t + key) * 512; };
            auto mkw = [&](int t, f32x16& s, float sh) { const float dq = (float)(qp - 32 * t);
                if (32 * t + 31 <= t0 && 32 * t >= t0 + 7 - WIN) bias_mask<1, false>(s, dq, nslope2, 0.f, 0.f, hi, sh);
                else bias_mask<1, true>(s, dq, nslope2, 0.f, (float)WIN, hi, sh); };
            attn_run<bf16_t, 0, 256, 2>(A, qf, tlo, thi + 1, vt, lane, rpw, mkw);
        }
        const float sc = g_win / fmaxf(A.l, 1e-30f);
#pragma unroll
        for (int j = 0; j < 4; ++j) { const u32x2 a = otl[64 * j], c = otl[64 * (4 + j)];
            A.o0[4 * j] = A.o0[4 * j] * sc + __uint_as_float(a.x << 16); A.o0[4 * j + 1] = A.o0[4 * j + 1] * sc + __uint_as_float(a.x & 0xffff0000u);
            A.o0[4 * j + 2] = A.o0[4 * j + 2] * sc + __uint_as_float(a.y << 16); A.o0[4 * j + 3] = A.o0[4 * j + 3] * sc + __uint_as_float(a.y & 0xffff0000u);
            A.o1[4 * j] = A.o1[4 * j] * sc + __uint_as_float(c.x << 16); A.o1[4 * j + 1] = A.o1[4 * j + 1] * sc + __uint_as_float(c.x & 0xffff0000u);
            A.o1[4 * j + 2] = A.o1[4 * j + 2] * sc + __uint_as_float(c.y << 16); A.o1[4 * j + 3] = A.o1[4 * j + 3] * sc + __uint_as_float(c.y & 0xffff0000u); }
    }
    store_o((bf16_t*)(F.ws + WS_O) + row * D + head * 64, A.o0, A.o1, 1.f, hi);
}

__device__ __forceinline__ void final_norm_row(float* y, const float* ssp, const float* g, int row, int lane) {
    const float rs = pg8::row_rstd(ssp, row);
    f32x4* yr = (f32x4*)(y + (size_t)row * D) + lane; const f32x4* gr = (const f32x4*)g + lane;
#pragma unroll
    for (int j = 0; j < 4; ++j) { const f32x4 v = yr[64 * j], gg = gr[64 * j]; yr[64 * j] = v * rs * gg; }
}

template <bool FINAL>
__device__ __forceinline__ void sample_finalize_row(const float* slab, int ns, const float* res, float* Y, bf16_t* Aout, const float* gain, float* ssp, int r, int lane) {
    f32x4 y[4]; float ss = 0.f;
#pragma unroll
    for (int j = 0; j < 4; ++j) y[j] = *((const f32x4*)(res + (size_t)r * D) + lane + 64 * j);
    for (int sl = 0; sl < ns; ++sl) {
#pragma unroll
        for (int j = 0; j < 4; ++j) y[j] += *((const f32x4*)(slab + ((size_t)sl * MS + r) * D) + lane + 64 * j); }
#pragma unroll
    for (int j = 0; j < 4; ++j) ss += (y[j].x * y[j].x + y[j].y * y[j].y) + (y[j].z * y[j].z + y[j].w * y[j].w);
    ss = wave_sum(ss);
    if (FINAL) { const float rs = 1.f / sqrtf(ss * (1.f / D) + EPS);
#pragma unroll
        for (int j = 0; j < 4; ++j) *((f32x4*)(Y + (size_t)r * D) + lane + 64 * j) = y[j] * rs * *((const f32x4*)gain + lane + 64 * j); }
    else {
#pragma unroll
        for (int j = 0; j < 4; ++j) { *((f32x4*)(Y + (size_t)r * D) + lane + 64 * j) = y[j];
            u32x2 w; w.x = cvtpk(y[j].x, y[j].y); w.y = cvtpk(y[j].z, y[j].w); *((u32x2*)(Aout + (size_t)r * D) + lane + 64 * j) = w; }
        if (lane < 16) ssp[(size_t)(MP + r) * 16 + lane] = lane == 0 ? ss : 0.f; }
}
__device__ __forceinline__ unsigned q_issue(unsigned* ctr, int lane) { unsigned v = 0u; if (lane == 0) v = __hip_atomic_fetch_add(ctr, 1u, __ATOMIC_RELAXED, __HIP_MEMORY_SCOPE_AGENT); return v; }
__device__ __forceinline__ int q_item(unsigned tk, int shard) { return (int)__builtin_amdgcn_readfirstlane(tk) * 8 + shard; }
constexpr int N_PHASES = 17;
#ifndef ONE_LAUNCH
#define ONE_LAUNCH 1
#endif
#define PH_BEGIN \
    const Args* ap_ = &args; size_t z_ = 0; asm volatile("" : "+s"(z_)); \
    Frame F; F.lds = (LAS unsigned char*)lds_raw; F.tid = threadIdx.x; F.lane = F.tid & 63; F.wave = __builtin_amdgcn_readfirstlane(F.tid >> 6); \
    F.G = gridDim.x; { const int vcu_ = (F.G % 8 == 0) ? ((int)blockIdx.x % 8) * (F.G / 8) + (int)blockIdx.x / 8 : (int)blockIdx.x; F.gw = vcu_ * NWAVES + F.wave; } F.NGW = F.G * NWAVES; \
    F.wscr = F.lds + F.wave * WSCR; F.ws = ap_->ws + z_; F.out = ap_->out + z_; F.a = ap_; \
    unsigned char* ws = F.ws; float* out = F.out; unsigned* ctl = (unsigned*)(ws + WS_CTL); float* ssp = (float*)(ws + WS_SSP); \
    const float* norm_mix = (const float*)ap_->in[9] + z_; const float* norm_ffn = (const float*)ap_->in[10] + z_; const float* norm_out = (const float*)ap_->in[11] + z_; \
    (void)ctl; (void)ssp; (void)norm_mix; (void)norm_ffn; (void)norm_out; (void)out;
__global__ void __launch_bounds__(NWAVES * 64, 2) fwd(Args args) {
    extern __shared__ __attribute__((aligned(16))) unsigned char lds_raw[];
    volatile LAS unsigned* MISC = (volatile LAS unsigned*)((LAS unsigned char*)lds_raw + MISC_OFF);
    if (threadIdx.x < 16) MISC[threadIdx.x] = 0u;
    __syncthreads();
    const int lo = args.ph_lo, hi = args.ph_hi;
    const bool multi = (hi - lo) > 1;
    if (multi) (void)xcd_barrier_post((unsigned*)(args.ws + WS_CTL) + CW_BAR, MISC);
#ifndef ONLY_PHASE
#define ONLY_PHASE -1
#endif
#define IN(k) ((ONLY_PHASE < 0 || ONLY_PHASE == (k)) && lo <= (k) && (k) < hi)
#define SEAM(k) do { if (IN(k) && IN((k) + 1)) { XcdBarrier bar_; bar_.bar = (unsigned*)(args.ws + WS_CTL) + CW_BAR; bar_.x = xb_xcc_id(); bar_.st = MISC; xcd_barrier(bar_); } } while (0)

#define GEMM_N1024(Aptr, Wptr, KFULL, RESF, RBF16) do { \
        { pg8::Gemm g{(const bf16_t*)(Aptr), (const bf16_t*)(Wptr), MP, D, (KFULL), (KFULL)}; \
          pg8::StaticOrder S; S.init(MP, D, F.G, (int)blockIdx.x); \
          pg8::EpiRes<RBF16> E{(RESF), (bf16_t*)(ws + WS_XN), nullptr, ssp}; \
          pg8::gemm_phase<pg8::EpiRes<RBF16>, pg8::StaticOrder, true, true>(F.lds, g, S, E); } } while (0)
#define DEFERRED_SAMPLE(Aptr, Wptr, KFULL, RESS, AOUT, GAIN, INST) do { \
        constexpr int ns_ = (KFULL) / 256; const int mu = (int)blockIdx.x - (F.G - 4 * ns_); \
        if (mu >= 0) { const int sl = mu >> 2; int ks_ = 256; asm volatile("" : "+s"(ks_)); \
          pg8::Gemm g{(const bf16_t*)(Aptr) + sl * 256, (const bf16_t*)(Wptr) + sl * 256, M, D, ks_, (KFULL)}; \
          pg8::OneUnit S{MP / 256, mu & 3}; \
          pg8::EpiSlab E{(float*)(ws + WS_SLAB) + (size_t)sl * MS * D}; \
          pg8::gemm_phase<pg8::EpiSlab, pg8::OneUnit, true, true>(F.lds, g, S, E); \
          subgrid_rendezvous(ctl + CW_SR + 64 * (INST), 4 * ns_, ctl + CW_BAR); \
          for (int r = mu * NWAVES + F.wave; r < MS; r += 4 * ns_ * NWAVES) \
              sample_finalize_row<false>((const float*)(ws + WS_SLAB), ns_, (RESS), out + O_YS, (AOUT) + (size_t)MP * D, (GAIN), ssp, r, F.lane); \
          asm volatile("s_waitcnt vmcnt(0)" ::: "memory"); \
          __syncthreads(); \
          if (threadIdx.x == 0) { __builtin_amdgcn_fence(__ATOMIC_RELEASE, "agent"); asm volatile("s_waitcnt vmcnt(0)" ::: "memory"); (void)xb_add(ctl + CW_SR + 64 * (4 + (INST)), 1u); } } } while (0)
#define GATED_ORDER(S, MROWS, NCOLS, KFULL, INST) pg8::GatedOrder S; S.init((MROWS), (NCOLS), F.G, (int)blockIdx.x); S.flag = ctl + CW_SR + 64 * (4 + (INST)); S.need = 4 * ((KFULL) / 256); S.bar = ctl + CW_BAR

    if (IN(0)) { PH_BEGIN p0_prologue(F); }
    SEAM(0);
    if (IN(1)) { PH_BEGIN
        pg8::Gemm g{(const bf16_t*)(ws + WS_XN), (const bf16_t*)(ws + WS_WIN0), M, AB_IN, D, D};
        pg8::StaticOrder S; S.init(M, AB_IN, F.G, (int)blockIdx.x);
        pg8::EpiIn0 E{(bf16_t*)(ws + WS_QD), (bf16_t*)(ws + WS_KVD), (float*)(ws + WS_XR), (bf16_t*)(ws + WS_GT), out};
        pg8::gemm_phase<pg8::EpiIn0, pg8::StaticOrder, true, true>(F.lds, g, S, E);
        {
            constexpr int units = (M / 256) * (AB_IN / 256); const int nfull = units % F.G, nbg = nfull ? F.G - nfull : F.G;
            const int me = (int)blockIdx.x - (F.G - nbg);
            if (me >= 0) { __syncthreads(); for (int it = WT_T4 + me * NWAVES + F.wave; it < WT_T9; it += nbg * NWAVES) weight_transpose_item(F, it); }
        }
        if ((int)blockIdx.x == F.G - 1 && F.wave < 2) {
            const float* pp = (const float*)(ws + WS_PETP) + (size_t)F.wave * 32 * 64 + F.lane; float acc = 0.f;
#pragma unroll
            for (int l = 0; l < 32; ++l) acc += pp[l * 64];
            ((float*)(ws + WS_PET))[F.wave * 64 + F.lane] = acc;
        }
    }
    SEAM(1);
    if (IN(2)) { PH_BEGIN
        constexpr int ND = 32, NGL = 256, NL = ND + NGL * 6 + 32;
        unsigned* qc = ctl + CW_Q2 + 64 * ((int)blockIdx.x & 7); const int shard = (int)blockIdx.x & 7;
        for (int k = (int)__builtin_amdgcn_readfirstlane(q_issue(qc, F.lane)); k < NL; ) {
            const unsigned tk = q_issue(qc, F.lane);
            Frame Fi = F; { size_t zz = 0; asm volatile("" : "+s"(zz)); Fi.ws += zz; Fi.out += zz; }
            if (k < ND) dil_item_sample(Fi, k * 8 + shard);
            else if (k >= ND + NGL * 6) rglru_gates_item<true>(Fi, (k - ND - NGL * 6) * 8 + shard);
            else { const int i2 = k - ND, gl = i2 / 6, slot = i2 - gl * 6;
                if (slot < 2) compress_item<true>(Fi, (2 * gl + slot) * 8 + shard);
                else { const int kd = 2 * gl + (slot & 1);
                    const int item = (((kd >> 3) * 8 + shard) << 3) | (kd & 7);
                    if (slot < 4) dil_item_prompt(Fi, item); else rglru_gates_item<false>(Fi, item); } }
            k = (int)__builtin_amdgcn_readfirstlane(tk);
        }
    }
    SEAM(2);
    if (IN(3)) { PH_BEGIN
        for (int it = F.gw; it < 2048 + 256; it += F.NGW) { if (it < 2048) rglru_scan_item<false>(F, it); else rglru_scan_item<true>(F, it - 2048); }
    }
    SEAM(3);
    if (IN(4)) { PH_BEGIN GEMM_N1024(ws + WS_O, ws + WS_WOUT0, D, (const float*)args.in[0], false); }
    SEAM(4);
    if (IN(6)) { PH_BEGIN
        DEFERRED_SAMPLE(ws + WS_O, ws + WS_WOUT0, D, (const float*)args.in[1], (bf16_t*)(ws + WS_XN), norm_ffn, 0);
        pg8::Gemm g{(const bf16_t*)(ws + WS_XN), (const bf16_t*)(ws + WS_W13_0), M, FF2, D, D};
        GATED_ORDER(S, M, FF2, D, 0);
        pg8::EpiUp E{ssp, (bf16_t*)(ws + WS_H)};
        pg8::gemm_phase<pg8::EpiUp, pg8::GatedOrder, true, true>(F.lds, g, S, E);
    }
    SEAM(6);
    if (IN(7)) { PH_BEGIN GEMM_N1024(ws + WS_H, ws + WS_W2_0, FF, nullptr, true); }
    SEAM(7);
    if (IN(9)) { PH_BEGIN
        DEFERRED_SAMPLE(ws + WS_H, ws + WS_W2_0, FF, out + O_YS, (bf16_t*)(ws + WS_XN), norm_mix + D, 1);
        pg8::Gemm g{(const bf16_t*)(ws + WS_XN), (const bf16_t*)(ws + WS_WIN1), M, C_IN_PAD, D, D};
        GATED_ORDER(S, M, C_IN_PAD, FF, 1);
        pg8::EpiIn1 E{ssp, (bf16_t*)(ws + WS_Q1), (bf16_t*)(ws + WS_KVSEL), (bf16_t*)(ws + WS_KVWIN), (float*)(ws + WS_G1), out};
        pg8::gemm_phase<pg8::EpiIn1, pg8::GatedOrder, true, true>(F.lds, g, S, E);
    }
    SEAM(9);
    if (IN(10)) { PH_BEGIN
        for (int it = (int)blockIdx.x; it < 4 * 8 * 8; it += F.G) compress_item<false, true>(F, it);
    }
    SEAM(10);
    if (IN(11)) { PH_BEGIN
        unsigned* qc = ctl + CW_Q9 + 64 * ((int)blockIdx.x & 7); const int shard = (int)blockIdx.x & 7;
        if (F.wave >= 6) for (int it = (int)blockIdx.x * 2 + (F.wave - 6); it < NDC + NWC; it += 2 * F.G) copy_item(F, it);
        for (int it = q_item(q_issue(qc, F.lane), shard); it < 128 + 8192; ) {
            const unsigned tk = q_issue(qc, F.lane);
            if (it < 128) nsa_item<true>(F, it);
            else { const int p = it - 128, qt = 511 - (p >> 4), bg = p & 15; nsa_item<false>(F, ((bg >> 2) << 11) | (qt << 2) | (bg & 3)); }
            it = q_item(tk, shard);
        }
    }
    SEAM(11);
    if (IN(12)) { PH_BEGIN GEMM_N1024(ws + WS_O, ws + WS_WOUT1, D, nullptr, true); }
    SEAM(12);
    if (IN(14)) { PH_BEGIN
        DEFERRED_SAMPLE(ws + WS_O, ws + WS_WOUT1, D, out + O_YS, (bf16_t*)(ws + WS_XN), norm_ffn + D, 2);
        pg8::Gemm g{(const bf16_t*)(ws + WS_XN), (const bf16_t*)(ws + WS_W13_1), M, FF2, D, D};
        GATED_ORDER(S, M, FF2, D, 2);
        pg8::EpiUp E{ssp, (bf16_t*)(ws + WS_H)};
        pg8::gemm_phase<pg8::EpiUp, pg8::GatedOrder, true, true>(F.lds, g, S, E);
    }
    SEAM(14);
    if (IN(15)) { PH_BEGIN
        if (F.G == MP / 256 * 4) {
            pg8::Gemm g{(const bf16_t*)(ws + WS_H), (const bf16_t*)(ws + WS_W2_1), MP, D, FF, FF};
            pg8::StaticOrder S; S.init(MP, D, F.G, (int)blockIdx.x);
            pg8::EpiResNorm E{(const bf16_t*)(ws + WS_XN), out + O_YP, norm_out, (float*)(ws + WS_XSL), ctl + CW_PN, ctl + CW_BAR + XB_TMO};
            pg8::gemm_phase<pg8::EpiResNorm, pg8::StaticOrder, true, true>(F.lds, g, S, E);
        } else {
            pg8::Gemm g{(const bf16_t*)(ws + WS_H), (const bf16_t*)(ws + WS_W2_1), MP, D, FF, FF};
            pg8::StaticOrder S; S.init(MP, D, F.G, (int)blockIdx.x);
            pg8::EpiRes<true, true> E{nullptr, (bf16_t*)(ws + WS_XN), out + O_YP, ssp};
            pg8::gemm_phase<pg8::EpiRes<true, true>, pg8::StaticOrder, true, true>(F.lds, g, S, E);
        }
        if ((int)blockIdx.x < 4 * (FF / 256)) { const int mu = (int)blockIdx.x; const int sl = mu >> 2;
            pg8::Gemm g{(const bf16_t*)(ws + WS_H) + sl * 256, (const bf16_t*)(ws + WS_W2_1) + sl * 256, M, D, 256, FF};
            pg8::OneUnit S{MP / 256, mu & 3};
            pg8::EpiSlab E{(float*)(ws + WS_SLAB) + (size_t)sl * MS * D};
            pg8::gemm_phase<pg8::EpiSlab, pg8::OneUnit, true, true>(F.lds, g, S, E);
            subgrid_rendezvous(ctl + CW_SR + 64 * 3, 4 * (FF / 256), ctl + CW_BAR);
            for (int r = mu * NWAVES + F.wave; r < MS; r += 4 * (FF / 256) * NWAVES)
                sample_finalize_row<true>((const float*)(ws + WS_SLAB), FF / 256, out + O_YS, out + O_YS, nullptr, norm_out, ssp, r, F.lane); }
    }
    if (gridDim.x != MP / 256 * 4) {
        SEAM(15);
        if (IN(16)) { PH_BEGIN
            for (int r = F.gw; r < MP; r += F.NGW) final_norm_row(out, ssp, norm_out, r, F.lane);
        }
    }
#undef GEMM_N1024
#undef DEFERRED_SAMPLE
#undef GATED_ORDER
#undef IN
#undef SEAM
}

extern "C" void kernel_launch(void* const* d_in, const int* in_sizes, int n_in, void* d_out, int out_size, void* d_ws, size_t ws_size, hipStream_t stream) {
    static int grid = 0;
    if (grid == 0) {
        if (n_in != 28 || (size_t)out_size != O_END || ws_size < WS_END) { fprintf(stderr, "kernel_launch: unexpected shapes (n_in %d out %d ws %zu need %zu)\n", n_in, out_size, ws_size, (size_t)WS_END); grid = -1; return; }
        int dev = 0, cus = 0, per_cu = 0;
        if (hipGetDevice(&dev) != hipSuccess || hipDeviceGetAttribute(&cus, hipDeviceAttributeMultiprocessorCount, dev) != hipSuccess) { grid = -1; return; }
        if (hipFuncSetAttribute((const void*)fwd, hipFuncAttributeMaxDynamicSharedMemorySize, LDS_BYTES) != hipSuccess) { fprintf(stderr, "kernel_launch: hipFuncSetAttribute failed\n"); grid = -1; return; }
        if (hipOccupancyMaxActiveBlocksPerMultiprocessor(&per_cu, (const void*)fwd, NWAVES * 64, LDS_BYTES) != hipSuccess || per_cu < 1) { fprintf(stderr, "kernel_launch: occupancy query says %d\n", per_cu); }
        (void)hipGetLastError();
        grid = cus;
    }
    if (grid < 0) return;
    (void)hipMemsetAsync((char*)d_ws + WS_CTL, 0, CTL_ZERO_BYTES, stream);
    Args a{};
    for (int i = 0; i < 28; ++i) a.in[i] = d_in[i];
    a.out = (float*)d_out; a.ws = (unsigned char*)d_ws;
#if ONE_LAUNCH
    a.ph_lo = 0; a.ph_hi = N_PHASES; hipLaunchKernelGGL(fwd, dim3(grid), dim3(NWAVES * 64), LDS_BYTES, stream, a);
#else
    for (int p = 0; p < N_PHASES; ++p) { a.ph_lo = p; a.ph_hi = p + 1; hipLaunchKernelGGL(fwd, dim3(grid), dim3(NWAVES * 64), LDS_BYTES, stream, a); }
#endif
}
```

```cpp
#include <hip/hip_runtime.h>
#include <cstdio>
#include <cstdint>
#include <type_traits>

#define LAS __attribute__((address_space(3)))
#define GAS __attribute__((address_space(1)))
typedef unsigned short bf16_t;
typedef short bf16x8 __attribute__((ext_vector_type(8)));
typedef short s16x4 __attribute__((ext_vector_type(4)));
typedef float f32x2 __attribute__((ext_vector_type(2)));
typedef float f32x4 __attribute__((ext_vector_type(4)));
typedef float f32x16 __attribute__((ext_vector_type(16)));
typedef unsigned u32x2 __attribute__((ext_vector_type(2)));
typedef unsigned u32x4 __attribute__((ext_vector_type(4)));
typedef __bf16 bf16x2_t __attribute__((ext_vector_type(2)));

constexpr int D = 1024, BP = 4, SEQ = 4096, MP = BP * SEQ, BS = 32, TS = 8, MS = BS * TS, M = MP + MS;
constexpr int PAST = 8192, PAGE = 128, NPG = PAST / PAGE;
constexpr int AB_IN = 2560, C_IN = 2608, C_IN_PAD = 2816, FF = 2816, FF2 = 2 * FF;
constexpr int DIL_KEEP = 2048, WIN = 512;
constexpr int NCP = 255, NCS = 511;
constexpr float EPS = 1e-6f;
constexpr float LOG2E = 1.4426950408889634f;
constexpr float C_SCALE2 = 0.125f * LOG2E;

constexpr size_t O_YP = 0, O_YS = O_YP + (size_t)MP * D, O_DILP = O_YS + (size_t)MS * D, O_DILS = O_DILP + (size_t)BP * 2048 * 1024,
                 O_CONVP = O_DILS + (size_t)BS * 2048 * 1024, O_CONVS = O_CONVP + (size_t)BP * 3 * 512, O_RNNP = O_CONVS + (size_t)BS * 3 * 512,
                 O_RNNS = O_RNNP + (size_t)BP * 512, O_WINP = O_RNNS + (size_t)BS * 512, O_WINS = O_WINP + (size_t)BP * 512 * 512,
                 O_CMPP = O_WINS + (size_t)BS * 512 * 512, O_CMPS = O_CMPP + (size_t)BP * SEQ * 512, O_SELP = O_CMPS + (size_t)BS * TS * 512,
                 O_SELS = O_SELP + (size_t)BP * SEQ * 512, O_END = O_SELS + (size_t)BS * TS * 512;
static_assert(O_END == 119087104, "output size");

constexpr size_t al256(size_t x) { return (x + 255) & ~(size_t)255; }
constexpr size_t WS_CTL = 0, CTL_ZERO_BYTES = 1u << 16;
constexpr size_t WS_WIN0 = CTL_ZERO_BYTES;
constexpr size_t WS_WOUT0 = WS_WIN0 + (size_t)AB_IN * D * 2;
constexpr size_t WS_W13_0 = WS_WOUT0 + (size_t)D * D * 2;
constexpr size_t WS_W2_0 = WS_W13_0 + (size_t)FF2 * D * 2;
constexpr size_t WS_WIN1 = WS_W2_0 + (size_t)D * FF * 2;
constexpr size_t WS_WOUT1 = WS_WIN1 + (size_t)C_IN_PAD * D * 2;
constexpr size_t WS_W13_1 = WS_WOUT1 + (size_t)D * D * 2;
constexpr size_t WS_W2_1 = WS_W13_1 + (size_t)FF2 * D * 2;
constexpr size_t WS_WG = WS_W2_1 + (size_t)D * FF * 2;
constexpr size_t WS_WCT = WS_WG + (size_t)2 * 8 * 64 * 64 * 2;
constexpr size_t WS_PET = WS_WCT + (size_t)2 * 64 * 2048 * 2;
constexpr size_t WS_C8 = WS_PET + 512;
constexpr size_t WS_XN = al256(WS_C8 + 2048);
constexpr size_t WS_QD = WS_XN + (size_t)M * D * 2;
constexpr size_t WS_KVD = WS_QD + (size_t)M * 512 * 2;
constexpr size_t WS_XR = WS_KVD + (size_t)M * 1024 * 2;
constexpr size_t WS_GT = WS_XR + (size_t)M * 512 * 4;
constexpr size_t WS_AU = WS_GT + (size_t)M * 512 * 2;
constexpr size_t WS_AGG = WS_AU + (size_t)M * 1024 * 4;
constexpr size_t WS_O = WS_AGG + (size_t)4 * 128 * 1024 * 4;
constexpr size_t WS_H = WS_O + (size_t)M * D * 2;
constexpr size_t WS_SSP = WS_H + (size_t)M * FF * 2;
constexpr size_t WS_Q1 = WS_SSP + (size_t)M * 16 * 4;
constexpr size_t WS_KVSEL = WS_Q1 + (size_t)M * D * 2;
constexpr size_t WS_KVWIN = WS_KVSEL + (size_t)MP * 512 * 2;
constexpr size_t WS_G1 = WS_KVWIN + (size_t)MP * 512 * 2;
constexpr size_t WS_KCP = al256(WS_G1 + (size_t)M * 48 * 4);
constexpr size_t WS_KCS = WS_KCP + (size_t)BP * 256 * 512 * 2;
constexpr size_t WS_SLAB = WS_KCS + (size_t)BS * 512 * 512 * 2;
constexpr size_t WS_XSL = WS_SLAB + (size_t)11 * MS * D * 4;
constexpr size_t WS_PETP = WS_XSL + (size_t)MP * 4 * 4;
constexpr size_t WS_END = WS_PETP + (size_t)2 * 32 * 64 * 4;

constexpr int CW_BAR = 4096;
constexpr int CW_Q2 = 8192, CW_Q9 = 8192 + 1024;
constexpr int CW_PN = 8192 + 2048;
constexpr int CW_SR = 8192 + 2048 + 4096;
constexpr int CW_QBG = 8192 + 2048, CW_DONE = 8192 + 3072;

constexpr int RING_BYTES = 131072;
constexpr int WSCR = 18432;
constexpr int MISC_OFF = 8 * WSCR;
constexpr int LDS_BYTES = MISC_OFF + 1024;

__device__ __forceinline__ unsigned cvtpk(float lo, float hi) { f32x2 v = {lo, hi}; bf16x2_t b = __builtin_convertvector(v, bf16x2_t); return __builtin_bit_cast(unsigned, b); }
__device__ __forceinline__ float bf2f(unsigned short h) { return __uint_as_float((unsigned)h << 16); }
__device__ __forceinline__ bf16x8 pack8(f32x4 a, f32x4 b) { u32x4 w; w.x = cvtpk(a[0], a[1]); w.y = cvtpk(a[2], a[3]); w.z = cvtpk(b[0], b[1]); w.w = cvtpk(b[2], b[3]); return __builtin_bit_cast(bf16x8, w); }
__device__ __forceinline__ float wave_sum(float v) {
#pragma unroll
    for (int o = 1; o < 64; o <<= 1) v += __shfl_xor(v, o);
    return v;
}
#define LDS_WAIT() asm volatile("s_waitcnt lgkmcnt(0)" ::: "memory")
#define VM_WAIT() asm volatile("s_waitcnt vmcnt(0)" ::: "memory")

namespace pg8 {
#define PG8_LAS __attribute__((address_space(3)))
constexpr int BM = 256, BK = 64, HALF = 128, HTB = HALF * BK * 2, STAGE_BYTES = 8 * HTB, NXCD = 8, WGM = 8;
__host__ __device__ __forceinline__ int lds_byte(int r, int c) { const int st = (r >> 4) * 2 + (c >> 5), rr = r & 15, cc = c & 31, ob = rr * 64 + cc * 2; return st * 1024 + (ob ^ (((ob >> 9) & 1) << 5)); }
__host__ __device__ __forceinline__ void stage_rc(int b, int& R, int& C) { const int st = b / 1024, sb = b % 1024, swz = sb ^ (((sb >> 9) & 1) << 5); R = (st >> 1) * 16 + swz / 64; C = (st & 1) * 32 + (swz % 64) / 2; }
__host__ __device__ __forceinline__ int perm32(int rho) { const int n = rho >> 4, i = rho & 15; return 8 * (i >> 2) + 4 * n + (i & 3); }
struct Unit { int pm, pn; };
struct Gemm { const bf16_t* A; const bf16_t* Bt; int M, N, K, ld; };
struct StaticOrder {
    int nM, nN, nwg, G, c;
    __host__ __device__ void init(int M_, int N_, int G_, int c_) { nM = M_ / BM; nN = N_ / BM; nwg = nM * nN; G = G_; c = c_; }
    __host__ __device__ bool next(int i, Unit& u) const {
        const long L = (long)i * G + c; if (L >= nwg) return false;
        int wgid = (int)L; { const int q = nwg / NXCD, r = nwg % NXCD, xcd = wgid % NXCD, off = wgid / NXCD; wgid = (xcd < r ? xcd * (q + 1) : r * (q + 1) + (xcd - r) * q) + off; }
        const int nig = WGM * nN, gid = wgid / nig, fm = gid * WGM, gsz = (nM - fm) < WGM ? (nM - fm) : WGM;
        u.pm = fm + ((wgid % nig) % gsz); u.pn = (wgid % nig) / gsz; return true;
    }
    __device__ __forceinline__ void a_ready(const Unit&) const {}
    __device__ __forceinline__ void done(const Unit&) const {}
};

struct CountingOrder : StaticOrder {
    unsigned* cnt; int lane;
    __device__ __forceinline__ void done(const Unit&) const { if (lane == 0) __hip_atomic_fetch_add(cnt, 1u, __ATOMIC_RELAXED, __HIP_MEMORY_SCOPE_AGENT); }
};
struct OneUnit {
    int pm, pn;
    __host__ __device__ bool next(int i, Unit& u) const { if (i) return false; u.pm = pm; u.pn = pn; return true; }
    __device__ __forceinline__ void a_ready(const Unit&) const {}
    __device__ __forceinline__ void done(const Unit&) const {}
};
template <class Epi, class Sched, bool ALIGN_EPI = false, bool SP2 = false>
__device__ __forceinline__ void gemm_phase(PG8_LAS unsigned char* lds, const Gemm g, const Sched& S, const Epi& E) {
    const int tid = threadIdx.x, wid = __builtin_amdgcn_readfirstlane(tid >> 6), lane = tid & 63, wr = wid >> 2, wc = wid & 3, fr = lane & 15, fq = lane >> 4;
    const int K = g.K, nt = K / BK, LD = g.ld;
    unsigned voffA[2], voffB[2];
#pragma unroll
    for (int i = 0; i < 2; ++i) { int R, C; stage_rc(tid * 16 + i * 8192, R, C); const int Rb = Epi::PERM ? ((R & ~31) + perm32(R & 31)) : R;
        voffA[i] = (unsigned)(R * LD + C) * 2u; voffB[i] = (unsigned)(Rb * LD + C) * 2u; }
    const size_t kstep = (size_t)(BK * 2);
    const size_t hstep = (size_t)HALF * LD * 2;
    const size_t tstep = 2 * hstep;
    const unsigned ldsw = (unsigned)wid * 1024u;
    const int aoff = lds_byte(wr * 64 + fr, fq * 8), boff = lds_byte(wc * 32 + fr, fq * 8);
#define PG8_SA(b, h) (((b) * 2 + (h)) * HTB)
#define PG8_SB(b, h) ((4 + (b) * 2 + (h)) * HTB)
#define PG8_STAGE(bufoff, gbase, voff) do { _Pragma("unroll") for (int _i = 0; _i < 2; ++_i) \
        __builtin_amdgcn_global_load_lds((const unsigned*)((const char*)(gbase) + (voff)[_i]), (PG8_LAS unsigned*)(lds + (bufoff) + ldsw + _i * 8192), 16, 0, 0); } while (0)
#define PG8_LDA(dst, b, h) do { _Pragma("unroll") for (int m = 0; m < 4; ++m) _Pragma("unroll") for (int k = 0; k < 2; ++k) dst[m][k] = *(const PG8_LAS bf16x8*)(lds + PG8_SA(b, h) + aoff + m * 2048 + k * 1024); } while (0)
#define PG8_LDB(dst, b, h) do { _Pragma("unroll") for (int n = 0; n < 2; ++n) _Pragma("unroll") for (int k = 0; k < 2; ++k) dst[n][k] = *(const PG8_LAS bf16x8*)(lds + PG8_SB(b, h) + boff + n * 2048 + k * 1024); } while (0)
#define PG8_MMA(ai, bj, At, Bt) do { __builtin_amdgcn_s_setprio(1); _Pragma("unroll") for (int m = 0; m < 4; ++m) _Pragma("unroll") for (int n = 0; n < 2; ++n) _Pragma("unroll") for (int k = 0; k < 2; ++k) \
        acc[ai][bj][m][n] = __builtin_amdgcn_mfma_f32_16x16x32_bf16(Bt[n][k], At[m][k], acc[ai][bj][m][n], 0, 0, 0); __builtin_amdgcn_s_setprio(0); } while (0)
#define PG8_WAIT_V(n) asm volatile("s_waitcnt vmcnt(" #n ")" ::: "memory")
#define PG8_WAIT_L(n) asm volatile("s_waitcnt lgkmcnt(" #n ")" ::: "memory")
#define PG8_BAR __builtin_amdgcn_s_barrier()
#define PG8_SCHED __builtin_amdgcn_sched_barrier(0)
    Unit cur, nxt; int ui = 0;
    if (!S.next(0, cur)) return;
    f32x4 acc[2][2][4][2];
#pragma unroll
    for (int a = 0; a < 2; ++a)
#pragma unroll
        for (int b = 0; b < 2; ++b)
#pragma unroll
            for (int m = 0; m < 4; ++m)
#pragma unroll
                for (int n = 0; n < 2; ++n) acc[a][b][m][n] = (f32x4){0.f, 0.f, 0.f, 0.f};
    bf16x8 At[4][2], B0[2][2], B1[2][2];
    const char* cA = (const char*)g.A + (size_t)cur.pm * tstep; const char* cB = (const char*)g.Bt + (size_t)cur.pn * tstep;
    S.a_ready(cur);
    if constexpr (SP2) {
        PG8_STAGE(PG8_SB(0, 0), cB, voffB); PG8_STAGE(PG8_SB(0, 1), cB + hstep, voffB); PG8_STAGE(PG8_SA(0, 0), cA, voffA); PG8_STAGE(PG8_SA(0, 1), cA + hstep, voffA);
        if (wr == 1) PG8_BAR;
        PG8_WAIT_V(2); PG8_BAR;
        PG8_STAGE(PG8_SB(1, 0), cB + kstep, voffB); PG8_STAGE(PG8_SA(1, 0), cA + kstep, voffA); PG8_STAGE(PG8_SB(1, 1), cB + hstep + kstep, voffB);
        PG8_WAIT_V(6); PG8_BAR;
    } else {
        PG8_STAGE(PG8_SB(0, 0), cB, voffB); PG8_STAGE(PG8_SA(0, 0), cA, voffA); PG8_STAGE(PG8_SB(0, 1), cB + hstep, voffB); PG8_STAGE(PG8_SA(0, 1), cA + hstep, voffA);
        if (wr == 1) PG8_BAR;
        PG8_WAIT_V(4); PG8_BAR;
        PG8_STAGE(PG8_SB(1, 0), cB + kstep, voffB); PG8_STAGE(PG8_SA(1, 0), cA + kstep, voffA); PG8_STAGE(PG8_SB(1, 1), cB + hstep + kstep, voffB);
        PG8_WAIT_V(6); PG8_BAR;
    }
    for (;;) {
        const bool has_next = S.next(ui + 1, nxt);
        const char* nA = has_next ? (const char*)g.A + (size_t)nxt.pm * tstep : cA; const char* nB = has_next ? (const char*)g.Bt + (size_t)nxt.pn * tstep : cB;
        for (int t = 0; t < nt; t += 2) {
            const bool last = (t == nt - 2);
            const char* a1 = cA + (size_t)(t + 1) * kstep;
            const char* a2 = last ? nA : cA + (size_t)(t + 2) * kstep; const char* b2 = last ? nB : cB + (size_t)(t + 2) * kstep;
            const char* a3 = a2 + kstep; const char* b3 = b2 + kstep;
            if (last && has_next) S.a_ready(nxt);
            if constexpr (SP2) {
            PG8_LDB(B0, 0, 0); PG8_LDB(B1, 0, 1); PG8_SCHED; PG8_LDA(At, 0, 0); PG8_STAGE(PG8_SA(1, 1), a1 + hstep, voffA);
            PG8_WAIT_V(8); PG8_WAIT_L(0); PG8_BAR; PG8_MMA(0, 0, At, B0); PG8_MMA(0, 1, At, B1); PG8_BAR; PG8_SCHED;
            PG8_LDA(At, 0, 1); PG8_STAGE(PG8_SB(0, 0), b2, voffB); PG8_STAGE(PG8_SB(0, 1), b2 + hstep, voffB); PG8_STAGE(PG8_SA(0, 0), a2, voffA);
            PG8_WAIT_V(8); PG8_WAIT_L(0); PG8_BAR; PG8_MMA(1, 0, At, B0); PG8_MMA(1, 1, At, B1); PG8_BAR; PG8_SCHED;
            PG8_LDB(B0, 1, 0); PG8_LDB(B1, 1, 1); PG8_SCHED; PG8_LDA(At, 1, 0); PG8_STAGE(PG8_SA(0, 1), a2 + hstep, voffA);
            PG8_WAIT_V(8); PG8_WAIT_L(0); PG8_BAR; PG8_MMA(0, 0, At, B0); PG8_MMA(0, 1, At, B1); PG8_BAR; PG8_SCHED;
            PG8_LDA(At, 1, 1); PG8_STAGE(PG8_SB(1, 0), b3, voffB); PG8_STAGE(PG8_SB(1, 1), b3 + hstep, voffB); PG8_STAGE(PG8_SA(1, 0), a3, voffA);
            PG8_WAIT_V(8); PG8_WAIT_L(0); PG8_BAR; PG8_MMA(1, 0, At, B0); PG8_MMA(1, 1, At, B1); PG8_BAR; PG8_SCHED;
            } else {
            PG8_LDB(B0, 0, 0); PG8_SCHED; PG8_LDA(At, 0, 0); PG8_STAGE(PG8_SA(1, 1), a1 + hstep, voffA);
            PG8_WAIT_L(8); PG8_BAR; PG8_WAIT_L(0); PG8_MMA(0, 0, At, B0); PG8_BAR; PG8_SCHED;
            PG8_LDB(B1, 0, 1); PG8_STAGE(PG8_SB(0, 0), b2, voffB);
            PG8_BAR; PG8_WAIT_L(0); PG8_MMA(0, 1, At, B1); PG8_BAR;
            PG8_LDA(At, 0, 1); PG8_STAGE(PG8_SA(0, 0), a2, voffA);
            PG8_BAR; PG8_WAIT_L(0); PG8_MMA(1, 0, At, B0); PG8_BAR; PG8_SCHED;
            PG8_STAGE(PG8_SB(0, 1), b2 + hstep, voffB);
            PG8_WAIT_V(6); PG8_BAR; PG8_MMA(1, 1, At, B1); PG8_BAR;
            PG8_LDB(B0, 1, 0); PG8_SCHED; PG8_LDA(At, 1, 0); PG8_STAGE(PG8_SA(0, 1), a2 + hstep, voffA);
            PG8_WAIT_L(8); PG8_BAR; PG8_WAIT_L(0); PG8_MMA(0, 0, At, B0); PG8_BAR; PG8_SCHED;
            PG8_LDB(B1, 1, 1); PG8_STAGE(PG8_SB(1, 0), b3, voffB);
            PG8_BAR; PG8_WAIT_L(0); PG8_MMA(0, 1, At, B1); PG8_BAR;
            PG8_LDA(At, 1, 1); PG8_STAGE(PG8_SA(1, 0), a3, voffA);
            PG8_BAR; PG8_WAIT_L(0); PG8_MMA(1, 0, At, B0); PG8_BAR; PG8_SCHED;
            PG8_STAGE(PG8_SB(1, 1), b3 + hstep, voffB);
            PG8_WAIT_V(6); PG8_BAR; PG8_MMA(1, 1, At, B1); PG8_BAR;
            }
        }
        if constexpr (ALIGN_EPI) { if (wr == 0) PG8_BAR; }
        if constexpr (!Epi::AFTER_DRAIN) { E(acc, cur, wr, wc, fr, fq); S.done(cur); }
        if (!has_next) break;
#pragma unroll
        for (int a = 0; a < 2; ++a)
#pragma unroll
            for (int b = 0; b < 2; ++b)
#pragma unroll
                for (int m = 0; m < 4; ++m)
#pragma unroll
                    for (int n = 0; n < 2; ++n) acc[a][b][m][n] = (f32x4){0.f, 0.f, 0.f, 0.f};
        cur = nxt; cA = nA; cB = nB; ++ui;
        if constexpr (ALIGN_EPI) { if (wr == 1) PG8_BAR; }
    }
    PG8_WAIT_V(0);
    if constexpr (!ALIGN_EPI) { if (wr == 0) PG8_BAR; }
    PG8_BAR;
    if constexpr (Epi::AFTER_DRAIN) { E.fused(acc, cur, wr, wc, fr, fq, lds, wid, lane, tid); S.done(cur); }
#undef PG8_SA
#undef PG8_SB
#undef PG8_STAGE
#undef PG8_LDA
#undef PG8_LDB
#undef PG8_MMA
#undef PG8_WAIT_V
#undef PG8_WAIT_L
#undef PG8_BAR
#undef PG8_SCHED
}

typedef f32x4 Acc[2][2][4][2];

struct EpiIn0 {
    static constexpr bool PERM = true, AFTER_DRAIN = false;
    bf16_t* QD; bf16_t* KVD; float* XR; bf16_t* GT; float* out;
    __device__ __forceinline__ void operator()(const Acc& acc, const Unit& u, int wr, int wc, int fr, int fq) const {
        const int region = u.pn >> 1, cb = (u.pn & 1) * 256 + wc * 32 + 8 * fq;
#pragma unroll
        for (int ai = 0; ai < 2; ++ai)
#pragma unroll
            for (int m = 0; m < 4; ++m) {
                const int row = u.pm * BM + ai * HALF + wr * 64 + m * 16 + fr;
                const bool smp = row >= MP; const int b = smp ? (row - MP) >> 3 : row >> 12, t = smp ? (row - MP) & 7 : row & 4095;
#pragma unroll
                for (int bj = 0; bj < 2; ++bj) {
                    const int col = cb + bj * HALF; const f32x4 v0 = acc[ai][bj][m][0], v1 = acc[ai][bj][m][1];
                    if (region == 0) { *(bf16x8*)(QD + (size_t)row * 512 + col) = pack8(v0 * C_SCALE2, v1 * C_SCALE2); }
                    else if (region <= 2) { const int c = region - 1;
                        *(bf16x8*)(KVD + (size_t)row * 1024 + c * 512 + col) = pack8(v0, v1);
                        float* o = nullptr;
                        if (smp) o = out + O_DILS + ((size_t)(b * 2048 + 2040 + t) * 2 + c) * 512 + col;
                        else if (t >= 2048) o = out + O_DILP + ((size_t)(b * 2048 + t - 2048) * 2 + c) * 512 + col;
                        if (o) { *(f32x4*)o = v0; *(f32x4*)(o + 4) = v1; } }
                    else if (region == 3) { float* x = XR + (size_t)row * 512 + col; *(f32x4*)x = v0; *(f32x4*)(x + 4) = v1;
                        float* o = nullptr;
                        if (smp) { if (t >= 5) o = out + O_CONVS + (size_t)(b * 3 + t - 5) * 512 + col; }
                        else if (t >= SEQ - 3) o = out + O_CONVP + (size_t)(b * 3 + t - (SEQ - 3)) * 512 + col;
                        if (o) { *(f32x4*)o = v0; *(f32x4*)(o + 4) = v1; } }
                    else { *(bf16x8*)(GT + (size_t)row * 512 + col) = pack8(v0, v1); }
                }
            }
    }
};
}

#define XB_TMO      128
#define XB_XCNT(j)  (256  + 64 * (j))
#define XB_XSUB(j)  (1280 + 64 * (j))
#define XB_XGEN(j)  (2304 + 64 * (j))
#define XB_TOP      3328
#define XB_TOPGEN   3392
#define XCD_BAR_WORDS 3456
#define XB_SPIN_CAP (1u << 18)
__device__ __forceinline__ unsigned xb_ld(unsigned* p)              { return __hip_atomic_load(p, __ATOMIC_RELAXED, __HIP_MEMORY_SCOPE_AGENT); }
__device__ __forceinline__ unsigned xb_add(unsigned* p, unsigned v) { return __hip_atomic_fetch_add(p, v, __ATOMIC_RELAXED, __HIP_MEMORY_SCOPE_AGENT); }
__device__ __forceinline__ unsigned xb_xcc_id() { return (unsigned)__builtin_amdgcn_s_getreg((3 << 11) | 20) & 0xFu; }
#define XB_SPIN(cond, bar) do { unsigned _sp = 0; while (cond) { __builtin_amdgcn_s_sleep(1); \
    if ((++_sp & 255u) == 0u) { if (xb_ld(&(bar)[XB_TMO])) break; if (_sp > XB_SPIN_CAP) { atomicAdd(&(bar)[XB_TMO], 1u); break; } } } } while (0)
struct XcdBarrier { unsigned* bar; unsigned x; volatile LAS unsigned* st; };
__device__ __forceinline__ XcdBarrier xcd_barrier_post(unsigned* bar, volatile LAS unsigned* st) {
    XcdBarrier b; b.bar = bar; b.x = xb_xcc_id(); b.st = st;
    if (threadIdx.x == 0) (void)xb_add(&bar[XB_XCNT(b.x)], 1u);
    return b;
}
__device__ __forceinline__ void xcd_barrier_complete(unsigned* bar, unsigned x, unsigned& nloc, unsigned& nx) {
    const unsigned G = gridDim.x * gridDim.y * gridDim.z;
    unsigned sum, cnt, mine, sp = 0u;
    for (;;) {
        sum = 0u; cnt = 0u; mine = 0u;
#pragma unroll
        for (unsigned j = 0; j < 16; ++j) { const unsigned c = xb_ld(&bar[XB_XCNT(j)]); sum += c; cnt += (c > 0u) ? 1u : 0u; mine = (j == x) ? c : mine; }
        if (sum == G) break;
        __builtin_amdgcn_s_sleep(1);
        if ((++sp & 255u) == 0u) { if (xb_ld(&bar[XB_TMO])) break; if (sp > XB_SPIN_CAP) { atomicAdd(&bar[XB_TMO], 1u); break; } }
    }
    nloc = mine > 0u ? mine : 1u; nx = cnt > 0u ? cnt : 1u;
}
__device__ __forceinline__ void xcd_barrier(const XcdBarrier& b) {
    asm volatile("s_waitcnt vmcnt(0)" ::: "memory");
    __syncthreads();
    if (threadIdx.x == 0) {
        unsigned* bar = b.bar;
        __builtin_amdgcn_s_waitcnt(0);
        unsigned nloc = b.st[0], nx = b.st[1];
        if (nloc == 0u) { xcd_barrier_complete(bar, b.x, nloc, nx); b.st[0] = nloc; b.st[1] = nx; }
        const unsigned old = xb_add(&bar[XB_XSUB(b.x)], 1u);
        const unsigned gen = old / nloc;
        if (old + 1u == (gen + 1u) * nloc) {
            __builtin_amdgcn_fence(__ATOMIC_RELEASE, "agent");
            asm volatile("s_waitcnt vmcnt(0)" ::: "memory");
            const unsigned og = xb_add(&bar[XB_TOP], 1u);
            const unsigned tg = og / nx;
            if (og + 1u == (tg + 1u) * nx) xb_add(&bar[XB_TOPGEN], 1u);
            else XB_SPIN(xb_ld(&bar[XB_TOPGEN]) == tg, bar);
            __builtin_amdgcn_fence(__ATOMIC_ACQUIRE, "agent");
            xb_add(&bar[XB_XGEN(b.x)], 1u);
            asm volatile("s_waitcnt vmcnt(0)" ::: "memory");
        } else {
            XB_SPIN(xb_ld(&bar[XB_XGEN(b.x)]) == gen, bar);
            __builtin_amdgcn_fence(__ATOMIC_ACQUIRE, "agent");
            asm volatile("s_waitcnt vmcnt(0)" ::: "memory");
        }
    }
    __syncthreads();
}

__device__ __forceinline__ void subgrid_rendezvous(unsigned* cnt, unsigned n, unsigned* bar) {
    asm volatile("s_waitcnt vmcnt(0)" ::: "memory");
    __syncthreads();
    if (threadIdx.x == 0) {
        __builtin_amdgcn_fence(__ATOMIC_RELEASE, "agent");
        asm volatile("s_waitcnt vmcnt(0)" ::: "memory");
        (void)xb_add(cnt, 1u);
        XB_SPIN(xb_ld(cnt) < n, bar);
        __builtin_amdgcn_fence(__ATOMIC_ACQUIRE, "agent");
        asm volatile("s_waitcnt vmcnt(0)" ::: "memory");
    }
    __syncthreads();
}

struct Args { const void* in[28]; float* out; unsigned char* ws; int ph_lo, ph_hi; };
constexpr int NWAVES = 8;

struct Frame {
    LAS unsigned char* lds; LAS unsigned char* wscr;
    int tid, lane, wave, gw, NGW, G;
    unsigned char* ws; float* out; const Args* a;
};

__device__ __forceinline__ void transpose_item(const float* W, int K, int Nsrc, int Npad, bf16_t* WT, int mode, LAS float* scr, int item, int lane, const float* gk = nullptr) {
    const int nblk = Npad / 32, kb = item / nblk, nb = item % nblk, k0 = 64 * kb, n0 = 32 * nb;
    const int nn = n0 + (lane & 31);
    float v[32];
#pragma unroll
    for (int i = 0; i < 32; ++i) { const int kk = 2 * i + (lane >> 5); v[i] = nn < Nsrc ? __builtin_nontemporal_load(W + (size_t)(k0 + kk) * Nsrc + nn) : 0.f; }
#pragma unroll
    for (int i = 0; i < 32; ++i) { const int kk = 2 * i + (lane >> 5); scr[kk * 33 + (lane & 31)] = v[i]; }
    LDS_WAIT();
    const int c = lane & 7;
    f32x4 ga = {1.f, 1.f, 1.f, 1.f}, gb = ga;
    if (gk) { ga = *(const f32x4*)(gk + k0 + 8 * c); gb = *(const f32x4*)(gk + k0 + 8 * c + 4); }
#pragma unroll
    for (int j = 0; j < 4; ++j) { const int n = (lane >> 3) + 8 * j; const LAS float* s = scr + (8 * c) * 33 + n;
        u32x4 o; o.x = cvtpk(s[0 * 33] * ga.x, s[1 * 33] * ga.y); o.y = cvtpk(s[2 * 33] * ga.z, s[3 * 33] * ga.w); o.z = cvtpk(s[4 * 33] * gb.x, s[5 * 33] * gb.y); o.w = cvtpk(s[6 * 33] * gb.z, s[7 * 33] * gb.w);
        const int ng = n0 + n; const int drow = mode == 0 ? ng : ((ng >> 7) * 256 + (ng & 127) + (mode == 2 ? 128 : 0));
        *(u32x4*)(WT + (size_t)drow * K + k0 + 8 * c) = o; }
    LDS_WAIT();
}
__device__ __forceinline__ void rms_row_to_bf16(const float* xrow, const float* g, bf16_t* orow, int lane) {
    const f32x4* xr = (const f32x4*)xrow + lane; const f32x4* gr = (const f32x4*)g + lane;
    f32x4 v[4]; float s = 0.f;
#pragma unroll
    for (int j = 0; j < 4; ++j) { v[j] = __builtin_nontemporal_load(xr + 64 * j); s += (v[j].x * v[j].x + v[j].y * v[j].y) + (v[j].z * v[j].z + v[j].w * v[j].w); }
    const float rstd = 1.f / sqrtf(wave_sum(s) * (1.f / D) + EPS);
    u32x2* o8 = (u32x2*)orow + lane;
#pragma unroll
    for (int j = 0; j < 4; ++j) { const f32x4 gg = gr[64 * j]; u32x2 w; w.x = cvtpk(v[j].x * rstd * gg.x, v[j].y * rstd * gg.y); w.y = cvtpk(v[j].z * rstd * gg.z, v[j].w * rstd * gg.w); o8[64 * j] = w; }
}

__device__ __forceinline__ void rms_rows4_to_bf16(const float* x0, const float* x1, const float* x2, const float* x3, const float* g, bf16_t* o0, bf16_t* o1, bf16_t* o2, bf16_t* o3, int lane) {
    const float* xs[4] = {x0, x1, x2, x3}; bf16_t* os[4] = {o0, o1, o2, o3};
    f32x4 v[4][4]; float s[4];
#pragma unroll
    for (int q = 0; q < 4; ++q)
#pragma unroll
        for (int j = 0; j < 4; ++j) v[q][j] = __builtin_nontemporal_load((const f32x4*)xs[q] + lane + 64 * j);
    f32x4 gg[4];
#pragma unroll
    for (int j = 0; j < 4; ++j) gg[j] = *((const f32x4*)g + lane + 64 * j);
#pragma unroll
    for (int q = 0; q < 4; ++q) { float t = 0.f;
#pragma unroll
        for (int j = 0; j < 4; ++j) t += (v[q][j].x * v[q][j].x + v[q][j].y * v[q][j].y) + (v[q][j].z * v[q][j].z + v[q][j].w * v[q][j].w);
        s[q] = 1.f / sqrtf(wave_sum(t) * (1.f / D) + EPS); }
#pragma unroll
    for (int q = 0; q < 4; ++q)
#pragma unroll
        for (int j = 0; j < 4; ++j) { const float rstd = s[q]; u32x2 w; w.x = cvtpk(v[q][j].x * rstd * gg[j].x, v[q][j].y * rstd * gg[j].y); w.y = cvtpk(v[q][j].z * rstd * gg[j].z, v[q][j].w * rstd * gg[j].w);
            *((u32x2*)os[q] + lane + 64 * j) = w; }
}

constexpr int WT_IN0 = 16 * (AB_IN / 32), WT_O = 16 * (D / 32), WT_F = 16 * (FF / 32), WT_2 = (FF / 64) * (D / 32), WT_IN1 = 16 * (C_IN_PAD / 32);
constexpr int WT_T0 = WT_IN0, WT_T1 = WT_T0 + WT_O, WT_T2 = WT_T1 + WT_F, WT_T3 = WT_T2 + WT_F, WT_T4 = WT_T3 + WT_2, WT_T5 = WT_T4 + WT_IN1, WT_T6 = WT_T5 + WT_O, WT_T7 = WT_T6 + WT_F, WT_T8 = WT_T7 + WT_F, WT_T9 = WT_T8 + WT_2;
__device__ __forceinline__ void weight_transpose_item(const Frame& F, int it) {
    const Args& A = *F.a; LAS float* scr = (LAS float*)F.wscr; unsigned char* ws = F.ws; const int lane = F.lane;
    constexpr int T0 = WT_T0, T1 = WT_T1, T2 = WT_T2, T3 = WT_T3, T4 = WT_T4, T5 = WT_T5, T6 = WT_T6, T7 = WT_T7, T8 = WT_T8;
    {
        {
            const float* w1_0 = (const float*)A.in[25]; const float* w3_0 = (const float*)A.in[26]; const float* w2_0 = (const float*)A.in[27];
            if (it < T0) transpose_item((const float*)A.in[12], D, AB_IN, AB_IN, (bf16_t*)(ws + WS_WIN0), 0, scr, it, lane);
            else if (it < T1) transpose_item((const float*)A.in[13], D, D, D, (bf16_t*)(ws + WS_WOUT0), 0, scr, it - T0, lane);
            else if (it < T2) transpose_item(w1_0, D, FF, FF, (bf16_t*)(ws + WS_W13_0), 1, scr, it - T1, lane, (const float*)A.in[10]);
            else if (it < T3) transpose_item(w3_0, D, FF, FF, (bf16_t*)(ws + WS_W13_0), 2, scr, it - T2, lane, (const float*)A.in[10]);
            else if (it < T4) transpose_item(w2_0, FF, D, D, (bf16_t*)(ws + WS_W2_0), 0, scr, it - T3, lane);
            else if (it < T5) transpose_item((const float*)A.in[21], D, C_IN, C_IN_PAD, (bf16_t*)(ws + WS_WIN1), 0, scr, it - T4, lane, (const float*)A.in[9] + D);
            else if (it < T6) transpose_item((const float*)A.in[22], D, D, D, (bf16_t*)(ws + WS_WOUT1), 0, scr, it - T5, lane);
            else if (it < T7) transpose_item(w1_0 + (size_t)D * FF, D, FF, FF, (bf16_t*)(ws + WS_W13_1), 1, scr, it - T6, lane, (const float*)A.in[10] + D);
            else if (it < T8) transpose_item(w3_0 + (size_t)D * FF, D, FF, FF, (bf16_t*)(ws + WS_W13_1), 2, scr, it - T7, lane, (const float*)A.in[10] + D);
            else transpose_item(w2_0 + (size_t)FF * D, FF, D, D, (bf16_t*)(ws + WS_W2_1), 0, scr, it - T8, lane);
        }
    }
}
__device__ __forceinline__ void p0_prologue(const Frame& F) {
    const Args& A = *F.a;
    unsigned char* ws = F.ws;
    const int lane = F.lane;
    constexpr int X0 = WT_T4;
    constexpr int NMISC = 16 + 64 + 1;
    constexpr int R0 = X0 + NMISC;
    constexpr int NITEMS = R0 + M;
    for (int it = F.gw; it < NITEMS; it += F.NGW) {
        if (it < WT_T4) { weight_transpose_item(F, it);
        } else if (it < R0) {
            const int mi = it - X0;
            if (mi < 16) {
                const int mat = mi >> 3, n = mi & 7; const float* W = (const float*)A.in[mat ? 18 : 16] + (size_t)n * 4096;
                bf16_t* dst = (bf16_t*)(ws + WS_WG) + ((size_t)(mat * 8 + n) * 64 + lane) * 64;
#pragma unroll
                for (int k8 = 0; k8 < 8; ++k8) { const int d0 = k8 >> 1, h = k8 & 1; float v[8];
#pragma unroll
                    for (int jj = 0; jj < 8; ++jj) { const int i = 16 * d0 + 8 * (jj >> 2) + 4 * h + (jj & 3); v[jj] = W[i * 64 + lane]; }
                    u32x4 o; o.x = cvtpk(v[0], v[1]); o.y = cvtpk(v[2], v[3]); o.z = cvtpk(v[4], v[5]); o.w = cvtpk(v[6], v[7]);
                    *(u32x4*)(dst + 8 * k8) = o; }
            } else if (mi < 16 + 64) {
                const int lc = mi - 16, l = lc >> 1, c = lc & 1; const float* W = (const float*)A.in[23] + (size_t)(l * 2 + c) * 4096;
                bf16_t* dst = (bf16_t*)(ws + WS_WCT) + ((size_t)(c * 32 + l) * 4 * 2) * 512 + lane * 8;
                const int r32 = lane & 31, hi = lane >> 5;
                const float* P = (const float*)A.in[24] + (size_t)(l * 2 + c) * 64 + 8 * hi;
                float pt0 = 0.f, pt1 = 0.f;
#pragma unroll
                for (int k4 = 0; k4 < 4; ++k4) {
                    const f32x4 pa = *(const f32x4*)(P + 16 * k4), pb = *(const f32x4*)(P + 16 * k4 + 4);
#pragma unroll
                    for (int eh = 0; eh < 2; ++eh) { float v[8];
#pragma unroll
                        for (int j = 0; j < 8; ++j) v[j] = W[(16 * k4 + 8 * hi + j) * 64 + r32 + 32 * eh];
                        u32x4 o; o.x = cvtpk(v[0], v[1]); o.y = cvtpk(v[2], v[3]); o.z = cvtpk(v[4], v[5]); o.w = cvtpk(v[6], v[7]);
                        *(u32x4*)(dst + (size_t)(k4 * 2 + eh) * 512) = o;
                        const float t = ((pa.x * v[0] + pa.y * v[1]) + (pa.z * v[2] + pa.w * v[3])) + ((pb.x * v[4] + pb.y * v[5]) + (pb.z * v[6] + pb.w * v[7]));
                        if (eh) pt1 += t; else pt0 += t; }
                }
                pt0 += __shfl_xor(pt0, 32); pt1 += __shfl_xor(pt1, 32);
                ((float*)(ws + WS_PETP))[(size_t)(c * 32 + l) * 64 + lane] = hi ? pt1 : pt0;
            } else {
                const float* L = (const float*)A.in[20];
#pragma unroll
                for (int j = 0; j < 8; ++j) { const float z = -L[j * 64 + lane]; ((float*)(ws + WS_C8))[j * 64 + lane] = 8.f * (fmaxf(z, 0.f) + log1pf(expf(-fabsf(z)))); }
            }
        } else {
            const int r = it - R0;
#define XROW(r_) ((r_) < MP ? (const float*)A.in[0] + (size_t)(r_) * D : (const float*)A.in[1] + (size_t)((r_) - MP) * D)
#define OROW(r_) ((bf16_t*)(ws + WS_XN) + (size_t)(r_) * D)
            if (r + 3 * F.NGW < M) {
                rms_rows4_to_bf16(XROW(r), XROW(r + F.NGW), XROW(r + 2 * F.NGW), XROW(r + 3 * F.NGW), (const float*)A.in[9], OROW(r), OROW(r + F.NGW), OROW(r + 2 * F.NGW), OROW(r + 3 * F.NGW), lane);
                it += 3 * F.NGW;
            } else rms_row_to_bf16(XROW(r), (const float*)A.in[9], OROW(r), lane);
#undef XROW
#undef OROW
        }
    }
}
constexpr int NDC = BS * 255, NWC = BS * 32;
__device__ __forceinline__ void copy_item(const Frame& F, int ci) {
    const float* src; float* dst; const int lane = F.lane; bool half2 = true;
    if (ci < NDC) { const int b = ci / 255, ch = ci % 255; src = (const float*)F.a->in[2] + ((size_t)b * 2048 + 8) * 1024 + (size_t)ch * 8192; dst = F.out + O_DILS + (size_t)b * 2048 * 1024 + (size_t)ch * 8192; }
    else { const int c2 = ci - NDC, b = c2 >> 5, ch = c2 & 31; src = (const float*)F.a->in[5] + ((size_t)b * 512 + 8) * 512 + (size_t)ch * 8192; dst = F.out + O_WINS + (size_t)b * 512 * 512 + (size_t)ch * 8192; half2 = ch < 31; }
    f32x4 v[32];
#pragma unroll
    for (int j = 0; j < 16; ++j) v[j] = __builtin_nontemporal_load((const f32x4*)src + j * 64 + lane);
    if (half2) {
#pragma unroll
        for (int j = 16; j < 32; ++j) v[j] = __builtin_nontemporal_load((const f32x4*)src + j * 64 + lane); }
#pragma unroll
    for (int j = 0; j < 16; ++j) __builtin_nontemporal_store(v[j], (f32x4*)dst + j * 64 + lane);
    if (half2) {
#pragma unroll
        for (int j = 16; j < 32; ++j) __builtin_nontemporal_store(v[j], (f32x4*)dst + j * 64 + lane); }
}

namespace pg8 {
struct GatedOrder : StaticOrder {
    unsigned* flag; unsigned need; unsigned* bar;
    __device__ __forceinline__ void a_ready(const Unit& u) const {
        if (u.pm == MP / BM) {
            XB_SPIN(xb_ld(flag) < need, bar);
            __builtin_amdgcn_fence(__ATOMIC_ACQUIRE, "agent");
            asm volatile("s_waitcnt vmcnt(0)" ::: "memory");
        }
    }
};
__device__ __forceinline__ float row_rstd_q(const float* ssp, int row, int fq) {
    const f32x4 a = *(const f32x4*)(ssp + (size_t)row * 16 + fq * 4);
    float t = (a.x + a.y) + (a.z + a.w);
    { auto rr = __builtin_amdgcn_permlane16_swap(__float_as_uint(t), __float_as_uint(t), false, false); t = __uint_as_float(rr[0]) + __uint_as_float(rr[1]); }
    { auto rr = __builtin_amdgcn_permlane32_swap(__float_as_uint(t), __float_as_uint(t), false, false); t = __uint_as_float(rr[0]) + __uint_as_float(rr[1]); }
    return __builtin_amdgcn_rsqf(t * (1.f / D) + EPS);
}
__device__ __forceinline__ float row_rstd(const float* ssp, int row) {
    const f32x4* p = (const f32x4*)(ssp + (size_t)row * 16);
    const f32x4 a = p[0], b = p[1], c = p[2], d = p[3];
    const float s = ((a.x + a.y) + (a.z + a.w)) + ((b.x + b.y) + (b.z + b.w)) + ((c.x + c.y) + (c.z + c.w)) + ((d.x + d.y) + (d.z + d.w));
    return __builtin_amdgcn_rsqf(s * (1.f / D) + EPS);
}
__device__ __forceinline__ void unpack8(const bf16x8& v, f32x4& a, f32x4& b) {
    const u32x4 w = __builtin_bit_cast(u32x4, v);
    a = (f32x4){__uint_as_float(w.x << 16), __uint_as_float(w.x & 0xffff0000u), __uint_as_float(w.y << 16), __uint_as_float(w.y & 0xffff0000u)};
    b = (f32x4){__uint_as_float(w.z << 16), __uint_as_float(w.z & 0xffff0000u), __uint_as_float(w.w << 16), __uint_as_float(w.w & 0xffff0000u)};
}
template <bool RES_BF16, bool OUT_F32 = false>
struct EpiRes {
    static constexpr bool PERM = true, AFTER_DRAIN = false;
    const float* resF; bf16_t* Yb; float* Yf; float* ssp;
    __device__ __forceinline__ void operator()(const Acc& acc, const Unit& u, int wr, int wc, int fr, int fq) const {
        const int cb = u.pn * BM + wc * 32 + 8 * fq;
#pragma unroll
        for (int ai = 0; ai < 2; ++ai)
#pragma unroll
            for (int m = 0; m < 4; ++m) {
                const int row = u.pm * BM + ai * HALF + wr * 64 + m * 16 + fr;
                float ss = 0.f;
#pragma unroll
                for (int bj = 0; bj < 2; ++bj) {
                    const int col = cb + bj * HALF;
                    f32x4 r0, r1;
                    if (RES_BF16) unpack8(*(const bf16x8*)(Yb + (size_t)row * D + col), r0, r1);
                    else { r0 = *(const f32x4*)(resF + (size_t)row * D + col); r1 = *(const f32x4*)(resF + (size_t)row * D + col + 4); }
                    const f32x4 y0 = acc[ai][bj][m][0] + r0, y1 = acc[ai][bj][m][1] + r1;
                    if (OUT_F32) { float* yp = Yf + (size_t)row * D + col; *(f32x4*)yp = y0; *(f32x4*)(yp + 4) = y1; }
                    else *(bf16x8*)(Yb + (size_t)row * D + col) = pack8(y0, y1);
                    ss += (y0.x * y0.x + y0.y * y0.y) + (y0.z * y0.z + y0.w * y0.w) + (y1.x * y1.x + y1.y * y1.y) + (y1.z * y1.z + y1.w * y1.w);
                }
                ss += __shfl_xor(ss, 16); ss += __shfl_xor(ss, 32);
                if (fq == 0) ssp[(size_t)row * 16 + u.pn * 4 + wc] = ss;
            }
    }
};
struct EpiResNorm {
    static constexpr bool PERM = true, AFTER_DRAIN = true;
    const bf16_t* res; float* out; const float* gain; float* xslot; unsigned* cnt; unsigned* tmo;
    __device__ __forceinline__ void fused(Acc& acc, const Unit& u, int wr, int wc, int fr, int fq, PG8_LAS unsigned char* lds, int wid, int lane, int tid) const {
        PG8_LAS float* P = (PG8_LAS float*)lds;
        PG8_LAS float* S = (PG8_LAS float*)(lds + 4096);
        const int cb = u.pn * BM + wc * 32 + 8 * fq;
#pragma unroll
        for (int am = 0; am < 4; ++am) {
            const int ai = am >> 1, m0 = (am & 1) * 2;
            f32x4 r[2][2][2];
#pragma unroll
            for (int mm = 0; mm < 2; ++mm) { const bf16_t* rp = res + (size_t)(u.pm * BM + ai * HALF + wr * 64 + (m0 + mm) * 16 + fr) * D;
#pragma unroll
                for (int bj = 0; bj < 2; ++bj) unpack8(*(const bf16x8*)(rp + cb + bj * HALF), r[mm][bj][0], r[mm][bj][1]); }
#pragma unroll
            for (int mm = 0; mm < 2; ++mm) { const int m = m0 + mm; float ss = 0.f;
#pragma unroll
                for (int bj = 0; bj < 2; ++bj)
#pragma unroll
                    for (int n = 0; n < 2; ++n) { const f32x4 y = acc[ai][bj][m][n] + r[mm][bj][n]; acc[ai][bj][m][n] = y; ss += (y.x * y.x + y.y * y.y) + (y.z * y.z + y.w * y.w); }
                ss += __shfl_xor(ss, 16); ss += __shfl_xor(ss, 32);
                if (fq == 0) P[(ai * HALF + wr * 64 + m * 16 + fr) * 4 + wc] = ss; }
        }
        asm volatile("s_waitcnt lgkmcnt(0)" ::: "memory"); __builtin_amdgcn_s_barrier(); asm volatile("" ::: "memory");
        if (tid < 256) { const float t = (P[tid * 4 + 0] + P[tid * 4 + 1]) + (P[tid * 4 + 2] + P[tid * 4 + 3]);
            __hip_atomic_store((unsigned*)xslot + ((size_t)(u.pm * BM + tid) * 4 + u.pn), __float_as_uint(t), __ATOMIC_RELAXED, __HIP_MEMORY_SCOPE_AGENT); }
        asm volatile("s_waitcnt vmcnt(0)" ::: "memory");
        if (lane == 0) __hip_atomic_fetch_add(cnt + 64 * u.pm, 1u, __ATOMIC_RELAXED, __HIP_MEMORY_SCOPE_AGENT);
        if (wid == 0) {
            unsigned spins = 0;
            while ((unsigned)__builtin_amdgcn_readfirstlane(__hip_atomic_load(cnt + 64 * u.pm, __ATOMIC_RELAXED, __HIP_MEMORY_SCOPE_AGENT)) < 32u) {
                __builtin_amdgcn_s_sleep(2); if (++spins > (1u << 22)) { if (lane == 0) atomicAdd(tmo, 1u); break; } }
            __builtin_amdgcn_fence(__ATOMIC_ACQUIRE, "agent");
        }
        asm volatile("s_waitcnt vmcnt(0) lgkmcnt(0)" ::: "memory"); __builtin_amdgcn_s_barrier(); asm volatile("" ::: "memory");
        if (tid < 256) { const unsigned* sl = (const unsigned*)xslot + (size_t)(u.pm * BM + tid) * 4; float t = 0.f;
#pragma unroll
            for (int k = 0; k < 4; ++k) t += __uint_as_float(__hip_atomic_load(sl + k, __ATOMIC_RELAXED, __HIP_MEMORY_SCOPE_AGENT));
            S[tid] = __builtin_amdgcn_rsqf(t * (1.f / D) + EPS); }
        asm volatile("s_waitcnt lgkmcnt(0)" ::: "memory"); __builtin_amdgcn_s_barrier(); asm volatile("" ::: "memory");
        f32x4 g[2][2];
#pragma unroll
        for (int bj = 0; bj < 2; ++bj) { g[bj][0] = *(const f32x4*)(gain + cb + bj * HALF); g[bj][1] = *(const f32x4*)(gain + cb + bj * HALF + 4); }
#pragma unroll
        for (int ai = 0; ai < 2; ++ai)
#pragma unroll
            for (int m = 0; m < 4; ++m) { const int rl = ai * HALF + wr * 64 + m * 16 + fr; const float rs = S[rl]; float* op = out + (size_t)(u.pm * BM + rl) * D + cb;
#pragma unroll
                for (int bj = 0; bj < 2; ++bj) { *(f32x4*)(op + bj * HALF) = acc[ai][bj][m][0] * rs * g[bj][0]; *(f32x4*)(op + bj * HALF + 4) = acc[ai][bj][m][1] * rs * g[bj][1]; } }
        asm volatile("s_waitcnt lgkmcnt(0)" ::: "memory"); __builtin_amdgcn_s_barrier(); asm volatile("" ::: "memory");
    }
};
struct EpiSlab {
    static constexpr bool PERM = true, AFTER_DRAIN = false;
    float* slab;
    __device__ __forceinline__ void operator()(const Acc& acc, const Unit& u, int wr, int wc, int fr, int fq) const {
        const int cb = u.pn * BM + wc * 32 + 8 * fq;
#pragma unroll
        for (int ai = 0; ai < 2; ++ai)
#pragma unroll
            for (int m = 0; m < 4; ++m) { float* rp = slab + (size_t)(ai * HALF + wr * 64 + m * 16 + fr) * D;
#pragma unroll
                for (int bj = 0; bj < 2; ++bj) { *(f32x4*)(rp + cb + bj * HALF) = acc[ai][bj][m][0]; *(f32x4*)(rp + cb + bj * HALF + 4) = acc[ai][bj][m][1]; } }
    }
};
struct EpiUp {
    static constexpr bool PERM = true, AFTER_DRAIN = false;
    const float* ssp; bf16_t* H;
    __device__ __forceinline__ void operator()(const Acc& acc, const Unit& u, int wr, int wc, int fr, int fq) const {
        const int col = u.pn * HALF + wc * 32 + 8 * fq;
#pragma unroll
        for (int ai = 0; ai < 2; ++ai)
#pragma unroll
            for (int m = 0; m < 4; ++m) {
                const int row = u.pm * BM + ai * HALF + wr * 64 + m * 16 + fr;
                const float rs = row_rstd_q(ssp, row, fq);
                f32x4 h[2];
#pragma unroll
                for (int n = 0; n < 2; ++n) {
                    const f32x4 a = acc[ai][0][m][n] * rs, b = acc[ai][1][m][n] * rs;
#pragma unroll
                    for (int e = 0; e < 4; ++e) h[n][e] = a[e] * b[e] * __builtin_amdgcn_rcpf(1.f + __expf(-a[e]));
                }
                *(bf16x8*)(H + (size_t)row * FF + col) = pack8(h[0], h[1]);
            }
    }
};
struct EpiIn1 {
    static constexpr bool PERM = true, AFTER_DRAIN = false;
    const float* ssp; bf16_t* Q1; bf16_t* KVSEL; bf16_t* KVWIN; float* G1; float* out;
    __device__ __forceinline__ void operator()(const Acc& acc, const Unit& u, int wr, int wc, int fr, int fq) const {
        const int pn = u.pn;
#pragma unroll
        for (int ai = 0; ai < 2; ++ai)
#pragma unroll
            for (int m = 0; m < 4; ++m) {
                const int row = u.pm * BM + ai * HALF + wr * 64 + m * 16 + fr;
                const float rs = row_rstd_q(ssp, row, fq);
                const bool smp = row >= MP; const int b = smp ? (row - MP) >> 3 : row >> 12, t = smp ? (row - MP) & 7 : row & 4095;
#pragma unroll
                for (int bj = 0; bj < 2; ++bj) {
                    const int lc = bj * HALF + wc * 32 + 8 * fq;
                    const f32x4 v0 = acc[ai][bj][m][0] * rs, v1 = acc[ai][bj][m][1] * rs;
                    if (pn < 4) { *(bf16x8*)(Q1 + (size_t)row * D + pn * 256 + lc) = pack8(v0 * C_SCALE2, v1 * C_SCALE2); }
                    else if (pn < 6) { const int col = (pn - 4) * 256 + lc;
                        float* o = smp ? out + O_CMPS + (size_t)(row - MP) * 512 + col : out + O_CMPP + (size_t)row * 512 + col;
                        *(f32x4*)o = v0; *(f32x4*)(o + 4) = v1; }
                    else if (pn < 8) { const int col = (pn - 6) * 256 + lc;
                        float* o = smp ? out + O_SELS + (size_t)(row - MP) * 512 + col : out + O_SELP + (size_t)row * 512 + col;
                        *(f32x4*)o = v0; *(f32x4*)(o + 4) = v1;
                        if (!smp) *(bf16x8*)(KVSEL + (size_t)row * 512 + col) = pack8(v0, v1); }
                    else if (pn < 10) { const int col = (pn - 8) * 256 + lc;
                        if (!smp) *(bf16x8*)(KVWIN + (size_t)row * 512 + col) = pack8(v0, v1);
                        float* o = nullptr;
                        if (smp) o = out + O_WINS + (size_t)(b * 512 + 504 + t) * 512 + col;
                        else if (t >= SEQ - WIN) o = out + O_WINP + (size_t)(b * 512 + t - (SEQ - WIN)) * 512 + col;
                        if (o) { *(f32x4*)o = v0; *(f32x4*)(o + 4) = v1; } }
                    else { if (lc < 48) { f32x4 s0, s1;
#pragma unroll
                            for (int e = 0; e < 4; ++e) { s0[e] = __builtin_amdgcn_rcpf(1.f + __expf(-v0[e])); s1[e] = __builtin_amdgcn_rcpf(1.f + __expf(-v1[e])); }
                            float* o = G1 + (size_t)row * 48 + lc; *(f32x4*)o = s0; *(f32x4*)(o + 4) = s1; } }
                }
            }
    }
};
}

template <typename T> struct Src;
template <> struct Src<bf16_t> { typedef bf16x8 raw;
    static __device__ __forceinline__ raw ld(const bf16_t* p) { return *(const bf16x8*)p; }
    static __device__ __forceinline__ bf16x8 cv(const raw& r) { return r; } };
template <> struct Src<float> { struct raw { f32x4 a, b; };
    static __device__ __forceinline__ raw ld(const float* p) { raw r; r.a = *(const f32x4*)p; r.b = *(const f32x4*)(p + 4); return r; }
    static __device__ __forceinline__ bf16x8 cv(const raw& r) { return pack8(r.a, r.b); } };

constexpr int VT_MT = 2112;
constexpr float NEG_INF = -__builtin_inff();
struct AttnAcc { f32x16 o0, o1; float m, l; };
__device__ __forceinline__ void acc_init(AttnAcc& A) {
#pragma unroll
    for (int r = 0; r < 16; ++r) { A.o0[r] = 0.f; A.o1[r] = 0.f; }
    A.m = NEG_INF; A.l = 0.f;
}
__device__ __forceinline__ float swap32_max(float v) { auto rr = __builtin_amdgcn_permlane32_swap(__float_as_uint(v), __float_as_uint(v), false, false); return fmaxf(__uint_as_float(rr[0]), __uint_as_float(rr[1])); }
__device__ __forceinline__ float swap32_sum(float v) { auto rr = __builtin_amdgcn_permlane32_swap(__float_as_uint(v), __float_as_uint(v), false, false); return __uint_as_float(rr[0]) + __uint_as_float(rr[1]); }
__device__ __forceinline__ int crow(int r, int hi) { return (r & 3) + 8 * (r >> 2) + 4 * hi; }
typedef short v4i16_t __attribute__((ext_vector_type(4)));
__device__ __forceinline__ s16x4 vtr(const LAS unsigned char* p) { return __builtin_bit_cast(s16x4, __builtin_amdgcn_ds_read_tr16_b64_v4i16((LAS v4i16_t*)p)); }

struct VFrag { s16x4 lo[4], hh[4]; };
__device__ __forceinline__ void vt_read(VFrag& f, const LAS unsigned char* vb) {
#pragma unroll
    for (int mt = 0; mt < 2; ++mt)
#pragma unroll
        for (int ks = 0; ks < 2; ++ks) { f.lo[mt * 2 + ks] = vtr(vb + mt * VT_MT + ks * 1024); f.hh[mt * 2 + ks] = vtr(vb + mt * VT_MT + ks * 1024 + 512); }
}
__device__ __forceinline__ void pv_tile(f32x16& o0, f32x16& o1, const VFrag& f, bf16x8 pf0, bf16x8 pf1) {
#define VFR(i) (bf16x8){f.lo[i][0], f.lo[i][1], f.lo[i][2], f.lo[i][3], f.hh[i][0], f.hh[i][1], f.hh[i][2], f.hh[i][3]}
    __builtin_amdgcn_s_setprio(1);
    o0 = __builtin_amdgcn_mfma_f32_32x32x16_bf16(VFR(0), pf0, o0, 0, 0, 0);
    o0 = __builtin_amdgcn_mfma_f32_32x32x16_bf16(VFR(1), pf1, o0, 0, 0, 0);
    o1 = __builtin_amdgcn_mfma_f32_32x32x16_bf16(VFR(2), pf0, o1, 0, 0, 0);
    o1 = __builtin_amdgcn_mfma_f32_32x32x16_bf16(VFR(3), pf1, o1, 0, 0, 0);
    __builtin_amdgcn_s_setprio(0);
#undef VFR
}
__device__ __forceinline__ bf16x8 pack_p(const f32x16& p, int base) {
    u32x4 w; w.x = cvtpk(p[base + 0], p[base + 1]); w.y = cvtpk(p[base + 2], p[base + 3]); w.z = cvtpk(p[base + 4], p[base + 5]); w.w = cvtpk(p[base + 6], p[base + 7]);
    return __builtin_bit_cast(bf16x8, w);
}

constexpr float RESC_THR = 6.f;
constexpr int KT_OFF = 4352;
struct NoHook { __device__ __forceinline__ void operator()(int, const f32x16&) const {} };
template <typename T, int MODE, int VOFF, int PFD = 1, class RP, class MK, class HK = NoHook>
__device__ __forceinline__ void attn_run(AttnAcc& A, const bf16x8 (&qf)[4], int t_begin, int t_end, LAS unsigned char* vt, int lane, RP rp, MK mk, HK hk = HK()) {
    if (t_begin >= t_end) return;
    const int r32 = lane & 31, hi = lane >> 5, vkey = lane >> 3, vch = lane & 7;
    LAS unsigned char* vdst = vt + (vch >> 2) * VT_MT + vkey * 64 + (vch & 3) * 16;
    const LAS unsigned char* vb = vt + ((lane >> 4) & 1) * 32 + (lane & 3) * 8 + (4 * hi + ((lane & 15) >> 2)) * 64;
    LAS unsigned char* kt = vt + KT_OFF;
    const int kswz_w = (vkey >> 1) & 3;
    const LAS unsigned char* krd = kt + r32 * 128; const int kswz_r = (r32 >> 1) & 7;
    typedef typename Src<T>::raw raw_t;
    auto loads = [&](raw_t (&kr)[4], raw_t (&vr)[4], int tt) {
#pragma unroll
        for (int i = 0; i < 4; ++i) { const T* p_ = rp(tt, vkey + 8 * i) + 8 * vch; kr[i] = Src<T>::ld(p_); if (MODE != 1) vr[i] = Src<T>::ld(p_ + VOFF); } };
    auto tile = [&](int t, raw_t (&kr)[4], raw_t (&vr)[4], int tnext) {
        asm volatile("" ::: "memory");
#pragma unroll
        for (int i = 0; i < 4; ++i) {
            *(LAS bf16x8*)(kt + (vkey + 8 * i) * 128 + ((vch ^ (kswz_w | ((i & 1) << 2))) * 16)) = Src<T>::cv(kr[i]);
            if (MODE != 1) *(LAS bf16x8*)(vdst + i * 512) = Src<T>::cv(vr[i]);
        }
        if (tnext >= t_begin) loads(kr, vr, tnext);
        asm volatile("s_waitcnt lgkmcnt(0)" ::: "memory");
        bf16x8 kf[4];
#pragma unroll
        for (int d0 = 0; d0 < 4; ++d0) kf[d0] = *(const LAS bf16x8*)(krd + (((2 * d0 + hi) ^ kswz_r) * 16));
        VFrag vf;
        if (MODE != 1) { vt_read(vf, vb); __builtin_amdgcn_sched_barrier(0); }
        f32x16 s;
#pragma unroll
        for (int r = 0; r < 16; ++r) s[r] = 0.f;
        __builtin_amdgcn_s_setprio(1);
#pragma unroll
        for (int d0 = 0; d0 < 4; ++d0) s = __builtin_amdgcn_mfma_f32_32x32x16_bf16(kf[d0], qf[d0], s, 0, 0, 0);
        __builtin_amdgcn_s_setprio(0);
        if (MODE == 2) {
            mk(t, s, -A.m);
#pragma unroll
            for (int r = 0; r < 16; ++r) s[r] = __builtin_amdgcn_exp2f(s[r]) * A.l;
            hk(t, s);
        } else {
            const bool first = A.m == NEG_INF;
            mk(t, s, first ? 0.f : -A.m);
            float tm = fmaxf(fmaxf(s[0], s[1]), fmaxf(s[2], s[3]));
#pragma unroll
            for (int r = 4; r < 16; r += 4) tm = fmaxf(tm, fmaxf(fmaxf(s[r], s[r + 1]), fmaxf(s[r + 2], s[r + 3])));
            tm = swap32_max(tm);
            if (__any(first ? tm > NEG_INF : tm > RESC_THR)) {
                const float up = first ? tm : fmaxf(tm, 0.f);
                const float alpha = first ? 0.f : __builtin_amdgcn_exp2f(-up);
                A.l *= alpha; A.m = first ? up : A.m + up;
                const float sh = (up == NEG_INF) ? 0.f : up;
#pragma unroll
                for (int r = 0; r < 16; ++r) s[r] -= sh;
                if (MODE == 0) {
#pragma unroll
                    for (int r = 0; r < 16; ++r) { A.o0[r] *= alpha; A.o1[r] *= alpha; } }
            }
            float ps = 0.f;
#pragma unroll
            for (int r = 0; r < 16; ++r) { s[r] = __builtin_amdgcn_exp2f(s[r]); ps += s[r]; }
            A.l += swap32_sum(ps);
        }
        if (MODE != 1) {
            const bf16x8 pf0 = pack_p(s, 0), pf1 = pack_p(s, 8);
            pv_tile(A.o0, A.o1, vf, pf0, pf1);
        }
        asm volatile("" ::: "memory");
    };
    raw_t krA[4], vrA[4];
    int t = t_end - 1;
    loads(krA, vrA, t);
    if (PFD == 2) {
        raw_t krB[4], vrB[4];
        if (t - 1 >= t_begin) loads(krB, vrB, t - 1);
        while (t >= t_begin) {
            tile(t, krA, vrA, t - 2);
            if (t - 1 < t_begin) break;
            tile(t - 1, krB, vrB, t - 3);
            t -= 2;
        }
    } else {
        for (; t >= t_begin; --t) tile(t, krA, vrA, t - 1);
    }
}
template <int KS, int CHECK>
__device__ __forceinline__ void bias_mask(f32x16& s, float dq, float nslope2, float lo, float hi_, int hi, float base = 0.f) {
    const float dq2 = dq - (float)(KS * 4 * hi);
#pragma unroll
    for (int r = 0; r < 16; ++r) {
        const float d = dq2 - (float)(KS * ((r & 3) + 8 * (r >> 2)));
        float x = __builtin_fmaf(d, nslope2, s[r] + base);
        asm volatile("" : "+v"(x));
        if (CHECK == 1) { const bool ok = (d >= lo) & (d <= hi_); s[r] = ok ? x : NEG_INF; } else if (CHECK == 2) { s[r] = d >= lo ? x : NEG_INF; } else s[r] = x;
    }
}

__device__ __forceinline__ void store_o(bf16_t* orow, const f32x16& o0, const f32x16& o1, float sc, int hi) {
#pragma unroll
    for (int i = 0; i < 4; ++i) {
        u32x2 w; w.x = cvtpk(o0[4 * i] * sc, o0[4 * i + 1] * sc); w.y = cvtpk(o0[4 * i + 2] * sc, o0[4 * i + 3] * sc); *(u32x2*)(orow + 8 * i + 4 * hi) = w;
        u32x2 x; x.x = cvtpk(o1[4 * i] * sc, o1[4 * i + 1] * sc); x.y = cvtpk(o1[4 * i + 2] * sc, o1[4 * i + 3] * sc); *(u32x2*)(orow + 32 + 8 * i + 4 * hi) = x;
    }
}

__device__ __forceinline__ void dil_item_prompt(const Frame& F, int item) {
    const int lane = F.lane, r32 = lane & 31, hi = lane >> 5;
    const int j = item & 7, blk = (item >> 3) & 15, h = (item >> 7) & 7, b = item >> 10;
    const int q0 = blk * 256 + j, q = q0 + 8 * r32;
    const bf16_t* QD = (const bf16_t*)(F.ws + WS_QD); const bf16_t* KVD = (const bf16_t*)(F.ws + WS_KVD);
    const size_t rb = (size_t)b * SEQ;
    bf16x8 qf[4];
#pragma unroll
    for (int d0 = 0; d0 < 4; ++d0) qf[d0] = *(const bf16x8*)(QD + (rb + q) * 512 + h * 64 + 16 * d0 + 8 * hi);
    const float nslope2 = -__builtin_amdgcn_exp2f(-(float)(h + 1)) * LOG2E; const bool par = (r32 & 1) != 0;
    const bf16_t* Kb = KVD + rb * 1024 + h * 64;
    AttnAcc A; acc_init(A);
    LAS unsigned char* vt = F.wscr;
#define DIL_BRANCH(ST, K0, NT, WINDOW, PAR) do { \
        const int need_ = -(K0) - 31 - q0 / (ST); const int tb_ = need_ <= 0 ? 0 : (need_ + 31) >> 5; \
        auto rp = [&](int t, int key) -> const bf16_t* { int pos = q0 + (ST) * ((K0) + 32 * t + key); pos = pos < 0 ? 0 : (pos > SEQ - 1 ? SEQ - 1 : pos); return Kb + (size_t)pos * 1024; }; \
        auto mk = [&](int t, f32x16& s, float sh) { \
            const int tb = q0 + (ST) * ((K0) + 32 * t);                      \
            const float dq = (float)(q - tb); const float lim = fminf((float)(WINDOW), (float)q); \
            bias_mask<(ST), true>(s, dq, nslope2, 0.f, lim, hi, sh); \
            if (PAR) { _Pragma("unroll") for (int r = 0; r < 16; ++r) { const bool keep = (r & 1) ? par : !par; s[r] = keep ? s[r] : NEG_INF; } } }; \
        attn_run<bf16_t, 0, 512, 2>(A, qf, tb_, (NT), vt, lane, rp, mk); } while (0)
    DIL_BRANCH(1, -128, 12, 128, false);
    DIL_BRANCH(4, -128, 6, 512, false);
    DIL_BRANCH(8, -256, 9, 2048, true);
#undef DIL_BRANCH
    const float inv = 1.f / fmaxf(A.l, 1e-30f);
    store_o((bf16_t*)(F.ws + WS_O) + (rb + q) * D + h * 64, A.o0, A.o1, inv, hi);
}
__device__ __forceinline__ void dil_item_sample(const Frame& F, int item) {
    const int lane = F.lane, hi = lane >> 5, qi = lane & 7;
    const int h = item & 7, b = item >> 3;
    const size_t row = (size_t)MP + b * 8 + qi;
    const bf16_t* QD = (const bf16_t*)(F.ws + WS_QD);
    bf16x8 qf[4];
#pragma unroll
    for (int d0 = 0; d0 < 4; ++d0) qf[d0] = *(const bf16x8*)(QD + row * 512 + h * 64 + 16 * d0 + 8 * hi);
    const float slope2 = __builtin_amdgcn_exp2f(-(float)(h + 1)) * LOG2E;
    const float* cache = (const float*)F.a->in[2] + (size_t)b * 2048 * 1024 + h * 64;
    const float* newr = F.out + O_DILS + (size_t)b * 2048 * 1024 + h * 64;
    AttnAcc A; acc_init(A);
    LAS unsigned char* vt = F.wscr;
    auto geom = [&](int t, int& sh, int& pos0, int& tt, int& cls) { if (t < 5) { sh = 0; cls = 0; tt = t; pos0 = 1920; } else if (t < 25) { sh = 2; cls = (t - 5) / 5; tt = (t - 5) - 5 * cls; pos0 = 1536 + cls; } else { sh = 4; cls = (t - 25) / 5; tt = (t - 25) - 5 * cls; pos0 = cls; } };
    auto rowp = [&](int t, int key) -> const float* { int sh, pos0, tt, cls; geom(t, sh, pos0, tt, cls); int c = pos0 + ((32 * tt + key) << sh); c = c > 2055 ? 2055 : c; return c < 2048 ? cache + (size_t)c * 1024 : newr + (size_t)(c - 8) * 1024; };
    auto mk = [&](int t, f32x16& s, float shf) {
        int sh, pos0, tt, cls; geom(t, sh, pos0, tt, cls);
        const bool ok2 = sh == 0 ? true : (sh == 2 ? (qi & 3) == cls : qi == cls);
        const float dq = (float)(((2048 + qi - pos0) >> sh) - 32 * tt);
        bias_mask<1, true>(s, dq, -slope2 * (float)(1 << sh), 0.f, 128.f, hi, ok2 ? shf : NEG_INF); };
    attn_run<float, 0, 512>(A, qf, 0, 65, vt, lane, rowp, mk);
    const float inv = 1.f / fmaxf(A.l, 1e-30f);
    if ((lane & 31) < 8) store_o((bf16_t*)(F.ws + WS_O) + row * D + h * 64, A.o0, A.o1, inv, hi);
}

template <bool SAMPLE>
__device__ __forceinline__ void rglru_gates_item(const Frame& F, int item) {
    const int lane = F.lane, r32 = lane & 31, hi = lane >> 5;
    const int n = item & 7, tile = item >> 3;
    const int b = SAMPLE ? tile : tile >> 7, t = SAMPLE ? (r32 < 8 ? r32 : 7) : ((tile & 127) * 32 + r32);
    const size_t rowbase = SAMPLE ? (size_t)MP + b * 8 : (size_t)b * SEQ;
    const float* XR = (const float*)(F.ws + WS_XR);
    const float* cw = (const float*)F.a->in[14]; const float* cbias = (const float*)F.a->in[15];
    const float* sconv = (const float*)F.a->in[3] + (size_t)b * 3 * 512;
    const int ch0 = 64 * n + 4 * hi;
    f32x4 xc[8];
#pragma unroll
    for (int a = 0; a < 8; ++a) {
        const int ch = ch0 + 8 * a;
        f32x4 acc = *(const f32x4*)(cbias + ch);
#pragma unroll
        for (int k = 0; k < 4; ++k) {
            const int tau = t + k - 3;
            const float* xp = XR + (rowbase + (tau >= 0 ? tau : 0)) * 512 + ch;
            if (SAMPLE) xp = tau >= 0 ? xp : sconv + (3 + tau) * 512 + ch;
            f32x4 x = *(const f32x4*)xp;
            const float keep = (SAMPLE || tau >= 0) ? 1.f : 0.f;
            acc += x * (*(const f32x4*)(cw + k * 512 + ch) * keep);
        }
        xc[a] = acc;
        if (a & 1) __builtin_amdgcn_sched_barrier(0);
    }
    bf16x8 xb[4];
#pragma unroll
    for (int d0 = 0; d0 < 4; ++d0) xb[d0] = pack8(xc[2 * d0], xc[2 * d0 + 1]);
    const bf16_t* WG = (const bf16_t*)(F.ws + WS_WG);
    const float* ba = (const float*)F.a->in[17]; const float* bx = (const float*)F.a->in[19]; const float* c8 = (const float*)(F.ws + WS_C8);
    float* AU = (float*)(F.ws + WS_AU) + (rowbase + t) * 1024;
    const bool valid = !SAMPLE || r32 < 8;
#pragma unroll
    for (int mt = 0; mt < 2; ++mt) {
        f32x16 ga, gx;
#pragma unroll
        for (int r = 0; r < 16; ++r) { ga[r] = 0.f; gx[r] = 0.f; }
#pragma unroll
        for (int d0 = 0; d0 < 4; ++d0) {
            const bf16x8 wa = *(const bf16x8*)(WG + ((size_t)(0 * 8 + n) * 64 + r32 + 32 * mt) * 64 + 16 * d0 + 8 * hi);
            const bf16x8 wx = *(const bf16x8*)(WG + ((size_t)(1 * 8 + n) * 64 + r32 + 32 * mt) * 64 + 16 * d0 + 8 * hi);
            ga = __builtin_amdgcn_mfma_f32_32x32x16_bf16(wa, xb[d0], ga, 0, 0, 0);
            gx = __builtin_amdgcn_mfma_f32_32x32x16_bf16(wx, xb[d0], gx, 0, 0, 0);
        }
#pragma unroll
        for (int a4 = 0; a4 < 4; ++a4) {
            const int a = 4 * mt + a4, ch = ch0 + 8 * a, rb = a4 * 4;
            const f32x4 vba = *(const f32x4*)(ba + ch), vbx = *(const f32x4*)(bx + ch), vc8 = *(const f32x4*)(c8 + ch);
            f32x4 av, uv;
#pragma unroll
            for (int e = 0; e < 4; ++e) {
                const float rg = __builtin_amdgcn_rcpf(1.f + __expf(-(ga[rb + e] + vba[e])));
                const float ig = __builtin_amdgcn_rcpf(1.f + __expf(-(gx[rb + e] + vbx[e])));
                const float la = -rg * vc8[e];
                av[e] = __expf(la);
                uv[e] = __builtin_amdgcn_sqrtf(fmaxf(1.f - av[e] * av[e], 0.f)) * ig * xc[a][e];
            }
            if (valid) { *(f32x4*)(AU + ch) = av; *(f32x4*)(AU + 512 + ch) = uv; }
            if (!SAMPLE) {
#pragma unroll
                for (int sft = 1; sft < 32; sft <<= 1) {
                    const bool upper = (r32 & sft) != 0;
#pragma unroll
                    for (int e = 0; e < 4; ++e) {
                        const float pa = __shfl_xor(av[e], sft), pu = __shfl_xor(uv[e], sft);
                        const float nu = upper ? av[e] * pu + uv[e] : pa * uv[e] + pu;
                        av[e] = av[e] * pa; uv[e] = nu;
                    }
                }
                if (r32 == 0) { float* ag = (float*)(F.ws + WS_AGG) + (size_t)tile * 1024; *(f32x4*)(ag + ch) = av; *(f32x4*)(ag + 512 + ch) = uv; }
            }
            __builtin_amdgcn_sched_barrier(0);
        }
    }
}
__device__ __forceinline__ float gelu_tanh(float x) { const float z = 0.7978845608028654f * (x + 0.044715f * x * x * x); const float e = __expf(2.f * z); return 0.5f * x * (2.f - 2.f * __builtin_amdgcn_rcpf(e + 1.f)); }
template <bool SAMPLE>
__device__ __forceinline__ void rglru_scan_item(const Frame& F, int item) {
    const int lane = F.lane, n = item & 7, tile = item >> 3;
    const int b = SAMPLE ? tile : tile >> 6, tt = SAMPLE ? 0 : 2 * (tile & 63);
    const int ch = 64 * n + lane;
    constexpr int NT = SAMPLE ? 8 : 32;
    const size_t row0 = SAMPLE ? (size_t)MP + b * 8 : (size_t)b * SEQ + tt * 32;
    const float* AU = (const float*)(F.ws + WS_AU) + row0 * 1024 + ch; const bf16_t* GT = (const bf16_t*)(F.ws + WS_GT) + row0 * 512 + ch;
    bf16_t* O = (bf16_t*)(F.ws + WS_O) + row0 * D + 512 + ch;
    float av[NT], uv[NT], gv[NT];
#pragma unroll
    for (int i = 0; i < NT; ++i) { av[i] = AU[(size_t)i * 1024]; uv[i] = AU[(size_t)i * 1024 + 512]; gv[i] = bf2f(GT[(size_t)i * 512]); }
    float h;
    if (SAMPLE) h = ((const float*)F.a->in[4])[b * 512 + ch];
    else { h = 0.f; const float* ag = (const float*)(F.ws + WS_AGG) + (size_t)(b * 128) * 1024 + ch;
        int c = 0;
        for (; c + 32 <= tt; c += 32) { float pa[32], ph[32];
#pragma unroll
            for (int k = 0; k < 32; ++k) { pa[k] = ag[(size_t)(c + k) * 1024]; ph[k] = ag[(size_t)(c + k) * 1024 + 512]; }
#pragma unroll
            for (int k = 0; k < 32; ++k) h = pa[k] * h + ph[k]; }
        if (c < tt) { float pa[32], ph[32];
#pragma unroll
            for (int k = 0; k < 32; ++k) { const int cc = c + k < tt ? c + k : 0; pa[k] = ag[(size_t)cc * 1024]; ph[k] = ag[(size_t)cc * 1024 + 512]; }
#pragma unroll
            for (int k = 0; k < 32; ++k) { const bool on = c + k < tt; h = on ? pa[k] * h + ph[k] : h; } }
    }
    float y[NT];
#pragma unroll
    for (int i = 0; i < NT; ++i) { h = av[i] * h + uv[i]; y[i] = h * gelu_tanh(gv[i]); }
    if (!SAMPLE) {
        const float* AU2 = AU + (size_t)32 * 1024; const bf16_t* GT2 = GT + (size_t)32 * 512;
#pragma unroll
        for (int i = 0; i < NT; ++i) { av[i] = AU2[(size_t)i * 1024]; uv[i] = AU2[(size_t)i * 1024 + 512]; gv[i] = bf2f(GT2[(size_t)i * 512]); }
#pragma unroll
        for (int i = 0; i < NT; ++i) O[(size_t)i * D] = (bf16_t)(cvtpk(y[i], 0.f) & 0xffffu);
#pragma unroll
        for (int i = 0; i < NT; ++i) { h = av[i] * h + uv[i]; y[i] = h * gelu_tanh(gv[i]); }
        O += (size_t)32 * D;
    }
#pragma unroll
    for (int i = 0; i < NT; ++i) O[(size_t)i * D] = (bf16_t)(cvtpk(y[i], 0.f) & 0xffffu);
    if (SAMPLE) F.out[O_RNNS + b * 512 + ch] = h;
    else if (tt == 126) F.out[O_RNNP + b * 512 + ch] = h;
}

template <bool SAMPLE, bool SPLIT = false>
__device__ __forceinline__ void compress_item(const Frame& F, int item) {
    const int lane = F.lane, r32 = lane & 31, hi = lane >> 5;
    constexpr int NTL = SAMPLE ? 64 : 32, NC = SAMPLE ? NCS : NCP;
    const int c = item & 1, nt = (item >> 1) % NTL, b = (item >> 1) / NTL;
    const int lg = lane >> 4, lch = lane & 15;
    const int* pt = (const int*)F.a->in[8] + b * NPG;
    const float* rbase[9];
#pragma unroll
    for (int j = 0; j < 9; ++j) { int ch = nt * 8 + j; ch = ch < NC ? ch : NC;
        if (SAMPLE) { const int pg = pt[ch >> 3]; rbase[j] = (const float*)F.a->in[6] + ((size_t)pg * PAGE + (ch & 7) * 16) * 512 + c * 256 + lane * 4; }
        else rbase[j] = F.out + O_CMPP + ((size_t)b * SEQ + ch * 16) * 512 + c * 256 + lane * 4; }
    const bf16_t* WF = (const bf16_t*)(F.ws + WS_WCT) + (size_t)c * 32 * 4 * 2 * 512 + lane * 8;
    LAS unsigned char* xt = F.wscr;
    f32x4 xr[9];
#define CMP_LOAD(X, l_) do { _Pragma("unroll") for (int j = 0; j < 9; ++j) X[j] = SAMPLE ? __builtin_nontemporal_load((const f32x4*)(rbase[j] + (size_t)(l_) * 512)) : *(const f32x4*)(rbase[j] + (size_t)(l_) * 512); } while (0)
#define CMP_STEP(X, l_, NEXT_OK, lnext_) do { \
        LAS unsigned char* img = xt + ((l_) & 1) * 4608; \
        bf16x8 wf[4][4];                                    \
        _Pragma("unroll") for (int k4 = 0; k4 < 4; ++k4) { \
            wf[k4][0] = *(const bf16x8*)(WF + (size_t)(((l_) * 4 + k4) * 2 + 0) * 512); wf[k4][1] = *(const bf16x8*)(WF + (size_t)(((l_) * 4 + k4) * 2 + 1) * 512); \
            wf[k4][2] = *(const bf16x8*)(WF + (size_t)((((l_) + 16) * 4 + k4) * 2 + 0) * 512); wf[k4][3] = *(const bf16x8*)(WF + (size_t)((((l_) + 16) * 4 + k4) * 2 + 1) * 512); } \
        _Pragma("unroll") for (int j = 0; j < 9; ++j) { const int q = 4 * j + lg; u32x2 w; w.x = cvtpk(X[j][0], X[j][1]); w.y = cvtpk(X[j][2], X[j][3]); \
            *(LAS u32x2*)(img + q * 128 + (((lch >> 1) ^ ((q >> 1) & 7)) * 16) + (lch & 1) * 8) = w; } \
        if (NEXT_OK) CMP_LOAD(X, lnext_); \
        asm volatile("s_waitcnt lgkmcnt(0)" ::: "memory"); \
        _Pragma("unroll") for (int k4 = 0; k4 < 4; ++k4) { \
            const bf16x8 x0 = *(const LAS bf16x8*)(img + r32 * 128 + (((2 * k4 + hi) ^ ((r32 >> 1) & 7)) * 16)); \
            const bf16x8 x1 = *(const LAS bf16x8*)(img + (r32 + 4) * 128 + (((2 * k4 + hi) ^ (((r32 + 4) >> 1) & 7)) * 16)); \
            const bf16x8 w0 = wf[k4][0], w1 = wf[k4][1], w2 = wf[k4][2], w3 = wf[k4][3]; \
            a0 = __builtin_amdgcn_mfma_f32_32x32x16_bf16(w0, x0, a0, 0, 0, 0); \
            a1 = __builtin_amdgcn_mfma_f32_32x32x16_bf16(w1, x0, a1, 0, 0, 0); \
            a0 = __builtin_amdgcn_mfma_f32_32x32x16_bf16(w2, x1, a0, 0, 0, 0); \
            a1 = __builtin_amdgcn_mfma_f32_32x32x16_bf16(w3, x1, a1, 0, 0, 0); } \
        asm volatile("" ::: "memory"); } while (0)
    f32x16 a0, a1;
#pragma unroll
    for (int r = 0; r < 16; ++r) { a0[r] = 0.f; a1[r] = 0.f; }
    const int l0 = SPLIT ? 2 * F.wave : 0, l1 = SPLIT ? l0 + 2 : 16;
    CMP_LOAD(xr, l0);
    for (int l = l0; l < l1; ++l) CMP_STEP(xr, l, l + 1 < l1, l + 1);
#undef CMP_STEP
#undef CMP_LOAD
    if (SPLIT) {
        constexpr int PART = 9216;
        LAS f32x4* mine = (LAS f32x4*)(F.wscr + PART);
#pragma unroll
        for (int i = 0; i < 4; ++i) { mine[i * 64 + lane] = (f32x4){a0[4 * i], a0[4 * i + 1], a0[4 * i + 2], a0[4 * i + 3]}; mine[(4 + i) * 64 + lane] = (f32x4){a1[4 * i], a1[4 * i + 1], a1[4 * i + 2], a1[4 * i + 3]}; }
        __syncthreads();
        {
            const int me = F.wave;
            for (int w = 0; w < NWAVES; ++w) { if (w == me) continue; const LAS f32x4* p = (const LAS f32x4*)(F.lds + w * WSCR + PART);
#pragma unroll
                for (int i = 0; i < 4; ++i) { const f32x4 u = p[i * 64 + lane], v = p[(4 + i) * 64 + lane];
                    a0[4 * i] += u.x; a0[4 * i + 1] += u.y; a0[4 * i + 2] += u.z; a0[4 * i + 3] += u.w; a1[4 * i] += v.x; a1[4 * i + 1] += v.y; a1[4 * i + 2] += v.z; a1[4 * i + 3] += v.w; } }
        }
        __syncthreads();
    }
    const int n = nt * 8 + (r32 >> 2), g = r32 & 3;
    if (n < NC && (!SPLIT || F.wave == 0)) {
        const float* pe = (const float*)(F.ws + WS_PET) + c * 64;
        bf16_t* o = SAMPLE ? (bf16_t*)(F.ws + WS_KCS) + ((size_t)(b * 512 + n) * 2 + c) * 256 + g * 64 : (bf16_t*)(F.ws + WS_KCP) + ((size_t)(b * 256 + n) * 2 + c) * 256 + g * 64;
#pragma unroll
        for (int i = 0; i < 4; ++i) {
            const int e0 = 8 * i + 4 * hi; const f32x4 p0 = *(const f32x4*)(pe + e0), p1 = *(const f32x4*)(pe + 32 + e0);
            u32x2 w; w.x = cvtpk(a0[4 * i] + p0.x, a0[4 * i + 1] + p0.y); w.y = cvtpk(a0[4 * i + 2] + p0.z, a0[4 * i + 3] + p0.w); *(u32x2*)(o + e0) = w;
            u32x2 x; x.x = cvtpk(a1[4 * i] + p1.x, a1[4 * i + 1] + p1.y); x.y = cvtpk(a1[4 * i + 2] + p1.z, a1[4 * i + 3] + p1.w); *(u32x2*)(o + 32 + e0) = x;
        }
    }
}

constexpr int WS_IMP = 8448, WS_SELM = WS_IMP + 8 * 132 * 4, WS_BLIST = WS_SELM + 8 * 4 * 8, WS_OT = 13568, WS_PT = WS_OT + 4096;
static_assert(KT_OFF + 4096 <= WS_IMP && WS_BLIST + 132 * 4 <= WS_OT && WS_PT + 256 <= WSCR, "per-wave scratch map");
template <bool SAMPLE>
__device__ __forceinline__ void nsa_item(const Frame& F, int item) {
    typedef typename std::conditional<SAMPLE, float, bf16_t>::type KT;
    const int lane = F.lane, r32 = lane & 31, hi = lane >> 5, qi = r32 >> 2, r = r32 & 3;
    const int g = item & 3, qt = SAMPLE ? 0 : (item >> 2) & 511, b = SAMPLE ? item >> 2 : item >> 11;
    const int t0 = 8 * qt, qp = SAMPLE ? PAST + qi : t0 + qi, qp_max = SAMPLE ? PAST + 7 : t0 + 7;
    const size_t row = SAMPLE ? (size_t)MP + b * 8 + qi : (size_t)b * SEQ + t0 + qi;
    const int head = 4 * g + r;
    const float nslope2 = -__builtin_amdgcn_exp2f(-0.5f * (float)(head + 1)) * LOG2E;
    const bf16_t* Q1 = (const bf16_t*)(F.ws + WS_Q1);
    bf16x8 qf[4];
#pragma unroll
    for (int d0 = 0; d0 < 4; ++d0) qf[d0] = *(const bf16x8*)(Q1 + row * D + head * 64 + 16 * d0 + 8 * hi);
    const float* gp = (const float*)(F.ws + WS_G1) + row * 48 + head * 3;
    const float g_cmp = gp[0], g_sel = gp[1], g_win = gp[2];
    LAS unsigned char* vt = F.wscr;
    LAS float* imp = (LAS float*)(F.wscr + WS_IMP);
    LAS unsigned long long* selm = (LAS unsigned long long*)(F.wscr + WS_SELM);
    LAS int* blist = (LAS int*)(F.wscr + WS_BLIST);
    constexpr int NC = SAMPLE ? NCS : NCP, NCH = SAMPLE ? 3 : 1;
    LAS u32x2* otl = (LAS u32x2*)(F.wscr + WS_OT) + lane;
    for (int i = lane; i < 8 * 132; i += 64) imp[i] = 0.f;

    const bf16_t* KC = SAMPLE ? (const bf16_t*)(F.ws + WS_KCS) + (size_t)b * 512 * 512 + g * 64 : (const bf16_t*)(F.ws + WS_KCP) + (size_t)b * 256 * 512 + g * 64;
    const int ncv = qp_max >= 31 ? (((qp_max - 31) >> 4) + 1 < NC ? ((qp_max - 31) >> 4) + 1 : NC) : 0;
    const int nct = (ncv + 31) >> 5;
    auto rpc = [&](int t, int key) -> const bf16_t* { int n = 32 * t + key; n = n < NC ? n : NC - 1; return KC + (size_t)n * 512; };
    auto mkc = [&](int t, f32x16& s, float sh) { bias_mask<16, 2>(s, (float)(qp - 31 - 512 * t), nslope2, 0.f, 1e30f, hi, sh); };
    AttnAcc A; acc_init(A);
    attn_run<bf16_t, 1, 256>(A, qf, 0, nct, vt, lane, rpc, mkc);
    {
        A.m = (A.m == NEG_INF) ? 0.f : A.m; A.l = A.l > 0.f ? 1.f / A.l : 0.f;
        auto hkc = [&](int t, const f32x16& p) {
#pragma unroll
            for (int i = 0; i < 4; ++i) {
                float p3 = p[4 * i + 3]; float a = 2.f * ((p[4 * i] + p[4 * i + 1]) + p[4 * i + 2]) + p3;
                a += __shfl_xor(a, 1); a += __shfl_xor(a, 2); p3 += __shfl_xor(p3, 1); p3 += __shfl_xor(p3, 2);
                if (r == 0) { const int J = 8 * t + 2 * i + hi; __hip_atomic_fetch_add(&imp[J * 8 + qi], a, __ATOMIC_RELAXED, __HIP_MEMORY_SCOPE_WORKGROUP); __hip_atomic_fetch_add(&imp[(J + 1) * 8 + qi], p3, __ATOMIC_RELAXED, __HIP_MEMORY_SCOPE_WORKGROUP); }
            } };
        attn_run<bf16_t, 2, 256>(A, qf, 0, nct, vt, lane, rpc, mkc, hkc);
#pragma unroll
        for (int j = 0; j < 4; ++j) {
            u32x2 w; w.x = cvtpk(A.o0[4 * j] * g_cmp, A.o0[4 * j + 1] * g_cmp); w.y = cvtpk(A.o0[4 * j + 2] * g_cmp, A.o0[4 * j + 3] * g_cmp); otl[64 * j] = w;
            u32x2 x; x.x = cvtpk(A.o1[4 * j] * g_cmp, A.o1[4 * j + 1] * g_cmp); x.y = cvtpk(A.o1[4 * j + 2] * g_cmp, A.o1[4 * j + 3] * g_cmp); otl[64 * (4 + j)] = x; }
    }
    asm volatile("s_waitcnt lgkmcnt(0)" ::: "memory");
    const int cb = qp_max >> 6;
    for (int idx = lane; idx < 8 * (cb + 1); idx += 64) { const int j = idx >> 3; if (j == 0 || j >= cb - 1) imp[idx] += 1000.f; }
    asm volatile("s_waitcnt lgkmcnt(0)" ::: "memory");
    {
        f32x4 sj[NCH][2]; int rank[NCH][8];
#pragma unroll
        for (int c2 = 0; c2 < NCH; ++c2) { int j = lane + 64 * c2; j = j <= cb ? j : cb; sj[c2][0] = *(const LAS f32x4*)(imp + j * 8); sj[c2][1] = *(const LAS f32x4*)(imp + j * 8 + 4);
#pragma unroll
            for (int q = 0; q < 8; ++q) rank[c2][q] = 0; }
#pragma unroll 2
        for (int i = 0; i <= cb; ++i) {
            const f32x4 v0 = *(const LAS f32x4*)(imp + i * 8), v1 = *(const LAS f32x4*)(imp + i * 8 + 4);
#pragma unroll
            for (int c2 = 0; c2 < NCH; ++c2) { const bool lower = i < lane + 64 * c2;
#pragma unroll
                for (int q = 0; q < 8; ++q) { const float vi = q < 4 ? v0[q & 3] : v1[q & 3], vj = q < 4 ? sj[c2][0][q & 3] : sj[c2][1][q & 3];
                    rank[c2][q] += ((vi > vj) | ((vi == vj) & lower)) ? 1 : 0; } }
        }
#pragma unroll
        for (int c2 = 0; c2 < NCH; ++c2) { const bool cand = lane + 64 * c2 <= cb;
#pragma unroll
            for (int q = 0; q < 8; ++q) { const unsigned long long mask = __ballot(cand && rank[c2][q] < 16); if (lane == 0) selm[q * 4 + c2] = mask; } }
    }
    asm volatile("s_waitcnt lgkmcnt(0)" ::: "memory");
    unsigned long long mym0 = 0ull, mym1 = 0ull, mym2 = 0ull; int nblk = 0;
#pragma unroll
    for (int c2 = 0; c2 < NCH; ++c2) { const unsigned long long mine = selm[qi * 4 + c2]; unsigned long long u = 0;
        if (c2 == 0) mym0 = mine; else if (c2 == 1) mym1 = mine; else mym2 = mine;
#pragma unroll
        for (int q = 0; q < 8; ++q) u |= selm[q * 4 + c2];
        const int j = lane + 64 * c2; const bool in = (u >> lane) & 1ull;
        const int pos = nblk + __popcll(u & ((1ull << lane) - 1ull));
        if (in) blist[pos] = j;
        nblk += __popcll(u); }
    asm volatile("s_waitcnt lgkmcnt(0)" ::: "memory");
    nblk = __builtin_amdgcn_readfirstlane(nblk);
    {
        const KT* sbase; LAS int* pt = (LAS int*)(F.wscr + WS_PT);
        if constexpr (SAMPLE) { pt[lane] = ((const int*)F.a->in[8])[b * NPG + lane]; asm volatile("s_waitcnt lgkmcnt(0)" ::: "memory"); }
        if constexpr (SAMPLE) sbase = (const float*)F.a->in[7] + g * 64; else sbase = (const bf16_t*)(F.ws + WS_KVSEL) + (size_t)b * SEQ * 512 + g * 64;
        const float* snew = F.out + O_SELS + (size_t)b * 8 * 512 + g * 64;
        auto rps = [&](int t, int key) -> const KT* {
            const int J = blist[t >> 1]; const int tok = 64 * J + 32 * (t & 1) + key;
            if constexpr (SAMPLE) { const int tk = tok < PAST ? tok : PAST - 1; const int pg = pt[tk >> 7]; const KT* p0 = sbase + ((size_t)pg * PAGE + (tk & 127)) * 512;
                int i2 = tok - PAST; i2 = i2 < 0 ? 0 : (i2 > 7 ? 7 : i2); const KT* p1 = (const KT*)(snew + (size_t)i2 * 512); return tok < PAST ? p0 : p1; }
            else return sbase + (size_t)tok * 512; };
        auto mks = [&](int t, f32x16& s, float sh) {
            const int J = blist[t >> 1]; bool sel = (mym0 >> (J & 63)) & 1ull; if constexpr (SAMPLE) { const bool s1 = (mym1 >> (J & 63)) & 1ull, s2 = (mym2 >> (J & 63)) & 1ull; sel = J < 64 ? sel : (J < 128 ? s1 : s2); } const int tb = 64 * J + 32 * (t & 1);
            const float base = sel ? sh : NEG_INF, dq = (float)(qp - tb);
            if (J < cb) bias_mask<1, false>(s, dq, nslope2, 0.f, 0.f, hi, base);
            else bias_mask<1, 2>(s, dq, nslope2, 0.f, 1e30f, hi, base); };
        acc_init(A);
        attn_run<KT, 0, 256, SAMPLE ? 1 : 2>(A, qf, 0, 2 * nblk, vt, lane, rps, mks);
        const float sc = g_sel / fmaxf(A.l, 1e-30f);
#pragma unroll
        for (int j = 0; j < 4; ++j) {
            const u32x2 a = otl[64 * j], c = otl[64 * (4 + j)];
            u32x2 w; w.x = cvtpk(A.o0[4 * j] * sc + __uint_as_float(a.x << 16), A.o0[4 * j + 1] * sc + __uint_as_float(a.x & 0xffff0000u)); w.y = cvtpk(A.o0[4 * j + 2] * sc + __uint_as_float(a.y << 16), A.o0[4 * j + 3] * sc + __uint_as_float(a.y & 0xffff0000u)); otl[64 * j] = w;
            u32x2 x; x.x = cvtpk(A.o1[4 * j] * sc + __uint_as_float(c.x << 16), A.o1[4 * j + 1] * sc + __uint_as_float(c.x & 0xffff0000u)); x.y = cvtpk(A.o1[4 * j + 2] * sc + __uint_as_float(c.y << 16), A.o1[4 * j + 3] * sc + __uint_as_float(c.y & 0xffff0000u)); otl[64 * (4 + j)] = x; }
    }
    {
        acc_init(A);
        if constexpr (SAMPLE) {
            const float* wc = (const float*)F.a->in[5] + (size_t)b * 512 * 512 + g * 64; const float* wn = F.out + O_WINS + (size_t)b * 512 * 512 + g * 64;
            auto rpw = [&](int t, int key) -> const float* { int c = 32 * t + key; c = c > 519 ? 519 : c; return c < 512 ? wc + (size_t)c * 512 : wn + (size_t)(c - 8) * 512; };
            auto mkw = [&](int t, f32x16& s, float sh) { bias_mask<1, true>(s, (float)(512 + qi - 32 * t), nslope2, 0.f, (float)WIN, hi, sh); };
            attn_run<float, 0, 256>(A, qf, 0, 17, vt, lane, rpw, mkw);
        } else {
            const bf16_t* wb = (const bf16_t*)(F.ws + WS_KVWIN) + (size_t)b * SEQ * 512 + g * 64;
            const int tlo = (t0 - WIN > 0 ? t0 - WIN : 0) >> 5, thi = (t0 + 7) >> 5;
            auto rpw = [&](int t, int key) -> const bf16_t* { return wb + (size_t)(32 * t + key) * 512; };
            auto mkw = [&](int t, f32x16& s, float sh) { const float dq = (float)(qp - 32 * t);
                if (32 * t + 31 <= t0 && 32 * t >= t0 + 7 - WIN) bias_mask<1, false>(s, dq, nslope2, 0.f, 0.f, hi, sh);
                else bias_mask<1, true>(s, dq, nslope2, 0.f, (float)WIN, hi, sh); };
            attn_run<bf16_t, 0, 256, 2>(A, qf, tlo, thi + 1, vt, lane, rpw, mkw);
        }
        const float sc = g_win / fmaxf(A.l, 1e-30f);
#pragma unroll
        for (int j = 0; j < 4; ++j) { const u32x2 a = otl[64 * j], c = otl[64 * (4 + j)];
            A.o0[4 * j] = A.o0[4 * j] * sc + __uint_as_float(a.x << 16); A.o0[4 * j + 1] = A.o0[4 * j + 1] * sc + __uint_as_float(a.x & 0xffff0000u);
            A.o0[4 * j + 2] = A.o0[4 * j + 2] * sc + __uint_as_float(a.y << 16); A.o0[4 * j + 3] = A.o0[4 * j + 3] * sc + __uint_as_float(a.y & 0xffff0000u);
            A.o1[4 * j] = A.o1[4 * j] * sc + __uint_as_float(c.x << 16); A.o1[4 * j + 1] = A.o1[4 * j + 1] * sc + __uint_as_float(c.x & 0xffff0000u);
            A.o1[4 * j + 2] = A.o1[4 * j + 2] * sc + __uint_as_float(c.y << 16); A.o1[4 * j + 3] = A.o1[4 * j + 3] * sc + __uint_as_float(c.y & 0xffff0000u); }
    }
    store_o((bf16_t*)(F.ws + WS_O) + row * D + head * 64, A.o0, A.o1, 1.f, hi);
}

__device__ __forceinline__ void final_norm_row(float* y, const float* ssp, const float* g, int row, int lane) {
    const float rs = pg8::row_rstd(ssp, row);
    f32x4* yr = (f32x4*)(y + (size_t)row * D) + lane; const f32x4* gr = (const f32x4*)g + lane;
#pragma unroll
    for (int j = 0; j < 4; ++j) { const f32x4 v = yr[64 * j], gg = gr[64 * j]; yr[64 * j] = v * rs * gg; }
}

template <bool FINAL>
__device__ __forceinline__ void sample_finalize_row(const float* slab, int ns, const float* res, float* Y, bf16_t* Aout, const float* gain, float* ssp, int r, int lane) {
    f32x4 y[4]; float ss = 0.f;
#pragma unroll
    for (int j = 0; j < 4; ++j) y[j] = *((const f32x4*)(res + (size_t)r * D) + lane + 64 * j);
    for (int sl = 0; sl < ns; ++sl) {
#pragma unroll
        for (int j = 0; j < 4; ++j) y[j] += *((const f32x4*)(slab + ((size_t)sl * MS + r) * D) + lane + 64 * j); }
#pragma unroll
    for (int j = 0; j < 4; ++j) ss += (y[j].x * y[j].x + y[j].y * y[j].y) + (y[j].z * y[j].z + y[j].w * y[j].w);
    ss = wave_sum(ss);
    if (FINAL) { const float rs = 1.f / sqrtf(ss * (1.f / D) + EPS);
#pragma unroll
        for (int j = 0; j < 4; ++j) *((f32x4*)(Y + (size_t)r * D) + lane + 64 * j) = y[j] * rs * *((const f32x4*)gain + lane + 64 * j); }
    else {
#pragma unroll
        for (int j = 0; j < 4; ++j) { *((f32x4*)(Y + (size_t)r * D) + lane + 64 * j) = y[j];
            u32x2 w; w.x = cvtpk(y[j].x, y[j].y); w.y = cvtpk(y[j].z, y[j].w); *((u32x2*)(Aout + (size_t)r * D) + lane + 64 * j) = w; }
        if (lane < 16) ssp[(size_t)(MP + r) * 16 + lane] = lane == 0 ? ss : 0.f; }
}
__device__ __forceinline__ unsigned q_issue(unsigned* ctr, int lane) { unsigned v = 0u; if (lane == 0) v = __hip_atomic_fetch_add(ctr, 1u, __ATOMIC_RELAXED, __HIP_MEMORY_SCOPE_AGENT); return v; }
__device__ __forceinline__ int q_item(unsigned tk, int shard) { return (int)__builtin_amdgcn_readfirstlane(tk) * 8 + shard; }
constexpr int N_PHASES = 17;
#ifndef ONE_LAUNCH
#define ONE_LAUNCH 1
#endif
#define PH_BEGIN \
    const Args* ap_ = &args; size_t z_ = 0; asm volatile("" : "+s"(z_)); \
    Frame F; F.lds = (LAS unsigned char*)lds_raw; F.tid = threadIdx.x; F.lane = F.tid & 63; F.wave = __builtin_amdgcn_readfirstlane(F.tid >> 6); \
    F.G = gridDim.x; { const int vcu_ = (F.G % 8 == 0) ? ((int)blockIdx.x % 8) * (F.G / 8) + (int)blockIdx.x / 8 : (int)blockIdx.x; F.gw = vcu_ * NWAVES + F.wave; } F.NGW = F.G * NWAVES; \
    F.wscr = F.lds + F.wave * WSCR; F.ws = ap_->ws + z_; F.out = ap_->out + z_; F.a = ap_; \
    unsigned char* ws = F.ws; float* out = F.out; unsigned* ctl = (unsigned*)(ws + WS_CTL); float* ssp = (float*)(ws + WS_SSP); \
    const float* norm_mix = (const float*)ap_->in[9] + z_; const float* norm_ffn = (const float*)ap_->in[10] + z_; const float* norm_out = (const float*)ap_->in[11] + z_; \
    (void)ctl; (void)ssp; (void)norm_mix; (void)norm_ffn; (void)norm_out; (void)out;
__global__ void __launch_bounds__(NWAVES * 64, 2) fwd(Args args) {
    extern __shared__ __attribute__((aligned(16))) unsigned char lds_raw[];
    volatile LAS unsigned* MISC = (volatile LAS unsigned*)((LAS unsigned char*)lds_raw + MISC_OFF);
    if (threadIdx.x < 16) MISC[threadIdx.x] = 0u;
    __syncthreads();
    const int lo = args.ph_lo, hi = args.ph_hi;
    const bool multi = (hi - lo) > 1;
    if (multi) (void)xcd_barrier_post((unsigned*)(args.ws + WS_CTL) + CW_BAR, MISC);
#ifndef ONLY_PHASE
#define ONLY_PHASE -1
#endif
#define IN(k) ((ONLY_PHASE < 0 || ONLY_PHASE == (k)) && lo <= (k) && (k) < hi)
#define SEAM(k) do { if (IN(k) && IN((k) + 1)) { XcdBarrier bar_; bar_.bar = (unsigned*)(args.ws + WS_CTL) + CW_BAR; bar_.x = xb_xcc_id(); bar_.st = MISC; xcd_barrier(bar_); } } while (0)

#define GEMM_N1024(Aptr, Wptr, KFULL, RESF, RBF16) do { \
        { pg8::Gemm g{(const bf16_t*)(Aptr), (const bf16_t*)(Wptr), MP, D, (KFULL), (KFULL)}; \
          pg8::StaticOrder S; S.init(MP, D, F.G, (int)blockIdx.x); \
          pg8::EpiRes<RBF16> E{(RESF), (bf16_t*)(ws + WS_XN), nullptr, ssp}; \
          pg8::gemm_phase<pg8::EpiRes<RBF16>, pg8::StaticOrder, true, true>(F.lds, g, S, E); } } while (0)
#define DEFERRED_SAMPLE(Aptr, Wptr, KFULL, RESS, AOUT, GAIN, INST) do { \
        constexpr int ns_ = (KFULL) / 256; const int mu = (int)blockIdx.x - (F.G - 4 * ns_); \
        if (mu >= 0) { const int sl = mu >> 2; int ks_ = 256; asm volatile("" : "+s"(ks_)); \
          pg8::Gemm g{(const bf16_t*)(Aptr) + sl * 256, (const bf16_t*)(Wptr) + sl * 256, M, D, ks_, (KFULL)}; \
          pg8::OneUnit S{MP / 256, mu & 3}; \
          pg8::EpiSlab E{(float*)(ws + WS_SLAB) + (size_t)sl * MS * D}; \
          pg8::gemm_phase<pg8::EpiSlab, pg8::OneUnit, true, true>(F.lds, g, S, E); \
          subgrid_rendezvous(ctl + CW_SR + 64 * (INST), 4 * ns_, ctl + CW_BAR); \
          for (int r = mu * NWAVES + F.wave; r < MS; r += 4 * ns_ * NWAVES) \
              sample_finalize_row<false>((const float*)(ws + WS_SLAB), ns_, (RESS), out + O_YS, (AOUT) + (size_t)MP * D, (GAIN), ssp, r, F.lane); \
          asm volatile("s_waitcnt vmcnt(0)" ::: "memory"); \
          __syncthreads(); \
          if (threadIdx.x == 0) { __builtin_amdgcn_fence(__ATOMIC_RELEASE, "agent"); asm volatile("s_waitcnt vmcnt(0)" ::: "memory"); (void)xb_add(ctl + CW_SR + 64 * (4 + (INST)), 1u); } } } while (0)
#define GATED_ORDER(S, MROWS, NCOLS, KFULL, INST) pg8::GatedOrder S; S.init((MROWS), (NCOLS), F.G, (int)blockIdx.x); S.flag = ctl + CW_SR + 64 * (4 + (INST)); S.need = 4 * ((KFULL) / 256); S.bar = ctl + CW_BAR

    if (IN(0)) { PH_BEGIN p0_prologue(F); }
    SEAM(0);
    if (IN(1)) { PH_BEGIN
        pg8::Gemm g{(const bf16_t*)(ws + WS_XN), (const bf16_t*)(ws + WS_WIN0), M, AB_IN, D, D};
        pg8::StaticOrder S; S.init(M, AB_IN, F.G, (int)blockIdx.x);
        pg8::EpiIn0 E{(bf16_t*)(ws + WS_QD), (bf16_t*)(ws + WS_KVD), (float*)(ws + WS_XR), (bf16_t*)(ws + WS_GT), out};
        pg8::gemm_phase<pg8::EpiIn0, pg8::StaticOrder, true, true>(F.lds, g, S, E);
        {
            constexpr int units = (M / 256) * (AB_IN / 256); const int nfull = units % F.G, nbg = nfull ? F.G - nfull : F.G;
            const int me = (int)blockIdx.x - (F.G - nbg);
            if (me >= 0) { __syncthreads(); for (int it = WT_T4 + me * NWAVES + F.wave; it < WT_T9; it += nbg * NWAVES) weight_transpose_item(F, it); }
        }
        if ((int)blockIdx.x == F.G - 1 && F.wave < 2) {
            const float* pp = (const float*)(ws + WS_PETP) + (size_t)F.wave * 32 * 64 + F.lane; float acc = 0.f;
#pragma unroll
            for (int l = 0; l < 32; ++l) acc += pp[l * 64];
            ((float*)(ws + WS_PET))[F.wave * 64 + F.lane] = acc;
        }
    }
    SEAM(1);
    if (IN(2)) { PH_BEGIN
        constexpr int ND = 32, NGL = 256, NL = ND + NGL * 6 + 32;
        unsigned* qc = ctl + CW_Q2 + 64 * ((int)blockIdx.x & 7); const int shard = (int)blockIdx.x & 7;
        for (int k = (int)__builtin_amdgcn_readfirstlane(q_issue(qc, F.lane)); k < NL; ) {
            const unsigned tk = q_issue(qc, F.lane);
            Frame Fi = F; { size_t zz = 0; asm volatile("" : "+s"(zz)); Fi.ws += zz; Fi.out += zz; }
            if (k < ND) dil_item_sample(Fi, k * 8 + shard);
            else if (k >= ND + NGL * 6) rglru_gates_item<true>(Fi, (k - ND - NGL * 6) * 8 + shard);
            else { const int i2 = k - ND, gl = i2 / 6, slot = i2 - gl * 6;
                if (slot < 2) compress_item<true>(Fi, (2 * gl + slot) * 8 + shard);
                else { const int kd = 2 * gl + (slot & 1);
                    const int item = (((kd >> 3) * 8 + shard) << 3) | (kd & 7);
                    if (slot < 4) dil_item_prompt(Fi, item); else rglru_gates_item<false>(Fi, item); } }
            k = (int)__builtin_amdgcn_readfirstlane(tk);
        }
    }
    SEAM(2);
    if (IN(3)) { PH_BEGIN
        for (int it = F.gw; it < 2048 + 256; it += F.NGW) { if (it < 2048) rglru_scan_item<false>(F, it); else rglru_scan_item<true>(F, it - 2048); }
    }
    SEAM(3);
    if (IN(4)) { PH_BEGIN GEMM_N1024(ws + WS_O, ws + WS_WOUT0, D, (const float*)args.in[0], false); }
    SEAM(4);
    if (IN(6)) { PH_BEGIN
        DEFERRED_SAMPLE(ws + WS_O, ws + WS_WOUT0, D, (const float*)args.in[1], (bf16_t*)(ws + WS_XN), norm_ffn, 0);
        pg8::Gemm g{(const bf16_t*)(ws + WS_XN), (const bf16_t*)(ws + WS_W13_0), M, FF2, D, D};
        GATED_ORDER(S, M, FF2, D, 0);
        pg8::EpiUp E{ssp, (bf16_t*)(ws + WS_H)};
        pg8::gemm_phase<pg8::EpiUp, pg8::GatedOrder, true, true>(F.lds, g, S, E);
    }
    SEAM(6);
    if (IN(7)) { PH_BEGIN GEMM_N1024(ws + WS_H, ws + WS_W2_0, FF, nullptr, true); }
    SEAM(7);
    if (IN(9)) { PH_BEGIN
        DEFERRED_SAMPLE(ws + WS_H, ws + WS_W2_0, FF, out + O_YS, (bf16_t*)(ws + WS_XN), norm_mix + D, 1);
        pg8::Gemm g{(const bf16_t*)(ws + WS_XN), (const bf16_t*)(ws + WS_WIN1), M, C_IN_PAD, D, D};
        GATED_ORDER(S, M, C_IN_PAD, FF, 1);
        pg8::EpiIn1 E{ssp, (bf16_t*)(ws + WS_Q1), (bf16_t*)(ws + WS_KVSEL), (bf16_t*)(ws + WS_KVWIN), (float*)(ws + WS_G1), out};
        pg8::gemm_phase<pg8::EpiIn1, pg8::GatedOrder, true, true>(F.lds, g, S, E);
    }
    SEAM(9);
    if (IN(10)) { PH_BEGIN
        for (int it = (int)blockIdx.x; it < 4 * 8 * 8; it += F.G) compress_item<false, true>(F, it);
    }
    SEAM(10);
    if (IN(11)) { PH_BEGIN
        unsigned* qc = ctl + CW_Q9 + 64 * ((int)blockIdx.x & 7); const int shard = (int)blockIdx.x & 7;
        if (F.wave == 7) for (int it = (int)blockIdx.x; it < NDC + NWC; it += F.G) copy_item(F, it);
        for (int it = q_item(q_issue(qc, F.lane), shard); it < 128 + 8192; ) {
            const unsigned tk = q_issue(qc, F.lane);
            if (it < 128) nsa_item<true>(F, it);
            else { const int p = it - 128, qt = 511 - (p >> 4), bg = p & 15; nsa_item<false>(F, ((bg >> 2) << 11) | (qt << 2) | (bg & 3)); }
            it = q_item(tk, shard);
        }
    }
    SEAM(11);
    if (IN(12)) { PH_BEGIN GEMM_N1024(ws + WS_O, ws + WS_WOUT1, D, nullptr, true); }
    SEAM(12);
    if (IN(14)) { PH_BEGIN
        DEFERRED_SAMPLE(ws + WS_O, ws + WS_WOUT1, D, out + O_YS, (bf16_t*)(ws + WS_XN), norm_ffn + D, 2);
        pg8::Gemm g{(const bf16_t*)(ws + WS_XN), (const bf16_t*)(ws + WS_W13_1), M, FF2, D, D};
        GATED_ORDER(S, M, FF2, D, 2);
        pg8::EpiUp E{ssp, (bf16_t*)(ws + WS_H)};
        pg8::gemm_phase<pg8::EpiUp, pg8::GatedOrder, true, true>(F.lds, g, S, E);
    }
    SEAM(14);
    if (IN(15)) { PH_BEGIN
        if (F.G == MP / 256 * 4) {
            pg8::Gemm g{(const bf16_t*)(ws + WS_H), (const bf16_t*)(ws + WS_W2_1), MP, D, FF, FF};
            pg8::StaticOrder S; S.init(MP, D, F.G, (int)blockIdx.x);
            pg8::EpiResNorm E{(const bf16_t*)(ws + WS_XN), out + O_YP, norm_out, (float*)(ws + WS_XSL), ctl + CW_PN, ctl + CW_BAR + XB_TMO};
            pg8::gemm_phase<pg8::EpiResNorm, pg8::StaticOrder, true, true>(F.lds, g, S, E);
        } else {
            pg8::Gemm g{(const bf16_t*)(ws + WS_H), (const bf16_t*)(ws + WS_W2_1), MP, D, FF, FF};
            pg8::StaticOrder S; S.init(MP, D, F.G, (int)blockIdx.x);
            pg8::EpiRes<true, true> E{nullptr, (bf16_t*)(ws + WS_XN), out + O_YP, ssp};
            pg8::gemm_phase<pg8::EpiRes<true, true>, pg8::StaticOrder, true, true>(F.lds, g, S, E);
        }
        if ((int)blockIdx.x < 4 * (FF / 256)) { const int mu = (int)blockIdx.x; const int sl = mu >> 2;
            pg8::Gemm g{(const bf16_t*)(ws + WS_H) + sl * 256, (const bf16_t*)(ws + WS_W2_1) + sl * 256, M, D, 256, FF};
            pg8::OneUnit S{MP / 256, mu & 3};
            pg8::EpiSlab E{(float*)(ws + WS_SLAB) + (size_t)sl * MS * D};
            pg8::gemm_phase<pg8::EpiSlab, pg8::OneUnit, true, true>(F.lds, g, S, E);
            subgrid_rendezvous(ctl + CW_SR + 64 * 3, 4 * (FF / 256), ctl + CW_BAR);
            for (int r = mu * NWAVES + F.wave; r < MS; r += 4 * (FF / 256) * NWAVES)
                sample_finalize_row<true>((const float*)(ws + WS_SLAB), FF / 256, out + O_YS, out + O_YS, nullptr, norm_out, ssp, r, F.lane); }
    }
    if (gridDim.x != MP / 256 * 4) {
        SEAM(15);
        if (IN(16)) { PH_BEGIN
            for (int r = F.gw; r < MP; r += F.NGW) final_norm_row(out, ssp, norm_out, r, F.lane);
        }
    }
#undef GEMM_N1024
#undef DEFERRED_SAMPLE
#undef GATED_ORDER
#undef IN
#undef SEAM
}

extern "C" void kernel_launch(void* const* d_in, const int* in_sizes, int n_in, void* d_out, int out_size, void* d_ws, size_t ws_size, hipStream_t stream) {
    static int grid = 0;
    if (grid == 0) {
        if (n_in != 28 || (size_t)out_size != O_END || ws_size < WS_END) { fprintf(stderr, "kernel_launch: unexpected shapes (n_in %d out %d ws %zu need %zu)\n", n_in, out_size, ws_size, (size_t)WS_END); grid = -1; return; }
        int dev = 0, cus = 0, per_cu = 0;
        if (hipGetDevice(&dev) != hipSuccess || hipDeviceGetAttribute(&cus, hipDeviceAttributeMultiprocessorCount, dev) != hipSuccess) { grid = -1; return; }
        if (hipFuncSetAttribute((const void*)fwd, hipFuncAttributeMaxDynamicSharedMemorySize, LDS_BYTES) != hipSuccess) { fprintf(stderr, "kernel_launch: hipFuncSetAttribute failed\n"); grid = -1; return; }
        if (hipOccupancyMaxActiveBlocksPerMultiprocessor(&per_cu, (const void*)fwd, NWAVES * 64, LDS_BYTES) != hipSuccess || per_cu < 1) { fprintf(stderr, "kernel_launch: occupancy query says %d\n", per_cu); }
        (void)hipGetLastError();
        grid = cus;
    }
    if (grid < 0) return;
    (void)hipMemsetAsync((char*)d_ws + WS_CTL, 0, CTL_ZERO_BYTES, stream);
    Args a{};
    for (int i = 0; i < 28; ++i) a.in[i] = d_in[i];
    a.out = (float*)d_out; a.ws = (unsigned char*)d_ws;
#if ONE_LAUNCH
    a.ph_lo = 0; a.ph_hi = N_PHASES; hipLaunchKernelGGL(fwd, dim3(grid), dim3(NWAVES * 64), LDS_BYTES, stream, a);
#else
    for (int p = 0; p < N_PHASES; ++p) { a.ph_lo = p; a.ph_hi = p + 1; hipLaunchKernelGGL(fwd, dim3(grid), dim3(NWAVES * 64), LDS_BYTES, stream, a); }
#endif
}
```

```cpp
#include <hip/hip_runtime.h>
#include <cstdio>
#include <cstdint>
#include <type_traits>

#define LAS __attribute__((address_space(3)))
#define GAS __attribute__((address_space(1)))
typedef unsigned short bf16_t;
typedef short bf16x8 __attribute__((ext_vector_type(8)));
typedef short s16x4 __attribute__((ext_vector_type(4)));
typedef float f32x2 __attribute__((ext_vector_type(2)));
typedef float f32x4 __attribute__((ext_vector_type(4)));
typedef float f32x16 __attribute__((ext_vector_type(16)));
typedef unsigned u32x2 __attribute__((ext_vector_type(2)));
typedef unsigned u32x4 __attribute__((ext_vector_type(4)));
typedef __bf16 bf16x2_t __attribute__((ext_vector_type(2)));

constexpr int D = 1024, BP = 4, SEQ = 4096, MP = BP * SEQ, BS = 32, TS = 8, MS = BS * TS, M = MP + MS;
constexpr int PAST = 8192, PAGE = 128, NPG = PAST / PAGE;
constexpr int AB_IN = 2560, C_IN = 2608, C_IN_PAD = 2816, FF = 2816, FF2 = 2 * FF;
constexpr int DIL_KEEP = 2048, WIN = 512;
constexpr int NCP = 255, NCS = 511;
constexpr float EPS = 1e-6f;
constexpr float LOG2E = 1.4426950408889634f;
constexpr float C_SCALE2 = 0.125f * LOG2E;

constexpr size_t O_YP = 0, O_YS = O_YP + (size_t)MP * D, O_DILP = O_YS + (size_t)MS * D, O_DILS = O_DILP + (size_t)BP * 2048 * 1024,
                 O_CONVP = O_DILS + (size_t)BS * 2048 * 1024, O_CONVS = O_CONVP + (size_t)BP * 3 * 512, O_RNNP = O_CONVS + (size_t)BS * 3 * 512,
                 O_RNNS = O_RNNP + (size_t)BP * 512, O_WINP = O_RNNS + (size_t)BS * 512, O_WINS = O_WINP + (size_t)BP * 512 * 512,
                 O_CMPP = O_WINS + (size_t)BS * 512 * 512, O_CMPS = O_CMPP + (size_t)BP * SEQ * 512, O_SELP = O_CMPS + (size_t)BS * TS * 512,
                 O_SELS = O_SELP + (size_t)BP * SEQ * 512, O_END = O_SELS + (size_t)BS * TS * 512;
static_assert(O_END == 119087104, "output size");

constexpr size_t al256(size_t x) { return (x + 255) & ~(size_t)255; }
constexpr size_t WS_CTL = 0, CTL_ZERO_BYTES = 1u << 16;
constexpr size_t WS_WIN0 = CTL_ZERO_BYTES;
constexpr size_t WS_WOUT0 = WS_WIN0 + (size_t)AB_IN * D * 2;
constexpr size_t WS_W13_0 = WS_WOUT0 + (size_t)D * D * 2;
constexpr size_t WS_W2_0 = WS_W13_0 + (size_t)FF2 * D * 2;
constexpr size_t WS_WIN1 = WS_W2_0 + (size_t)D * FF * 2;
constexpr size_t WS_WOUT1 = WS_WIN1 + (size_t)C_IN_PAD * D * 2;
constexpr size_t WS_W13_1 = WS_WOUT1 + (size_t)D * D * 2;
constexpr size_t WS_W2_1 = WS_W13_1 + (size_t)FF2 * D * 2;
constexpr size_t WS_WG = WS_W2_1 + (size_t)D * FF * 2;
constexpr size_t WS_WCT = WS_WG + (size_t)2 * 8 * 64 * 64 * 2;
constexpr size_t WS_PET = WS_WCT + (size_t)2 * 64 * 2048 * 2;
constexpr size_t WS_C8 = WS_PET + 512;
constexpr size_t WS_XN = al256(WS_C8 + 2048);
constexpr size_t WS_QD = WS_XN + (size_t)M * D * 2;
constexpr size_t WS_KVD = WS_QD + (size_t)M * 512 * 2;
constexpr size_t WS_XR = WS_KVD + (size_t)M * 1024 * 2;
constexpr size_t WS_GT = WS_XR + (size_t)M * 512 * 4;
constexpr size_t WS_AU = WS_GT + (size_t)M * 512 * 2;
constexpr size_t WS_AGG = WS_AU + (size_t)M * 1024 * 4;
constexpr size_t WS_O = WS_AGG + (size_t)4 * 128 * 1024 * 4;
constexpr size_t WS_H = WS_O + (size_t)M * D * 2;
constexpr size_t WS_SSP = WS_H + (size_t)M * FF * 2;
constexpr size_t WS_Q1 = WS_SSP + (size_t)M * 16 * 4;
constexpr size_t WS_KVSEL = WS_Q1 + (size_t)M * D * 2;
constexpr size_t WS_KVWIN = WS_KVSEL + (size_t)MP * 512 * 2;
constexpr size_t WS_G1 = WS_KVWIN + (size_t)MP * 512 * 2;
constexpr size_t WS_KCP = al256(WS_G1 + (size_t)M * 48 * 4);
constexpr size_t WS_KCS = WS_KCP + (size_t)BP * 256 * 512 * 2;
constexpr size_t WS_SLAB = WS_KCS + (size_t)BS * 512 * 512 * 2;
constexpr size_t WS_XSL = WS_SLAB + (size_t)11 * MS * D * 4;
constexpr size_t WS_PETP = WS_XSL + (size_t)MP * 4 * 4;
constexpr size_t WS_END = WS_PETP + (size_t)2 * 32 * 64 * 4;

constexpr int CW_BAR = 4096;
constexpr int CW_Q2 = 8192, CW_Q9 = 8192 + 1024;
constexpr int CW_PN = 8192 + 2048;
constexpr int CW_SR = 8192 + 2048 + 4096;
constexpr int CW_QBG = 8192 + 2048, CW_DONE = 8192 + 3072;

constexpr int RING_BYTES = 131072;
constexpr int WSCR = 18432;
constexpr int MISC_OFF = 8 * WSCR;
constexpr int LDS_BYTES = MISC_OFF + 1024;

__device__ __forceinline__ unsigned cvtpk(float lo, float hi) { f32x2 v = {lo, hi}; bf16x2_t b = __builtin_convertvector(v, bf16x2_t); return __builtin_bit_cast(unsigned, b); }
__device__ __forceinline__ float bf2f(unsigned short h) { return __uint_as_float((unsigned)h << 16); }
__device__ __forceinline__ bf16x8 pack8(f32x4 a, f32x4 b) { u32x4 w; w.x = cvtpk(a[0], a[1]); w.y = cvtpk(a[2], a[3]); w.z = cvtpk(b[0], b[1]); w.w = cvtpk(b[2], b[3]); return __builtin_bit_cast(bf16x8, w); }
__device__ __forceinline__ float wave_sum(float v) {
#pragma unroll
    for (int o = 1; o < 64; o <<= 1) v += __shfl_xor(v, o);
    return v;
}
#define LDS_WAIT() asm volatile("s_waitcnt lgkmcnt(0)" ::: "memory")
#define VM_WAIT() asm volatile("s_waitcnt vmcnt(0)" ::: "memory")

namespace pg8 {
#define PG8_LAS __attribute__((address_space(3)))
constexpr int BM = 256, BK = 64, HALF = 128, HTB = HALF * BK * 2, STAGE_BYTES = 8 * HTB, NXCD = 8, WGM = 8;
__host__ __device__ __forceinline__ int lds_byte(int r, int c) { const int st = (r >> 4) * 2 + (c >> 5), rr = r & 15, cc = c & 31, ob = rr * 64 + cc * 2; return st * 1024 + (ob ^ (((ob >> 9) & 1) << 5)); }
__host__ __device__ __forceinline__ void stage_rc(int b, int& R, int& C) { const int st = b / 1024, sb = b % 1024, swz = sb ^ (((sb >> 9) & 1) << 5); R = (st >> 1) * 16 + swz / 64; C = (st & 1) * 32 + (swz % 64) / 2; }
__host__ __device__ __forceinline__ int perm32(int rho) { const int n = rho >> 4, i = rho & 15; return 8 * (i >> 2) + 4 * n + (i & 3); }
struct Unit { int pm, pn; };
struct Gemm { const bf16_t* A; const bf16_t* Bt; int M, N, K, ld; };
struct StaticOrder {
    int nM, nN, nwg, G, c;
    __host__ __device__ void init(int M_, int N_, int G_, int c_) { nM = M_ / BM; nN = N_ / BM; nwg = nM * nN; G = G_; c = c_; }
    __host__ __device__ bool next(int i, Unit& u) const {
        const long L = (long)i * G + c; if (L >= nwg) return false;
        int wgid = (int)L; { const int q = nwg / NXCD, r = nwg % NXCD, xcd = wgid % NXCD, off = wgid / NXCD; wgid = (xcd < r ? xcd * (q + 1) : r * (q + 1) + (xcd - r) * q) + off; }
        const int nig = WGM * nN, gid = wgid / nig, fm = gid * WGM, gsz = (nM - fm) < WGM ? (nM - fm) : WGM;
        u.pm = fm + ((wgid % nig) % gsz); u.pn = (wgid % nig) / gsz; return true;
    }
    __device__ __forceinline__ void a_ready(const Unit&) const {}
    __device__ __forceinline__ void done(const Unit&) const {}
};

struct CountingOrder : StaticOrder {
    unsigned* cnt; int lane;
    __device__ __forceinline__ void done(const Unit&) const { if (lane == 0) __hip_atomic_fetch_add(cnt, 1u, __ATOMIC_RELAXED, __HIP_MEMORY_SCOPE_AGENT); }
};
struct OneUnit {
    int pm, pn;
    __host__ __device__ bool next(int i, Unit& u) const { if (i) return false; u.pm = pm; u.pn = pn; return true; }
    __device__ __forceinline__ void a_ready(const Unit&) const {}
    __device__ __forceinline__ void done(const Unit&) const {}
};
template <class Epi, class Sched, bool ALIGN_EPI = false, bool SP2 = false>
__device__ __forceinline__ void gemm_phase(PG8_LAS unsigned char* lds, const Gemm g, const Sched& S, const Epi& E) {
    const int tid = threadIdx.x, wid = __builtin_amdgcn_readfirstlane(tid >> 6), lane = tid & 63, wr = wid >> 2, wc = wid & 3, fr = lane & 15, fq = lane >> 4;
    const int K = g.K, nt = K / BK, LD = g.ld;
    unsigned voffA[2], voffB[2];
#pragma unroll
    for (int i = 0; i < 2; ++i) { int R, C; stage_rc(tid * 16 + i * 8192, R, C); const int Rb = Epi::PERM ? ((R & ~31) + perm32(R & 31)) : R;
        voffA[i] = (unsigned)(R * LD + C) * 2u; voffB[i] = (unsigned)(Rb * LD + C) * 2u; }
    const size_t kstep = (size_t)(BK * 2);
    const size_t hstep = (size_t)HALF * LD * 2;
    const size_t tstep = 2 * hstep;
    const unsigned ldsw = (unsigned)wid * 1024u;
    const int aoff = lds_byte(wr * 64 + fr, fq * 8), boff = lds_byte(wc * 32 + fr, fq * 8);
#define PG8_SA(b, h) (((b) * 2 + (h)) * HTB)
#define PG8_SB(b, h) ((4 + (b) * 2 + (h)) * HTB)
#define PG8_STAGE(bufoff, gbase, voff) do { _Pragma("unroll") for (int _i = 0; _i < 2; ++_i) \
        __builtin_amdgcn_global_load_lds((const unsigned*)((const char*)(gbase) + (voff)[_i]), (PG8_LAS unsigned*)(lds + (bufoff) + ldsw + _i * 8192), 16, 0, 0); } while (0)
#define PG8_LDA(dst, b, h) do { _Pragma("unroll") for (int m = 0; m < 4; ++m) _Pragma("unroll") for (int k = 0; k < 2; ++k) dst[m][k] = *(const PG8_LAS bf16x8*)(lds + PG8_SA(b, h) + aoff + m * 2048 + k * 1024); } while (0)
#define PG8_LDB(dst, b, h) do { _Pragma("unroll") for (int n = 0; n < 2; ++n) _Pragma("unroll") for (int k = 0; k < 2; ++k) dst[n][k] = *(const PG8_LAS bf16x8*)(lds + PG8_SB(b, h) + boff + n * 2048 + k * 1024); } while (0)
#define PG8_MMA(ai, bj, At, Bt) do { __builtin_amdgcn_s_setprio(1); _Pragma("unroll") for (int m = 0; m < 4; ++m) _Pragma("unroll") for (int n = 0; n < 2; ++n) _Pragma("unroll") for (int k = 0; k < 2; ++k) \
        acc[ai][bj][m][n] = __builtin_amdgcn_mfma_f32_16x16x32_bf16(Bt[n][k], At[m][k], acc[ai][bj][m][n], 0, 0, 0); __builtin_amdgcn_s_setprio(0); } while (0)
#define PG8_WAIT_V(n) asm volatile("s_waitcnt vmcnt(" #n ")" ::: "memory")
#define PG8_WAIT_L(n) asm volatile("s_waitcnt lgkmcnt(" #n ")" ::: "memory")
#define PG8_BAR __builtin_amdgcn_s_barrier()
#define PG8_SCHED __builtin_amdgcn_sched_barrier(0)
    Unit cur, nxt; int ui = 0;
    if (!S.next(0, cur)) return;
    f32x4 acc[2][2][4][2];
#pragma unroll
    for (int a = 0; a < 2; ++a)
#pragma unroll
        for (int b = 0; b < 2; ++b)
#pragma unroll
            for (int m = 0; m < 4; ++m)
#pragma unroll
                for (int n = 0; n < 2; ++n) acc[a][b][m][n] = (f32x4){0.f, 0.f, 0.f, 0.f};
    bf16x8 At[4][2], B0[2][2], B1[2][2];
    const char* cA = (const char*)g.A + (size_t)cur.pm * tstep; const char* cB = (const char*)g.Bt + (size_t)cur.pn * tstep;
    S.a_ready(cur);
    if constexpr (SP2) {
        PG8_STAGE(PG8_SB(0, 0), cB, voffB); PG8_STAGE(PG8_SB(0, 1), cB + hstep, voffB); PG8_STAGE(PG8_SA(0, 0), cA, voffA); PG8_STAGE(PG8_SA(0, 1), cA + hstep, voffA);
        if (wr == 1) PG8_BAR;
        PG8_WAIT_V(2); PG8_BAR;
        PG8_STAGE(PG8_SB(1, 0), cB + kstep, voffB); PG8_STAGE(PG8_SA(1, 0), cA + kstep, voffA); PG8_STAGE(PG8_SB(1, 1), cB + hstep + kstep, voffB);
        PG8_WAIT_V(6); PG8_BAR;
    } else {
        PG8_STAGE(PG8_SB(0, 0), cB, voffB); PG8_STAGE(PG8_SA(0, 0), cA, voffA); PG8_STAGE(PG8_SB(0, 1), cB + hstep, voffB); PG8_STAGE(PG8_SA(0, 1), cA + hstep, voffA);
        if (wr == 1) PG8_BAR;
        PG8_WAIT_V(4); PG8_BAR;
        PG8_STAGE(PG8_SB(1, 0), cB + kstep, voffB); PG8_STAGE(PG8_SA(1, 0), cA + kstep, voffA); PG8_STAGE(PG8_SB(1, 1), cB + hstep + kstep, voffB);
        PG8_WAIT_V(6); PG8_BAR;
    }
    for (;;) {
        const bool has_next = S.next(ui + 1, nxt);
        const char* nA = has_next ? (const char*)g.A + (size_t)nxt.pm * tstep : cA; const char* nB = has_next ? (const char*)g.Bt + (size_t)nxt.pn * tstep : cB;
        for (int t = 0; t < nt; t += 2) {
            const bool last = (t == nt - 2);
            const char* a1 = cA + (size_t)(t + 1) * kstep;
            const char* a2 = last ? nA : cA + (size_t)(t + 2) * kstep; const char* b2 = last ? nB : cB + (size_t)(t + 2) * kstep;
            const char* a3 = a2 + kstep; const char* b3 = b2 + kstep;
            if (last && has_next) S.a_ready(nxt);
            if constexpr (SP2) {
            PG8_LDB(B0, 0, 0); PG8_LDB(B1, 0, 1); PG8_SCHED; PG8_LDA(At, 0, 0); PG8_STAGE(PG8_SA(1, 1), a1 + hstep, voffA);
            PG8_WAIT_V(8); PG8_WAIT_L(0); PG8_BAR; PG8_MMA(0, 0, At, B0); PG8_MMA(0, 1, At, B1); PG8_BAR; PG8_SCHED;
            PG8_LDA(At, 0, 1); PG8_STAGE(PG8_SB(0, 0), b2, voffB); PG8_STAGE(PG8_SB(0, 1), b2 + hstep, voffB); PG8_STAGE(PG8_SA(0, 0), a2, voffA);
            PG8_WAIT_V(8); PG8_WAIT_L(0); PG8_BAR; PG8_MMA(1, 0, At, B0); PG8_MMA(1, 1, At, B1); PG8_BAR; PG8_SCHED;
            PG8_LDB(B0, 1, 0); PG8_LDB(B1, 1, 1); PG8_SCHED; PG8_LDA(At, 1, 0); PG8_STAGE(PG8_SA(0, 1), a2 + hstep, voffA);
            PG8_WAIT_V(8); PG8_WAIT_L(0); PG8_BAR; PG8_MMA(0, 0, At, B0); PG8_MMA(0, 1, At, B1); PG8_BAR; PG8_SCHED;
            PG8_LDA(At, 1, 1); PG8_STAGE(PG8_SB(1, 0), b3, voffB); PG8_STAGE(PG8_SB(1, 1), b3 + hstep, voffB); PG8_STAGE(PG8_SA(1, 0), a3, voffA);
            PG8_WAIT_V(8); PG8_WAIT_L(0); PG8_BAR; PG8_MMA(1, 0, At, B0); PG8_MMA(1, 1, At, B1); PG8_BAR; PG8_SCHED;
            } else {
            PG8_LDB(B0, 0, 0); PG8_SCHED; PG8_LDA(At, 0, 0); PG8_STAGE(PG8_SA(1, 1), a1 + hstep, voffA);
            PG8_WAIT_L(8); PG8_BAR; PG8_WAIT_L(0); PG8_MMA(0, 0, At, B0); PG8_BAR; PG8_SCHED;
            PG8_LDB(B1, 0, 1); PG8_STAGE(PG8_SB(0, 0), b2, voffB);
            PG8_BAR; PG8_WAIT_L(0); PG8_MMA(0, 1, At, B1); PG8_BAR;
            PG8_LDA(At, 0, 1); PG8_STAGE(PG8_SA(0, 0), a2, voffA);
            PG8_BAR; PG8_WAIT_L(0); PG8_MMA(1, 0, At, B0); PG8_BAR; PG8_SCHED;
            PG8_STAGE(PG8_SB(0, 1), b2 + hstep, voffB);
            PG8_WAIT_V(6); PG8_BAR; PG8_MMA(1, 1, At, B1); PG8_BAR;
            PG8_LDB(B0, 1, 0); PG8_SCHED; PG8_LDA(At, 1, 0); PG8_STAGE(PG8_SA(0, 1), a2 + hstep, voffA);
            PG8_WAIT_L(8); PG8_BAR; PG8_WAIT_L(0); PG8_MMA(0, 0, At, B0); PG8_BAR; PG8_SCHED;
            PG8_LDB(B1, 1, 1); PG8_STAGE(PG8_SB(1, 0), b3, voffB);
            PG8_BAR; PG8_WAIT_L(0); PG8_MMA(0, 1, At, B1); PG8_BAR;
            PG8_LDA(At, 1, 1); PG8_STAGE(PG8_SA(1, 0), a3, voffA);
            PG8_BAR; PG8_WAIT_L(0); PG8_MMA(1, 0, At, B0); PG8_BAR; PG8_SCHED;
            PG8_STAGE(PG8_SB(1, 1), b3 + hstep, voffB);
            PG8_WAIT_V(6); PG8_BAR; PG8_MMA(1, 1, At, B1); PG8_BAR;
            }
        }
        if constexpr (ALIGN_EPI) { if (wr == 0) PG8_BAR; }
        if constexpr (!Epi::AFTER_DRAIN) { E(acc, cur, wr, wc, fr, fq); S.done(cur); }
        if (!has_next) break;
#pragma unroll
        for (int a = 0; a < 2; ++a)
#pragma unroll
            for (int b = 0; b < 2; ++b)
#pragma unroll
                for (int m = 0; m < 4; ++m)
#pragma unroll
                    for (int n = 0; n < 2; ++n) acc[a][b][m][n] = (f32x4){0.f, 0.f, 0.f, 0.f};
        cur = nxt; cA = nA; cB = nB; ++ui;
        if constexpr (ALIGN_EPI) { if (wr == 1) PG8_BAR; }
    }
    PG8_WAIT_V(0);
    if constexpr (!ALIGN_EPI) { if (wr == 0) PG8_BAR; }
    PG8_BAR;
    if constexpr (Epi::AFTER_DRAIN) { E.fused(acc, cur, wr, wc, fr, fq, lds, wid, lane, tid); S.done(cur); }
#undef PG8_SA
#undef PG8_SB
#undef PG8_STAGE
#undef PG8_LDA
#undef PG8_LDB
#undef PG8_MMA
#undef PG8_WAIT_V
#undef PG8_WAIT_L
#undef PG8_BAR
#undef PG8_SCHED
}

typedef f32x4 Acc[2][2][4][2];

struct EpiIn0 {
    static constexpr bool PERM = true, AFTER_DRAIN = false;
    bf16_t* QD; bf16_t* KVD; float* XR; bf16_t* GT; float* out;
    __device__ __forceinline__ void operator()(const Acc& acc, const Unit& u, int wr, int wc, int fr, int fq) const {
        const int region = u.pn >> 1, cb = (u.pn & 1) * 256 + wc * 32 + 8 * fq;
#pragma unroll
        for (int ai = 0; ai < 2; ++ai)
#pragma unroll
            for (int m = 0; m < 4; ++m) {
                const int row = u.pm * BM + ai * HALF + wr * 64 + m * 16 + fr;
                const bool smp = row >= MP; const int b = smp ? (row - MP) >> 3 : row >> 12, t = smp ? (row - MP) & 7 : row & 4095;
#pragma unroll
                for (int bj = 0; bj < 2; ++bj) {
                    const int col = cb + bj * HALF; const f32x4 v0 = acc[ai][bj][m][0], v1 = acc[ai][bj][m][1];
                    if (region == 0) { *(bf16x8*)(QD + (size_t)row * 512 + col) = pack8(v0 * C_SCALE2, v1 * C_SCALE2); }
                    else if (region <= 2) { const int c = region - 1;
                        *(bf16x8*)(KVD + (size_t)row * 1024 + c * 512 + col) = pack8(v0, v1);
                        float* o = nullptr;
                        if (smp) o = out + O_DILS + ((size_t)(b * 2048 + 2040 + t) * 2 + c) * 512 + col;
                        else if (t >= 2048) o = out + O_DILP + ((size_t)(b * 2048 + t - 2048) * 2 + c) * 512 + col;
                        if (o) { *(f32x4*)o = v0; *(f32x4*)(o + 4) = v1; } }
                    else if (region == 3) { float* x = XR + (size_t)row * 512 + col; *(f32x4*)x = v0; *(f32x4*)(x + 4) = v1;
                        float* o = nullptr;
                        if (smp) { if (t >= 5) o = out + O_CONVS + (size_t)(b * 3 + t - 5) * 512 + col; }
                        else if (t >= SEQ - 3) o = out + O_CONVP + (size_t)(b * 3 + t - (SEQ - 3)) * 512 + col;
                        if (o) { *(f32x4*)o = v0; *(f32x4*)(o + 4) = v1; } }
                    else { *(bf16x8*)(GT + (size_t)row * 512 + col) = pack8(v0, v1); }
                }
            }
    }
};
}

#define XB_TMO      128
#define XB_XCNT(j)  (256  + 64 * (j))
#define XB_XSUB(j)  (1280 + 64 * (j))
#define XB_XGEN(j)  (2304 + 64 * (j))
#define XB_TOP      3328
#define XB_TOPGEN   3392
#define XCD_BAR_WORDS 3456
#define XB_SPIN_CAP (1u << 18)
__device__ __forceinline__ unsigned xb_ld(unsigned* p)              { return __hip_atomic_load(p, __ATOMIC_RELAXED, __HIP_MEMORY_SCOPE_AGENT); }
__device__ __forceinline__ unsigned xb_add(unsigned* p, unsigned v) { return __hip_atomic_fetch_add(p, v, __ATOMIC_RELAXED, __HIP_MEMORY_SCOPE_AGENT); }
__device__ __forceinline__ unsigned xb_xcc_id() { return (unsigned)__builtin_amdgcn_s_getreg((3 << 11) | 20) & 0xFu; }
#define XB_SPIN(cond, bar) do { unsigned _sp = 0; while (cond) { __builtin_amdgcn_s_sleep(1); \
    if ((++_sp & 255u) == 0u) { if (xb_ld(&(bar)[XB_TMO])) break; if (_sp > XB_SPIN_CAP) { atomicAdd(&(bar)[XB_TMO], 1u); break; } } } } while (0)
struct XcdBarrier { unsigned* bar; unsigned x; volatile LAS unsigned* st; };
__device__ __forceinline__ XcdBarrier xcd_barrier_post(unsigned* bar, volatile LAS unsigned* st) {
    XcdBarrier b; b.bar = bar; b.x = xb_xcc_id(); b.st = st;
    if (threadIdx.x == 0) (void)xb_add(&bar[XB_XCNT(b.x)], 1u);
    return b;
}
__device__ __forceinline__ void xcd_barrier_complete(unsigned* bar, unsigned x, unsigned& nloc, unsigned& nx) {
    const unsigned G = gridDim.x * gridDim.y * gridDim.z;
    unsigned sum, cnt, mine, sp = 0u;
    for (;;) {
        sum = 0u; cnt = 0u; mine = 0u;
#pragma unroll
        for (unsigned j = 0; j < 16; ++j) { const unsigned c = xb_ld(&bar[XB_XCNT(j)]); sum += c; cnt += (c > 0u) ? 1u : 0u; mine = (j == x) ? c : mine; }
        if (sum == G) break;
        __builtin_amdgcn_s_sleep(1);
        if ((++sp & 255u) == 0u) { if (xb_ld(&bar[XB_TMO])) break; if (sp > XB_SPIN_CAP) { atomicAdd(&bar[XB_TMO], 1u); break; } }
    }
    nloc = mine > 0u ? mine : 1u; nx = cnt > 0u ? cnt : 1u;
}
__device__ __forceinline__ void xcd_barrier(const XcdBarrier& b) {
    asm volatile("s_waitcnt vmcnt(0)" ::: "memory");
    __syncthreads();
    if (threadIdx.x == 0) {
        unsigned* bar = b.bar;
        __builtin_amdgcn_s_waitcnt(0);
        unsigned nloc = b.st[0], nx = b.st[1];
        if (nloc == 0u) { xcd_barrier_complete(bar, b.x, nloc, nx); b.st[0] = nloc; b.st[1] = nx; }
        const unsigned old = xb_add(&bar[XB_XSUB(b.x)], 1u);
        const unsigned gen = old / nloc;
        if (old + 1u == (gen + 1u) * nloc) {
            __builtin_amdgcn_fence(__ATOMIC_RELEASE, "agent");
            asm volatile("s_waitcnt vmcnt(0)" ::: "memory");
            const unsigned og = xb_add(&bar[XB_TOP], 1u);
            const unsigned tg = og / nx;
            if (og + 1u == (tg + 1u) * nx) xb_add(&bar[XB_TOPGEN], 1u);
            else XB_SPIN(xb_ld(&bar[XB_TOPGEN]) == tg, bar);
            __builtin_amdgcn_fence(__ATOMIC_ACQUIRE, "agent");
            xb_add(&bar[XB_XGEN(b.x)], 1u);
            asm volatile("s_waitcnt vmcnt(0)" ::: "memory");
        } else {
            XB_SPIN(xb_ld(&bar[XB_XGEN(b.x)]) == gen, bar);
            __builtin_amdgcn_fence(__ATOMIC_ACQUIRE, "agent");
            asm volatile("s_waitcnt vmcnt(0)" ::: "memory");
        }
    }
    __syncthreads();
}

__device__ __forceinline__ void subgrid_rendezvous(unsigned* cnt, unsigned n, unsigned* bar) {
    asm volatile("s_waitcnt vmcnt(0)" ::: "memory");
    __syncthreads();
    if (threadIdx.x == 0) {
        __builtin_amdgcn_fence(__ATOMIC_RELEASE, "agent");
        asm volatile("s_waitcnt vmcnt(0)" ::: "memory");
        (void)xb_add(cnt, 1u);
        XB_SPIN(xb_ld(cnt) < n, bar);
        __builtin_amdgcn_fence(__ATOMIC_ACQUIRE, "agent");
        asm volatile("s_waitcnt vmcnt(0)" ::: "memory");
    }
    __syncthreads();
}

struct Args { const void* in[28]; float* out; unsigned char* ws; int ph_lo, ph_hi; };
constexpr int NWAVES = 8;

struct Frame {
    LAS unsigned char* lds; LAS unsigned char* wscr;
    int tid, lane, wave, gw, NGW, G;
    unsigned char* ws; float* out; const Args* a;
};

__device__ __forceinline__ void transpose_item(const float* W, int K, int Nsrc, int Npad, bf16_t* WT, int mode, LAS float* scr, int item, int lane, const float* gk = nullptr) {
    const int nblk = Npad / 32, kb = item / nblk, nb = item % nblk, k0 = 64 * kb, n0 = 32 * nb;
    const int nn = n0 + (lane & 31);
    float v[32];
#pragma unroll
    for (int i = 0; i < 32; ++i) { const int kk = 2 * i + (lane >> 5); v[i] = nn < Nsrc ? __builtin_nontemporal_load(W + (size_t)(k0 + kk) * Nsrc + nn) : 0.f; }
#pragma unroll
    for (int i = 0; i < 32; ++i) { const int kk = 2 * i + (lane >> 5); scr[kk * 33 + (lane & 31)] = v[i]; }
    LDS_WAIT();
    const int c = lane & 7;
    f32x4 ga = {1.f, 1.f, 1.f, 1.f}, gb = ga;
    if (gk) { ga = *(const f32x4*)(gk + k0 + 8 * c); gb = *(const f32x4*)(gk + k0 + 8 * c + 4); }
#pragma unroll
    for (int j = 0; j < 4; ++j) { const int n = (lane >> 3) + 8 * j; const LAS float* s = scr + (8 * c) * 33 + n;
        u32x4 o; o.x = cvtpk(s[0 * 33] * ga.x, s[1 * 33] * ga.y); o.y = cvtpk(s[2 * 33] * ga.z, s[3 * 33] * ga.w); o.z = cvtpk(s[4 * 33] * gb.x, s[5 * 33] * gb.y); o.w = cvtpk(s[6 * 33] * gb.z, s[7 * 33] * gb.w);
        const int ng = n0 + n; const int drow = mode == 0 ? ng : ((ng >> 7) * 256 + (ng & 127) + (mode == 2 ? 128 : 0));
        *(u32x4*)(WT + (size_t)drow * K + k0 + 8 * c) = o; }
    LDS_WAIT();
}
__device__ __forceinline__ void rms_row_to_bf16(const float* xrow, const float* g, bf16_t* orow, int lane) {
    const f32x4* xr = (const f32x4*)xrow + lane; const f32x4* gr = (const f32x4*)g + lane;
    f32x4 v[4]; float s = 0.f;
#pragma unroll
    for (int j = 0; j < 4; ++j) { v[j] = __builtin_nontemporal_load(xr + 64 * j); s += (v[j].x * v[j].x + v[j].y * v[j].y) + (v[j].z * v[j].z + v[j].w * v[j].w); }
    const float rstd = 1.f / sqrtf(wave_sum(s) * (1.f / D) + EPS);
    u32x2* o8 = (u32x2*)orow + lane;
#pragma unroll
    for (int j = 0; j < 4; ++j) { const f32x4 gg = gr[64 * j]; u32x2 w; w.x = cvtpk(v[j].x * rstd * gg.x, v[j].y * rstd * gg.y); w.y = cvtpk(v[j].z * rstd * gg.z, v[j].w * rstd * gg.w); o8[64 * j] = w; }
}

__device__ __forceinline__ void rms_rows4_to_bf16(const float* x0, const float* x1, const float* x2, const float* x3, const float* g, bf16_t* o0, bf16_t* o1, bf16_t* o2, bf16_t* o3, int lane) {
    const float* xs[4] = {x0, x1, x2, x3}; bf16_t* os[4] = {o0, o1, o2, o3};
    f32x4 v[4][4]; float s[4];
#pragma unroll
    for (int q = 0; q < 4; ++q)
#pragma unroll
        for (int j = 0; j < 4; ++j) v[q][j] = __builtin_nontemporal_load((const f32x4*)xs[q] + lane + 64 * j);
    f32x4 gg[4];
#pragma unroll
    for (int j = 0; j < 4; ++j) gg[j] = *((const f32x4*)g + lane + 64 * j);
#pragma unroll
    for (int q = 0; q < 4; ++q) { float t = 0.f;
#pragma unroll
        for (int j = 0; j < 4; ++j) t += (v[q][j].x * v[q][j].x + v[q][j].y * v[q][j].y) + (v[q][j].z * v[q][j].z + v[q][j].w * v[q][j].w);
        s[q] = 1.f / sqrtf(wave_sum(t) * (1.f / D) + EPS); }
#pragma unroll
    for (int q = 0; q < 4; ++q)
#pragma unroll
        for (int j = 0; j < 4; ++j) { const float rstd = s[q]; u32x2 w; w.x = cvtpk(v[q][j].x * rstd * gg[j].x, v[q][j].y * rstd * gg[j].y); w.y = cvtpk(v[q][j].z * rstd * gg[j].z, v[q][j].w * rstd * gg[j].w);
            *((u32x2*)os[q] + lane + 64 * j) = w; }
}

constexpr int WT_IN0 = 16 * (AB_IN / 32), WT_O = 16 * (D / 32), WT_F = 16 * (FF / 32), WT_2 = (FF / 64) * (D / 32), WT_IN1 = 16 * (C_IN_PAD / 32);
constexpr int WT_T0 = WT_IN0, WT_T1 = WT_T0 + WT_O, WT_T2 = WT_T1 + WT_F, WT_T3 = WT_T2 + WT_F, WT_T4 = WT_T3 + WT_2, WT_T5 = WT_T4 + WT_IN1, WT_T6 = WT_T5 + WT_O, WT_T7 = WT_T6 + WT_F, WT_T8 = WT_T7 + WT_F, WT_T9 = WT_T8 + WT_2;
__device__ __forceinline__ void weight_transpose_item(const Frame& F, int it) {
    const Args& A = *F.a; LAS float* scr = (LAS float*)F.wscr; unsigned char* ws = F.ws; const int lane = F.lane;
    constexpr int T0 = WT_T0, T1 = WT_T1, T2 = WT_T2, T3 = WT_T3, T4 = WT_T4, T5 = WT_T5, T6 = WT_T6, T7 = WT_T7, T8 = WT_T8;
    {
        {
            const float* w1_0 = (const float*)A.in[25]; const float* w3_0 = (const float*)A.in[26]; const float* w2_0 = (const float*)A.in[27];
            if (it < T0) transpose_item((const float*)A.in[12], D, AB_IN, AB_IN, (bf16_t*)(ws + WS_WIN0), 0, scr, it, lane);
            else if (it < T1) transpose_item((const float*)A.in[13], D, D, D, (bf16_t*)(ws + WS_WOUT0), 0, scr, it - T0, lane);
            else if (it < T2) transpose_item(w1_0, D, FF, FF, (bf16_t*)(ws + WS_W13_0), 1, scr, it - T1, lane, (const float*)A.in[10]);
            else if (it < T3) transpose_item(w3_0, D, FF, FF, (bf16_t*)(ws + WS_W13_0), 2, scr, it - T2, lane, (const float*)A.in[10]);
            else if (it < T4) transpose_item(w2_0, FF, D, D, (bf16_t*)(ws + WS_W2_0), 0, scr, it - T3, lane);
            else if (it < T5) transpose_item((const float*)A.in[21], D, C_IN, C_IN_PAD, (bf16_t*)(ws + WS_WIN1), 0, scr, it - T4, lane, (const float*)A.in[9] + D);
            else if (it < T6) transpose_item((const float*)A.in[22], D, D, D, (bf16_t*)(ws + WS_WOUT1), 0, scr, it - T5, lane);
            else if (it < T7) transpose_item(w1_0 + (size_t)D * FF, D, FF, FF, (bf16_t*)(ws + WS_W13_1), 1, scr, it - T6, lane, (const float*)A.in[10] + D);
            else if (it < T8) transpose_item(w3_0 + (size_t)D * FF, D, FF, FF, (bf16_t*)(ws + WS_W13_1), 2, scr, it - T7, lane, (const float*)A.in[10] + D);
            else transpose_item(w2_0 + (size_t)FF * D, FF, D, D, (bf16_t*)(ws + WS_W2_1), 0, scr, it - T8, lane);
        }
    }
}
__device__ __forceinline__ void p0_prologue(const Frame& F) {
    const Args& A = *F.a;
    unsigned char* ws = F.ws;
    const int lane = F.lane;
    constexpr int X0 = WT_T4;
    constexpr int NMISC = 16 + 64 + 1;
    constexpr int R0 = X0 + NMISC;
    constexpr int NITEMS = R0 + M;
    for (int it = F.gw; it < NITEMS; it += F.NGW) {
        if (it < WT_T4) { weight_transpose_item(F, it);
        } else if (it < R0) {
            const int mi = it - X0;
            if (mi < 16) {
                const int mat = mi >> 3, n = mi & 7; const float* W = (const float*)A.in[mat ? 18 : 16] + (size_t)n * 4096;
                bf16_t* dst = (bf16_t*)(ws + WS_WG) + ((size_t)(mat * 8 + n) * 64 + lane) * 64;
#pragma unroll
                for (int k8 = 0; k8 < 8; ++k8) { const int d0 = k8 >> 1, h = k8 & 1; float v[8];
#pragma unroll
                    for (int jj = 0; jj < 8; ++jj) { const int i = 16 * d0 + 8 * (jj >> 2) + 4 * h + (jj & 3); v[jj] = W[i * 64 + lane]; }
                    u32x4 o; o.x = cvtpk(v[0], v[1]); o.y = cvtpk(v[2], v[3]); o.z = cvtpk(v[4], v[5]); o.w = cvtpk(v[6], v[7]);
                    *(u32x4*)(dst + 8 * k8) = o; }
            } else if (mi < 16 + 64) {
                const int lc = mi - 16, l = lc >> 1, c = lc & 1; const float* W = (const float*)A.in[23] + (size_t)(l * 2 + c) * 4096;
                bf16_t* dst = (bf16_t*)(ws + WS_WCT) + ((size_t)(c * 32 + l) * 4 * 2) * 512 + lane * 8;
                const int r32 = lane & 31, hi = lane >> 5;
                const float* P = (const float*)A.in[24] + (size_t)(l * 2 + c) * 64 + 8 * hi;
                float pt0 = 0.f, pt1 = 0.f;
#pragma unroll
                for (int k4 = 0; k4 < 4; ++k4) {
                    const f32x4 pa = *(const f32x4*)(P + 16 * k4), pb = *(const f32x4*)(P + 16 * k4 + 4);
#pragma unroll
                    for (int eh = 0; eh < 2; ++eh) { float v[8];
#pragma unroll
                        for (int j = 0; j < 8; ++j) v[j] = W[(16 * k4 + 8 * hi + j) * 64 + r32 + 32 * eh];
                        u32x4 o; o.x = cvtpk(v[0], v[1]); o.y = cvtpk(v[2], v[3]); o.z = cvtpk(v[4], v[5]); o.w = cvtpk(v[6], v[7]);
                        *(u32x4*)(dst + (size_t)(k4 * 2 + eh) * 512) = o;
                        const float t = ((pa.x * v[0] + pa.y * v[1]) + (pa.z * v[2] + pa.w * v[3])) + ((pb.x * v[4] + pb.y * v[5]) + (pb.z * v[6] + pb.w * v[7]));
                        if (eh) pt1 += t; else pt0 += t; }
                }
                pt0 += __shfl_xor(pt0, 32); pt1 += __shfl_xor(pt1, 32);
                ((float*)(ws + WS_PETP))[(size_t)(c * 32 + l) * 64 + lane] = hi ? pt1 : pt0;
            } else {
                const float* L = (const float*)A.in[20];
#pragma unroll
                for (int j = 0; j < 8; ++j) { const float z = -L[j * 64 + lane]; ((float*)(ws + WS_C8))[j * 64 + lane] = 8.f * (fmaxf(z, 0.f) + log1pf(expf(-fabsf(z)))); }
            }
        } else {
            const int r = it - R0;
#define XROW(r_) ((r_) < MP ? (const float*)A.in[0] + (size_t)(r_) * D : (const float*)A.in[1] + (size_t)((r_) - MP) * D)
#define OROW(r_) ((bf16_t*)(ws + WS_XN) + (size_t)(r_) * D)
            if (r + 3 * F.NGW < M) {
                rms_rows4_to_bf16(XROW(r), XROW(r + F.NGW), XROW(r + 2 * F.NGW), XROW(r + 3 * F.NGW), (const float*)A.in[9], OROW(r), OROW(r + F.NGW), OROW(r + 2 * F.NGW), OROW(r + 3 * F.NGW), lane);
                it += 3 * F.NGW;
            } else rms_row_to_bf16(XROW(r), (const float*)A.in[9], OROW(r), lane);
#undef XROW
#undef OROW
        }
    }
}
constexpr int NDC = BS * 255, NWC = BS * 32;
__device__ __forceinline__ void copy_item(const Frame& F, int ci) {
    const float* src; float* dst; const int lane = F.lane; bool half2 = true;
    if (ci < NDC) { const int b = ci / 255, ch = ci % 255; src = (const float*)F.a->in[2] + ((size_t)b * 2048 + 8) * 1024 + (size_t)ch * 8192; dst = F.out + O_DILS + (size_t)b * 2048 * 1024 + (size_t)ch * 8192; }
    else { const int c2 = ci - NDC, b = c2 >> 5, ch = c2 & 31; src = (const float*)F.a->in[5] + ((size_t)b * 512 + 8) * 512 + (size_t)ch * 8192; dst = F.out + O_WINS + (size_t)b * 512 * 512 + (size_t)ch * 8192; half2 = ch < 31; }
    f32x4 v[32];
#pragma unroll
    for (int j = 0; j < 16; ++j) v[j] = __builtin_nontemporal_load((const f32x4*)src + j * 64 + lane);
    if (half2) {
#pragma unroll
        for (int j = 16; j < 32; ++j) v[j] = __builtin_nontemporal_load((const f32x4*)src + j * 64 + lane); }
#pragma unroll
    for (int j = 0; j < 16; ++j) __builtin_nontemporal_store(v[j], (f32x4*)dst + j * 64 + lane);
    if (half2) {
#pragma unroll
        for (int j = 16; j < 32; ++j) __builtin_nontemporal_store(v[j], (f32x4*)dst + j * 64 + lane); }
}

namespace pg8 {
struct GatedOrder : StaticOrder {
    unsigned* flag; unsigned need; unsigned* bar;
    __device__ __forceinline__ void a_ready(const Unit& u) const {
        if (u.pm == MP / BM) {
            XB_SPIN(xb_ld(flag) < need, bar);
            __builtin_amdgcn_fence(__ATOMIC_ACQUIRE, "agent");
            asm volatile("s_waitcnt vmcnt(0)" ::: "memory");
        }
    }
};
__device__ __forceinline__ float row_rstd_q(const float* ssp, int row, int fq) {
    const f32x4 a = *(const f32x4*)(ssp + (size_t)row * 16 + fq * 4);
    float t = (a.x + a.y) + (a.z + a.w);
    { auto rr = __builtin_amdgcn_permlane16_swap(__float_as_uint(t), __float_as_uint(t), false, false); t = __uint_as_float(rr[0]) + __uint_as_float(rr[1]); }
    { auto rr = __builtin_amdgcn_permlane32_swap(__float_as_uint(t), __float_as_uint(t), false, false); t = __uint_as_float(rr[0]) + __uint_as_float(rr[1]); }
    return __builtin_amdgcn_rsqf(t * (1.f / D) + EPS);
}
__device__ __forceinline__ float row_rstd(const float* ssp, int row) {
    const f32x4* p = (const f32x4*)(ssp + (size_t)row * 16);
    const f32x4 a = p[0], b = p[1], c = p[2], d = p[3];
    const float s = ((a.x + a.y) + (a.z + a.w)) + ((b.x + b.y) + (b.z + b.w)) + ((c.x + c.y) + (c.z + c.w)) + ((d.x + d.y) + (d.z + d.w));
    return __builtin_amdgcn_rsqf(s * (1.f / D) + EPS);
}
__device__ __forceinline__ void unpack8(const bf16x8& v, f32x4& a, f32x4& b) {
    const u32x4 w = __builtin_bit_cast(u32x4, v);
    a = (f32x4){__uint_as_float(w.x << 16), __uint_as_float(w.x & 0xffff0000u), __uint_as_float(w.y << 16), __uint_as_float(w.y & 0xffff0000u)};
    b = (f32x4){__uint_as_float(w.z << 16), __uint_as_float(w.z & 0xffff0000u), __uint_as_float(w.w << 16), __uint_as_float(w.w & 0xffff0000u)};
}
template <bool RES_BF16, bool OUT_F32 = false>
struct EpiRes {
    static constexpr bool PERM = true, AFTER_DRAIN = false;
    const float* resF; bf16_t* Yb; float* Yf; float* ssp;
    __device__ __forceinline__ void operator()(const Acc& acc, const Unit& u, int wr, int wc, int fr, int fq) const {
        const int cb = u.pn * BM + wc * 32 + 8 * fq;
#pragma unroll
        for (int ai = 0; ai < 2; ++ai)
#pragma unroll
            for (int m = 0; m < 4; ++m) {
                const int row = u.pm * BM + ai * HALF + wr * 64 + m * 16 + fr;
                float ss = 0.f;
#pragma unroll
                for (int bj = 0; bj < 2; ++bj) {
                    const int col = cb + bj * HALF;
                    f32x4 r0, r1;
                    if (RES_BF16) unpack8(*(const bf16x8*)(Yb + (size_t)row * D + col), r0, r1);
                    else { r0 = *(const f32x4*)(resF + (size_t)row * D + col); r1 = *(const f32x4*)(resF + (size_t)row * D + col + 4); }
                    const f32x4 y0 = acc[ai][bj][m][0] + r0, y1 = acc[ai][bj][m][1] + r1;
                    if (OUT_F32) { float* yp = Yf + (size_t)row * D + col; *(f32x4*)yp = y0; *(f32x4*)(yp + 4) = y1; }
                    else *(bf16x8*)(Yb + (size_t)row * D + col) = pack8(y0, y1);
                    ss += (y0.x * y0.x + y0.y * y0.y) + (y0.z * y0.z + y0.w * y0.w) + (y1.x * y1.x + y1.y * y1.y) + (y1.z * y1.z + y1.w * y1.w);
                }
                ss += __shfl_xor(ss, 16); ss += __shfl_xor(ss, 32);
                if (fq == 0) ssp[(size_t)row * 16 + u.pn * 4 + wc] = ss;
            }
    }
};
struct EpiResNorm {
    static constexpr bool PERM = true, AFTER_DRAIN = true;
    const bf16_t* res; float* out; const float* gain; float* xslot; unsigned* cnt; unsigned* tmo;
    __device__ __forceinline__ void fused(Acc& acc, const Unit& u, int wr, int wc, int fr, int fq, PG8_LAS unsigned char* lds, int wid, int lane, int tid) const {
        PG8_LAS float* P = (PG8_LAS float*)lds;
        PG8_LAS float* S = (PG8_LAS float*)(lds + 4096);
        const int cb = u.pn * BM + wc * 32 + 8 * fq;
#pragma unroll
        for (int am = 0; am < 4; ++am) {
            const int ai = am >> 1, m0 = (am & 1) * 2;
            f32x4 r[2][2][2];
#pragma unroll
            for (int mm = 0; mm < 2; ++mm) { const bf16_t* rp = res + (size_t)(u.pm * BM + ai * HALF + wr * 64 + (m0 + mm) * 16 + fr) * D;
#pragma unroll
                for (int bj = 0; bj < 2; ++bj) unpack8(*(const bf16x8*)(rp + cb + bj * HALF), r[mm][bj][0], r[mm][bj][1]); }
#pragma unroll
            for (int mm = 0; mm < 2; ++mm) { const int m = m0 + mm; float ss = 0.f;
#pragma unroll
                for (int bj = 0; bj < 2; ++bj)
#pragma unroll
                    for (int n = 0; n < 2; ++n) { const f32x4 y = acc[ai][bj][m][n] + r[mm][bj][n]; acc[ai][bj][m][n] = y; ss += (y.x * y.x + y.y * y.y) + (y.z * y.z + y.w * y.w); }
                ss += __shfl_xor(ss, 16); ss += __shfl_xor(ss, 32);
                if (fq == 0) P[(ai * HALF + wr * 64 + m * 16 + fr) * 4 + wc] = ss; }
        }
        asm volatile("s_waitcnt lgkmcnt(0)" ::: "memory"); __builtin_amdgcn_s_barrier(); asm volatile("" ::: "memory");
        if (tid < 256) { const float t = (P[tid * 4 + 0] + P[tid * 4 + 1]) + (P[tid * 4 + 2] + P[tid * 4 + 3]);
            __hip_atomic_store((unsigned*)xslot + ((size_t)(u.pm * BM + tid) * 4 + u.pn), __float_as_uint(t), __ATOMIC_RELAXED, __HIP_MEMORY_SCOPE_AGENT); }
        asm volatile("s_waitcnt vmcnt(0)" ::: "memory");
        if (lane == 0) __hip_atomic_fetch_add(cnt + 64 * u.pm, 1u, __ATOMIC_RELAXED, __HIP_MEMORY_SCOPE_AGENT);
        if (wid == 0) {
            unsigned spins = 0;
            while ((unsigned)__builtin_amdgcn_readfirstlane(__hip_atomic_load(cnt + 64 * u.pm, __ATOMIC_RELAXED, __HIP_MEMORY_SCOPE_AGENT)) < 32u) {
                __builtin_amdgcn_s_sleep(2); if (++spins > (1u << 22)) { if (lane == 0) atomicAdd(tmo, 1u); break; } }
            __builtin_amdgcn_fence(__ATOMIC_ACQUIRE, "agent");
        }
        asm volatile("s_waitcnt vmcnt(0) lgkmcnt(0)" ::: "memory"); __builtin_amdgcn_s_barrier(); asm volatile("" ::: "memory");
        if (tid < 256) { const unsigned* sl = (const unsigned*)xslot + (size_t)(u.pm * BM + tid) * 4; float t = 0.f;
#pragma unroll
            for (int k = 0; k < 4; ++k) t += __uint_as_float(__hip_atomic_load(sl + k, __ATOMIC_RELAXED, __HIP_MEMORY_SCOPE_AGENT));
            S[tid] = __builtin_amdgcn_rsqf(t * (1.f / D) + EPS); }
        asm volatile("s_waitcnt lgkmcnt(0)" ::: "memory"); __builtin_amdgcn_s_barrier(); asm volatile("" ::: "memory");
        f32x4 g[2][2];
#pragma unroll
        for (int bj = 0; bj < 2; ++bj) { g[bj][0] = *(const f32x4*)(gain + cb + bj * HALF); g[bj][1] = *(const f32x4*)(gain + cb + bj * HALF + 4); }
#pragma unroll
        for (int ai = 0; ai < 2; ++ai)
#pragma unroll
            for (int m = 0; m < 4; ++m) { const int rl = ai * HALF + wr * 64 + m * 16 + fr; const float rs = S[rl]; float* op = out + (size_t)(u.pm * BM + rl) * D + cb;
#pragma unroll
                for (int bj = 0; bj < 2; ++bj) { *(f32x4*)(op + bj * HALF) = acc[ai][bj][m][0] * rs * g[bj][0]; *(f32x4*)(op + bj * HALF + 4) = acc[ai][bj][m][1] * rs * g[bj][1]; } }
        asm volatile("s_waitcnt lgkmcnt(0)" ::: "memory"); __builtin_amdgcn_s_barrier(); asm volatile("" ::: "memory");
    }
};
struct EpiSlab {
    static constexpr bool PERM = true, AFTER_DRAIN = false;
    float* slab;
    __device__ __forceinline__ void operator()(const Acc& acc, const Unit& u, int wr, int wc, int fr, int fq) const {
        const int cb = u.pn * BM + wc * 32 + 8 * fq;
#pragma unroll
        for (int ai = 0; ai < 2; ++ai)
#pragma unroll
            for (int m = 0; m < 4; ++m) { float* rp = slab + (size_t)(ai * HALF + wr * 64 + m * 16 + fr) * D;
#pragma unroll
                for (int bj = 0; bj < 2; ++bj) { *(f32x4*)(rp + cb + bj * HALF) = acc[ai][bj][m][0]; *(f32x4*)(rp + cb + bj * HALF + 4) = acc[ai][bj][m][1]; } }
    }
};
struct EpiUp {
    static constexpr bool PERM = true, AFTER_DRAIN = false;
    const float* ssp; bf16_t* H;
    __device__ __forceinline__ void operator()(const Acc& acc, const Unit& u, int wr, int wc, int fr, int fq) const {
        const int col = u.pn * HALF + wc * 32 + 8 * fq;
#pragma unroll
        for (int ai = 0; ai < 2; ++ai)
#pragma unroll
            for (int m = 0; m < 4; ++m) {
                const int row = u.pm * BM + ai * HALF + wr * 64 + m * 16 + fr;
                const float rs = row_rstd_q(ssp, row, fq);
                f32x4 h[2];
#pragma unroll
                for (int n = 0; n < 2; ++n) {
                    const f32x4 a = acc[ai][0][m][n] * rs, b = acc[ai][1][m][n] * rs;
#pragma unroll
                    for (int e = 0; e < 4; ++e) h[n][e] = a[e] * b[e] * __builtin_amdgcn_rcpf(1.f + __expf(-a[e]));
                }
                *(bf16x8*)(H + (size_t)row * FF + col) = pack8(h[0], h[1]);
            }
    }
};
struct EpiIn1 {
    static constexpr bool PERM = true, AFTER_DRAIN = false;
    const float* ssp; bf16_t* Q1; bf16_t* KVSEL; bf16_t* KVWIN; float* G1; float* out;
    __device__ __forceinline__ void operator()(const Acc& acc, const Unit& u, int wr, int wc, int fr, int fq) const {
        const int pn = u.pn;
#pragma unroll
        for (int ai = 0; ai < 2; ++ai)
#pragma unroll
            for (int m = 0; m < 4; ++m) {
                const int row = u.pm * BM + ai * HALF + wr * 64 + m * 16 + fr;
                const float rs = row_rstd_q(ssp, row, fq);
                const bool smp = row >= MP; const int b = smp ? (row - MP) >> 3 : row >> 12, t = smp ? (row - MP) & 7 : row & 4095;
#pragma unroll
                for (int bj = 0; bj < 2; ++bj) {
                    const int lc = bj * HALF + wc * 32 + 8 * fq;
                    const f32x4 v0 = acc[ai][bj][m][0] * rs, v1 = acc[ai][bj][m][1] * rs;
                    if (pn < 4) { *(bf16x8*)(Q1 + (size_t)row * D + pn * 256 + lc) = pack8(v0 * C_SCALE2, v1 * C_SCALE2); }
                    else if (pn < 6) { const int col = (pn - 4) * 256 + lc;
                        float* o = smp ? out + O_CMPS + (size_t)(row - MP) * 512 + col : out + O_CMPP + (size_t)row * 512 + col;
                        *(f32x4*)o = v0; *(f32x4*)(o + 4) = v1; }
                    else if (pn < 8) { const int col = (pn - 6) * 256 + lc;
                        float* o = smp ? out + O_SELS + (size_t)(row - MP) * 512 + col : out + O_SELP + (size_t)row * 512 + col;
                        *(f32x4*)o = v0; *(f32x4*)(o + 4) = v1;
                        if (!smp) *(bf16x8*)(KVSEL + (size_t)row * 512 + col) = pack8(v0, v1); }
                    else if (pn < 10) { const int col = (pn - 8) * 256 + lc;
                        if (!smp) *(bf16x8*)(KVWIN + (size_t)row * 512 + col) = pack8(v0, v1);
                        float* o = nullptr;
                        if (smp) o = out + O_WINS + (size_t)(b * 512 + 504 + t) * 512 + col;
                        else if (t >= SEQ - WIN) o = out + O_WINP + (size_t)(b * 512 + t - (SEQ - WIN)) * 512 + col;
                        if (o) { *(f32x4*)o = v0; *(f32x4*)(o + 4) = v1; } }
                    else { if (lc < 48) { f32x4 s0, s1;
#pragma unroll
                            for (int e = 0; e < 4; ++e) { s0[e] = __builtin_amdgcn_rcpf(1.f + __expf(-v0[e])); s1[e] = __builtin_amdgcn_rcpf(1.f + __expf(-v1[e])); }
                            float* o = G1 + (size_t)row * 48 + lc; *(f32x4*)o = s0; *(f32x4*)(o + 4) = s1; } }
                }
            }
    }
};
}

template <typename T> struct Src;
template <> struct Src<bf16_t> { typedef bf16x8 raw;
    static __device__ __forceinline__ raw ld(const bf16_t* p) { return *(const bf16x8*)p; }
    static __device__ __forceinline__ bf16x8 cv(const raw& r) { return r; } };
template <> struct Src<float> { struct raw { f32x4 a, b; };
    static __device__ __forceinline__ raw ld(const float* p) { raw r; r.a = *(const f32x4*)p; r.b = *(const f32x4*)(p + 4); return r; }
    static __device__ __forceinline__ bf16x8 cv(const raw& r) { return pack8(r.a, r.b); } };

constexpr int VT_MT = 2112;
constexpr float NEG_INF = -__builtin_inff();
struct AttnAcc { f32x16 o0, o1; float m, l; };
__device__ __forceinline__ void acc_init(AttnAcc& A) {
#pragma unroll
    for (int r = 0; r < 16; ++r) { A.o0[r] = 0.f; A.o1[r] = 0.f; }
    A.m = NEG_INF; A.l = 0.f;
}
__device__ __forceinline__ float swap32_max(float v) { auto rr = __builtin_amdgcn_permlane32_swap(__float_as_uint(v), __float_as_uint(v), false, false); return fmaxf(__uint_as_float(rr[0]), __uint_as_float(rr[1])); }
__device__ __forceinline__ float swap32_sum(float v) { auto rr = __builtin_amdgcn_permlane32_swap(__float_as_uint(v), __float_as_uint(v), false, false); return __uint_as_float(rr[0]) + __uint_as_float(rr[1]); }
__device__ __forceinline__ int crow(int r, int hi) { return (r & 3) + 8 * (r >> 2) + 4 * hi; }
typedef short v4i16_t __attribute__((ext_vector_type(4)));
__device__ __forceinline__ s16x4 vtr(const LAS unsigned char* p) { return __builtin_bit_cast(s16x4, __builtin_amdgcn_ds_read_tr16_b64_v4i16((LAS v4i16_t*)p)); }

struct VFrag { s16x4 lo[4], hh[4]; };
__device__ __forceinline__ void vt_read(VFrag& f, const LAS unsigned char* vb) {
#pragma unroll
    for (int mt = 0; mt < 2; ++mt)
#pragma unroll
        for (int ks = 0; ks < 2; ++ks) { f.lo[mt * 2 + ks] = vtr(vb + mt * VT_MT + ks * 1024); f.hh[mt * 2 + ks] = vtr(vb + mt * VT_MT + ks * 1024 + 512); }
}
__device__ __forceinline__ void pv_tile(f32x16& o0, f32x16& o1, const VFrag& f, bf16x8 pf0, bf16x8 pf1) {
#define VFR(i) (bf16x8){f.lo[i][0], f.lo[i][1], f.lo[i][2], f.lo[i][3], f.hh[i][0], f.hh[i][1], f.hh[i][2], f.hh[i][3]}
    __builtin_amdgcn_s_setprio(1);
    o0 = __builtin_amdgcn_mfma_f32_32x32x16_bf16(VFR(0), pf0, o0, 0, 0, 0);
    o0 = __builtin_amdgcn_mfma_f32_32x32x16_bf16(VFR(1), pf1, o0, 0, 0, 0);
    o1 = __builtin_amdgcn_mfma_f32_32x32x16_bf16(VFR(2), pf0, o1, 0, 0, 0);
    o1 = __builtin_amdgcn_mfma_f32_32x32x16_bf16(VFR(3), pf1, o1, 0, 0, 0);
    __builtin_amdgcn_s_setprio(0);
#undef VFR
}
__device__ __forceinline__ bf16x8 pack_p(const f32x16& p, int base) {
    u32x4 w; w.x = cvtpk(p[base + 0], p[base + 1]); w.y = cvtpk(p[base + 2], p[base + 3]); w.z = cvtpk(p[base + 4], p[base + 5]); w.w = cvtpk(p[base + 6], p[base + 7]);
    return __builtin_bit_cast(bf16x8, w);
}

constexpr float RESC_THR = 6.f;
constexpr int KT_OFF = 4352;
struct NoHook { __device__ __forceinline__ void operator()(int, const f32x16&) const {} };
template <typename T, int MODE, int VOFF, int PFD = 1, class RP, class MK, class HK = NoHook>
__device__ __forceinline__ void attn_run(AttnAcc& A, const bf16x8 (&qf)[4], int t_begin, int t_end, LAS unsigned char* vt, int lane, RP rp, MK mk, HK hk = HK()) {
    if (t_begin >= t_end) return;
    const int r32 = lane & 31, hi = lane >> 5, vkey = lane >> 3, vch = lane & 7;
    LAS unsigned char* vdst = vt + (vch >> 2) * VT_MT + vkey * 64 + (vch & 3) * 16;
    const LAS unsigned char* vb = vt + ((lane >> 4) & 1) * 32 + (lane & 3) * 8 + (4 * hi + ((lane & 15) >> 2)) * 64;
    LAS unsigned char* kt = vt + KT_OFF;
    const int kswz_w = (vkey >> 1) & 3;
    const LAS unsigned char* krd = kt + r32 * 128; const int kswz_r = (r32 >> 1) & 7;
    typedef typename Src<T>::raw raw_t;
    auto loads = [&](raw_t (&kr)[4], raw_t (&vr)[4], int tt) {
#pragma unroll
        for (int i = 0; i < 4; ++i) { const T* p_ = rp(tt, vkey + 8 * i) + 8 * vch; kr[i] = Src<T>::ld(p_); if (MODE != 1) vr[i] = Src<T>::ld(p_ + VOFF); } };
    auto tile = [&](int t, raw_t (&kr)[4], raw_t (&vr)[4], int tnext) {
        asm volatile("" ::: "memory");
#pragma unroll
        for (int i = 0; i < 4; ++i) {
            *(LAS bf16x8*)(kt + (vkey + 8 * i) * 128 + ((vch ^ (kswz_w | ((i & 1) << 2))) * 16)) = Src<T>::cv(kr[i]);
            if (MODE != 1) *(LAS bf16x8*)(vdst + i * 512) = Src<T>::cv(vr[i]);
        }
        if (tnext >= t_begin) loads(kr, vr, tnext);
        asm volatile("s_waitcnt lgkmcnt(0)" ::: "memory");
        bf16x8 kf[4];
#pragma unroll
        for (int d0 = 0; d0 < 4; ++d0) kf[d0] = *(const LAS bf16x8*)(krd + (((2 * d0 + hi) ^ kswz_r) * 16));
        VFrag vf;
        if (MODE != 1) { vt_read(vf, vb); __builtin_amdgcn_sched_barrier(0); }
        f32x16 s;
#pragma unroll
        for (int r = 0; r < 16; ++r) s[r] = 0.f;
        __builtin_amdgcn_s_setprio(1);
#pragma unroll
        for (int d0 = 0; d0 < 4; ++d0) s = __builtin_amdgcn_mfma_f32_32x32x16_bf16(kf[d0], qf[d0], s, 0, 0, 0);
        __builtin_amdgcn_s_setprio(0);
        if (MODE == 2) {
            mk(t, s, -A.m);
#pragma unroll
            for (int r = 0; r < 16; ++r) s[r] = __builtin_amdgcn_exp2f(s[r]) * A.l;
            hk(t, s);
        } else {
            const bool first = A.m == NEG_INF;
            mk(t, s, first ? 0.f : -A.m);
            float tm = fmaxf(fmaxf(s[0], s[1]), fmaxf(s[2], s[3]));
#pragma unroll
            for (int r = 4; r < 16; r += 4) tm = fmaxf(tm, fmaxf(fmaxf(s[r], s[r + 1]), fmaxf(s[r + 2], s[r + 3])));
            tm = swap32_max(tm);
            if (__any(first ? tm > NEG_INF : tm > RESC_THR)) {
                const float up = first ? tm : fmaxf(tm, 0.f);
                const float alpha = first ? 0.f : __builtin_amdgcn_exp2f(-up);
                A.l *= alpha; A.m = first ? up : A.m + up;
                const float sh = (up == NEG_INF) ? 0.f : up;
#pragma unroll
                for (int r = 0; r < 16; ++r) s[r] -= sh;
                if (MODE == 0) {
#pragma unroll
                    for (int r = 0; r < 16; ++r) { A.o0[r] *= alpha; A.o1[r] *= alpha; } }
            }
            float ps = 0.f;
#pragma unroll
            for (int r = 0; r < 16; ++r) { s[r] = __builtin_amdgcn_exp2f(s[r]); ps += s[r]; }
            A.l += swap32_sum(ps);
        }
        if (MODE != 1) {
            const bf16x8 pf0 = pack_p(s, 0), pf1 = pack_p(s, 8);
            pv_tile(A.o0, A.o1, vf, pf0, pf1);
        }
        asm volatile("" ::: "memory");
    };
    raw_t krA[4], vrA[4];
    int t = t_end - 1;
    loads(krA, vrA, t);
    if (PFD == 2) {
        raw_t krB[4], vrB[4];
        if (t - 1 >= t_begin) loads(krB, vrB, t - 1);
        while (t >= t_begin) {
            tile(t, krA, vrA, t - 2);
            if (t - 1 < t_begin) break;
            tile(t - 1, krB, vrB, t - 3);
            t -= 2;
        }
    } else {
        for (; t >= t_begin; --t) tile(t, krA, vrA, t - 1);
    }
}
template <int KS, int CHECK>
__device__ __forceinline__ void bias_mask(f32x16& s, float dq, float nslope2, float lo, float hi_, int hi, float base = 0.f) {
    const float dq2 = dq - (float)(KS * 4 * hi);
#pragma unroll
    for (int r = 0; r < 16; ++r) {
        const float d = dq2 - (float)(KS * ((r & 3) + 8 * (r >> 2)));
        float x = __builtin_fmaf(d, nslope2, s[r] + base);
        asm volatile("" : "+v"(x));
        if (CHECK == 1) { const bool ok = (d >= lo) & (d <= hi_); s[r] = ok ? x : NEG_INF; } else if (CHECK == 2) { s[r] = d >= lo ? x : NEG_INF; } else s[r] = x;
    }
}

__device__ __forceinline__ void store_o(bf16_t* orow, const f32x16& o0, const f32x16& o1, float sc, int hi) {
#pragma unroll
    for (int i = 0; i < 4; ++i) {
        u32x2 w; w.x = cvtpk(o0[4 * i] * sc, o0[4 * i + 1] * sc); w.y = cvtpk(o0[4 * i + 2] * sc, o0[4 * i + 3] * sc); *(u32x2*)(orow + 8 * i + 4 * hi) = w;
        u32x2 x; x.x = cvtpk(o1[4 * i] * sc, o1[4 * i + 1] * sc); x.y = cvtpk(o1[4 * i + 2] * sc, o1[4 * i + 3] * sc); *(u32x2*)(orow + 32 + 8 * i + 4 * hi) = x;
    }
}

__device__ __forceinline__ void dil_item_prompt(const Frame& F, int item) {
    const int lane = F.lane, r32 = lane & 31, hi = lane >> 5;
    const int j = item & 7, blk = (item >> 3) & 15, h = (item >> 7) & 7, b = item >> 10;
    const int q0 = blk * 256 + j, q = q0 + 8 * r32;
    const bf16_t* QD = (const bf16_t*)(F.ws + WS_QD); const bf16_t* KVD = (const bf16_t*)(F.ws + WS_KVD);
    const size_t rb = (size_t)b * SEQ;
    bf16x8 qf[4];
#pragma unroll
    for (int d0 = 0; d0 < 4; ++d0) qf[d0] = *(const bf16x8*)(QD + (rb + q) * 512 + h * 64 + 16 * d0 + 8 * hi);
    const float nslope2 = -__builtin_amdgcn_exp2f(-(float)(h + 1)) * LOG2E; const bool par = (r32 & 1) != 0;
    const bf16_t* Kb = KVD + rb * 1024 + h * 64;
    AttnAcc A; acc_init(A);
    LAS unsigned char* vt = F.wscr;
#define DIL_BRANCH(ST, K0, NT, WINDOW, PAR) do { \
        const int need_ = -(K0) - 31 - q0 / (ST); const int tb_ = need_ <= 0 ? 0 : (need_ + 31) >> 5; \
        auto rp = [&](int t, int key) -> const bf16_t* { int pos = q0 + (ST) * ((K0) + 32 * t + key); pos = pos < 0 ? 0 : (pos > SEQ - 1 ? SEQ - 1 : pos); return Kb + (size_t)pos * 1024; }; \
        auto mk = [&](int t, f32x16& s, float sh) { \
            const int tb = q0 + (ST) * ((K0) + 32 * t);                      \
            const float dq = (float)(q - tb); const float lim = fminf((float)(WINDOW), (float)q); \
            bias_mask<(ST), true>(s, dq, nslope2, 0.f, lim, hi, sh); \
            if (PAR) { _Pragma("unroll") for (int r = 0; r < 16; ++r) { const bool keep = (r & 1) ? par : !par; s[r] = keep ? s[r] : NEG_INF; } } }; \
        attn_run<bf16_t, 0, 512, 2>(A, qf, tb_, (NT), vt, lane, rp, mk); } while (0)
    DIL_BRANCH(1, -128, 12, 128, false);
    DIL_BRANCH(4, -128, 6, 512, false);
    DIL_BRANCH(8, -256, 9, 2048, true);
#undef DIL_BRANCH
    const float inv = 1.f / fmaxf(A.l, 1e-30f);
    store_o((bf16_t*)(F.ws + WS_O) + (rb + q) * D + h * 64, A.o0, A.o1, inv, hi);
}
__device__ __forceinline__ void dil_item_sample(const Frame& F, int item) {
    const int lane = F.lane, hi = lane >> 5, qi = lane & 7;
    const int h = item & 7, b = item >> 3;
    const size_t row = (size_t)MP + b * 8 + qi;
    const bf16_t* QD = (const bf16_t*)(F.ws + WS_QD);
    bf16x8 qf[4];
#pragma unroll
    for (int d0 = 0; d0 < 4; ++d0) qf[d0] = *(const bf16x8*)(QD + row * 512 + h * 64 + 16 * d0 + 8 * hi);
    const float slope2 = __builtin_amdgcn_exp2f(-(float)(h + 1)) * LOG2E;
    const float* cache = (const float*)F.a->in[2] + (size_t)b * 2048 * 1024 + h * 64;
    const float* newr = F.out + O_DILS + (size_t)b * 2048 * 1024 + h * 64;
    AttnAcc A; acc_init(A);
    LAS unsigned char* vt = F.wscr;
    auto geom = [&](int t, int& sh, int& pos0, int& tt, int& cls) { if (t < 5) { sh = 0; cls = 0; tt = t; pos0 = 1920; } else if (t < 25) { sh = 2; cls = (t - 5) / 5; tt = (t - 5) - 5 * cls; pos0 = 1536 + cls; } else { sh = 4; cls = (t - 25) / 5; tt = (t - 25) - 5 * cls; pos0 = cls; } };
    auto rowp = [&](int t, int key) -> const float* { int sh, pos0, tt, cls; geom(t, sh, pos0, tt, cls); int c = pos0 + ((32 * tt + key) << sh); c = c > 2055 ? 2055 : c; return c < 2048 ? cache + (size_t)c * 1024 : newr + (size_t)(c - 8) * 1024; };
    auto mk = [&](int t, f32x16& s, float shf) {
        int sh, pos0, tt, cls; geom(t, sh, pos0, tt, cls);
        const bool ok2 = sh == 0 ? true : (sh == 2 ? (qi & 3) == cls : qi == cls);
        const float dq = (float)(((2048 + qi - pos0) >> sh) - 32 * tt);
        bias_mask<1, true>(s, dq, -slope2 * (float)(1 << sh), 0.f, 128.f, hi, ok2 ? shf : NEG_INF); };
    attn_run<float, 0, 512>(A, qf, 0, 65, vt, lane, rowp, mk);
    const float inv = 1.f / fmaxf(A.l, 1e-30f);
    if ((lane & 31) < 8) store_o((bf16_t*)(F.ws + WS_O) + row * D + h * 64, A.o0, A.o1, inv, hi);
}

template <bool SAMPLE>
__device__ __forceinline__ void rglru_gates_item(const Frame& F, int item) {
    const int lane = F.lane, r32 = lane & 31, hi = lane >> 5;
    const int n = item & 7, tile = item >> 3;
    const int b = SAMPLE ? tile : tile >> 7, t = SAMPLE ? (r32 < 8 ? r32 : 7) : ((tile & 127) * 32 + r32);
    const size_t rowbase = SAMPLE ? (size_t)MP + b * 8 : (size_t)b * SEQ;
    const float* XR = (const float*)(F.ws + WS_XR);
    const float* cw = (const float*)F.a->in[14]; const float* cbias = (const float*)F.a->in[15];
    const float* sconv = (const float*)F.a->in[3] + (size_t)b * 3 * 512;
    const int ch0 = 64 * n + 4 * hi;
    f32x4 xc[8];
#pragma unroll
    for (int a = 0; a < 8; ++a) {
        const int ch = ch0 + 8 * a;
        f32x4 acc = *(const f32x4*)(cbias + ch);
#pragma unroll
        for (int k = 0; k < 4; ++k) {
            const int tau = t + k - 3;
            const float* xp = XR + (rowbase + (tau >= 0 ? tau : 0)) * 512 + ch;
            if (SAMPLE) xp = tau >= 0 ? xp : sconv + (3 + tau) * 512 + ch;
            f32x4 x = *(const f32x4*)xp;
            const float keep = (SAMPLE || tau >= 0) ? 1.f : 0.f;
            acc += x * (*(const f32x4*)(cw + k * 512 + ch) * keep);
        }
        xc[a] = acc;
        if (a & 1) __builtin_amdgcn_sched_barrier(0);
    }
    bf16x8 xb[4];
#pragma unroll
    for (int d0 = 0; d0 < 4; ++d0) xb[d0] = pack8(xc[2 * d0], xc[2 * d0 + 1]);
    const bf16_t* WG = (const bf16_t*)(F.ws + WS_WG);
    const float* ba = (const float*)F.a->in[17]; const float* bx = (const float*)F.a->in[19]; const float* c8 = (const float*)(F.ws + WS_C8);
    float* AU = (float*)(F.ws + WS_AU) + (rowbase + t) * 1024;
    const bool valid = !SAMPLE || r32 < 8;
#pragma unroll
    for (int mt = 0; mt < 2; ++mt) {
        f32x16 ga, gx;
#pragma unroll
        for (int r = 0; r < 16; ++r) { ga[r] = 0.f; gx[r] = 0.f; }
        f32x4 vba[4], vbx[4], vc8[4];
#pragma unroll
        for (int a4 = 0; a4 < 4; ++a4) { const int ch = ch0 + 8 * (4 * mt + a4); vba[a4] = *(const f32x4*)(ba + ch); vbx[a4] = *(const f32x4*)(bx + ch); vc8[a4] = *(const f32x4*)(c8 + ch); }
#pragma unroll
        for (int d0 = 0; d0 < 4; ++d0) {
            const bf16x8 wa = *(const bf16x8*)(WG + ((size_t)(0 * 8 + n) * 64 + r32 + 32 * mt) * 64 + 16 * d0 + 8 * hi);
            const bf16x8 wx = *(const bf16x8*)(WG + ((size_t)(1 * 8 + n) * 64 + r32 + 32 * mt) * 64 + 16 * d0 + 8 * hi);
            ga = __builtin_amdgcn_mfma_f32_32x32x16_bf16(wa, xb[d0], ga, 0, 0, 0);
            gx = __builtin_amdgcn_mfma_f32_32x32x16_bf16(wx, xb[d0], gx, 0, 0, 0);
        }
        f32x4 av[4], uv[4];
#pragma unroll
        for (int a4 = 0; a4 < 4; ++a4) {
            const int a = 4 * mt + a4, ch = ch0 + 8 * a, rb = a4 * 4;
#pragma unroll
            for (int e = 0; e < 4; ++e) {
                const float rg = __builtin_amdgcn_rcpf(1.f + __expf(-(ga[rb + e] + vba[a4][e])));
                const float ig = __builtin_amdgcn_rcpf(1.f + __expf(-(gx[rb + e] + vbx[a4][e])));
                const float la = -rg * vc8[a4][e];
                av[a4][e] = __expf(la);
                uv[a4][e] = __builtin_amdgcn_sqrtf(fmaxf(1.f - av[a4][e] * av[a4][e], 0.f)) * ig * xc[a][e];
            }
            if (valid) { *(f32x4*)(AU + ch) = av[a4]; *(f32x4*)(AU + 512 + ch) = uv[a4]; }
        }
        if (!SAMPLE) {
#pragma unroll
            for (int sft = 1; sft < 32; sft <<= 1) {
                const bool upper = (r32 & sft) != 0;
#pragma unroll
                for (int a4 = 0; a4 < 4; ++a4)
#pragma unroll
                    for (int e = 0; e < 4; ++e) {
                        const float pa = __shfl_xor(av[a4][e], sft), pu = __shfl_xor(uv[a4][e], sft);
                        const float nu = upper ? av[a4][e] * pu + uv[a4][e] : pa * uv[a4][e] + pu;
                        av[a4][e] = av[a4][e] * pa; uv[a4][e] = nu;
                    }
            }
            if (r32 == 0) { float* ag = (float*)(F.ws + WS_AGG) + (size_t)tile * 1024;
#pragma unroll
                for (int a4 = 0; a4 < 4; ++a4) { const int ch = ch0 + 8 * (4 * mt + a4); *(f32x4*)(ag + ch) = av[a4]; *(f32x4*)(ag + 512 + ch) = uv[a4]; } }
        }
        __builtin_amdgcn_sched_barrier(0);
    }
}
__device__ __forceinline__ float gelu_tanh(float x) { const float z = 0.7978845608028654f * (x + 0.044715f * x * x * x); const float e = __expf(2.f * z); return 0.5f * x * (2.f - 2.f * __builtin_amdgcn_rcpf(e + 1.f)); }
template <bool SAMPLE>
__device__ __forceinline__ void rglru_scan_item(const Frame& F, int item) {
    const int lane = F.lane, n = item & 7, tile = item >> 3;
    const int b = SAMPLE ? tile : tile >> 6, tt = SAMPLE ? 0 : 2 * (tile & 63);
    const int ch = 64 * n + lane;
    constexpr int NT = SAMPLE ? 8 : 32;
    const size_t row0 = SAMPLE ? (size_t)MP + b * 8 : (size_t)b * SEQ + tt * 32;
    const float* AU = (const float*)(F.ws + WS_AU) + row0 * 1024 + ch; const bf16_t* GT = (const bf16_t*)(F.ws + WS_GT) + row0 * 512 + ch;
    bf16_t* O = (bf16_t*)(F.ws + WS_O) + row0 * D + 512 + ch;
    float av[NT], uv[NT], gv[NT];
#pragma unroll
    for (int i = 0; i < NT; ++i) { av[i] = AU[(size_t)i * 1024]; uv[i] = AU[(size_t)i * 1024 + 512]; gv[i] = bf2f(GT[(size_t)i * 512]); }
    float h;
    if (SAMPLE) h = ((const float*)F.a->in[4])[b * 512 + ch];
    else { h = 0.f; const float* ag = (const float*)(F.ws + WS_AGG) + (size_t)(b * 128) * 1024 + ch;
        int c = 0;
        for (; c + 32 <= tt; c += 32) { float pa[32], ph[32];
#pragma unroll
            for (int k = 0; k < 32; ++k) { pa[k] = ag[(size_t)(c + k) * 1024]; ph[k] = ag[(size_t)(c + k) * 1024 + 512]; }
#pragma unroll
            for (int k = 0; k < 32; ++k) h = pa[k] * h + ph[k]; }
        if (c < tt) { float pa[32], ph[32];
#pragma unroll
            for (int k = 0; k < 32; ++k) { const int cc = c + k < tt ? c + k : 0; pa[k] = ag[(size_t)cc * 1024]; ph[k] = ag[(size_t)cc * 1024 + 512]; }
#pragma unroll
            for (int k = 0; k < 32; ++k) { const bool on = c + k < tt; h = on ? pa[k] * h + ph[k] : h; } }
    }
    float y[NT];
#pragma unroll
    for (int i = 0; i < NT; ++i) { h = av[i] * h + uv[i]; y[i] = h * gelu_tanh(gv[i]); }
    if (!SAMPLE) {
        const float* AU2 = AU + (size_t)32 * 1024; const bf16_t* GT2 = GT + (size_t)32 * 512;
#pragma unroll
        for (int i = 0; i < NT; ++i) { av[i] = AU2[(size_t)i * 1024]; uv[i] = AU2[(size_t)i * 1024 + 512]; gv[i] = bf2f(GT2[(size_t)i * 512]); }
#pragma unroll
        for (int i = 0; i < NT; ++i) O[(size_t)i * D] = (bf16_t)(cvtpk(y[i], 0.f) & 0xffffu);
#pragma unroll
        for (int i = 0; i < NT; ++i) { h = av[i] * h + uv[i]; y[i] = h * gelu_tanh(gv[i]); }
        O += (size_t)32 * D;
    }
#pragma unroll
    for (int i = 0; i < NT; ++i) O[(size_t)i * D] = (bf16_t)(cvtpk(y[i], 0.f) & 0xffffu);
    if (SAMPLE) F.out[O_RNNS + b * 512 + ch] = h;
    else if (tt == 126) F.out[O_RNNP + b * 512 + ch] = h;
}

template <bool SAMPLE, bool SPLIT = false>
__device__ __forceinline__ void compress_item(const Frame& F, int item) {
    const int lane = F.lane, r32 = lane & 31, hi = lane >> 5;
    constexpr int NTL = SAMPLE ? 64 : 32, NC = SAMPLE ? NCS : NCP;
    const int c = item & 1, nt = (item >> 1) % NTL, b = (item >> 1) / NTL;
    const int lg = lane >> 4, lch = lane & 15;
    const int* pt = (const int*)F.a->in[8] + b * NPG;
    const float* rbase[9];
#pragma unroll
    for (int j = 0; j < 9; ++j) { int ch = nt * 8 + j; ch = ch < NC ? ch : NC;
        if (SAMPLE) { const int pg = pt[ch >> 3]; rbase[j] = (const float*)F.a->in[6] + ((size_t)pg * PAGE + (ch & 7) * 16) * 512 + c * 256 + lane * 4; }
        else rbase[j] = F.out + O_CMPP + ((size_t)b * SEQ + ch * 16) * 512 + c * 256 + lane * 4; }
    const bf16_t* WF = (const bf16_t*)(F.ws + WS_WCT) + (size_t)c * 32 * 4 * 2 * 512 + lane * 8;
    LAS unsigned char* xt = F.wscr;
    f32x4 xr[9];
#define CMP_LOAD(X, l_) do { _Pragma("unroll") for (int j = 0; j < 9; ++j) X[j] = SAMPLE ? __builtin_nontemporal_load((const f32x4*)(rbase[j] + (size_t)(l_) * 512)) : *(const f32x4*)(rbase[j] + (size_t)(l_) * 512); } while (0)
#define CMP_STEP(X, l_, NEXT_OK, lnext_) do { \
        LAS unsigned char* img = xt + ((l_) & 1) * 4608; \
        bf16x8 wf[4][4];                                    \
        _Pragma("unroll") for (int k4 = 0; k4 < 4; ++k4) { \
            wf[k4][0] = *(const bf16x8*)(WF + (size_t)(((l_) * 4 + k4) * 2 + 0) * 512); wf[k4][1] = *(const bf16x8*)(WF + (size_t)(((l_) * 4 + k4) * 2 + 1) * 512); \
            wf[k4][2] = *(const bf16x8*)(WF + (size_t)((((l_) + 16) * 4 + k4) * 2 + 0) * 512); wf[k4][3] = *(const bf16x8*)(WF + (size_t)((((l_) + 16) * 4 + k4) * 2 + 1) * 512); } \
        _Pragma("unroll") for (int j = 0; j < 9; ++j) { const int q = 4 * j + lg; u32x2 w; w.x = cvtpk(X[j][0], X[j][1]); w.y = cvtpk(X[j][2], X[j][3]); \
            *(LAS u32x2*)(img + q * 128 + (((lch >> 1) ^ ((q >> 1) & 7)) * 16) + (lch & 1) * 8) = w; } \
        if (NEXT_OK) CMP_LOAD(X, lnext_); \
        asm volatile("s_waitcnt lgkmcnt(0)" ::: "memory"); \
        _Pragma("unroll") for (int k4 = 0; k4 < 4; ++k4) { \
            const bf16x8 x0 = *(const LAS bf16x8*)(img + r32 * 128 + (((2 * k4 + hi) ^ ((r32 >> 1) & 7)) * 16)); \
            const bf16x8 x1 = *(const LAS bf16x8*)(img + (r32 + 4) * 128 + (((2 * k4 + hi) ^ (((r32 + 4) >> 1) & 7)) * 16)); \
            const bf16x8 w0 = wf[k4][0], w1 = wf[k4][1], w2 = wf[k4][2], w3 = wf[k4][3]; \
            a0 = __builtin_amdgcn_mfma_f32_32x32x16_bf16(w0, x0, a0, 0, 0, 0); \
            a1 = __builtin_amdgcn_mfma_f32_32x32x16_bf16(w1, x0, a1, 0, 0, 0); \
            a0 = __builtin_amdgcn_mfma_f32_32x32x16_bf16(w2, x1, a0, 0, 0, 0); \
            a1 = __builtin_amdgcn_mfma_f32_32x32x16_bf16(w3, x1, a1, 0, 0, 0); } \
        asm volatile("" ::: "memory"); } while (0)
    f32x16 a0, a1;
#pragma unroll
    for (int r = 0; r < 16; ++r) { a0[r] = 0.f; a1[r] = 0.f; }
    const int l0 = SPLIT ? 2 * F.wave : 0, l1 = SPLIT ? l0 + 2 : 16;
    CMP_LOAD(xr, l0);
    for (int l = l0; l < l1; ++l) CMP_STEP(xr, l, l + 1 < l1, l + 1);
#undef CMP_STEP
#undef CMP_LOAD
    if (SPLIT) {
        constexpr int PART = 9216;
        LAS f32x4* mine = (LAS f32x4*)(F.wscr + PART);
#pragma unroll
        for (int i = 0; i < 4; ++i) { mine[i * 64 + lane] = (f32x4){a0[4 * i], a0[4 * i + 1], a0[4 * i + 2], a0[4 * i + 3]}; mine[(4 + i) * 64 + lane] = (f32x4){a1[4 * i], a1[4 * i + 1], a1[4 * i + 2], a1[4 * i + 3]}; }
        __syncthreads();
        {
            const int me = F.wave;
            for (int w = 0; w < NWAVES; ++w) { if (w == me) continue; const LAS f32x4* p = (const LAS f32x4*)(F.lds + w * WSCR + PART);
#pragma unroll
                for (int i = 0; i < 4; ++i) { const f32x4 u = p[i * 64 + lane], v = p[(4 + i) * 64 + lane];
                    a0[4 * i] += u.x; a0[4 * i + 1] += u.y; a0[4 * i + 2] += u.z; a0[4 * i + 3] += u.w; a1[4 * i] += v.x; a1[4 * i + 1] += v.y; a1[4 * i + 2] += v.z; a1[4 * i + 3] += v.w; } }
        }
        __syncthreads();
    }
    const int n = nt * 8 + (r32 >> 2), g = r32 & 3;
    if (n < NC && (!SPLIT || F.wave == 0)) {
        const float* pe = (const float*)(F.ws + WS_PET) + c * 64;
        bf16_t* o = SAMPLE ? (bf16_t*)(F.ws + WS_KCS) + ((size_t)(b * 512 + n) * 2 + c) * 256 + g * 64 : (bf16_t*)(F.ws + WS_KCP) + ((size_t)(b * 256 + n) * 2 + c) * 256 + g * 64;
#pragma unroll
        for (int i = 0; i < 4; ++i) {
            const int e0 = 8 * i + 4 * hi; const f32x4 p0 = *(const f32x4*)(pe + e0), p1 = *(const f32x4*)(pe + 32 + e0);
            u32x2 w; w.x = cvtpk(a0[4 * i] + p0.x, a0[4 * i + 1] + p0.y); w.y = cvtpk(a0[4 * i + 2] + p0.z, a0[4 * i + 3] + p0.w); *(u32x2*)(o + e0) = w;
            u32x2 x; x.x = cvtpk(a1[4 * i] + p1.x, a1[4 * i + 1] + p1.y); x.y = cvtpk(a1[4 * i + 2] + p1.z, a1[4 * i + 3] + p1.w); *(u32x2*)(o + 32 + e0) = x;
        }
    }
}

constexpr int WS_IMP = 8448, WS_SELM = WS_IMP + 8 * 132 * 4, WS_BLIST = WS_SELM + 8 * 4 * 8, WS_OT = 13568, WS_PT = WS_OT + 4096;
static_assert(KT_OFF + 4096 <= WS_IMP && WS_BLIST + 132 * 4 <= WS_OT && WS_PT + 256 <= WSCR, "per-wave scratch map");
template <bool SAMPLE>
__device__ __forceinline__ void nsa_item(const Frame& F, int item) {
    typedef typename std::conditional<SAMPLE, float, bf16_t>::type KT;
    const int lane = F.lane, r32 = lane & 31, hi = lane >> 5, qi = r32 >> 2, r = r32 & 3;
    const int g = item & 3, qt = SAMPLE ? 0 : (item >> 2) & 511, b = SAMPLE ? item >> 2 : item >> 11;
    const int t0 = 8 * qt, qp = SAMPLE ? PAST + qi : t0 + qi, qp_max = SAMPLE ? PAST + 7 : t0 + 7;
    const size_t row = SAMPLE ? (size_t)MP + b * 8 + qi : (size_t)b * SEQ + t0 + qi;
    const int head = 4 * g + r;
    const float nslope2 = -__builtin_amdgcn_exp2f(-0.5f * (float)(head + 1)) * LOG2E;
    const bf16_t* Q1 = (const bf16_t*)(F.ws + WS_Q1);
    bf16x8 qf[4];
#pragma unroll
    for (int d0 = 0; d0 < 4; ++d0) qf[d0] = *(const bf16x8*)(Q1 + row * D + head * 64 + 16 * d0 + 8 * hi);
    const float* gp = (const float*)(F.ws + WS_G1) + row * 48 + head * 3;
    const float g_cmp = gp[0], g_sel = gp[1], g_win = gp[2];
    LAS unsigned char* vt = F.wscr;
    LAS float* imp = (LAS float*)(F.wscr + WS_IMP);
    LAS unsigned long long* selm = (LAS unsigned long long*)(F.wscr + WS_SELM);
    LAS int* blist = (LAS int*)(F.wscr + WS_BLIST);
    constexpr int NC = SAMPLE ? NCS : NCP, NCH = SAMPLE ? 3 : 1;
    LAS u32x2* otl = (LAS u32x2*)(F.wscr + WS_OT) + lane;
    for (int i = lane; i < 8 * 132; i += 64) imp[i] = 0.f;

    const bf16_t* KC = SAMPLE ? (const bf16_t*)(F.ws + WS_KCS) + (size_t)b * 512 * 512 + g * 64 : (const bf16_t*)(F.ws + WS_KCP) + (size_t)b * 256 * 512 + g * 64;
    const int ncv = qp_max >= 31 ? (((qp_max - 31) >> 4) + 1 < NC ? ((qp_max - 31) >> 4) + 1 : NC) : 0;
    const int nct = (ncv + 31) >> 5;
    auto rpc = [&](int t, int key) -> const bf16_t* { int n = 32 * t + key; n = n < NC ? n : NC - 1; return KC + (size_t)n * 512; };
    auto mkc = [&](int t, f32x16& s, float sh) { bias_mask<16, 2>(s, (float)(qp - 31 - 512 * t), nslope2, 0.f, 1e30f, hi, sh); };
    AttnAcc A; acc_init(A);
    attn_run<bf16_t, 1, 256>(A, qf, 0, nct, vt, lane, rpc, mkc);
    {
        A.m = (A.m == NEG_INF) ? 0.f : A.m; A.l = A.l > 0.f ? 1.f / A.l : 0.f;
        auto hkc = [&](int t, const f32x16& p) {
#pragma unroll
            for (int i = 0; i < 4; ++i) {
                float p3 = p[4 * i + 3]; float a = 2.f * ((p[4 * i] + p[4 * i + 1]) + p[4 * i + 2]) + p3;
                a += __shfl_xor(a, 1); a += __shfl_xor(a, 2); p3 += __shfl_xor(p3, 1); p3 += __shfl_xor(p3, 2);
                if (r == 0) { const int J = 8 * t + 2 * i + hi; __hip_atomic_fetch_add(&imp[J * 8 + qi], a, __ATOMIC_RELAXED, __HIP_MEMORY_SCOPE_WORKGROUP); __hip_atomic_fetch_add(&imp[(J + 1) * 8 + qi], p3, __ATOMIC_RELAXED, __HIP_MEMORY_SCOPE_WORKGROUP); }
            } };
        attn_run<bf16_t, 2, 256>(A, qf, 0, nct, vt, lane, rpc, mkc, hkc);
#pragma unroll
        for (int j = 0; j < 4; ++j) {
            u32x2 w; w.x = cvtpk(A.o0[4 * j] * g_cmp, A.o0[4 * j + 1] * g_cmp); w.y = cvtpk(A.o0[4 * j + 2] * g_cmp, A.o0[4 * j + 3] * g_cmp); otl[64 * j] = w;
            u32x2 x; x.x = cvtpk(A.o1[4 * j] * g_cmp, A.o1[4 * j + 1] * g_cmp); x.y = cvtpk(A.o1[4 * j + 2] * g_cmp, A.o1[4 * j + 3] * g_cmp); otl[64 * (4 + j)] = x; }
    }
    asm volatile("s_waitcnt lgkmcnt(0)" ::: "memory");
    const int cb = qp_max >> 6;
    for (int idx = lane; idx < 8 * (cb + 1); idx += 64) { const int j = idx >> 3; if (j == 0 || j >= cb - 1) imp[idx] += 1000.f; }
    asm volatile("s_waitcnt lgkmcnt(0)" ::: "memory");
    {
        f32x4 sj[NCH][2]; int rank[NCH][8];
#pragma unroll
        for (int c2 = 0; c2 < NCH; ++c2) { int j = lane + 64 * c2; j = j <= cb ? j : cb; sj[c2][0] = *(const LAS f32x4*)(imp + j * 8); sj[c2][1] = *(const LAS f32x4*)(imp + j * 8 + 4);
#pragma unroll
            for (int q = 0; q < 8; ++q) rank[c2][q] = 0; }
#pragma unroll 2
        for (int i = 0; i <= cb; ++i) {
            const f32x4 v0 = *(const LAS f32x4*)(imp + i * 8), v1 = *(const LAS f32x4*)(imp + i * 8 + 4);
#pragma unroll
            for (int c2 = 0; c2 < NCH; ++c2) { const bool lower = i < lane + 64 * c2;
#pragma unroll
                for (int q = 0; q < 8; ++q) { const float vi = q < 4 ? v0[q & 3] : v1[q & 3], vj = q < 4 ? sj[c2][0][q & 3] : sj[c2][1][q & 3];
                    rank[c2][q] += ((vi > vj) | ((vi == vj) & lower)) ? 1 : 0; } }
        }
#pragma unroll
        for (int c2 = 0; c2 < NCH; ++c2) { const bool cand = lane + 64 * c2 <= cb;
#pragma unroll
            for (int q = 0; q < 8; ++q) { const unsigned long long mask = __ballot(cand && rank[c2][q] < 16); if (lane == 0) selm[q * 4 + c2] = mask; } }
    }
    asm volatile("s_waitcnt lgkmcnt(0)" ::: "memory");
    unsigned long long mym0 = 0ull, mym1 = 0ull, mym2 = 0ull; int nblk = 0;
#pragma unroll
    for (int c2 = 0; c2 < NCH; ++c2) { const unsigned long long mine = selm[qi * 4 + c2]; unsigned long long u = 0;
        if (c2 == 0) mym0 = mine; else if (c2 == 1) mym1 = mine; else mym2 = mine;
#pragma unroll
        for (int q = 0; q < 8; ++q) u |= selm[q * 4 + c2];
        const int j = lane + 64 * c2; const bool in = (u >> lane) & 1ull;
        const int pos = nblk + __popcll(u & ((1ull << lane) - 1ull));
        if (in) blist[pos] = j;
        nblk += __popcll(u); }
    asm volatile("s_waitcnt lgkmcnt(0)" ::: "memory");
    nblk = __builtin_amdgcn_readfirstlane(nblk);
    {
        const KT* sbase; LAS int* pt = (LAS int*)(F.wscr + WS_PT);
        if constexpr (SAMPLE) { pt[lane] = ((const int*)F.a->in[8])[b * NPG + lane]; asm volatile("s_waitcnt lgkmcnt(0)" ::: "memory"); }
        if constexpr (SAMPLE) sbase = (const float*)F.a->in[7] + g * 64; else sbase = (const bf16_t*)(F.ws + WS_KVSEL) + (size_t)b * SEQ * 512 + g * 64;
        const float* snew = F.out + O_SELS + (size_t)b * 8 * 512 + g * 64;
        auto rps = [&](int t, int key) -> const KT* {
            const int J = blist[t >> 1]; const int tok = 64 * J + 32 * (t & 1) + key;
            if constexpr (SAMPLE) { const int tk = tok < PAST ? tok : PAST - 1; const int pg = pt[tk >> 7]; const KT* p0 = sbase + ((size_t)pg * PAGE + (tk & 127)) * 512;
                int i2 = tok - PAST; i2 = i2 < 0 ? 0 : (i2 > 7 ? 7 : i2); const KT* p1 = (const KT*)(snew + (size_t)i2 * 512); return tok < PAST ? p0 : p1; }
            else return sbase + (size_t)tok * 512; };
        auto mks = [&](int t, f32x16& s, float sh) {
            const int J = blist[t >> 1]; bool sel = (mym0 >> (J & 63)) & 1ull; if constexpr (SAMPLE) { const bool s1 = (mym1 >> (J & 63)) & 1ull, s2 = (mym2 >> (J & 63)) & 1ull; sel = J < 64 ? sel : (J < 128 ? s1 : s2); } const int tb = 64 * J + 32 * (t & 1);
            const float base = sel ? sh : NEG_INF, dq = (float)(qp - tb);
            if (J < cb) bias_mask<1, false>(s, dq, nslope2, 0.f, 0.f, hi, base);
            else bias_mask<1, 2>(s, dq, nslope2, 0.f, 1e30f, hi, base); };
        acc_init(A);
        attn_run<KT, 0, 256, SAMPLE ? 1 : 2>(A, qf, 0, 2 * nblk, vt, lane, rps, mks);
        const float sc = g_sel / fmaxf(A.l, 1e-30f);
#pragma unroll
        for (int j = 0; j < 4; ++j) {
            const u32x2 a = otl[64 * j], c = otl[64 * (4 + j)];
            u32x2 w; w.x = cvtpk(A.o0[4 * j] * sc + __uint_as_float(a.x << 16), A.o0[4 * j + 1] * sc + __uint_as_float(a.x & 0xffff0000u)); w.y = cvtpk(A.o0[4 * j + 2] * sc + __uint_as_float(a.y << 16), A.o0[4 * j + 3] * sc + __uint_as_float(a.y & 0xffff0000u)); otl[64 * j] = w;
            u32x2 x; x.x = cvtpk(A.o1[4 * j] * sc + __uint_as_float(c.x << 16), A.o1[4 * j + 1] * sc + __uint_as_float(c.x & 0xffff0000u)); x.y = cvtpk(A.o1[4 * j + 2] * sc + __uint_as_float(c.y << 16), A.o1[4 * j + 3] * sc + __uint_as_float(c.y & 0xffff0000u)); otl[64 * (4 + j)] = x; }
    }
    {
        acc_init(A);
        if constexpr (SAMPLE) {
            const float* wc = (const float*)F.a->in[5] + (size_t)b * 512 * 512 + g * 64; const float* wn = F.out + O_WINS + (size_t)b * 512 * 512 + g * 64;
            auto rpw = [&](int t, int key) -> const float* { int c = 32 * t + key; c = c > 519 ? 519 : c; return c < 512 ? wc + (size_t)c * 512 : wn + (size_t)(c - 8) * 512; };
            auto mkw = [&](int t, f32x16& s, float sh) { bias_mask<1, true>(s, (float)(512 + qi - 32 * t), nslope2, 0.f, (float)WIN, hi, sh); };
            attn_run<float, 0, 256>(A, qf, 0, 17, vt, lane, rpw, mkw);
        } else {
            const bf16_t* wb = (const bf16_t*)(F.ws + WS_KVWIN) + (size_t)b * SEQ * 512 + g * 64;
            const int tlo = (t0 - WIN > 0 ? t0 - WIN : 0) >> 5, thi = (t0 + 7) >> 5;
            auto rpw = [&](int t, int key) -> const bf16_t* { return wb + (size_t)(32 * t + key) * 512; };
            auto mkw = [&](int t, f32x16& s, float sh) { const float dq = (float)(qp - 32 * t);
                if (32 * t + 31 <= t0 && 32 * t >= t0 + 7 - WIN) bias_mask<1, false>(s, dq, nslope2, 0.f, 0.f, hi, sh);
                else bias_mask<1, true>(s, dq, nslope2, 0.f, (float)WIN, hi, sh); };
            attn_run<bf16_t, 0, 256, 2>(A, qf, tlo, thi + 1, vt, lane, rpw, mkw);
        }
        const float sc = g_win / fmaxf(A.l, 1e-30f);
#pragma unroll
        for (int j = 0; j < 4; ++j) { const u32x2 a = otl[64 * j], c = otl[64 * (4 + j)];
            A.o0[4 * j] = A.o0[4 * j] * sc + __uint_as_float(a.x << 16); A.o0[4 * j + 1] = A.o0[4 * j + 1] * sc + __uint_as_float(a.x & 0xffff0000u);
            A.o0[4 * j + 2] = A.o0[4 * j + 2] * sc + __uint_as_float(a.y << 16); A.o0[4 * j + 3] = A.o0[4 * j + 3] * sc + __uint_as_float(a.y & 0xffff0000u);
            A.o1[4 * j] = A.o1[4 * j] * sc + __uint_as_float(c.x << 16); A.o1[4 * j + 1] = A.o1[4 * j + 1] * sc + __uint_as_float(c.x & 0xffff0000u);
            A.o1[4 * j + 2] = A.o1[4 * j + 2] * sc + __uint_as_float(c.y << 16); A.o1[4 * j + 3] = A.o1[4 * j + 3] * sc + __uint_as_float(c.y & 0xffff0000u); }
    }
    store_o((bf16_t*)(F.ws + WS_O) + row * D + head * 64, A.o0, A.o1, 1.f, hi);
}

__device__ __forceinline__ void final_norm_row(float* y, const float* ssp, const float* g, int row, int lane) {
    const float rs = pg8::row_rstd(ssp, row);
    f32x4* yr = (f32x4*)(y + (size_t)row * D) + lane; const f32x4* gr = (const f32x4*)g + lane;
#pragma unroll
    for (int j = 0; j < 4; ++j) { const f32x4 v = yr[64 * j], gg = gr[64 * j]; yr[64 * j] = v * rs * gg; }
}

template <bool FINAL>
__device__ __forceinline__ void sample_finalize_row(const float* slab, int ns, const float* res, float* Y, bf16_t* Aout, const float* gain, float* ssp, int r, int lane) {
    f32x4 y[4]; float ss = 0.f;
#pragma unroll
    for (int j = 0; j < 4; ++j) y[j] = *((const f32x4*)(res + (size_t)r * D) + lane + 64 * j);
    for (int sl = 0; sl < ns; ++sl) {
#pragma unroll
        for (int j = 0; j < 4; ++j) y[j] += *((const f32x4*)(slab + ((size_t)sl * MS + r) * D) + lane + 64 * j); }
#pragma unroll
    for (int j = 0; j < 4; ++j) ss += (y[j].x * y[j].x + y[j].y * y[j].y) + (y[j].z * y[j].z + y[j].w * y[j].w);
    ss = wave_sum(ss);
    if (FINAL) { const float rs = 1.f / sqrtf(ss * (1.f / D) + EPS);
#pragma unroll
        for (int j = 0; j < 4; ++j) *((f32x4*)(Y + (size_t)r * D) + lane + 64 * j) = y[j] * rs * *((const f32x4*)gain + lane + 64 * j); }
    else {
#pragma unroll
        for (int j = 0; j < 4; ++j) { *((f32x4*)(Y + (size_t)r * D) + lane + 64 * j) = y[j];
            u32x2 w; w.x = cvtpk(y[j].x, y[j].y); w.y = cvtpk(y[j].z, y[j].w); *((u32x2*)(Aout + (size_t)r * D) + lane + 64 * j) = w; }
        if (lane < 16) ssp[(size_t)(MP + r) * 16 + lane] = lane == 0 ? ss : 0.f; }
}
__device__ __forceinline__ unsigned q_issue(unsigned* ctr, int lane) { unsigned v = 0u; if (lane == 0) v = __hip_atomic_fetch_add(ctr, 1u, __ATOMIC_RELAXED, __HIP_MEMORY_SCOPE_AGENT); return v; }
__device__ __forceinline__ int q_item(unsigned tk, int shard) { return (int)__builtin_amdgcn_readfirstlane(tk) * 8 + shard; }
constexpr int N_PHASES = 17;
#ifndef ONE_LAUNCH
#define ONE_LAUNCH 1
#endif
#define PH_BEGIN \
    const Args* ap_ = &args; size_t z_ = 0; asm volatile("" : "+s"(z_)); \
    Frame F; F.lds = (LAS unsigned char*)lds_raw; F.tid = threadIdx.x; F.lane = F.tid & 63; F.wave = __builtin_amdgcn_readfirstlane(F.tid >> 6); \
    F.G = gridDim.x; { const int vcu_ = (F.G % 8 == 0) ? ((int)blockIdx.x % 8) * (F.G / 8) + (int)blockIdx.x / 8 : (int)blockIdx.x; F.gw = vcu_ * NWAVES + F.wave; } F.NGW = F.G * NWAVES; \
    F.wscr = F.lds + F.wave * WSCR; F.ws = ap_->ws + z_; F.out = ap_->out + z_; F.a = ap_; \
    unsigned char* ws = F.ws; float* out = F.out; unsigned* ctl = (unsigned*)(ws + WS_CTL); float* ssp = (float*)(ws + WS_SSP); \
    const float* norm_mix = (const float*)ap_->in[9] + z_; const float* norm_ffn = (const float*)ap_->in[10] + z_; const float* norm_out = (const float*)ap_->in[11] + z_; \
    (void)ctl; (void)ssp; (void)norm_mix; (void)norm_ffn; (void)norm_out; (void)out;
__global__ void __launch_bounds__(NWAVES * 64, 2) fwd(Args args) {
    extern __shared__ __attribute__((aligned(16))) unsigned char lds_raw[];
    volatile LAS unsigned* MISC = (volatile LAS unsigned*)((LAS unsigned char*)lds_raw + MISC_OFF);
    if (threadIdx.x < 16) MISC[threadIdx.x] = 0u;
    __syncthreads();
    const int lo = args.ph_lo, hi = args.ph_hi;
    const bool multi = (hi - lo) > 1;
    if (multi) (void)xcd_barrier_post((unsigned*)(args.ws + WS_CTL) + CW_BAR, MISC);
#ifndef ONLY_PHASE
#define ONLY_PHASE -1
#endif
#define IN(k) ((ONLY_PHASE < 0 || ONLY_PHASE == (k)) && lo <= (k) && (k) < hi)
#define SEAM(k) do { if (IN(k) && IN((k) + 1)) { XcdBarrier bar_; bar_.bar = (unsigned*)(args.ws + WS_CTL) + CW_BAR; bar_.x = xb_xcc_id(); bar_.st = MISC; xcd_barrier(bar_); } } while (0)

#define GEMM_N1024(Aptr, Wptr, KFULL, RESF, RBF16) do { \
        { pg8::Gemm g{(const bf16_t*)(Aptr), (const bf16_t*)(Wptr), MP, D, (KFULL), (KFULL)}; \
          pg8::StaticOrder S; S.init(MP, D, F.G, (int)blockIdx.x); \
          pg8::EpiRes<RBF16> E{(RESF), (bf16_t*)(ws + WS_XN), nullptr, ssp}; \
          pg8::gemm_phase<pg8::EpiRes<RBF16>, pg8::StaticOrder, true, true>(F.lds, g, S, E); } } while (0)
#define DEFERRED_SAMPLE(Aptr, Wptr, KFULL, RESS, AOUT, GAIN, INST) do { \
        constexpr int ns_ = (KFULL) / 256; const int mu = (int)blockIdx.x - (F.G - 4 * ns_); \
        if (mu >= 0) { const int sl = mu >> 2; int ks_ = 256; asm volatile("" : "+s"(ks_)); \
          pg8::Gemm g{(const bf16_t*)(Aptr) + sl * 256, (const bf16_t*)(Wptr) + sl * 256, M, D, ks_, (KFULL)}; \
          pg8::OneUnit S{MP / 256, mu & 3}; \
          pg8::EpiSlab E{(float*)(ws + WS_SLAB) + (size_t)sl * MS * D}; \
          pg8::gemm_phase<pg8::EpiSlab, pg8::OneUnit, true, true>(F.lds, g, S, E); \
          subgrid_rendezvous(ctl + CW_SR + 64 * (INST), 4 * ns_, ctl + CW_BAR); \
          for (int r = mu * NWAVES + F.wave; r < MS; r += 4 * ns_ * NWAVES) \
              sample_finalize_row<false>((const float*)(ws + WS_SLAB), ns_, (RESS), out + O_YS, (AOUT) + (size_t)MP * D, (GAIN), ssp, r, F.lane); \
          asm volatile("s_waitcnt vmcnt(0)" ::: "memory"); \
          __syncthreads(); \
          if (threadIdx.x == 0) { __builtin_amdgcn_fence(__ATOMIC_RELEASE, "agent"); asm volatile("s_waitcnt vmcnt(0)" ::: "memory"); (void)xb_add(ctl + CW_SR + 64 * (4 + (INST)), 1u); } } } while (0)
#define GATED_ORDER(S, MROWS, NCOLS, KFULL, INST) pg8::GatedOrder S; S.init((MROWS), (NCOLS), F.G, (int)blockIdx.x); S.flag = ctl + CW_SR + 64 * (4 + (INST)); S.need = 4 * ((KFULL) / 256); S.bar = ctl + CW_BAR

    if (IN(0)) { PH_BEGIN p0_prologue(F); }
    SEAM(0);
    if (IN(1)) { PH_BEGIN
        pg8::Gemm g{(const bf16_t*)(ws + WS_XN), (const bf16_t*)(ws + WS_WIN0), M, AB_IN, D, D};
        pg8::StaticOrder S; S.init(M, AB_IN, F.G, (int)blockIdx.x);
        pg8::EpiIn0 E{(bf16_t*)(ws + WS_QD), (bf16_t*)(ws + WS_KVD), (float*)(ws + WS_XR), (bf16_t*)(ws + WS_GT), out};
        pg8::gemm_phase<pg8::EpiIn0, pg8::StaticOrder, true, true>(F.lds, g, S, E);
        {
            constexpr int units = (M / 256) * (AB_IN / 256); const int nfull = units % F.G, nbg = nfull ? F.G - nfull : F.G;
            const int me = (int)blockIdx.x - (F.G - nbg);
            if (me >= 0) { __syncthreads(); for (int it = WT_T4 + me * NWAVES + F.wave; it < WT_T9; it += nbg * NWAVES) weight_transpose_item(F, it); }
        }
        if ((int)blockIdx.x == F.G - 1 && F.wave < 2) {
            const float* pp = (const float*)(ws + WS_PETP) + (size_t)F.wave * 32 * 64 + F.lane; float acc = 0.f;
#pragma unroll
            for (int l = 0; l < 32; ++l) acc += pp[l * 64];
            ((float*)(ws + WS_PET))[F.wave * 64 + F.lane] = acc;
        }
    }
    SEAM(1);
    if (IN(2)) { PH_BEGIN
        constexpr int ND = 32, NGL = 256, NL = ND + NGL * 6 + 32;
        unsigned* qc = ctl + CW_Q2 + 64 * ((int)blockIdx.x & 7); const int shard = (int)blockIdx.x & 7;
        for (int k = (int)__builtin_amdgcn_readfirstlane(q_issue(qc, F.lane)); k < NL; ) {
            const unsigned tk = q_issue(qc, F.lane);
            Frame Fi = F; { size_t zz = 0; asm volatile("" : "+s"(zz)); Fi.ws += zz; Fi.out += zz; }
            if (k < ND) dil_item_sample(Fi, k * 8 + shard);
            else if (k >= ND + NGL * 6) rglru_gates_item<true>(Fi, (k - ND - NGL * 6) * 8 + shard);
            else { const int i2 = k - ND, gl = i2 / 6, slot = i2 - gl * 6;
                if (slot < 2) compress_item<true>(Fi, (2 * gl + slot) * 8 + shard);
                else { const int kd = 2 * gl + (slot & 1);
                    const int item = (((kd >> 3) * 8 + shard) << 3) | (kd & 7);
                    if (slot < 4) dil_item_prompt(Fi, item); else rglru_gates_item<false>(Fi, item); } }
            k = (int)__builtin_amdgcn_readfirstlane(tk);
        }
    }
    SEAM(2);
    if (IN(3)) { PH_BEGIN
        for (int it = F.gw; it < 2048 + 256; it += F.NGW) { if (it < 2048) rglru_scan_item<false>(F, it); else rglru_scan_item<true>(F, it - 2048); }
    }
    SEAM(3);
    if (IN(4)) { PH_BEGIN GEMM_N1024(ws + WS_O, ws + WS_WOUT0, D, (const float*)args.in[0], false); }
    SEAM(4);
    if (IN(6)) { PH_BEGIN
        DEFERRED_SAMPLE(ws + WS_O, ws + WS_WOUT0, D, (const float*)args.in[1], (bf16_t*)(ws + WS_XN), norm_ffn, 0);
        pg8::Gemm g{(const bf16_t*)(ws + WS_XN), (const bf16_t*)(ws + WS_W13_0), M, FF2, D, D};
        GATED_ORDER(S, M, FF2, D, 0);
        pg8::EpiUp E{ssp, (bf16_t*)(ws + WS_H)};
        pg8::gemm_phase<pg8::EpiUp, pg8::GatedOrder, true, true>(F.lds, g, S, E);
    }
    SEAM(6);
    if (IN(7)) { PH_BEGIN GEMM_N1024(ws + WS_H, ws + WS_W2_0, FF, nullptr, true); }
    SEAM(7);
    if (IN(9)) { PH_BEGIN
        DEFERRED_SAMPLE(ws + WS_H, ws + WS_W2_0, FF, out + O_YS, (bf16_t*)(ws + WS_XN), norm_mix + D, 1);
        pg8::Gemm g{(const bf16_t*)(ws + WS_XN), (const bf16_t*)(ws + WS_WIN1), M, C_IN_PAD, D, D};
        GATED_ORDER(S, M, C_IN_PAD, FF, 1);
        pg8::EpiIn1 E{ssp, (bf16_t*)(ws + WS_Q1), (bf16_t*)(ws + WS_KVSEL), (bf16_t*)(ws + WS_KVWIN), (float*)(ws + WS_G1), out};
        pg8::gemm_phase<pg8::EpiIn1, pg8::GatedOrder, true, true>(F.lds, g, S, E);
    }
    SEAM(9);
    if (IN(10)) { PH_BEGIN
        for (int it = (int)blockIdx.x; it < 4 * 8 * 8; it += F.G) compress_item<false, true>(F, it);
    }
    SEAM(10);
    if (IN(11)) { PH_BEGIN
        unsigned* qc = ctl + CW_Q9 + 64 * ((int)blockIdx.x & 7); const int shard = (int)blockIdx.x & 7;
        if (F.wave == 7) for (int it = (int)blockIdx.x; it < NDC + NWC; it += F.G) copy_item(F, it);
        for (int it = q_item(q_issue(qc, F.lane), shard); it < 128 + 8192; ) {
            const unsigned tk = q_issue(qc, F.lane);
            if (it < 128) nsa_item<true>(F, it);
            else { const int p = it - 128, qt = 511 - (p >> 4), bg = p & 15; nsa_item<false>(F, ((bg >> 2) << 11) | (qt << 2) | (bg & 3)); }
            it = q_item(tk, shard);
        }
    }
    SEAM(11);
    if (IN(12)) { PH_BEGIN GEMM_N1024(ws + WS_O, ws + WS_WOUT1, D, nullptr, true); }
    SEAM(12);
    if (IN(14)) { PH_BEGIN
        DEFERRED_SAMPLE(ws + WS_O, ws + WS_WOUT1, D, out + O_YS, (bf16_t*)(ws + WS_XN), norm_ffn + D, 2);
        pg8::Gemm g{(const bf16_t*)(ws + WS_XN), (const bf16_t*)(ws + WS_W13_1), M, FF2, D, D};
        GATED_ORDER(S, M, FF2, D, 2);
        pg8::EpiUp E{ssp, (bf16_t*)(ws + WS_H)};
        pg8::gemm_phase<pg8::EpiUp, pg8::GatedOrder, true, true>(F.lds, g, S, E);
    }
    SEAM(14);
    if (IN(15)) { PH_BEGIN
        if (F.G == MP / 256 * 4) {
            pg8::Gemm g{(const bf16_t*)(ws + WS_H), (const bf16_t*)(ws + WS_W2_1), MP, D, FF, FF};
            pg8::StaticOrder S; S.init(MP, D, F.G, (int)blockIdx.x);
            pg8::EpiResNorm E{(const bf16_t*)(ws + WS_XN), out + O_YP, norm_out, (float*)(ws + WS_XSL), ctl + CW_PN, ctl + CW_BAR + XB_TMO};
            pg8::gemm_phase<pg8::EpiResNorm, pg8::StaticOrder, true, true>(F.lds, g, S, E);
        } else {
            pg8::Gemm g{(const bf16_t*)(ws + WS_H), (const bf16_t*)(ws + WS_W2_1), MP, D, FF, FF};
            pg8::StaticOrder S; S.init(MP, D, F.G, (int)blockIdx.x);
            pg8::EpiRes<true, true> E{nullptr, (bf16_t*)(ws + WS_XN), out + O_YP, ssp};
            pg8::gemm_phase<pg8::EpiRes<true, true>, pg8::StaticOrder, true, true>(F.lds, g, S, E);
        }
        if ((int)blockIdx.x < 4 * (FF / 256)) { const int mu = (int)blockIdx.x; const int sl = mu >> 2;
            pg8::Gemm g{(const bf16_t*)(ws + WS_H) + sl * 256, (const bf16_t*)(ws + WS_W2_1) + sl * 256, M, D, 256, FF};
            pg8::OneUnit S{MP / 256, mu & 3};
            pg8::EpiSlab E{(float*)(ws + WS_SLAB) + (size_t)sl * MS * D};
            pg8::gemm_phase<pg8::EpiSlab, pg8::OneUnit, true, true>(F.lds, g, S, E);
            subgrid_rendezvous(ctl + CW_SR + 64 * 3, 4 * (FF / 256), ctl + CW_BAR);
            for (int r = mu * NWAVES + F.wave; r < MS; r += 4 * (FF / 256) * NWAVES)
                sample_finalize_row<true>((const float*)(ws + WS_SLAB), FF / 256, out + O_YS, out + O_YS, nullptr, norm_out, ssp, r, F.lane); }
    }
    if (gridDim.x != MP / 256 * 4) {
        SEAM(15);
        if (IN(16)) { PH_BEGIN
            for (int r = F.gw; r < MP; r += F.NGW) final_norm_row(out, ssp, norm_out, r, F.lane);
        }
    }
#undef GEMM_N1024
#undef DEFERRED_SAMPLE
#undef GATED_ORDER
#undef IN
#undef SEAM
}

extern "C" void kernel_launch(void* const* d_in, const int* in_sizes, int n_in, void* d_out, int out_size, void* d_ws, size_t ws_size, hipStream_t stream) {
    static int grid = 0;
    if (grid == 0) {
        if (n_in != 28 || (size_t)out_size != O_END || ws_size < WS_END) { fprintf(stderr, "kernel_launch: unexpected shapes (n_in %d out %d ws %zu need %zu)\n", n_in, out_size, ws_size, (size_t)WS_END); grid = -1; return; }
        int dev = 0, cus = 0, per_cu = 0;
        if (hipGetDevice(&dev) != hipSuccess || hipDeviceGetAttribute(&cus, hipDeviceAttributeMultiprocessorCount, dev) != hipSuccess) { grid = -1; return; }
        if (hipFuncSetAttribute((const void*)fwd, hipFuncAttributeMaxDynamicSharedMemorySize, LDS_BYTES) != hipSuccess) { fprintf(stderr, "kernel_launch: hipFuncSetAttribute failed\n"); grid = -1; return; }
        if (hipOccupancyMaxActiveBlocksPerMultiprocessor(&per_cu, (const void*)fwd, NWAVES * 64, LDS_BYTES) != hipSuccess || per_cu < 1) { fprintf(stderr, "kernel_launch: occupancy query says %d\n", per_cu); }
        (void)hipGetLastError();
        grid = cus;
    }
    if (grid < 0) return;
    (void)hipMemsetAsync((char*)d_ws + WS_CTL, 0, CTL_ZERO_BYTES, stream);
    Args a{};
    for (int i = 0; i < 28; ++i) a.in[i] = d_in[i];
    a.out = (float*)d_out; a.ws = (unsigned char*)d_ws;
#if ONE_LAUNCH
    a.ph_lo = 0; a.ph_hi = N_PHASES; hipLaunchKernelGGL(fwd, dim3(grid), dim3(NWAVES * 64), LDS_BYTES, stream, a);
#else
    for (int p = 0; p < N_PHASES; ++p) { a.ph_lo = p; a.ph_hi = p + 1; hipLaunchKernelGGL(fwd, dim3(grid), dim3(NWAVES * 64), LDS_BYTES, stream, a); }
#endif
}
```

```cpp
#include <hip/hip_runtime.h>
#include <cstdio>
#include <cstdint>
#include <type_traits>

#define LAS __attribute__((address_space(3)))
#define GAS __attribute__((address_space(1)))
typedef unsigned short bf16_t;
typedef short bf16x8 __attribute__((ext_vector_type(8)));
typedef short s16x4 __attribute__((ext_vector_type(4)));
typedef float f32x2 __attribute__((ext_vector_type(2)));
typedef float f32x4 __attribute__((ext_vector_type(4)));
typedef float f32x16 __attribute__((ext_vector_type(16)));
typedef unsigned u32x2 __attribute__((ext_vector_type(2)));
typedef unsigned u32x4 __attribute__((ext_vector_type(4)));
typedef __bf16 bf16x2_t __attribute__((ext_vector_type(2)));

constexpr int D = 1024, BP = 4, SEQ = 4096, MP = BP * SEQ, BS = 32, TS = 8, MS = BS * TS, M = MP + MS;
constexpr int PAST = 8192, PAGE = 128, NPG = PAST / PAGE;
constexpr int AB_IN = 2560, C_IN = 2608, C_IN_PAD = 2816, FF = 2816, FF2 = 2 * FF;
constexpr int DIL_KEEP = 2048, WIN = 512;
constexpr int NCP = 255, NCS = 511;
constexpr float EPS = 1e-6f;
constexpr float LOG2E = 1.4426950408889634f;
constexpr float C_SCALE2 = 0.125f * LOG2E;

constexpr size_t O_YP = 0, O_YS = O_YP + (size_t)MP * D, O_DILP = O_YS + (size_t)MS * D, O_DILS = O_DILP + (size_t)BP * 2048 * 1024,
                 O_CONVP = O_DILS + (size_t)BS * 2048 * 1024, O_CONVS = O_CONVP + (size_t)BP * 3 * 512, O_RNNP = O_CONVS + (size_t)BS * 3 * 512,
                 O_RNNS = O_RNNP + (size_t)BP * 512, O_WINP = O_RNNS + (size_t)BS * 512, O_WINS = O_WINP + (size_t)BP * 512 * 512,
                 O_CMPP = O_WINS + (size_t)BS * 512 * 512, O_CMPS = O_CMPP + (size_t)BP * SEQ * 512, O_SELP = O_CMPS + (size_t)BS * TS * 512,
                 O_SELS = O_SELP + (size_t)BP * SEQ * 512, O_END = O_SELS + (size_t)BS * TS * 512;
static_assert(O_END == 119087104, "output size");

constexpr size_t al256(size_t x) { return (x + 255) & ~(size_t)255; }
constexpr size_t WS_CTL = 0, CTL_ZERO_BYTES = 1u << 16;
constexpr size_t WS_WIN0 = CTL_ZERO_BYTES;
constexpr size_t WS_WOUT0 = WS_WIN0 + (size_t)AB_IN * D * 2;
constexpr size_t WS_W13_0 = WS_WOUT0 + (size_t)D * D * 2;
constexpr size_t WS_W2_0 = WS_W13_0 + (size_t)FF2 * D * 2;
constexpr size_t WS_WIN1 = WS_W2_0 + (size_t)D * FF * 2;
constexpr size_t WS_WOUT1 = WS_WIN1 + (size_t)C_IN_PAD * D * 2;
constexpr size_t WS_W13_1 = WS_WOUT1 + (size_t)D * D * 2;
constexpr size_t WS_W2_1 = WS_W13_1 + (size_t)FF2 * D * 2;
constexpr size_t WS_WG = WS_W2_1 + (size_t)D * FF * 2;
constexpr size_t WS_WCT = WS_WG + (size_t)2 * 8 * 64 * 64 * 2;
constexpr size_t WS_PET = WS_WCT + (size_t)2 * 64 * 2048 * 2;
constexpr size_t WS_C8 = WS_PET + 512;
constexpr size_t WS_XN = al256(WS_C8 + 2048);
constexpr size_t WS_QD = WS_XN + (size_t)M * D * 2;
constexpr size_t WS_KVD = WS_QD + (size_t)M * 512 * 2;
constexpr size_t WS_XR = WS_KVD + (size_t)M * 1024 * 2;
constexpr size_t WS_GT = WS_XR + (size_t)M * 512 * 4;
constexpr size_t WS_AU = WS_GT + (size_t)M * 512 * 2;
constexpr size_t WS_AGG = WS_AU + (size_t)M * 1024 * 4;
constexpr size_t WS_O = WS_AGG + (size_t)4 * 128 * 1024 * 4;
constexpr size_t WS_H = WS_O + (size_t)M * D * 2;
constexpr size_t WS_SSP = WS_H + (size_t)M * FF * 2;
constexpr size_t WS_Q1 = WS_SSP + (size_t)M * 16 * 4;
constexpr size_t WS_KVSEL = WS_Q1 + (size_t)M * D * 2;
constexpr size_t WS_KVWIN = WS_KVSEL + (size_t)MP * 512 * 2;
constexpr size_t WS_G1 = WS_KVWIN + (size_t)MP * 512 * 2;
constexpr size_t WS_KCP = al256(WS_G1 + (size_t)M * 48 * 4);
constexpr size_t WS_KCS = WS_KCP + (size_t)BP * 256 * 512 * 2;
constexpr size_t WS_SLAB = WS_KCS + (size_t)BS * 512 * 512 * 2;
constexpr size_t WS_XSL = WS_SLAB + (size_t)11 * MS * D * 4;
constexpr size_t WS_PETP = WS_XSL + (size_t)MP * 4 * 4;
constexpr size_t WS_END = WS_PETP + (size_t)2 * 32 * 64 * 4;

constexpr int CW_BAR = 4096;
constexpr int CW_Q2 = 8192, CW_Q9 = 8192 + 1024;
constexpr int CW_PN = 8192 + 2048;
constexpr int CW_SR = 8192 + 2048 + 4096;
constexpr int CW_QBG = 8192 + 2048, CW_DONE = 8192 + 3072;

constexpr int RING_BYTES = 131072;
constexpr int WSCR = 18432;
constexpr int MISC_OFF = 8 * WSCR;
constexpr int LDS_BYTES = MISC_OFF + 1024;

__device__ __forceinline__ unsigned cvtpk(float lo, float hi) { f32x2 v = {lo, hi}; bf16x2_t b = __builtin_convertvector(v, bf16x2_t); return __builtin_bit_cast(unsigned, b); }
__device__ __forceinline__ float bf2f(unsigned short h) { return __uint_as_float((unsigned)h << 16); }
__device__ __forceinline__ bf16x8 pack8(f32x4 a, f32x4 b) { u32x4 w; w.x = cvtpk(a[0], a[1]); w.y = cvtpk(a[2], a[3]); w.z = cvtpk(b[0], b[1]); w.w = cvtpk(b[2], b[3]); return __builtin_bit_cast(bf16x8, w); }
__device__ __forceinline__ float wave_sum(float v) {
#pragma unroll
    for (int o = 1; o < 64; o <<= 1) v += __shfl_xor(v, o);
    return v;
}
#define LDS_WAIT() asm volatile("s_waitcnt lgkmcnt(0)" ::: "memory")
#define VM_WAIT() asm volatile("s_waitcnt vmcnt(0)" ::: "memory")

namespace pg8 {
#define PG8_LAS __attribute__((address_space(3)))
constexpr int BM = 256, BK = 64, HALF = 128, HTB = HALF * BK * 2, STAGE_BYTES = 8 * HTB, NXCD = 8, WGM = 8;
__host__ __device__ __forceinline__ int lds_byte(int r, int c) { const int st = (r >> 4) * 2 + (c >> 5), rr = r & 15, cc = c & 31, ob = rr * 64 + cc * 2; return st * 1024 + (ob ^ (((ob >> 9) & 1) << 5)); }
__host__ __device__ __forceinline__ void stage_rc(int b, int& R, int& C) { const int st = b / 1024, sb = b % 1024, swz = sb ^ (((sb >> 9) & 1) << 5); R = (st >> 1) * 16 + swz / 64; C = (st & 1) * 32 + (swz % 64) / 2; }
__host__ __device__ __forceinline__ int perm32(int rho) { const int n = rho >> 4, i = rho & 15; return 8 * (i >> 2) + 4 * n + (i & 3); }
struct Unit { int pm, pn; };
struct Gemm { const bf16_t* A; const bf16_t* Bt; int M, N, K, ld; };
struct StaticOrder {
    int nM, nN, nwg, G, c;
    __host__ __device__ void init(int M_, int N_, int G_, int c_) { nM = M_ / BM; nN = N_ / BM; nwg = nM * nN; G = G_; c = c_; }
    __host__ __device__ bool next(int i, Unit& u) const {
        const long L = (long)i * G + c; if (L >= nwg) return false;
        int wgid = (int)L; { const int q = nwg / NXCD, r = nwg % NXCD, xcd = wgid % NXCD, off = wgid / NXCD; wgid = (xcd < r ? xcd * (q + 1) : r * (q + 1) + (xcd - r) * q) + off; }
        const int nig = WGM * nN, gid = wgid / nig, fm = gid * WGM, gsz = (nM - fm) < WGM ? (nM - fm) : WGM;
        u.pm = fm + ((wgid % nig) % gsz); u.pn = (wgid % nig) / gsz; return true;
    }
    __device__ __forceinline__ void a_ready(const Unit&) const {}
    __device__ __forceinline__ void done(const Unit&) const {}
};

struct CountingOrder : StaticOrder {
    unsigned* cnt; int lane;
    __device__ __forceinline__ void done(const Unit&) const { if (lane == 0) __hip_atomic_fetch_add(cnt, 1u, __ATOMIC_RELAXED, __HIP_MEMORY_SCOPE_AGENT); }
};
struct OneUnit {
    int pm, pn;
    __host__ __device__ bool next(int i, Unit& u) const { if (i) return false; u.pm = pm; u.pn = pn; return true; }
    __device__ __forceinline__ void a_ready(const Unit&) const {}
    __device__ __forceinline__ void done(const Unit&) const {}
};
template <class Epi, class Sched, bool ALIGN_EPI = false, bool SP2 = false>
__device__ __forceinline__ void gemm_phase(PG8_LAS unsigned char* lds, const Gemm g, const Sched& S, const Epi& E) {
    const int tid = threadIdx.x, wid = __builtin_amdgcn_readfirstlane(tid >> 6), lane = tid & 63, wr = wid >> 2, wc = wid & 3, fr = lane & 15, fq = lane >> 4;
    const int K = g.K, nt = K / BK, LD = g.ld;
    unsigned voffA[2], voffB[2];
#pragma unroll
    for (int i = 0; i < 2; ++i) { int R, C; stage_rc(tid * 16 + i * 8192, R, C); const int Rb = Epi::PERM ? ((R & ~31) + perm32(R & 31)) : R;
        voffA[i] = (unsigned)(R * LD + C) * 2u; voffB[i] = (unsigned)(Rb * LD + C) * 2u; }
    const size_t kstep = (size_t)(BK * 2);
    const size_t hstep = (size_t)HALF * LD * 2;
    const size_t tstep = 2 * hstep;
    const unsigned ldsw = (unsigned)wid * 1024u;
    const int aoff = lds_byte(wr * 64 + fr, fq * 8), boff = lds_byte(wc * 32 + fr, fq * 8);
#define PG8_SA(b, h) (((b) * 2 + (h)) * HTB)
#define PG8_SB(b, h) ((4 + (b) * 2 + (h)) * HTB)
#define PG8_STAGE(bufoff, gbase, voff) do { _Pragma("unroll") for (int _i = 0; _i < 2; ++_i) \
        __builtin_amdgcn_global_load_lds((const unsigned*)((const char*)(gbase) + (voff)[_i]), (PG8_LAS unsigned*)(lds + (bufoff) + ldsw + _i * 8192), 16, 0, 0); } while (0)
#define PG8_LDA(dst, b, h) do { _Pragma("unroll") for (int m = 0; m < 4; ++m) _Pragma("unroll") for (int k = 0; k < 2; ++k) dst[m][k] = *(const PG8_LAS bf16x8*)(lds + PG8_SA(b, h) + aoff + m * 2048 + k * 1024); } while (0)
#define PG8_LDB(dst, b, h) do { _Pragma("unroll") for (int n = 0; n < 2; ++n) _Pragma("unroll") for (int k = 0; k < 2; ++k) dst[n][k] = *(const PG8_LAS bf16x8*)(lds + PG8_SB(b, h) + boff + n * 2048 + k * 1024); } while (0)
#define PG8_MMA(ai, bj, At, Bt) do { __builtin_amdgcn_s_setprio(1); _Pragma("unroll") for (int m = 0; m < 4; ++m) _Pragma("unroll") for (int n = 0; n < 2; ++n) _Pragma("unroll") for (int k = 0; k < 2; ++k) \
        acc[ai][bj][m][n] = __builtin_amdgcn_mfma_f32_16x16x32_bf16(Bt[n][k], At[m][k], acc[ai][bj][m][n], 0, 0, 0); __builtin_amdgcn_s_setprio(0); } while (0)
#define PG8_WAIT_V(n) asm volatile("s_waitcnt vmcnt(" #n ")" ::: "memory")
#define PG8_WAIT_L(n) asm volatile("s_waitcnt lgkmcnt(" #n ")" ::: "memory")
#define PG8_BAR __builtin_amdgcn_s_barrier()
#define PG8_SCHED __builtin_amdgcn_sched_barrier(0)
    Unit cur, nxt; int ui = 0;
    if (!S.next(0, cur)) return;
    f32x4 acc[2][2][4][2];
#pragma unroll
    for (int a = 0; a < 2; ++a)
#pragma unroll
        for (int b = 0; b < 2; ++b)
#pragma unroll
            for (int m = 0; m < 4; ++m)
#pragma unroll
                for (int n = 0; n < 2; ++n) acc[a][b][m][n] = (f32x4){0.f, 0.f, 0.f, 0.f};
    bf16x8 At[4][2], B0[2][2], B1[2][2];
    const char* cA = (const char*)g.A + (size_t)cur.pm * tstep; const char* cB = (const char*)g.Bt + (size_t)cur.pn * tstep;
    S.a_ready(cur);
    if constexpr (SP2) {
        PG8_STAGE(PG8_SB(0, 0), cB, voffB); PG8_STAGE(PG8_SB(0, 1), cB + hstep, voffB); PG8_STAGE(PG8_SA(0, 0), cA, voffA); PG8_STAGE(PG8_SA(0, 1), cA + hstep, voffA);
        if (wr == 1) PG8_BAR;
        PG8_WAIT_V(2); PG8_BAR;
        PG8_STAGE(PG8_SB(1, 0), cB + kstep, voffB); PG8_STAGE(PG8_SA(1, 0), cA + kstep, voffA); PG8_STAGE(PG8_SB(1, 1), cB + hstep + kstep, voffB);
        PG8_WAIT_V(6); PG8_BAR;
    } else {
        PG8_STAGE(PG8_SB(0, 0), cB, voffB); PG8_STAGE(PG8_SA(0, 0), cA, voffA); PG8_STAGE(PG8_SB(0, 1), cB + hstep, voffB); PG8_STAGE(PG8_SA(0, 1), cA + hstep, voffA);
        if (wr == 1) PG8_BAR;
        PG8_WAIT_V(4); PG8_BAR;
        PG8_STAGE(PG8_SB(1, 0), cB + kstep, voffB); PG8_STAGE(PG8_SA(1, 0), cA + kstep, voffA); PG8_STAGE(PG8_SB(1, 1), cB + hstep + kstep, voffB);
        PG8_WAIT_V(6); PG8_BAR;
    }
    for (;;) {
        const bool has_next = S.next(ui + 1, nxt);
        const char* nA = has_next ? (const char*)g.A + (size_t)nxt.pm * tstep : cA; const char* nB = has_next ? (const char*)g.Bt + (size_t)nxt.pn * tstep : cB;
        for (int t = 0; t < nt; t += 2) {
            const bool last = (t == nt - 2);
            const char* a1 = cA + (size_t)(t + 1) * kstep;
            const char* a2 = last ? nA : cA + (size_t)(t + 2) * kstep; const char* b2 = last ? nB : cB + (size_t)(t + 2) * kstep;
            const char* a3 = a2 + kstep; const char* b3 = b2 + kstep;
            if (last && has_next) S.a_ready(nxt);
            if constexpr (SP2) {
            PG8_LDB(B0, 0, 0); PG8_LDB(B1, 0, 1); PG8_SCHED; PG8_LDA(At, 0, 0); PG8_STAGE(PG8_SA(1, 1), a1 + hstep, voffA);
            PG8_WAIT_V(8); PG8_WAIT_L(0); PG8_BAR; PG8_MMA(0, 0, At, B0); PG8_MMA(0, 1, At, B1); PG8_BAR; PG8_SCHED;
            PG8_LDA(At, 0, 1); PG8_STAGE(PG8_SB(0, 0), b2, voffB); PG8_STAGE(PG8_SB(0, 1), b2 + hstep, voffB); PG8_STAGE(PG8_SA(0, 0), a2, voffA);
            PG8_WAIT_V(8); PG8_WAIT_L(0); PG8_BAR; PG8_MMA(1, 0, At, B0); PG8_MMA(1, 1, At, B1); PG8_BAR; PG8_SCHED;
            PG8_LDB(B0, 1, 0); PG8_LDB(B1, 1, 1); PG8_SCHED; PG8_LDA(At, 1, 0); PG8_STAGE(PG8_SA(0, 1), a2 + hstep, voffA);
            PG8_WAIT_V(8); PG8_WAIT_L(0); PG8_BAR; PG8_MMA(0, 0, At, B0); PG8_MMA(0, 1, At, B1); PG8_BAR; PG8_SCHED;
            PG8_LDA(At, 1, 1); PG8_STAGE(PG8_SB(1, 0), b3, voffB); PG8_STAGE(PG8_SB(1, 1), b3 + hstep, voffB); PG8_STAGE(PG8_SA(1, 0), a3, voffA);
            PG8_WAIT_V(8); PG8_WAIT_L(0); PG8_BAR; PG8_MMA(1, 0, At, B0); PG8_MMA(1, 1, At, B1); PG8_BAR; PG8_SCHED;
            } else {
            PG8_LDB(B0, 0, 0); PG8_SCHED; PG8_LDA(At, 0, 0); PG8_STAGE(PG8_SA(1, 1), a1 + hstep, voffA);
            PG8_WAIT_L(8); PG8_BAR; PG8_WAIT_L(0); PG8_MMA(0, 0, At, B0); PG8_BAR; PG8_SCHED;
            PG8_LDB(B1, 0, 1); PG8_STAGE(PG8_SB(0, 0), b2, voffB);
            PG8_BAR; PG8_WAIT_L(0); PG8_MMA(0, 1, At, B1); PG8_BAR;
            PG8_LDA(At, 0, 1); PG8_STAGE(PG8_SA(0, 0), a2, voffA);
            PG8_BAR; PG8_WAIT_L(0); PG8_MMA(1, 0, At, B0); PG8_BAR; PG8_SCHED;
            PG8_STAGE(PG8_SB(0, 1), b2 + hstep, voffB);
            PG8_WAIT_V(6); PG8_BAR; PG8_MMA(1, 1, At, B1); PG8_BAR;
            PG8_LDB(B0, 1, 0); PG8_SCHED; PG8_LDA(At, 1, 0); PG8_STAGE(PG8_SA(0, 1), a2 + hstep, voffA);
            PG8_WAIT_L(8); PG8_BAR; PG8_WAIT_L(0); PG8_MMA(0, 0, At, B0); PG8_BAR; PG8_SCHED;
            PG8_LDB(B1, 1, 1); PG8_STAGE(PG8_SB(1, 0), b3, voffB);
            PG8_BAR; PG8_WAIT_L(0); PG8_MMA(0, 1, At, B1); PG8_BAR;
            PG8_LDA(At, 1, 1); PG8_STAGE(PG8_SA(1, 0), a3, voffA);
            PG8_BAR; PG8_WAIT_L(0); PG8_MMA(1, 0, At, B0); PG8_BAR; PG8_SCHED;
            PG8_STAGE(PG8_SB(1, 1), b3 + hstep, voffB);
            PG8_WAIT_V(6); PG8_BAR; PG8_MMA(1, 1, At, B1); PG8_BAR;
            }
        }
        if constexpr (ALIGN_EPI) { if (wr == 0) PG8_BAR; }
        if constexpr (!Epi::AFTER_DRAIN) { E(acc, cur, wr, wc, fr, fq); S.done(cur); }
        if (!has_next) break;
#pragma unroll
        for (int a = 0; a < 2; ++a)
#pragma unroll
            for (int b = 0; b < 2; ++b)
#pragma unroll
                for (int m = 0; m < 4; ++m)
#pragma unroll
                    for (int n = 0; n < 2; ++n) acc[a][b][m][n] = (f32x4){0.f, 0.f, 0.f, 0.f};
        cur = nxt; cA = nA; cB = nB; ++ui;
        if constexpr (ALIGN_EPI) { if (wr == 1) PG8_BAR; }
    }
    PG8_WAIT_V(0);
    if constexpr (!ALIGN_EPI) { if (wr == 0) PG8_BAR; }
    PG8_BAR;
    if constexpr (Epi::AFTER_DRAIN) { E.fused(acc, cur, wr, wc, fr, fq, lds, wid, lane, tid); S.done(cur); }
#undef PG8_SA
#undef PG8_SB
#undef PG8_STAGE
#undef PG8_LDA
#undef PG8_LDB
#undef PG8_MMA
#undef PG8_WAIT_V
#undef PG8_WAIT_L
#undef PG8_BAR
#undef PG8_SCHED
}

typedef f32x4 Acc[2][2][4][2];

struct EpiIn0 {
    static constexpr bool PERM = true, AFTER_DRAIN = false;
    bf16_t* QD; bf16_t* KVD; float* XR; bf16_t* GT; float* out;
    __device__ __forceinline__ void operator()(const Acc& acc, const Unit& u, int wr, int wc, int fr, int fq) const {
        const int region = u.pn >> 1, cb = (u.pn & 1) * 256 + wc * 32 + 8 * fq;
#pragma unroll
        for (int ai = 0; ai < 2; ++ai)
#pragma unroll
            for (int m = 0; m < 4; ++m) {
                const int row = u.pm * BM + ai * HALF + wr * 64 + m * 16 + fr;
                const bool smp = row >= MP; const int b = smp ? (row - MP) >> 3 : row >> 12, t = smp ? (row - MP) & 7 : row & 4095;
#pragma unroll
                for (int bj = 0; bj < 2; ++bj) {
                    const int col = cb + bj * HALF; const f32x4 v0 = acc[ai][bj][m][0], v1 = acc[ai][bj][m][1];
                    if (region == 0) { *(bf16x8*)(QD + (size_t)row * 512 + col) = pack8(v0 * C_SCALE2, v1 * C_SCALE2); }
                    else if (region <= 2) { const int c = region - 1;
                        *(bf16x8*)(KVD + (size_t)row * 1024 + c * 512 + col) = pack8(v0, v1);
                        float* o = nullptr;
                        if (smp) o = out + O_DILS + ((size_t)(b * 2048 + 2040 + t) * 2 + c) * 512 + col;
                        else if (t >= 2048) o = out + O_DILP + ((size_t)(b * 2048 + t - 2048) * 2 + c) * 512 + col;
                        if (o) { *(f32x4*)o = v0; *(f32x4*)(o + 4) = v1; } }
                    else if (region == 3) { float* x = XR + (size_t)row * 512 + col; *(f32x4*)x = v0; *(f32x4*)(x + 4) = v1;
                        float* o = nullptr;
                        if (smp) { if (t >= 5) o = out + O_CONVS + (size_t)(b * 3 + t - 5) * 512 + col; }
                        else if (t >= SEQ - 3) o = out + O_CONVP + (size_t)(b * 3 + t - (SEQ - 3)) * 512 + col;
                        if (o) { *(f32x4*)o = v0; *(f32x4*)(o + 4) = v1; } }
                    else { *(bf16x8*)(GT + (size_t)row * 512 + col) = pack8(v0, v1); }
                }
            }
    }
};
}

#define XB_TMO      128
#define XB_XCNT(j)  (256  + 64 * (j))
#define XB_XSUB(j)  (1280 + 64 * (j))
#define XB_XGEN(j)  (2304 + 64 * (j))
#define XB_TOP      3328
#define XB_TOPGEN   3392
#define XCD_BAR_WORDS 3456
#define XB_SPIN_CAP (1u << 18)
__device__ __forceinline__ unsigned xb_ld(unsigned* p)              { return __hip_atomic_load(p, __ATOMIC_RELAXED, __HIP_MEMORY_SCOPE_AGENT); }
__device__ __forceinline__ unsigned xb_add(unsigned* p, unsigned v) { return __hip_atomic_fetch_add(p, v, __ATOMIC_RELAXED, __HIP_MEMORY_SCOPE_AGENT); }
__device__ __forceinline__ unsigned xb_xcc_id() { return (unsigned)__builtin_amdgcn_s_getreg((3 << 11) | 20) & 0xFu; }
#define XB_SPIN(cond, bar) do { unsigned _sp = 0; while (cond) { __builtin_amdgcn_s_sleep(1); \
    if ((++_sp & 255u) == 0u) { if (xb_ld(&(bar)[XB_TMO])) break; if (_sp > XB_SPIN_CAP) { atomicAdd(&(bar)[XB_TMO], 1u); break; } } } } while (0)
struct XcdBarrier { unsigned* bar; unsigned x; volatile LAS unsigned* st; };
__device__ __forceinline__ XcdBarrier xcd_barrier_post(unsigned* bar, volatile LAS unsigned* st) {
    XcdBarrier b; b.bar = bar; b.x = xb_xcc_id(); b.st = st;
    if (threadIdx.x == 0) (void)xb_add(&bar[XB_XCNT(b.x)], 1u);
    return b;
}
__device__ __forceinline__ void xcd_barrier_complete(unsigned* bar, unsigned x, unsigned& nloc, unsigned& nx) {
    const unsigned G = gridDim.x * gridDim.y * gridDim.z;
    unsigned sum, cnt, mine, sp = 0u;
    for (;;) {
        sum = 0u; cnt = 0u; mine = 0u;
#pragma unroll
        for (unsigned j = 0; j < 16; ++j) { const unsigned c = xb_ld(&bar[XB_XCNT(j)]); sum += c; cnt += (c > 0u) ? 1u : 0u; mine = (j == x) ? c : mine; }
        if (sum == G) break;
        __builtin_amdgcn_s_sleep(1);
        if ((++sp & 255u) == 0u) { if (xb_ld(&bar[XB_TMO])) break; if (sp > XB_SPIN_CAP) { atomicAdd(&bar[XB_TMO], 1u); break; } }
    }
    nloc = mine > 0u ? mine : 1u; nx = cnt > 0u ? cnt : 1u;
}
__device__ __forceinline__ void xcd_barrier(const XcdBarrier& b) {
    asm volatile("s_waitcnt vmcnt(0)" ::: "memory");
    __syncthreads();
    if (threadIdx.x == 0) {
        unsigned* bar = b.bar;
        __builtin_amdgcn_s_waitcnt(0);
        unsigned nloc = b.st[0], nx = b.st[1];
        if (nloc == 0u) { xcd_barrier_complete(bar, b.x, nloc, nx); b.st[0] = nloc; b.st[1] = nx; }
        const unsigned old = xb_add(&bar[XB_XSUB(b.x)], 1u);
        const unsigned gen = old / nloc;
        if (old + 1u == (gen + 1u) * nloc) {
            __builtin_amdgcn_fence(__ATOMIC_RELEASE, "agent");
            asm volatile("s_waitcnt vmcnt(0)" ::: "memory");
            const unsigned og = xb_add(&bar[XB_TOP], 1u);
            const unsigned tg = og / nx;
            if (og + 1u == (tg + 1u) * nx) xb_add(&bar[XB_TOPGEN], 1u);
            else XB_SPIN(xb_ld(&bar[XB_TOPGEN]) == tg, bar);
            __builtin_amdgcn_fence(__ATOMIC_ACQUIRE, "agent");
            xb_add(&bar[XB_XGEN(b.x)], 1u);
            asm volatile("s_waitcnt vmcnt(0)" ::: "memory");
        } else {
            XB_SPIN(xb_ld(&bar[XB_XGEN(b.x)]) == gen, bar);
            __builtin_amdgcn_fence(__ATOMIC_ACQUIRE, "agent");
            asm volatile("s_waitcnt vmcnt(0)" ::: "memory");
        }
    }
    __syncthreads();
}

__device__ __forceinline__ void subgrid_rendezvous(unsigned* cnt, unsigned n, unsigned* bar) {
    asm volatile("s_waitcnt vmcnt(0)" ::: "memory");
    __syncthreads();
    if (threadIdx.x == 0) {
        __builtin_amdgcn_fence(__ATOMIC_RELEASE, "agent");
        asm volatile("s_waitcnt vmcnt(0)" ::: "memory");
        (void)xb_add(cnt, 1u);
        XB_SPIN(xb_ld(cnt) < n, bar);
        __builtin_amdgcn_fence(__ATOMIC_ACQUIRE, "agent");
        asm volatile("s_waitcnt vmcnt(0)" ::: "memory");
    }
    __syncthreads();
}

struct Args { const void* in[28]; float* out; unsigned char* ws; int ph_lo, ph_hi; };
constexpr int NWAVES = 8;

struct Frame {
    LAS unsigned char* lds; LAS unsigned char* wscr;
    int tid, lane, wave, gw, NGW, G;
    unsigned char* ws; float* out; const Args* a;
};

__device__ __forceinline__ void transpose_item(const float* W, int K, int Nsrc, int Npad, bf16_t* WT, int mode, LAS float* scr, int item, int lane, const float* gk = nullptr) {
    const int nblk = Npad / 32, kb = item / nblk, nb = item % nblk, k0 = 64 * kb, n0 = 32 * nb;
    const int nn = n0 + (lane & 31);
    float v[32];
#pragma unroll
    for (int i = 0; i < 32; ++i) { const int kk = 2 * i + (lane >> 5); v[i] = nn < Nsrc ? __builtin_nontemporal_load(W + (size_t)(k0 + kk) * Nsrc + nn) : 0.f; }
#pragma unroll
    for (int i = 0; i < 32; ++i) { const int kk = 2 * i + (lane >> 5); scr[kk * 33 + (lane & 31)] = v[i]; }
    LDS_WAIT();
    const int c = lane & 7;
    f32x4 ga = {1.f, 1.f, 1.f, 1.f}, gb = ga;
    if (gk) { ga = *(const f32x4*)(gk + k0 + 8 * c); gb = *(const f32x4*)(gk + k0 + 8 * c + 4); }
#pragma unroll
    for (int j = 0; j < 4; ++j) { const int n = (lane >> 3) + 8 * j; const LAS float* s = scr + (8 * c) * 33 + n;
        u32x4 o; o.x = cvtpk(s[0 * 33] * ga.x, s[1 * 33] * ga.y); o.y = cvtpk(s[2 * 33] * ga.z, s[3 * 33] * ga.w); o.z = cvtpk(s[4 * 33] * gb.x, s[5 * 33] * gb.y); o.w = cvtpk(s[6 * 33] * gb.z, s[7 * 33] * gb.w);
        const int ng = n0 + n; const int drow = mode == 0 ? ng : ((ng >> 7) * 256 + (ng & 127) + (mode == 2 ? 128 : 0));
        *(u32x4*)(WT + (size_t)drow * K + k0 + 8 * c) = o; }
    LDS_WAIT();
}
__device__ __forceinline__ void rms_row_to_bf16(const float* xrow, const float* g, bf16_t* orow, int lane) {
    const f32x4* xr = (const f32x4*)xrow + lane; const f32x4* gr = (const f32x4*)g + lane;
    f32x4 v[4]; float s = 0.f;
#pragma unroll
    for (int j = 0; j < 4; ++j) { v[j] = __builtin_nontemporal_load(xr + 64 * j); s += (v[j].x * v[j].x + v[j].y * v[j].y) + (v[j].z * v[j].z + v[j].w * v[j].w); }
    const float rstd = 1.f / sqrtf(wave_sum(s) * (1.f / D) + EPS);
    u32x2* o8 = (u32x2*)orow + lane;
#pragma unroll
    for (int j = 0; j < 4; ++j) { const f32x4 gg = gr[64 * j]; u32x2 w; w.x = cvtpk(v[j].x * rstd * gg.x, v[j].y * rstd * gg.y); w.y = cvtpk(v[j].z * rstd * gg.z, v[j].w * rstd * gg.w); o8[64 * j] = w; }
}

__device__ __forceinline__ void rms_rows4_to_bf16(const float* x0, const float* x1, const float* x2, const float* x3, const float* g, bf16_t* o0, bf16_t* o1, bf16_t* o2, bf16_t* o3, int lane) {
    const float* xs[4] = {x0, x1, x2, x3}; bf16_t* os[4] = {o0, o1, o2, o3};
    f32x4 v[4][4]; float s[4];
#pragma unroll
    for (int q = 0; q < 4; ++q)
#pragma unroll
        for (int j = 0; j < 4; ++j) v[q][j] = __builtin_nontemporal_load((const f32x4*)xs[q] + lane + 64 * j);
    f32x4 gg[4];
#pragma unroll
    for (int j = 0; j < 4; ++j) gg[j] = *((const f32x4*)g + lane + 64 * j);
#pragma unroll
    for (int q = 0; q < 4; ++q) { float t = 0.f;
#pragma unroll
        for (int j = 0; j < 4; ++j) t += (v[q][j].x * v[q][j].x + v[q][j].y * v[q][j].y) + (v[q][j].z * v[q][j].z + v[q][j].w * v[q][j].w);
        s[q] = 1.f / sqrtf(wave_sum(t) * (1.f / D) + EPS); }
#pragma unroll
    for (int q = 0; q < 4; ++q)
#pragma unroll
        for (int j = 0; j < 4; ++j) { const float rstd = s[q]; u32x2 w; w.x = cvtpk(v[q][j].x * rstd * gg[j].x, v[q][j].y * rstd * gg[j].y); w.y = cvtpk(v[q][j].z * rstd * gg[j].z, v[q][j].w * rstd * gg[j].w);
            *((u32x2*)os[q] + lane + 64 * j) = w; }
}

constexpr int WT_IN0 = 16 * (AB_IN / 32), WT_O = 16 * (D / 32), WT_F = 16 * (FF / 32), WT_2 = (FF / 64) * (D / 32), WT_IN1 = 16 * (C_IN_PAD / 32);
constexpr int WT_T0 = WT_IN0, WT_T1 = WT_T0 + WT_O, WT_T2 = WT_T1 + WT_F, WT_T3 = WT_T2 + WT_F, WT_T4 = WT_T3 + WT_2, WT_T5 = WT_T4 + WT_IN1, WT_T6 = WT_T5 + WT_O, WT_T7 = WT_T6 + WT_F, WT_T8 = WT_T7 + WT_F, WT_T9 = WT_T8 + WT_2;
__device__ __forceinline__ void weight_transpose_item(const Frame& F, int it) {
    const Args& A = *F.a; LAS float* scr = (LAS float*)F.wscr; unsigned char* ws = F.ws; const int lane = F.lane;
    constexpr int T0 = WT_T0, T1 = WT_T1, T2 = WT_T2, T3 = WT_T3, T4 = WT_T4, T5 = WT_T5, T6 = WT_T6, T7 = WT_T7, T8 = WT_T8;
    {
        {
            const float* w1_0 = (const float*)A.in[25]; const float* w3_0 = (const float*)A.in[26]; const float* w2_0 = (const float*)A.in[27];
            if (it < T0) transpose_item((const float*)A.in[12], D, AB_IN, AB_IN, (bf16_t*)(ws + WS_WIN0), 0, scr, it, lane);
            else if (it < T1) transpose_item((const float*)A.in[13], D, D, D, (bf16_t*)(ws + WS_WOUT0), 0, scr, it - T0, lane);
            else if (it < T2) transpose_item(w1_0, D, FF, FF, (bf16_t*)(ws + WS_W13_0), 1, scr, it - T1, lane, (const float*)A.in[10]);
            else if (it < T3) transpose_item(w3_0, D, FF, FF, (bf16_t*)(ws + WS_W13_0), 2, scr, it - T2, lane, (const float*)A.in[10]);
            else if (it < T4) transpose_item(w2_0, FF, D, D, (bf16_t*)(ws + WS_W2_0), 0, scr, it - T3, lane);
            else if (it < T5) transpose_item((const float*)A.in[21], D, C_IN, C_IN_PAD, (bf16_t*)(ws + WS_WIN1), 0, scr, it - T4, lane, (const float*)A.in[9] + D);
            else if (it < T6) transpose_item((const float*)A.in[22], D, D, D, (bf16_t*)(ws + WS_WOUT1), 0, scr, it - T5, lane);
            else if (it < T7) transpose_item(w1_0 + (size_t)D * FF, D, FF, FF, (bf16_t*)(ws + WS_W13_1), 1, scr, it - T6, lane, (const float*)A.in[10] + D);
            else if (it < T8) transpose_item(w3_0 + (size_t)D * FF, D, FF, FF, (bf16_t*)(ws + WS_W13_1), 2, scr, it - T7, lane, (const float*)A.in[10] + D);
            else transpose_item(w2_0 + (size_t)FF * D, FF, D, D, (bf16_t*)(ws + WS_W2_1), 0, scr, it - T8, lane);
        }
    }
}
__device__ __forceinline__ void p0_prologue(const Frame& F) {
    const Args& A = *F.a;
    unsigned char* ws = F.ws;
    const int lane = F.lane;
    constexpr int X0 = WT_T4;
    constexpr int NMISC = 16 + 64 + 1;
    constexpr int R0 = X0 + NMISC;
    constexpr int NITEMS = R0 + M;
    for (int it = F.gw; it < NITEMS; it += F.NGW) {
        if (it < WT_T4) { weight_transpose_item(F, it);
        } else if (it < R0) {
            const int mi = it - X0;
            if (mi < 16) {
                const int mat = mi >> 3, n = mi & 7; const float* W = (const float*)A.in[mat ? 18 : 16] + (size_t)n * 4096;
                bf16_t* dst = (bf16_t*)(ws + WS_WG) + ((size_t)(mat * 8 + n) * 64 + lane) * 64;
#pragma unroll
                for (int k8 = 0; k8 < 8; ++k8) { const int d0 = k8 >> 1, h = k8 & 1; float v[8];
#pragma unroll
                    for (int jj = 0; jj < 8; ++jj) { const int i = 16 * d0 + 8 * (jj >> 2) + 4 * h + (jj & 3); v[jj] = W[i * 64 + lane]; }
                    u32x4 o; o.x = cvtpk(v[0], v[1]); o.y = cvtpk(v[2], v[3]); o.z = cvtpk(v[4], v[5]); o.w = cvtpk(v[6], v[7]);
                    *(u32x4*)(dst + 8 * k8) = o; }
            } else if (mi < 16 + 64) {
                const int lc = mi - 16, l = lc >> 1, c = lc & 1; const float* W = (const float*)A.in[23] + (size_t)(l * 2 + c) * 4096;
                bf16_t* dst = (bf16_t*)(ws + WS_WCT) + ((size_t)(c * 32 + l) * 4 * 2) * 512 + lane * 8;
                const int r32 = lane & 31, hi = lane >> 5;
                const float* P = (const float*)A.in[24] + (size_t)(l * 2 + c) * 64 + 8 * hi;
                float pt0 = 0.f, pt1 = 0.f;
#pragma unroll
                for (int k4 = 0; k4 < 4; ++k4) {
                    const f32x4 pa = *(const f32x4*)(P + 16 * k4), pb = *(const f32x4*)(P + 16 * k4 + 4);
#pragma unroll
                    for (int eh = 0; eh < 2; ++eh) { float v[8];
#pragma unroll
                        for (int j = 0; j < 8; ++j) v[j] = W[(16 * k4 + 8 * hi + j) * 64 + r32 + 32 * eh];
                        u32x4 o; o.x = cvtpk(v[0], v[1]); o.y = cvtpk(v[2], v[3]); o.z = cvtpk(v[4], v[5]); o.w = cvtpk(v[6], v[7]);
                        *(u32x4*)(dst + (size_t)(k4 * 2 + eh) * 512) = o;
                        const float t = ((pa.x * v[0] + pa.y * v[1]) + (pa.z * v[2] + pa.w * v[3])) + ((pb.x * v[4] + pb.y * v[5]) + (pb.z * v[6] + pb.w * v[7]));
                        if (eh) pt1 += t; else pt0 += t; }
                }
                pt0 += __shfl_xor(pt0, 32); pt1 += __shfl_xor(pt1, 32);
                ((float*)(ws + WS_PETP))[(size_t)(c * 32 + l) * 64 + lane] = hi ? pt1 : pt0;
            } else {
                const float* L = (const float*)A.in[20];
#pragma unroll
                for (int j = 0; j < 8; ++j) { const float z = -L[j * 64 + lane]; ((float*)(ws + WS_C8))[j * 64 + lane] = 8.f * (fmaxf(z, 0.f) + log1pf(expf(-fabsf(z)))); }
            }
        } else {
            const int r = it - R0;
#define XROW(r_) ((r_) < MP ? (const float*)A.in[0] + (size_t)(r_) * D : (const float*)A.in[1] + (size_t)((r_) - MP) * D)
#define OROW(r_) ((bf16_t*)(ws + WS_XN) + (size_t)(r_) * D)
            if (r + 3 * F.NGW < M) {
                rms_rows4_to_bf16(XROW(r), XROW(r + F.NGW), XROW(r + 2 * F.NGW), XROW(r + 3 * F.NGW), (const float*)A.in[9], OROW(r), OROW(r + F.NGW), OROW(r + 2 * F.NGW), OROW(r + 3 * F.NGW), lane);
                it += 3 * F.NGW;
            } else rms_row_to_bf16(XROW(r), (const float*)A.in[9], OROW(r), lane);
#undef XROW
#undef OROW
        }
    }
}
constexpr int NDC = BS * 255, NWC = BS * 32;
__device__ __forceinline__ void copy_item(const Frame& F, int ci) {
    const float* src; float* dst; const int lane = F.lane; bool half2 = true;
    if (ci < NDC) { const int b = ci / 255, ch = ci % 255; src = (const float*)F.a->in[2] + ((size_t)b * 2048 + 8) * 1024 + (size_t)ch * 8192; dst = F.out + O_DILS + (size_t)b * 2048 * 1024 + (size_t)ch * 8192; }
    else { const int c2 = ci - NDC, b = c2 >> 5, ch = c2 & 31; src = (const float*)F.a->in[5] + ((size_t)b * 512 + 8) * 512 + (size_t)ch * 8192; dst = F.out + O_WINS + (size_t)b * 512 * 512 + (size_t)ch * 8192; half2 = ch < 31; }
    f32x4 v[32];
#pragma unroll
    for (int j = 0; j < 16; ++j) v[j] = __builtin_nontemporal_load((const f32x4*)src + j * 64 + lane);
    if (half2) {
#pragma unroll
        for (int j = 16; j < 32; ++j) v[j] = __builtin_nontemporal_load((const f32x4*)src + j * 64 + lane); }
#pragma unroll
    for (int j = 0; j < 16; ++j) __builtin_nontemporal_store(v[j], (f32x4*)dst + j * 64 + lane);
    if (half2) {
#pragma unroll
        for (int j = 16; j < 32; ++j) __builtin_nontemporal_store(v[j], (f32x4*)dst + j * 64 + lane); }
}

namespace pg8 {
struct GatedOrder : StaticOrder {
    unsigned* flag; unsigned need; unsigned* bar;
    __device__ __forceinline__ void a_ready(const Unit& u) const {
        if (u.pm == MP / BM) {
            XB_SPIN(xb_ld(flag) < need, bar);
            __builtin_amdgcn_fence(__ATOMIC_ACQUIRE, "agent");
            asm volatile("s_waitcnt vmcnt(0)" ::: "memory");
        }
    }
};
__device__ __forceinline__ float row_rstd_q(const float* ssp, int row, int fq) {
    const f32x4 a = *(const f32x4*)(ssp + (size_t)row * 16 + fq * 4);
    float t = (a.x + a.y) + (a.z + a.w);
    { auto rr = __builtin_amdgcn_permlane16_swap(__float_as_uint(t), __float_as_uint(t), false, false); t = __uint_as_float(rr[0]) + __uint_as_float(rr[1]); }
    { auto rr = __builtin_amdgcn_permlane32_swap(__float_as_uint(t), __float_as_uint(t), false, false); t = __uint_as_float(rr[0]) + __uint_as_float(rr[1]); }
    return __builtin_amdgcn_rsqf(t * (1.f / D) + EPS);
}
__device__ __forceinline__ float row_rstd(const float* ssp, int row) {
    const f32x4* p = (const f32x4*)(ssp + (size_t)row * 16);
    const f32x4 a = p[0], b = p[1], c = p[2], d = p[3];
    const float s = ((a.x + a.y) + (a.z + a.w)) + ((b.x + b.y) + (b.z + b.w)) + ((c.x + c.y) + (c.z + c.w)) + ((d.x + d.y) + (d.z + d.w));
    return __builtin_amdgcn_rsqf(s * (1.f / D) + EPS);
}
__device__ __forceinline__ void unpack8(const bf16x8& v, f32x4& a, f32x4& b) {
    const u32x4 w = __builtin_bit_cast(u32x4, v);
    a = (f32x4){__uint_as_float(w.x << 16), __uint_as_float(w.x & 0xffff0000u), __uint_as_float(w.y << 16), __uint_as_float(w.y & 0xffff0000u)};
    b = (f32x4){__uint_as_float(w.z << 16), __uint_as_float(w.z & 0xffff0000u), __uint_as_float(w.w << 16), __uint_as_float(w.w & 0xffff0000u)};
}
template <bool RES_BF16, bool OUT_F32 = false>
struct EpiRes {
    static constexpr bool PERM = true, AFTER_DRAIN = false;
    const float* resF; bf16_t* Yb; float* Yf; float* ssp;
    __device__ __forceinline__ void operator()(const Acc& acc, const Unit& u, int wr, int wc, int fr, int fq) const {
        const int cb = u.pn * BM + wc * 32 + 8 * fq;
#pragma unroll
        for (int ai = 0; ai < 2; ++ai)
#pragma unroll
            for (int m = 0; m < 4; ++m) {
                const int row = u.pm * BM + ai * HALF + wr * 64 + m * 16 + fr;
                float ss = 0.f;
#pragma unroll
                for (int bj = 0; bj < 2; ++bj) {
                    const int col = cb + bj * HALF;
                    f32x4 r0, r1;
                    if (RES_BF16) unpack8(*(const bf16x8*)(Yb + (size_t)row * D + col), r0, r1);
                    else { r0 = *(const f32x4*)(resF + (size_t)row * D + col); r1 = *(const f32x4*)(resF + (size_t)row * D + col + 4); }
                    const f32x4 y0 = acc[ai][bj][m][0] + r0, y1 = acc[ai][bj][m][1] + r1;
                    if (OUT_F32) { float* yp = Yf + (size_t)row * D + col; *(f32x4*)yp = y0; *(f32x4*)(yp + 4) = y1; }
                    else *(bf16x8*)(Yb + (size_t)row * D + col) = pack8(y0, y1);
                    ss += (y0.x * y0.x + y0.y * y0.y) + (y0.z * y0.z + y0.w * y0.w) + (y1.x * y1.x + y1.y * y1.y) + (y1.z * y1.z + y1.w * y1.w);
                }
                ss += __shfl_xor(ss, 16); ss += __shfl_xor(ss, 32);
                if (fq == 0) ssp[(size_t)row * 16 + u.pn * 4 + wc] = ss;
            }
    }
};
struct EpiResNorm {
    static constexpr bool PERM = true, AFTER_DRAIN = true;
    const bf16_t* res; float* out; const float* gain; float* xslot; unsigned* cnt; unsigned* tmo;
    __device__ __forceinline__ void fused(Acc& acc, const Unit& u, int wr, int wc, int fr, int fq, PG8_LAS unsigned char* lds, int wid, int lane, int tid) const {
        PG8_LAS float* P = (PG8_LAS float*)lds;
        PG8_LAS float* S = (PG8_LAS float*)(lds + 4096);
        const int cb = u.pn * BM + wc * 32 + 8 * fq;
#pragma unroll
        for (int am = 0; am < 4; ++am) {
            const int ai = am >> 1, m0 = (am & 1) * 2;
            f32x4 r[2][2][2];
#pragma unroll
            for (int mm = 0; mm < 2; ++mm) { const bf16_t* rp = res + (size_t)(u.pm * BM + ai * HALF + wr * 64 + (m0 + mm) * 16 + fr) * D;
#pragma unroll
                for (int bj = 0; bj < 2; ++bj) unpack8(*(const bf16x8*)(rp + cb + bj * HALF), r[mm][bj][0], r[mm][bj][1]); }
#pragma unroll
            for (int mm = 0; mm < 2; ++mm) { const int m = m0 + mm; float ss = 0.f;
#pragma unroll
                for (int bj = 0; bj < 2; ++bj)
#pragma unroll
                    for (int n = 0; n < 2; ++n) { const f32x4 y = acc[ai][bj][m][n] + r[mm][bj][n]; acc[ai][bj][m][n] = y; ss += (y.x * y.x + y.y * y.y) + (y.z * y.z + y.w * y.w); }
                ss += __shfl_xor(ss, 16); ss += __shfl_xor(ss, 32);
                if (fq == 0) P[(ai * HALF + wr * 64 + m * 16 + fr) * 4 + wc] = ss; }
        }
        asm volatile("s_waitcnt lgkmcnt(0)" ::: "memory"); __builtin_amdgcn_s_barrier(); asm volatile("" ::: "memory");
        if (tid < 256) { const float t = (P[tid * 4 + 0] + P[tid * 4 + 1]) + (P[tid * 4 + 2] + P[tid * 4 + 3]);
            __hip_atomic_store((unsigned*)xslot + ((size_t)(u.pm * BM + tid) * 4 + u.pn), __float_as_uint(t), __ATOMIC_RELAXED, __HIP_MEMORY_SCOPE_AGENT); }
        asm volatile("s_waitcnt vmcnt(0)" ::: "memory");
        if (lane == 0) __hip_atomic_fetch_add(cnt + 64 * u.pm, 1u, __ATOMIC_RELAXED, __HIP_MEMORY_SCOPE_AGENT);
        if (wid == 0) {
            unsigned spins = 0;
            while ((unsigned)__builtin_amdgcn_readfirstlane(__hip_atomic_load(cnt + 64 * u.pm, __ATOMIC_RELAXED, __HIP_MEMORY_SCOPE_AGENT)) < 32u) {
                __builtin_amdgcn_s_sleep(2); if (++spins > (1u << 22)) { if (lane == 0) atomicAdd(tmo, 1u); break; } }
            __builtin_amdgcn_fence(__ATOMIC_ACQUIRE, "agent");
        }
        asm volatile("s_waitcnt vmcnt(0) lgkmcnt(0)" ::: "memory"); __builtin_amdgcn_s_barrier(); asm volatile("" ::: "memory");
        if (tid < 256) { const unsigned* sl = (const unsigned*)xslot + (size_t)(u.pm * BM + tid) * 4; float t = 0.f;
#pragma unroll
            for (int k = 0; k < 4; ++k) t += __uint_as_float(__hip_atomic_load(sl + k, __ATOMIC_RELAXED, __HIP_MEMORY_SCOPE_AGENT));
            S[tid] = __builtin_amdgcn_rsqf(t * (1.f / D) + EPS); }
        asm volatile("s_waitcnt lgkmcnt(0)" ::: "memory"); __builtin_amdgcn_s_barrier(); asm volatile("" ::: "memory");
        f32x4 g[2][2];
#pragma unroll
        for (int bj = 0; bj < 2; ++bj) { g[bj][0] = *(const f32x4*)(gain + cb + bj * HALF); g[bj][1] = *(const f32x4*)(gain + cb + bj * HALF + 4); }
#pragma unroll
        for (int ai = 0; ai < 2; ++ai)
#pragma unroll
            for (int m = 0; m < 4; ++m) { const int rl = ai * HALF + wr * 64 + m * 16 + fr; const float rs = S[rl]; float* op = out + (size_t)(u.pm * BM + rl) * D + cb;
#pragma unroll
                for (int bj = 0; bj < 2; ++bj) { *(f32x4*)(op + bj * HALF) = acc[ai][bj][m][0] * rs * g[bj][0]; *(f32x4*)(op + bj * HALF + 4) = acc[ai][bj][m][1] * rs * g[bj][1]; } }
        asm volatile("s_waitcnt lgkmcnt(0)" ::: "memory"); __builtin_amdgcn_s_barrier(); asm volatile("" ::: "memory");
    }
};
struct EpiSlab {
    static constexpr bool PERM = true, AFTER_DRAIN = false;
    float* slab;
    __device__ __forceinline__ void operator()(const Acc& acc, const Unit& u, int wr, int wc, int fr, int fq) const {
        const int cb = u.pn * BM + wc * 32 + 8 * fq;
#pragma unroll
        for (int ai = 0; ai < 2; ++ai)
#pragma unroll
            for (int m = 0; m < 4; ++m) { float* rp = slab + (size_t)(ai * HALF + wr * 64 + m * 16 + fr) * D;
#pragma unroll
                for (int bj = 0; bj < 2; ++bj) { *(f32x4*)(rp + cb + bj * HALF) = acc[ai][bj][m][0]; *(f32x4*)(rp + cb + bj * HALF + 4) = acc[ai][bj][m][1]; } }
    }
};
struct EpiUp {
    static constexpr bool PERM = true, AFTER_DRAIN = false;
    const float* ssp; bf16_t* H;
    __device__ __forceinline__ void operator()(const Acc& acc, const Unit& u, int wr, int wc, int fr, int fq) const {
        const int col = u.pn * HALF + wc * 32 + 8 * fq;
#pragma unroll
        for (int ai = 0; ai < 2; ++ai)
#pragma unroll
            for (int m = 0; m < 4; ++m) {
                const int row = u.pm * BM + ai * HALF + wr * 64 + m * 16 + fr;
                const float rs = row_rstd_q(ssp, row, fq);
                f32x4 h[2];
#pragma unroll
                for (int n = 0; n < 2; ++n) {
                    const f32x4 a = acc[ai][0][m][n] * rs, b = acc[ai][1][m][n] * rs;
#pragma unroll
                    for (int e = 0; e < 4; ++e) h[n][e] = a[e] * b[e] * __builtin_amdgcn_rcpf(1.f + __expf(-a[e]));
                }
                *(bf16x8*)(H + (size_t)row * FF + col) = pack8(h[0], h[1]);
            }
    }
};
struct EpiIn1 {
    static constexpr bool PERM = true, AFTER_DRAIN = false;
    const float* ssp; bf16_t* Q1; bf16_t* KVSEL; bf16_t* KVWIN; float* G1; float* out;
    __device__ __forceinline__ void operator()(const Acc& acc, const Unit& u, int wr, int wc, int fr, int fq) const {
        const int pn = u.pn;
#pragma unroll
        for (int ai = 0; ai < 2; ++ai)
#pragma unroll
            for (int m = 0; m < 4; ++m) {
                const int row = u.pm * BM + ai * HALF + wr * 64 + m * 16 + fr;
                const float rs = row_rstd_q(ssp, row, fq);
                const bool smp = row >= MP; const int b = smp ? (row - MP) >> 3 : row >> 12, t = smp ? (row - MP) & 7 : row & 4095;
#pragma unroll
                for (int bj = 0; bj < 2; ++bj) {
                    const int lc = bj * HALF + wc * 32 + 8 * fq;
                    const f32x4 v0 = acc[ai][bj][m][0] * rs, v1 = acc[ai][bj][m][1] * rs;
                    if (pn < 4) { *(bf16x8*)(Q1 + (size_t)row * D + pn * 256 + lc) = pack8(v0 * C_SCALE2, v1 * C_SCALE2); }
                    else if (pn < 6) { const int col = (pn - 4) * 256 + lc;
                        float* o = smp ? out + O_CMPS + (size_t)(row - MP) * 512 + col : out + O_CMPP + (size_t)row * 512 + col;
                        *(f32x4*)o = v0; *(f32x4*)(o + 4) = v1; }
                    else if (pn < 8) { const int col = (pn - 6) * 256 + lc;
                        float* o = smp ? out + O_SELS + (size_t)(row - MP) * 512 + col : out + O_SELP + (size_t)row * 512 + col;
                        *(f32x4*)o = v0; *(f32x4*)(o + 4) = v1;
                        if (!smp) *(bf16x8*)(KVSEL + (size_t)row * 512 + col) = pack8(v0, v1); }
                    else if (pn < 10) { const int col = (pn - 8) * 256 + lc;
                        if (!smp) *(bf16x8*)(KVWIN + (size_t)row * 512 + col) = pack8(v0, v1);
                        float* o = nullptr;
                        if (smp) o = out + O_WINS + (size_t)(b * 512 + 504 + t) * 512 + col;
                        else if (t >= SEQ - WIN) o = out + O_WINP + (size_t)(b * 512 + t - (SEQ - WIN)) * 512 + col;
                        if (o) { *(f32x4*)o = v0; *(f32x4*)(o + 4) = v1; } }
                    else { if (lc < 48) { f32x4 s0, s1;
#pragma unroll
                            for (int e = 0; e < 4; ++e) { s0[e] = __builtin_amdgcn_rcpf(1.f + __expf(-v0[e])); s1[e] = __builtin_amdgcn_rcpf(1.f + __expf(-v1[e])); }
                            float* o = G1 + (size_t)row * 48 + lc; *(f32x4*)o = s0; *(f32x4*)(o + 4) = s1; } }
                }
            }
    }
};
}

template <typename T> struct Src;
template <> struct Src<bf16_t> { typedef bf16x8 raw;
    static __device__ __forceinline__ raw ld(const bf16_t* p) { return *(const bf16x8*)p; }
    static __device__ __forceinline__ bf16x8 cv(const raw& r) { return r; } };
template <> struct Src<float> { struct raw { f32x4 a, b; };
    static __device__ __forceinline__ raw ld(const float* p) { raw r; r.a = *(const f32x4*)p; r.b = *(const f32x4*)(p + 4); return r; }
    static __device__ __forceinline__ bf16x8 cv(const raw& r) { return pack8(r.a, r.b); } };

constexpr int VT_MT = 2112;
constexpr float NEG_INF = -__builtin_inff();
struct AttnAcc { f32x16 o0, o1; float m, l; };
__device__ __forceinline__ void acc_init(AttnAcc& A) {
#pragma unroll
    for (int r = 0; r < 16; ++r) { A.o0[r] = 0.f; A.o1[r] = 0.f; }
    A.m = NEG_INF; A.l = 0.f;
}
__device__ __forceinline__ float swap32_max(float v) { auto rr = __builtin_amdgcn_permlane32_swap(__float_as_uint(v), __float_as_uint(v), false, false); return fmaxf(__uint_as_float(rr[0]), __uint_as_float(rr[1])); }
__device__ __forceinline__ float swap32_sum(float v) { auto rr = __builtin_amdgcn_permlane32_swap(__float_as_uint(v), __float_as_uint(v), false, false); return __uint_as_float(rr[0]) + __uint_as_float(rr[1]); }
__device__ __forceinline__ int crow(int r, int hi) { return (r & 3) + 8 * (r >> 2) + 4 * hi; }
typedef short v4i16_t __attribute__((ext_vector_type(4)));
__device__ __forceinline__ s16x4 vtr(const LAS unsigned char* p) { return __builtin_bit_cast(s16x4, __builtin_amdgcn_ds_read_tr16_b64_v4i16((LAS v4i16_t*)p)); }

struct VFrag { s16x4 lo[4], hh[4]; };
__device__ __forceinline__ void vt_read(VFrag& f, const LAS unsigned char* vb) {
#pragma unroll
    for (int mt = 0; mt < 2; ++mt)
#pragma unroll
        for (int ks = 0; ks < 2; ++ks) { f.lo[mt * 2 + ks] = vtr(vb + mt * VT_MT + ks * 1024); f.hh[mt * 2 + ks] = vtr(vb + mt * VT_MT + ks * 1024 + 512); }
}
__device__ __forceinline__ void pv_tile(f32x16& o0, f32x16& o1, const VFrag& f, bf16x8 pf0, bf16x8 pf1) {
#define VFR(i) (bf16x8){f.lo[i][0], f.lo[i][1], f.lo[i][2], f.lo[i][3], f.hh[i][0], f.hh[i][1], f.hh[i][2], f.hh[i][3]}
    __builtin_amdgcn_s_setprio(1);
    o0 = __builtin_amdgcn_mfma_f32_32x32x16_bf16(VFR(0), pf0, o0, 0, 0, 0);
    o0 = __builtin_amdgcn_mfma_f32_32x32x16_bf16(VFR(1), pf1, o0, 0, 0, 0);
    o1 = __builtin_amdgcn_mfma_f32_32x32x16_bf16(VFR(2), pf0, o1, 0, 0, 0);
    o1 = __builtin_amdgcn_mfma_f32_32x32x16_bf16(VFR(3), pf1, o1, 0, 0, 0);
    __builtin_amdgcn_s_setprio(0);
#undef VFR
}
__device__ __forceinline__ bf16x8 pack_p(const f32x16& p, int base) {
    u32x4 w; w.x = cvtpk(p[base + 0], p[base + 1]); w.y = cvtpk(p[base + 2], p[base + 3]); w.z = cvtpk(p[base + 4], p[base + 5]); w.w = cvtpk(p[base + 6], p[base + 7]);
    return __builtin_bit_cast(bf16x8, w);
}

constexpr float RESC_THR = 6.f;
constexpr int KT_OFF = 4352;
struct NoHook { __device__ __forceinline__ void operator()(int, const f32x16&) const {} };
template <typename T, int MODE, int VOFF, int PFD = 1, class RP, class MK, class HK = NoHook>
__device__ __forceinline__ void attn_run(AttnAcc& A, const bf16x8 (&qf)[4], int t_begin, int t_end, LAS unsigned char* vt, int lane, RP rp, MK mk, HK hk = HK()) {
    if (t_begin >= t_end) return;
    const int r32 = lane & 31, hi = lane >> 5, vkey = lane >> 3, vch = lane & 7;
    LAS unsigned char* vdst = vt + (vch >> 2) * VT_MT + vkey * 64 + (vch & 3) * 16;
    const LAS unsigned char* vb = vt + ((lane >> 4) & 1) * 32 + (lane & 3) * 8 + (4 * hi + ((lane & 15) >> 2)) * 64;
    LAS unsigned char* kt = vt + KT_OFF;
    const int kswz_w = (vkey >> 1) & 3;
    const LAS unsigned char* krd = kt + r32 * 128; const int kswz_r = (r32 >> 1) & 7;
    typedef typename Src<T>::raw raw_t;
    auto loads = [&](raw_t (&kr)[4], raw_t (&vr)[4], int tt) {
#pragma unroll
        for (int i = 0; i < 4; ++i) { const T* p_ = rp(tt, vkey + 8 * i) + 8 * vch; kr[i] = Src<T>::ld(p_); if (MODE != 1) vr[i] = Src<T>::ld(p_ + VOFF); } };
    auto tile = [&](int t, raw_t (&kr)[4], raw_t (&vr)[4], int tnext) {
        asm volatile("" ::: "memory");
#pragma unroll
        for (int i = 0; i < 4; ++i) {
            *(LAS bf16x8*)(kt + (vkey + 8 * i) * 128 + ((vch ^ (kswz_w | ((i & 1) << 2))) * 16)) = Src<T>::cv(kr[i]);
            if (MODE != 1) *(LAS bf16x8*)(vdst + i * 512) = Src<T>::cv(vr[i]);
        }
        if (tnext >= t_begin) loads(kr, vr, tnext);
        asm volatile("s_waitcnt lgkmcnt(0)" ::: "memory");
        bf16x8 kf[4];
#pragma unroll
        for (int d0 = 0; d0 < 4; ++d0) kf[d0] = *(const LAS bf16x8*)(krd + (((2 * d0 + hi) ^ kswz_r) * 16));
        VFrag vf;
        if (MODE != 1) { vt_read(vf, vb); __builtin_amdgcn_sched_barrier(0); }
        f32x16 s;
#pragma unroll
        for (int r = 0; r < 16; ++r) s[r] = 0.f;
        __builtin_amdgcn_s_setprio(1);
#pragma unroll
        for (int d0 = 0; d0 < 4; ++d0) s = __builtin_amdgcn_mfma_f32_32x32x16_bf16(kf[d0], qf[d0], s, 0, 0, 0);
        __builtin_amdgcn_s_setprio(0);
        if (MODE == 2) {
            mk(t, s, -A.m);
#pragma unroll
            for (int r = 0; r < 16; ++r) s[r] = __builtin_amdgcn_exp2f(s[r]) * A.l;
            hk(t, s);
        } else {
            const bool first = A.m == NEG_INF;
            mk(t, s, first ? 0.f : -A.m);
            float tm = fmaxf(fmaxf(s[0], s[1]), fmaxf(s[2], s[3]));
#pragma unroll
            for (int r = 4; r < 16; r += 4) tm = fmaxf(tm, fmaxf(fmaxf(s[r], s[r + 1]), fmaxf(s[r + 2], s[r + 3])));
            tm = swap32_max(tm);
            if (__any(first ? tm > NEG_INF : tm > RESC_THR)) {
                const float up = first ? tm : fmaxf(tm, 0.f);
                const float alpha = first ? 0.f : __builtin_amdgcn_exp2f(-up);
                A.l *= alpha; A.m = first ? up : A.m + up;
                const float sh = (up == NEG_INF) ? 0.f : up;
#pragma unroll
                for (int r = 0; r < 16; ++r) s[r] -= sh;
                if (MODE == 0) {
#pragma unroll
                    for (int r = 0; r < 16; ++r) { A.o0[r] *= alpha; A.o1[r] *= alpha; } }
            }
            float ps = 0.f;
#pragma unroll
            for (int r = 0; r < 16; ++r) { s[r] = __builtin_amdgcn_exp2f(s[r]); ps += s[r]; }
            A.l += swap32_sum(ps);
        }
        if (MODE != 1) {
            const bf16x8 pf0 = pack_p(s, 0), pf1 = pack_p(s, 8);
            pv_tile(A.o0, A.o1, vf, pf0, pf1);
        }
        asm volatile("" ::: "memory");
    };
    raw_t krA[4], vrA[4];
    int t = t_end - 1;
    loads(krA, vrA, t);
    if (PFD == 2) {
        raw_t krB[4], vrB[4];
        if (t - 1 >= t_begin) loads(krB, vrB, t - 1);
        while (t >= t_begin) {
            tile(t, krA, vrA, t - 2);
            if (t - 1 < t_begin) break;
            tile(t - 1, krB, vrB, t - 3);
            t -= 2;
        }
    } else {
        for (; t >= t_begin; --t) tile(t, krA, vrA, t - 1);
    }
}
template <int KS, int CHECK>
__device__ __forceinline__ void bias_mask(f32x16& s, float dq, float nslope2, float lo, float hi_, int hi, float base = 0.f) {
    const float dq2 = dq - (float)(KS * 4 * hi);
#pragma unroll
    for (int r = 0; r < 16; ++r) {
        const float d = dq2 - (float)(KS * ((r & 3) + 8 * (r >> 2)));
        float x = __builtin_fmaf(d, nslope2, s[r] + base);
        asm volatile("" : "+v"(x));
        if (CHECK == 1) { const bool ok = (d >= lo) & (d <= hi_); s[r] = ok ? x : NEG_INF; } else if (CHECK == 2) { s[r] = d >= lo ? x : NEG_INF; } else s[r] = x;
    }
}

__device__ __forceinline__ void store_o(bf16_t* orow, const f32x16& o0, const f32x16& o1, float sc, int hi) {
#pragma unroll
    for (int i = 0; i < 4; ++i) {
        u32x2 w; w.x = cvtpk(o0[4 * i] * sc, o0[4 * i + 1] * sc); w.y = cvtpk(o0[4 * i + 2] * sc, o0[4 * i + 3] * sc); *(u32x2*)(orow + 8 * i + 4 * hi) = w;
        u32x2 x; x.x = cvtpk(o1[4 * i] * sc, o1[4 * i + 1] * sc); x.y = cvtpk(o1[4 * i + 2] * sc, o1[4 * i + 3] * sc); *(u32x2*)(orow + 32 + 8 * i + 4 * hi) = x;
    }
}

__device__ __forceinline__ void dil_item_prompt(const Frame& F, int item) {
    const int lane = F.lane, r32 = lane & 31, hi = lane >> 5;
    const int j = item & 7, blk = (item >> 3) & 15, h = (item >> 7) & 7, b = item >> 10;
    const int q0 = blk * 256 + j, q = q0 + 8 * r32;
    const bf16_t* QD = (const bf16_t*)(F.ws + WS_QD); const bf16_t* KVD = (const bf16_t*)(F.ws + WS_KVD);
    const size_t rb = (size_t)b * SEQ;
    bf16x8 qf[4];
#pragma unroll
    for (int d0 = 0; d0 < 4; ++d0) qf[d0] = *(const bf16x8*)(QD + (rb + q) * 512 + h * 64 + 16 * d0 + 8 * hi);
    const float nslope2 = -__builtin_amdgcn_exp2f(-(float)(h + 1)) * LOG2E; const bool par = (r32 & 1) != 0;
    const bf16_t* Kb = KVD + rb * 1024 + h * 64;
    AttnAcc A; acc_init(A);
    LAS unsigned char* vt = F.wscr;
#define DIL_BRANCH(ST, K0, NT, WINDOW, PAR) do { \
        const int need_ = -(K0) - 31 - q0 / (ST); const int tb_ = need_ <= 0 ? 0 : (need_ + 31) >> 5; \
        auto rp = [&](int t, int key) -> const bf16_t* { int pos = q0 + (ST) * ((K0) + 32 * t + key); pos = pos < 0 ? 0 : (pos > SEQ - 1 ? SEQ - 1 : pos); return Kb + (size_t)pos * 1024; }; \
        auto mk = [&](int t, f32x16& s, float sh) { \
            const int tb = q0 + (ST) * ((K0) + 32 * t);                      \
            const float dq = (float)(q - tb); const float lim = fminf((float)(WINDOW), (float)q); \
            bias_mask<(ST), true>(s, dq, nslope2, 0.f, lim, hi, sh); \
            if (PAR) { _Pragma("unroll") for (int r = 0; r < 16; ++r) { const bool keep = (r & 1) ? par : !par; s[r] = keep ? s[r] : NEG_INF; } } }; \
        attn_run<bf16_t, 0, 512, 2>(A, qf, tb_, (NT), vt, lane, rp, mk); } while (0)
    DIL_BRANCH(1, -128, 12, 128, false);
    DIL_BRANCH(4, -128, 6, 512, false);
    DIL_BRANCH(8, -256, 9, 2048, true);
#undef DIL_BRANCH
    const float inv = 1.f / fmaxf(A.l, 1e-30f);
    store_o((bf16_t*)(F.ws + WS_O) + (rb + q) * D + h * 64, A.o0, A.o1, inv, hi);
}
__device__ __forceinline__ void dil_item_sample(const Frame& F, int item) {
    const int lane = F.lane, hi = lane >> 5, qi = lane & 7;
    const int h = item & 7, b = item >> 3;
    const size_t row = (size_t)MP + b * 8 + qi;
    const bf16_t* QD = (const bf16_t*)(F.ws + WS_QD);
    bf16x8 qf[4];
#pragma unroll
    for (int d0 = 0; d0 < 4; ++d0) qf[d0] = *(const bf16x8*)(QD + row * 512 + h * 64 + 16 * d0 + 8 * hi);
    const float slope2 = __builtin_amdgcn_exp2f(-(float)(h + 1)) * LOG2E;
    const float* cache = (const float*)F.a->in[2] + (size_t)b * 2048 * 1024 + h * 64;
    const float* newr = F.out + O_DILS + (size_t)b * 2048 * 1024 + h * 64;
    AttnAcc A; acc_init(A);
    LAS unsigned char* vt = F.wscr;
    auto geom = [&](int t, int& sh, int& pos0, int& tt, int& cls) { if (t < 5) { sh = 0; cls = 0; tt = t; pos0 = 1920; } else if (t < 25) { sh = 2; cls = (t - 5) / 5; tt = (t - 5) - 5 * cls; pos0 = 1536 + cls; } else { sh = 4; cls = (t - 25) / 5; tt = (t - 25) - 5 * cls; pos0 = cls; } };
    auto rowp = [&](int t, int key) -> const float* { int sh, pos0, tt, cls; geom(t, sh, pos0, tt, cls); int c = pos0 + ((32 * tt + key) << sh); c = c > 2055 ? 2055 : c; return c < 2048 ? cache + (size_t)c * 1024 : newr + (size_t)(c - 8) * 1024; };
    auto mk = [&](int t, f32x16& s, float shf) {
        int sh, pos0, tt, cls; geom(t, sh, pos0, tt, cls);
        const bool ok2 = sh == 0 ? true : (sh == 2 ? (qi & 3) == cls : qi == cls);
        const float dq = (float)(((2048 + qi - pos0) >> sh) - 32 * tt);
        bias_mask<1, true>(s, dq, -slope2 * (float)(1 << sh), 0.f, 128.f, hi, ok2 ? shf : NEG_INF); };
    attn_run<float, 0, 512>(A, qf, 0, 65, vt, lane, rowp, mk);
    const float inv = 1.f / fmaxf(A.l, 1e-30f);
    if ((lane & 31) < 8) store_o((bf16_t*)(F.ws + WS_O) + row * D + h * 64, A.o0, A.o1, inv, hi);
}

template <bool SAMPLE>
__device__ __forceinline__ void rglru_gates_item(const Frame& F, int item) {
    const int lane = F.lane, r32 = lane & 31, hi = lane >> 5;
    const int n = item & 7, tile = item >> 3;
    const int b = SAMPLE ? tile : tile >> 7, t = SAMPLE ? (r32 < 8 ? r32 : 7) : ((tile & 127) * 32 + r32);
    const size_t rowbase = SAMPLE ? (size_t)MP + b * 8 : (size_t)b * SEQ;
    const float* XR = (const float*)(F.ws + WS_XR);
    const float* cw = (const float*)F.a->in[14]; const float* cbias = (const float*)F.a->in[15];
    const float* sconv = (const float*)F.a->in[3] + (size_t)b * 3 * 512;
    const int ch0 = 64 * n + 4 * hi;
    f32x4 xc[8];
#pragma unroll
    for (int a = 0; a < 8; ++a) {
        const int ch = ch0 + 8 * a;
        f32x4 acc = *(const f32x4*)(cbias + ch);
#pragma unroll
        for (int k = 0; k < 4; ++k) {
            const int tau = t + k - 3;
            const float* xp = XR + (rowbase + (tau >= 0 ? tau : 0)) * 512 + ch;
            if (SAMPLE) xp = tau >= 0 ? xp : sconv + (3 + tau) * 512 + ch;
            f32x4 x = *(const f32x4*)xp;
            const float keep = (SAMPLE || tau >= 0) ? 1.f : 0.f;
            acc += x * (*(const f32x4*)(cw + k * 512 + ch) * keep);
        }
        xc[a] = acc;
        if ((a & 3) == 3) __builtin_amdgcn_sched_barrier(0);
    }
    bf16x8 xb[4];
#pragma unroll
    for (int d0 = 0; d0 < 4; ++d0) xb[d0] = pack8(xc[2 * d0], xc[2 * d0 + 1]);
    const bf16_t* WG = (const bf16_t*)(F.ws + WS_WG);
    const float* ba = (const float*)F.a->in[17]; const float* bx = (const float*)F.a->in[19]; const float* c8 = (const float*)(F.ws + WS_C8);
    float* AU = (float*)(F.ws + WS_AU) + (rowbase + t) * 1024;
    const bool valid = !SAMPLE || r32 < 8;
#pragma unroll
    for (int mt = 0; mt < 2; ++mt) {
        f32x16 ga, gx;
#pragma unroll
        for (int r = 0; r < 16; ++r) { ga[r] = 0.f; gx[r] = 0.f; }
        f32x4 vba[4], vbx[4], vc8[4];
#pragma unroll
        for (int a4 = 0; a4 < 4; ++a4) { const int ch = ch0 + 8 * (4 * mt + a4); vba[a4] = *(const f32x4*)(ba + ch); vbx[a4] = *(const f32x4*)(bx + ch); vc8[a4] = *(const f32x4*)(c8 + ch); }
#pragma unroll
        for (int d0 = 0; d0 < 4; ++d0) {
            const bf16x8 wa = *(const bf16x8*)(WG + ((size_t)(0 * 8 + n) * 64 + r32 + 32 * mt) * 64 + 16 * d0 + 8 * hi);
            const bf16x8 wx = *(const bf16x8*)(WG + ((size_t)(1 * 8 + n) * 64 + r32 + 32 * mt) * 64 + 16 * d0 + 8 * hi);
            ga = __builtin_amdgcn_mfma_f32_32x32x16_bf16(wa, xb[d0], ga, 0, 0, 0);
            gx = __builtin_amdgcn_mfma_f32_32x32x16_bf16(wx, xb[d0], gx, 0, 0, 0);
        }
        f32x4 av[4], uv[4];
#pragma unroll
        for (int a4 = 0; a4 < 4; ++a4) {
            const int a = 4 * mt + a4, ch = ch0 + 8 * a, rb = a4 * 4;
#pragma unroll
            for (int e = 0; e < 4; ++e) {
                const float rg = __builtin_amdgcn_rcpf(1.f + __expf(-(ga[rb + e] + vba[a4][e])));
                const float ig = __builtin_amdgcn_rcpf(1.f + __expf(-(gx[rb + e] + vbx[a4][e])));
                const float la = -rg * vc8[a4][e];
                av[a4][e] = __expf(la);
                uv[a4][e] = __builtin_amdgcn_sqrtf(fmaxf(1.f - av[a4][e] * av[a4][e], 0.f)) * ig * xc[a][e];
            }
            if (valid) { *(f32x4*)(AU + ch) = av[a4]; *(f32x4*)(AU + 512 + ch) = uv[a4]; }
        }
        if (!SAMPLE) {
#pragma unroll
            for (int sft = 1; sft < 32; sft <<= 1) {
                const bool upper = (r32 & sft) != 0;
#pragma unroll
                for (int a4 = 0; a4 < 4; ++a4)
#pragma unroll
                    for (int e = 0; e < 4; ++e) {
                        const float pa = __shfl_xor(av[a4][e], sft), pu = __shfl_xor(uv[a4][e], sft);
                        const float nu = upper ? av[a4][e] * pu + uv[a4][e] : pa * uv[a4][e] + pu;
                        av[a4][e] = av[a4][e] * pa; uv[a4][e] = nu;
                    }
            }
            if (r32 == 0) { float* ag = (float*)(F.ws + WS_AGG) + (size_t)tile * 1024;
#pragma unroll
                for (int a4 = 0; a4 < 4; ++a4) { const int ch = ch0 + 8 * (4 * mt + a4); *(f32x4*)(ag + ch) = av[a4]; *(f32x4*)(ag + 512 + ch) = uv[a4]; } }
        }
        __builtin_amdgcn_sched_barrier(0);
    }
}
__device__ __forceinline__ float gelu_tanh(float x) { const float z = 0.7978845608028654f * (x + 0.044715f * x * x * x); const float e = __expf(2.f * z); return 0.5f * x * (2.f - 2.f * __builtin_amdgcn_rcpf(e + 1.f)); }
template <bool SAMPLE>
__device__ __forceinline__ void rglru_scan_item(const Frame& F, int item) {
    const int lane = F.lane, n = item & 7, tile = item >> 3;
    const int b = SAMPLE ? tile : tile >> 6, tt = SAMPLE ? 0 : 2 * (tile & 63);
    const int ch = 64 * n + lane;
    constexpr int NT = SAMPLE ? 8 : 32;
    const size_t row0 = SAMPLE ? (size_t)MP + b * 8 : (size_t)b * SEQ + tt * 32;
    const float* AU = (const float*)(F.ws + WS_AU) + row0 * 1024 + ch; const bf16_t* GT = (const bf16_t*)(F.ws + WS_GT) + row0 * 512 + ch;
    bf16_t* O = (bf16_t*)(F.ws + WS_O) + row0 * D + 512 + ch;
    float av[NT], uv[NT], gv[NT];
#pragma unroll
    for (int i = 0; i < NT; ++i) { av[i] = AU[(size_t)i * 1024]; uv[i] = AU[(size_t)i * 1024 + 512]; gv[i] = bf2f(GT[(size_t)i * 512]); }
    float h;
    if (SAMPLE) h = ((const float*)F.a->in[4])[b * 512 + ch];
    else { h = 0.f; const float* ag = (const float*)(F.ws + WS_AGG) + (size_t)(b * 128) * 1024 + ch;
        int c = 0;
        for (; c + 32 <= tt; c += 32) { float pa[32], ph[32];
#pragma unroll
            for (int k = 0; k < 32; ++k) { pa[k] = ag[(size_t)(c + k) * 1024]; ph[k] = ag[(size_t)(c + k) * 1024 + 512]; }
#pragma unroll
            for (int k = 0; k < 32; ++k) h = pa[k] * h + ph[k]; }
        if (c < tt) { float pa[32], ph[32];
#pragma unroll
            for (int k = 0; k < 32; ++k) { const int cc = c + k < tt ? c + k : 0; pa[k] = ag[(size_t)cc * 1024]; ph[k] = ag[(size_t)cc * 1024 + 512]; }
#pragma unroll
            for (int k = 0; k < 32; ++k) { const bool on = c + k < tt; h = on ? pa[k] * h + ph[k] : h; } }
    }
    float y[NT];
#pragma unroll
    for (int i = 0; i < NT; ++i) { h = av[i] * h + uv[i]; y[i] = h * gelu_tanh(gv[i]); }
    if (!SAMPLE) {
        const float* AU2 = AU + (size_t)32 * 1024; const bf16_t* GT2 = GT + (size_t)32 * 512;
#pragma unroll
        for (int i = 0; i < NT; ++i) { av[i] = AU2[(size_t)i * 1024]; uv[i] = AU2[(size_t)i * 1024 + 512]; gv[i] = bf2f(GT2[(size_t)i * 512]); }
#pragma unroll
        for (int i = 0; i < NT; ++i) O[(size_t)i * D] = (bf16_t)(cvtpk(y[i], 0.f) & 0xffffu);
#pragma unroll
        for (int i = 0; i < NT; ++i) { h = av[i] * h + uv[i]; y[i] = h * gelu_tanh(gv[i]); }
        O += (size_t)32 * D;
    }
#pragma unroll
    for (int i = 0; i < NT; ++i) O[(size_t)i * D] = (bf16_t)(cvtpk(y[i], 0.f) & 0xffffu);
    if (SAMPLE) F.out[O_RNNS + b * 512 + ch] = h;
    else if (tt == 126) F.out[O_RNNP + b * 512 + ch] = h;
}

template <bool SAMPLE, bool SPLIT = false>
__device__ __forceinline__ void compress_item(const Frame& F, int item) {
    const int lane = F.lane, r32 = lane & 31, hi = lane >> 5;
    constexpr int NTL = SAMPLE ? 64 : 32, NC = SAMPLE ? NCS : NCP;
    const int c = item & 1, nt = (item >> 1) % NTL, b = (item >> 1) / NTL;
    const int lg = lane >> 4, lch = lane & 15;
    const int* pt = (const int*)F.a->in[8] + b * NPG;
    const float* rbase[9];
#pragma unroll
    for (int j = 0; j < 9; ++j) { int ch = nt * 8 + j; ch = ch < NC ? ch : NC;
        if (SAMPLE) { const int pg = pt[ch >> 3]; rbase[j] = (const float*)F.a->in[6] + ((size_t)pg * PAGE + (ch & 7) * 16) * 512 + c * 256 + lane * 4; }
        else rbase[j] = F.out + O_CMPP + ((size_t)b * SEQ + ch * 16) * 512 + c * 256 + lane * 4; }
    const bf16_t* WF = (const bf16_t*)(F.ws + WS_WCT) + (size_t)c * 32 * 4 * 2 * 512 + lane * 8;
    LAS unsigned char* xt = F.wscr;
    f32x4 xr[9];
#define CMP_LOAD(X, l_) do { _Pragma("unroll") for (int j = 0; j < 9; ++j) X[j] = SAMPLE ? __builtin_nontemporal_load((const f32x4*)(rbase[j] + (size_t)(l_) * 512)) : *(const f32x4*)(rbase[j] + (size_t)(l_) * 512); } while (0)
#define CMP_STEP(X, l_, NEXT_OK, lnext_) do { \
        LAS unsigned char* img = xt + ((l_) & 1) * 4608; \
        bf16x8 wf[4][4];                                    \
        _Pragma("unroll") for (int k4 = 0; k4 < 4; ++k4) { \
            wf[k4][0] = *(const bf16x8*)(WF + (size_t)(((l_) * 4 + k4) * 2 + 0) * 512); wf[k4][1] = *(const bf16x8*)(WF + (size_t)(((l_) * 4 + k4) * 2 + 1) * 512); \
            wf[k4][2] = *(const bf16x8*)(WF + (size_t)((((l_) + 16) * 4 + k4) * 2 + 0) * 512); wf[k4][3] = *(const bf16x8*)(WF + (size_t)((((l_) + 16) * 4 + k4) * 2 + 1) * 512); } \
        _Pragma("unroll") for (int j = 0; j < 9; ++j) { const int q = 4 * j + lg; u32x2 w; w.x = cvtpk(X[j][0], X[j][1]); w.y = cvtpk(X[j][2], X[j][3]); \
            *(LAS u32x2*)(img + q * 128 + (((lch >> 1) ^ ((q >> 1) & 7)) * 16) + (lch & 1) * 8) = w; } \
        if (NEXT_OK) CMP_LOAD(X, lnext_); \
        asm volatile("s_waitcnt lgkmcnt(0)" ::: "memory"); \
        _Pragma("unroll") for (int k4 = 0; k4 < 4; ++k4) { \
            const bf16x8 x0 = *(const LAS bf16x8*)(img + r32 * 128 + (((2 * k4 + hi) ^ ((r32 >> 1) & 7)) * 16)); \
            const bf16x8 x1 = *(const LAS bf16x8*)(img + (r32 + 4) * 128 + (((2 * k4 + hi) ^ (((r32 + 4) >> 1) & 7)) * 16)); \
            const bf16x8 w0 = wf[k4][0], w1 = wf[k4][1], w2 = wf[k4][2], w3 = wf[k4][3]; \
            a0 = __builtin_amdgcn_mfma_f32_32x32x16_bf16(w0, x0, a0, 0, 0, 0); \
            a1 = __builtin_amdgcn_mfma_f32_32x32x16_bf16(w1, x0, a1, 0, 0, 0); \
            a0 = __builtin_amdgcn_mfma_f32_32x32x16_bf16(w2, x1, a0, 0, 0, 0); \
            a1 = __builtin_amdgcn_mfma_f32_32x32x16_bf16(w3, x1, a1, 0, 0, 0); } \
        asm volatile("" ::: "memory"); } while (0)
    f32x16 a0, a1;
#pragma unroll
    for (int r = 0; r < 16; ++r) { a0[r] = 0.f; a1[r] = 0.f; }
    const int l0 = SPLIT ? 2 * F.wave : 0, l1 = SPLIT ? l0 + 2 : 16;
    CMP_LOAD(xr, l0);
    for (int l = l0; l < l1; ++l) CMP_STEP(xr, l, l + 1 < l1, l + 1);
#undef CMP_STEP
#undef CMP_LOAD
    if (SPLIT) {
        constexpr int PART = 9216;
        LAS f32x4* mine = (LAS f32x4*)(F.wscr + PART);
#pragma unroll
        for (int i = 0; i < 4; ++i) { mine[i * 64 + lane] = (f32x4){a0[4 * i], a0[4 * i + 1], a0[4 * i + 2], a0[4 * i + 3]}; mine[(4 + i) * 64 + lane] = (f32x4){a1[4 * i], a1[4 * i + 1], a1[4 * i + 2], a1[4 * i + 3]}; }
        __syncthreads();
        {
            const int me = F.wave;
            for (int w = 0; w < NWAVES; ++w) { if (w == me) continue; const LAS f32x4* p = (const LAS f32x4*)(F.lds + w * WSCR + PART);
#pragma unroll
                for (int i = 0; i < 4; ++i) { const f32x4 u = p[i * 64 + lane], v = p[(4 + i) * 64 + lane];
                    a0[4 * i] += u.x; a0[4 * i + 1] += u.y; a0[4 * i + 2] += u.z; a0[4 * i + 3] += u.w; a1[4 * i] += v.x; a1[4 * i + 1] += v.y; a1[4 * i + 2] += v.z; a1[4 * i + 3] += v.w; } }
        }
        __syncthreads();
    }
    const int n = nt * 8 + (r32 >> 2), g = r32 & 3;
    if (n < NC && (!SPLIT || F.wave == 0)) {
        const float* pe = (const float*)(F.ws + WS_PET) + c * 64;
        bf16_t* o = SAMPLE ? (bf16_t*)(F.ws + WS_KCS) + ((size_t)(b * 512 + n) * 2 + c) * 256 + g * 64 : (bf16_t*)(F.ws + WS_KCP) + ((size_t)(b * 256 + n) * 2 + c) * 256 + g * 64;
#pragma unroll
        for (int i = 0; i < 4; ++i) {
            const int e0 = 8 * i + 4 * hi; const f32x4 p0 = *(const f32x4*)(pe + e0), p1 = *(const f32x4*)(pe + 32 + e0);
            u32x2 w; w.x = cvtpk(a0[4 * i] + p0.x, a0[4 * i + 1] + p0.y); w.y = cvtpk(a0[4 * i + 2] + p0.z, a0[4 * i + 3] + p0.w); *(u32x2*)(o + e0) = w;
            u32x2 x; x.x = cvtpk(a1[4 * i] + p1.x, a1[4 * i + 1] + p1.y); x.y = cvtpk(a1[4 * i + 2] + p1.z, a1[4 * i + 3] + p1.w); *(u32x2*)(o + 32 + e0) = x;
        }
    }
}

constexpr int WS_IMP = 8448, WS_SELM = WS_IMP + 8 * 132 * 4, WS_BLIST = WS_SELM + 8 * 4 * 8, WS_OT = 13568, WS_PT = WS_OT + 4096;
static_assert(KT_OFF + 4096 <= WS_IMP && WS_BLIST + 132 * 4 <= WS_OT && WS_PT + 256 <= WSCR, "per-wave scratch map");
template <bool SAMPLE>
__device__ __forceinline__ void nsa_item(const Frame& F, int item) {
    typedef typename std::conditional<SAMPLE, float, bf16_t>::type KT;
    const int lane = F.lane, r32 = lane & 31, hi = lane >> 5, qi = r32 >> 2, r = r32 & 3;
    const int g = item & 3, qt = SAMPLE ? 0 : (item >> 2) & 511, b = SAMPLE ? item >> 2 : item >> 11;
    const int t0 = 8 * qt, qp = SAMPLE ? PAST + qi : t0 + qi, qp_max = SAMPLE ? PAST + 7 : t0 + 7;
    const size_t row = SAMPLE ? (size_t)MP + b * 8 + qi : (size_t)b * SEQ + t0 + qi;
    const int head = 4 * g + r;
    const float nslope2 = -__builtin_amdgcn_exp2f(-0.5f * (float)(head + 1)) * LOG2E;
    const bf16_t* Q1 = (const bf16_t*)(F.ws + WS_Q1);
    bf16x8 qf[4];
#pragma unroll
    for (int d0 = 0; d0 < 4; ++d0) qf[d0] = *(const bf16x8*)(Q1 + row * D + head * 64 + 16 * d0 + 8 * hi);
    const float* gp = (const float*)(F.ws + WS_G1) + row * 48 + head * 3;
    const float g_cmp = gp[0], g_sel = gp[1], g_win = gp[2];
    LAS unsigned char* vt = F.wscr;
    LAS float* imp = (LAS float*)(F.wscr + WS_IMP);
    LAS unsigned long long* selm = (LAS unsigned long long*)(F.wscr + WS_SELM);
    LAS int* blist = (LAS int*)(F.wscr + WS_BLIST);
    constexpr int NC = SAMPLE ? NCS : NCP, NCH = SAMPLE ? 3 : 1;
    LAS u32x2* otl = (LAS u32x2*)(F.wscr + WS_OT) + lane;
    for (int i = lane; i < 8 * 132; i += 64) imp[i] = 0.f;

    const bf16_t* KC = SAMPLE ? (const bf16_t*)(F.ws + WS_KCS) + (size_t)b * 512 * 512 + g * 64 : (const bf16_t*)(F.ws + WS_KCP) + (size_t)b * 256 * 512 + g * 64;
    const int ncv = qp_max >= 31 ? (((qp_max - 31) >> 4) + 1 < NC ? ((qp_max - 31) >> 4) + 1 : NC) : 0;
    const int nct = (ncv + 31) >> 5;
    auto rpc = [&](int t, int key) -> const bf16_t* { int n = 32 * t + key; n = n < NC ? n : NC - 1; return KC + (size_t)n * 512; };
    auto mkc = [&](int t, f32x16& s, float sh) { bias_mask<16, 2>(s, (float)(qp - 31 - 512 * t), nslope2, 0.f, 1e30f, hi, sh); };
    AttnAcc A; acc_init(A);
    attn_run<bf16_t, 1, 256>(A, qf, 0, nct, vt, lane, rpc, mkc);
    {
        A.m = (A.m == NEG_INF) ? 0.f : A.m; A.l = A.l > 0.f ? 1.f / A.l : 0.f;
        auto hkc = [&](int t, const f32x16& p) {
#pragma unroll
            for (int i = 0; i < 4; ++i) {
                float p3 = p[4 * i + 3]; float a = 2.f * ((p[4 * i] + p[4 * i + 1]) + p[4 * i + 2]) + p3;
                a += __shfl_xor(a, 1); a += __shfl_xor(a, 2); p3 += __shfl_xor(p3, 1); p3 += __shfl_xor(p3, 2);
                if (r == 0) { const int J = 8 * t + 2 * i + hi; __hip_atomic_fetch_add(&imp[J * 8 + qi], a, __ATOMIC_RELAXED, __HIP_MEMORY_SCOPE_WORKGROUP); __hip_atomic_fetch_add(&imp[(J + 1) * 8 + qi], p3, __ATOMIC_RELAXED, __HIP_MEMORY_SCOPE_WORKGROUP); }
            } };
        attn_run<bf16_t, 2, 256>(A, qf, 0, nct, vt, lane, rpc, mkc, hkc);
#pragma unroll
        for (int j = 0; j < 4; ++j) {
            u32x2 w; w.x = cvtpk(A.o0[4 * j] * g_cmp, A.o0[4 * j + 1] * g_cmp); w.y = cvtpk(A.o0[4 * j + 2] * g_cmp, A.o0[4 * j + 3] * g_cmp); otl[64 * j] = w;
            u32x2 x; x.x = cvtpk(A.o1[4 * j] * g_cmp, A.o1[4 * j + 1] * g_cmp); x.y = cvtpk(A.o1[4 * j + 2] * g_cmp, A.o1[4 * j + 3] * g_cmp); otl[64 * (4 + j)] = x; }
    }
    asm volatile("s_waitcnt lgkmcnt(0)" ::: "memory");
    const int cb = qp_max >> 6;
    for (int idx = lane; idx < 8 * (cb + 1); idx += 64) { const int j = idx >> 3; if (j == 0 || j >= cb - 1) imp[idx] += 1000.f; }
    asm volatile("s_waitcnt lgkmcnt(0)" ::: "memory");
    {
        f32x4 sj[NCH][2]; int rank[NCH][8];
#pragma unroll
        for (int c2 = 0; c2 < NCH; ++c2) { int j = lane + 64 * c2; j = j <= cb ? j : cb; sj[c2][0] = *(const LAS f32x4*)(imp + j * 8); sj[c2][1] = *(const LAS f32x4*)(imp + j * 8 + 4);
#pragma unroll
            for (int q = 0; q < 8; ++q) rank[c2][q] = 0; }
#pragma unroll 2
        for (int i = 0; i <= cb; ++i) {
            const f32x4 v0 = *(const LAS f32x4*)(imp + i * 8), v1 = *(const LAS f32x4*)(imp + i * 8 + 4);
#pragma unroll
            for (int c2 = 0; c2 < NCH; ++c2) { const bool lower = i < lane + 64 * c2;
#pragma unroll
                for (int q = 0; q < 8; ++q) { const float vi = q < 4 ? v0[q & 3] : v1[q & 3], vj = q < 4 ? sj[c2][0][q & 3] : sj[c2][1][q & 3];
                    rank[c2][q] += ((vi > vj) | ((vi == vj) & lower)) ? 1 : 0; } }
        }
#pragma unroll
        for (int c2 = 0; c2 < NCH; ++c2) { const bool cand = lane + 64 * c2 <= cb;
#pragma unroll
            for (int q = 0; q < 8; ++q) { const unsigned long long mask = __ballot(cand && rank[c2][q] < 16); if (lane == 0) selm[q * 4 + c2] = mask; } }
    }
    asm volatile("s_waitcnt lgkmcnt(0)" ::: "memory");
    unsigned long long mym0 = 0ull, mym1 = 0ull, mym2 = 0ull; int nblk = 0;
#pragma unroll
    for (int c2 = 0; c2 < NCH; ++c2) { const unsigned long long mine = selm[qi * 4 + c2]; unsigned long long u = 0;
        if (c2 == 0) mym0 = mine; else if (c2 == 1) mym1 = mine; else mym2 = mine;
#pragma unroll
        for (int q = 0; q < 8; ++q) u |= selm[q * 4 + c2];
        const int j = lane + 64 * c2; const bool in = (u >> lane) & 1ull;
        const int pos = nblk + __popcll(u & ((1ull << lane) - 1ull));
        if (in) blist[pos] = j;
        nblk += __popcll(u); }
    asm volatile("s_waitcnt lgkmcnt(0)" ::: "memory");
    nblk = __builtin_amdgcn_readfirstlane(nblk);
    {
        const KT* sbase; LAS int* pt = (LAS int*)(F.wscr + WS_PT);
        if constexpr (SAMPLE) { pt[lane] = ((const int*)F.a->in[8])[b * NPG + lane]; asm volatile("s_waitcnt lgkmcnt(0)" ::: "memory"); }
        if constexpr (SAMPLE) sbase = (const float*)F.a->in[7] + g * 64; else sbase = (const bf16_t*)(F.ws + WS_KVSEL) + (size_t)b * SEQ * 512 + g * 64;
        const float* snew = F.out + O_SELS + (size_t)b * 8 * 512 + g * 64;
        auto rps = [&](int t, int key) -> const KT* {
            const int J = blist[t >> 1]; const int tok = 64 * J + 32 * (t & 1) + key;
            if constexpr (SAMPLE) { const int tk = tok < PAST ? tok : PAST - 1; const int pg = pt[tk >> 7]; const KT* p0 = sbase + ((size_t)pg * PAGE + (tk & 127)) * 512;
                int i2 = tok - PAST; i2 = i2 < 0 ? 0 : (i2 > 7 ? 7 : i2); const KT* p1 = (const KT*)(snew + (size_t)i2 * 512); return tok < PAST ? p0 : p1; }
            else return sbase + (size_t)tok * 512; };
        auto mks = [&](int t, f32x16& s, float sh) {
            const int J = blist[t >> 1]; bool sel = (mym0 >> (J & 63)) & 1ull; if constexpr (SAMPLE) { const bool s1 = (mym1 >> (J & 63)) & 1ull, s2 = (mym2 >> (J & 63)) & 1ull; sel = J < 64 ? sel : (J < 128 ? s1 : s2); } const int tb = 64 * J + 32 * (t & 1);
            const float base = sel ? sh : NEG_INF, dq = (float)(qp - tb);
            if (J < cb) bias_mask<1, false>(s, dq, nslope2, 0.f, 0.f, hi, base);
            else bias_mask<1, 2>(s, dq, nslope2, 0.f, 1e30f, hi, base); };
        acc_init(A);
        attn_run<KT, 0, 256, SAMPLE ? 1 : 2>(A, qf, 0, 2 * nblk, vt, lane, rps, mks);
        const float sc = g_sel / fmaxf(A.l, 1e-30f);
#pragma unroll
        for (int j = 0; j < 4; ++j) {
            const u32x2 a = otl[64 * j], c = otl[64 * (4 + j)];
            u32x2 w; w.x = cvtpk(A.o0[4 * j] * sc + __uint_as_float(a.x << 16), A.o0[4 * j + 1] * sc + __uint_as_float(a.x & 0xffff0000u)); w.y = cvtpk(A.o0[4 * j + 2] * sc + __uint_as_float(a.y << 16), A.o0[4 * j + 3] * sc + __uint_as_float(a.y & 0xffff0000u)); otl[64 * j] = w;
            u32x2 x; x.x = cvtpk(A.o1[4 * j] * sc + __uint_as_float(c.x << 16), A.o1[4 * j + 1] * sc + __uint_as_float(c.x & 0xffff0000u)); x.y = cvtpk(A.o1[4 * j + 2] * sc + __uint_as_float(c.y << 16), A.o1[4 * j + 3] * sc + __uint_as_float(c.y & 0xffff0000u)); otl[64 * (4 + j)] = x; }
    }
    {
        acc_init(A);
        if constexpr (SAMPLE) {
            const float* wc = (const float*)F.a->in[5] + (size_t)b * 512 * 512 + g * 64; const float* wn = F.out + O_WINS + (size_t)b * 512 * 512 + g * 64;
            auto rpw = [&](int t, int key) -> const float* { int c = 32 * t + key; c = c > 519 ? 519 : c; return c < 512 ? wc + (size_t)c * 512 : wn + (size_t)(c - 8) * 512; };
            auto mkw = [&](int t, f32x16& s, float sh) { bias_mask<1, true>(s, (float)(512 + qi - 32 * t), nslope2, 0.f, (float)WIN, hi, sh); };
            attn_run<float, 0, 256>(A, qf, 0, 17, vt, lane, rpw, mkw);
        } else {
            const bf16_t* wb = (const bf16_t*)(F.ws + WS_KVWIN) + (size_t)b * SEQ * 512 + g * 64;
            const int tlo = (t0 - WIN > 0 ? t0 - WIN : 0) >> 5, thi = (t0 + 7) >> 5;
            auto rpw = [&](int t, int key) -> const bf16_t* { return wb + (size_t)(32 * t + key) * 512; };
            auto mkw = [&](int t, f32x16& s, float sh) { const float dq = (float)(qp - 32 * t);
                if (32 * t + 31 <= t0 && 32 * t >= t0 + 7 - WIN) bias_mask<1, false>(s, dq, nslope2, 0.f, 0.f, hi, sh);
                else bias_mask<1, true>(s, dq, nslope2, 0.f, (float)WIN, hi, sh); };
            attn_run<bf16_t, 0, 256, 2>(A, qf, tlo, thi + 1, vt, lane, rpw, mkw);
        }
        const float sc = g_win / fmaxf(A.l, 1e-30f);
#pragma unroll
        for (int j = 0; j < 4; ++j) { const u32x2 a = otl[64 * j], c = otl[64 * (4 + j)];
            A.o0[4 * j] = A.o0[4 * j] * sc + __uint_as_float(a.x << 16); A.o0[4 * j + 1] = A.o0[4 * j + 1] * sc + __uint_as_float(a.x & 0xffff0000u);
            A.o0[4 * j + 2] = A.o0[4 * j + 2] * sc + __uint_as_float(a.y << 16); A.o0[4 * j + 3] = A.o0[4 * j + 3] * sc + __uint_as_float(a.y & 0xffff0000u);
            A.o1[4 * j] = A.o1[4 * j] * sc + __uint_as_float(c.x << 16); A.o1[4 * j + 1] = A.o1[4 * j + 1] * sc + __uint_as_float(c.x & 0xffff0000u);
            A.o1[4 * j + 2] = A.o1[4 * j + 2] * sc + __uint_as_float(c.y << 16); A.o1[4 * j + 3] = A.o1[4 * j + 3] * sc + __uint_as_float(c.y & 0xffff0000u); }
    }
    store_o((bf16_t*)(F.ws + WS_O) + row * D + head * 64, A.o0, A.o1, 1.f, hi);
}

__device__ __forceinline__ void final_norm_row(float* y, const float* ssp, const float* g, int row, int lane) {
    const float rs = pg8::row_rstd(ssp, row);
    f32x4* yr = (f32x4*)(y + (size_t)row * D) + lane; const f32x4* gr = (const f32x4*)g + lane;
#pragma unroll
    for (int j = 0; j < 4; ++j) { const f32x4 v = yr[64 * j], gg = gr[64 * j]; yr[64 * j] = v * rs * gg; }
}

template <bool FINAL>
__device__ __forceinline__ void sample_finalize_row(const float* slab, int ns, const float* res, float* Y, bf16_t* Aout, const float* gain, float* ssp, int r, int lane) {
    f32x4 y[4]; float ss = 0.f;
#pragma unroll
    for (int j = 0; j < 4; ++j) y[j] = *((const f32x4*)(res + (size_t)r * D) + lane + 64 * j);
#pragma unroll 4
    for (int sl = 0; sl < ns; ++sl) {
#pragma unroll
        for (int j = 0; j < 4; ++j) y[j] += *((const f32x4*)(slab + ((size_t)sl * MS + r) * D) + lane + 64 * j); }
#pragma unroll
    for (int j = 0; j < 4; ++j) ss += (y[j].x * y[j].x + y[j].y * y[j].y) + (y[j].z * y[j].z + y[j].w * y[j].w);
    ss = wave_sum(ss);
    if (FINAL) { const float rs = 1.f / sqrtf(ss * (1.f / D) + EPS);
#pragma unroll
        for (int j = 0; j < 4; ++j) *((f32x4*)(Y + (size_t)r * D) + lane + 64 * j) = y[j] * rs * *((const f32x4*)gain + lane + 64 * j); }
    else {
#pragma unroll
        for (int j = 0; j < 4; ++j) { *((f32x4*)(Y + (size_t)r * D) + lane + 64 * j) = y[j];
            u32x2 w; w.x = cvtpk(y[j].x, y[j].y); w.y = cvtpk(y[j].z, y[j].w); *((u32x2*)(Aout + (size_t)r * D) + lane + 64 * j) = w; }
        if (lane < 16) ssp[(size_t)(MP + r) * 16 + lane] = lane == 0 ? ss : 0.f; }
}
__device__ __forceinline__ unsigned q_issue(unsigned* ctr, int lane) { unsigned v = 0u; if (lane == 0) v = __hip_atomic_fetch_add(ctr, 1u, __ATOMIC_RELAXED, __HIP_MEMORY_SCOPE_AGENT); return v; }
__device__ __forceinline__ int q_item(unsigned tk, int shard) { return (int)__builtin_amdgcn_readfirstlane(tk) * 8 + shard; }
constexpr int N_PHASES = 17;
#ifndef ONE_LAUNCH
#define ONE_LAUNCH 1
#endif
#define PH_BEGIN \
    const Args* ap_ = &args; size_t z_ = 0; asm volatile("" : "+s"(z_)); \
    Frame F; F.lds = (LAS unsigned char*)lds_raw; F.tid = threadIdx.x; F.lane = F.tid & 63; F.wave = __builtin_amdgcn_readfirstlane(F.tid >> 6); \
    F.G = gridDim.x; { const int vcu_ = (F.G % 8 == 0) ? ((int)blockIdx.x % 8) * (F.G / 8) + (int)blockIdx.x / 8 : (int)blockIdx.x; F.gw = vcu_ * NWAVES + F.wave; } F.NGW = F.G * NWAVES; \
    F.wscr = F.lds + F.wave * WSCR; F.ws = ap_->ws + z_; F.out = ap_->out + z_; F.a = ap_; \
    unsigned char* ws = F.ws; float* out = F.out; unsigned* ctl = (unsigned*)(ws + WS_CTL); float* ssp = (float*)(ws + WS_SSP); \
    const float* norm_mix = (const float*)ap_->in[9] + z_; const float* norm_ffn = (const float*)ap_->in[10] + z_; const float* norm_out = (const float*)ap_->in[11] + z_; \
    (void)ctl; (void)ssp; (void)norm_mix; (void)norm_ffn; (void)norm_out; (void)out;
__global__ void __launch_bounds__(NWAVES * 64, 2) fwd(Args args) {
    extern __shared__ __attribute__((aligned(16))) unsigned char lds_raw[];
    volatile LAS unsigned* MISC = (volatile LAS unsigned*)((LAS unsigned char*)lds_raw + MISC_OFF);
    if (threadIdx.x < 16) MISC[threadIdx.x] = 0u;
    __syncthreads();
    const int lo = args.ph_lo, hi = args.ph_hi;
    const bool multi = (hi - lo) > 1;
    if (multi) (void)xcd_barrier_post((unsigned*)(args.ws + WS_CTL) + CW_BAR, MISC);
#ifndef ONLY_PHASE
#define ONLY_PHASE -1
#endif
#define IN(k) ((ONLY_PHASE < 0 || ONLY_PHASE == (k)) && lo <= (k) && (k) < hi)
#define SEAM(k) do { if (IN(k) && IN((k) + 1)) { XcdBarrier bar_; bar_.bar = (unsigned*)(args.ws + WS_CTL) + CW_BAR; bar_.x = xb_xcc_id(); bar_.st = MISC; xcd_barrier(bar_); } } while (0)

#define GEMM_N1024(Aptr, Wptr, KFULL, RESF, RBF16) do { \
        { pg8::Gemm g{(const bf16_t*)(Aptr), (const bf16_t*)(Wptr), MP, D, (KFULL), (KFULL)}; \
          pg8::StaticOrder S; S.init(MP, D, F.G, (int)blockIdx.x); \
          pg8::EpiRes<RBF16> E{(RESF), (bf16_t*)(ws + WS_XN), nullptr, ssp}; \
          pg8::gemm_phase<pg8::EpiRes<RBF16>, pg8::StaticOrder, true, true>(F.lds, g, S, E); } } while (0)
#define DEFERRED_SAMPLE(Aptr, Wptr, KFULL, RESS, AOUT, GAIN, INST) do { \
        constexpr int ns_ = (KFULL) / 256; const int mu = (int)blockIdx.x - (F.G - 4 * ns_); \
        if (mu >= 0) { const int sl = mu >> 2; int ks_ = 256; asm volatile("" : "+s"(ks_)); \
          pg8::Gemm g{(const bf16_t*)(Aptr) + sl * 256, (const bf16_t*)(Wptr) + sl * 256, M, D, ks_, (KFULL)}; \
          pg8::OneUnit S{MP / 256, mu & 3}; \
          pg8::EpiSlab E{(float*)(ws + WS_SLAB) + (size_t)sl * MS * D}; \
          pg8::gemm_phase<pg8::EpiSlab, pg8::OneUnit, true, true>(F.lds, g, S, E); \
          subgrid_rendezvous(ctl + CW_SR + 64 * (INST), 4 * ns_, ctl + CW_BAR); \
          for (int r = mu * NWAVES + F.wave; r < MS; r += 4 * ns_ * NWAVES) \
              sample_finalize_row<false>((const float*)(ws + WS_SLAB), ns_, (RESS), out + O_YS, (AOUT) + (size_t)MP * D, (GAIN), ssp, r, F.lane); \
          asm volatile("s_waitcnt vmcnt(0)" ::: "memory"); \
          __syncthreads(); \
          if (threadIdx.x == 0) { __builtin_amdgcn_fence(__ATOMIC_RELEASE, "agent"); asm volatile("s_waitcnt vmcnt(0)" ::: "memory"); (void)xb_add(ctl + CW_SR + 64 * (4 + (INST)), 1u); } } } while (0)
#define GATED_ORDER(S, MROWS, NCOLS, KFULL, INST) pg8::GatedOrder S; S.init((MROWS), (NCOLS), F.G, (int)blockIdx.x); S.flag = ctl + CW_SR + 64 * (4 + (INST)); S.need = 4 * ((KFULL) / 256); S.bar = ctl + CW_BAR

    if (IN(0)) { PH_BEGIN p0_prologue(F); }
    SEAM(0);
    if (IN(1)) { PH_BEGIN
        pg8::Gemm g{(const bf16_t*)(ws + WS_XN), (const bf16_t*)(ws + WS_WIN0), M, AB_IN, D, D};
        pg8::StaticOrder S; S.init(M, AB_IN, F.G, (int)blockIdx.x);
        pg8::EpiIn0 E{(bf16_t*)(ws + WS_QD), (bf16_t*)(ws + WS_KVD), (float*)(ws + WS_XR), (bf16_t*)(ws + WS_GT), out};
        pg8::gemm_phase<pg8::EpiIn0, pg8::StaticOrder, true, true>(F.lds, g, S, E);
        {
            constexpr int units = (M / 256) * (AB_IN / 256); const int nfull = units % F.G, nbg = nfull ? F.G - nfull : F.G;
            const int me = (int)blockIdx.x - (F.G - nbg);
            if (me >= 0) { __syncthreads(); for (int it = WT_T4 + me * NWAVES + F.wave; it < WT_T9; it += nbg * NWAVES) weight_transpose_item(F, it); }
        }
        if ((int)blockIdx.x == F.G - 1 && F.wave < 2) {
            const float* pp = (const float*)(ws + WS_PETP) + (size_t)F.wave * 32 * 64 + F.lane; float acc = 0.f;
#pragma unroll
            for (int l = 0; l < 32; ++l) acc += pp[l * 64];
            ((float*)(ws + WS_PET))[F.wave * 64 + F.lane] = acc;
        }
    }
    SEAM(1);
    if (IN(2)) { PH_BEGIN
        constexpr int ND = 32, NGL = 256, NL = ND + NGL * 6 + 32;
        unsigned* qc = ctl + CW_Q2 + 64 * ((int)blockIdx.x & 7); const int shard = (int)blockIdx.x & 7;
        for (int k = (int)__builtin_amdgcn_readfirstlane(q_issue(qc, F.lane)); k < NL; ) {
            const unsigned tk = q_issue(qc, F.lane);
            Frame Fi = F; { size_t zz = 0; asm volatile("" : "+s"(zz)); Fi.ws += zz; Fi.out += zz; }
            if (k < ND) dil_item_sample(Fi, k * 8 + shard);
            else if (k >= ND + NGL * 6) rglru_gates_item<true>(Fi, (k - ND - NGL * 6) * 8 + shard);
            else { const int i2 = k - ND, gl = i2 / 6, slot = i2 - gl * 6;
                if (slot < 2) compress_item<true>(Fi, (2 * gl + slot) * 8 + shard);
                else { const int kd = 2 * gl + (slot & 1);
                    const int item = (((kd >> 3) * 8 + shard) << 3) | (kd & 7);
                    if (slot < 4) dil_item_prompt(Fi, item); else rglru_gates_item<false>(Fi, item); } }
            k = (int)__builtin_amdgcn_readfirstlane(tk);
        }
    }
    SEAM(2);
    if (IN(3)) { PH_BEGIN
        for (int it = F.gw; it < 2048 + 256; it += F.NGW) { if (it < 2048) rglru_scan_item<false>(F, it); else rglru_scan_item<true>(F, it - 2048); }
    }
    SEAM(3);
    if (IN(4)) { PH_BEGIN GEMM_N1024(ws + WS_O, ws + WS_WOUT0, D, (const float*)args.in[0], false); }
    SEAM(4);
    if (IN(6)) { PH_BEGIN
        DEFERRED_SAMPLE(ws + WS_O, ws + WS_WOUT0, D, (const float*)args.in[1], (bf16_t*)(ws + WS_XN), norm_ffn, 0);
        pg8::Gemm g{(const bf16_t*)(ws + WS_XN), (const bf16_t*)(ws + WS_W13_0), M, FF2, D, D};
        GATED_ORDER(S, M, FF2, D, 0);
        pg8::EpiUp E{ssp, (bf16_t*)(ws + WS_H)};
        pg8::gemm_phase<pg8::EpiUp, pg8::GatedOrder, true, true>(F.lds, g, S, E);
    }
    SEAM(6);
    if (IN(7)) { PH_BEGIN GEMM_N1024(ws + WS_H, ws + WS_W2_0, FF, nullptr, true); }
    SEAM(7);
    if (IN(9)) { PH_BEGIN
        DEFERRED_SAMPLE(ws + WS_H, ws + WS_W2_0, FF, out + O_YS, (bf16_t*)(ws + WS_XN), norm_mix + D, 1);
        pg8::Gemm g{(const bf16_t*)(ws + WS_XN), (const bf16_t*)(ws + WS_WIN1), M, C_IN_PAD, D, D};
        GATED_ORDER(S, M, C_IN_PAD, FF, 1);
        pg8::EpiIn1 E{ssp, (bf16_t*)(ws + WS_Q1), (bf16_t*)(ws + WS_KVSEL), (bf16_t*)(ws + WS_KVWIN), (float*)(ws + WS_G1), out};
        pg8::gemm_phase<pg8::EpiIn1, pg8::GatedOrder, true, true>(F.lds, g, S, E);
    }
    SEAM(9);
    if (IN(10)) { PH_BEGIN
        for (int it = (int)blockIdx.x; it < 4 * 8 * 8; it += F.G) compress_item<false, true>(F, it);
    }
    SEAM(10);
    if (IN(11)) { PH_BEGIN
        unsigned* qc = ctl + CW_Q9 + 64 * ((int)blockIdx.x & 7); const int shard = (int)blockIdx.x & 7;
        if (F.wave == 7) for (int it = (int)blockIdx.x; it < NDC + NWC; it += F.G) copy_item(F, it);
        for (int it = q_item(q_issue(qc, F.lane), shard); it < 128 + 8192; ) {
            const unsigned tk = q_issue(qc, F.lane);
            if (it < 128) nsa_item<true>(F, it);
            else { const int p = it - 128, qt = 511 - (p >> 4), bg = p & 15; nsa_item<false>(F, ((bg >> 2) << 11) | (qt << 2) | (bg & 3)); }
            it = q_item(tk, shard);
        }
    }
    SEAM(11);
    if (IN(12)) { PH_BEGIN GEMM_N1024(ws + WS_O, ws + WS_WOUT1, D, nullptr, true); }
    SEAM(12);
    if (IN(14)) { PH_BEGIN
        DEFERRED_SAMPLE(ws + WS_O, ws + WS_WOUT1, D, out + O_YS, (bf16_t*)(ws + WS_XN), norm_ffn + D, 2);
        pg8::Gemm g{(const bf16_t*)(ws + WS_XN), (const bf16_t*)(ws + WS_W13_1), M, FF2, D, D};
        GATED_ORDER(S, M, FF2, D, 2);
        pg8::EpiUp E{ssp, (bf16_t*)(ws + WS_H)};
        pg8::gemm_phase<pg8::EpiUp, pg8::GatedOrder, true, true>(F.lds, g, S, E);
    }
    SEAM(14);
    if (IN(15)) { PH_BEGIN
        if (F.G == MP / 256 * 4) {
            pg8::Gemm g{(const bf16_t*)(ws + WS_H), (const bf16_t*)(ws + WS_W2_1), MP, D, FF, FF};
            pg8::StaticOrder S; S.init(MP, D, F.G, (int)blockIdx.x);
            pg8::EpiResNorm E{(const bf16_t*)(ws + WS_XN), out + O_YP, norm_out, (float*)(ws + WS_XSL), ctl + CW_PN, ctl + CW_BAR + XB_TMO};
            pg8::gemm_phase<pg8::EpiResNorm, pg8::StaticOrder, true, true>(F.lds, g, S, E);
        } else {
            pg8::Gemm g{(const bf16_t*)(ws + WS_H), (const bf16_t*)(ws + WS_W2_1), MP, D, FF, FF};
            pg8::StaticOrder S; S.init(MP, D, F.G, (int)blockIdx.x);
            pg8::EpiRes<true, true> E{nullptr, (bf16_t*)(ws + WS_XN), out + O_YP, ssp};
            pg8::gemm_phase<pg8::EpiRes<true, true>, pg8::StaticOrder, true, true>(F.lds, g, S, E);
        }
        if ((int)blockIdx.x < 4 * (FF / 256)) { const int mu = (int)blockIdx.x; const int sl = mu >> 2;
            pg8::Gemm g{(const bf16_t*)(ws + WS_H) + sl * 256, (const bf16_t*)(ws + WS_W2_1) + sl * 256, M, D, 256, FF};
            pg8::OneUnit S{MP / 256, mu & 3};
            pg8::EpiSlab E{(float*)(ws + WS_SLAB) + (size_t)sl * MS * D};
            pg8::gemm_phase<pg8::EpiSlab, pg8::OneUnit, true, true>(F.lds, g, S, E);
            subgrid_rendezvous(ctl + CW_SR + 64 * 3, 4 * (FF / 256), ctl + CW_BAR);
            for (int r = mu * NWAVES + F.wave; r < MS; r += 4 * (FF / 256) * NWAVES)
                sample_finalize_row<true>((const float*)(ws + WS_SLAB), FF / 256, out + O_YS, out + O_YS, nullptr, norm_out, ssp, r, F.lane); }
    }
    if (gridDim.x != MP / 256 * 4) {
        SEAM(15);
        if (IN(16)) { PH_BEGIN
            for (int r = F.gw; r < MP; r += F.NGW) final_norm_row(out, ssp, norm_out, r, F.lane);
        }
    }
#undef GEMM_N1024
#undef DEFERRED_SAMPLE
#undef GATED_ORDER
#undef IN
#undef SEAM
}

extern "C" void kernel_launch(void* const* d_in, const int* in_sizes, int n_in, void* d_out, int out_size, void* d_ws, size_t ws_size, hipStream_t stream) {
    static int grid = 0;
    if (grid == 0) {
        if (n_in != 28 || (size_t)out_size != O_END || ws_size < WS_END) { fprintf(stderr, "kernel_launch: unexpected shapes (n_in %d out %d ws %zu need %zu)\n", n_in, out_size, ws_size, (size_t)WS_END); grid = -1; return; }
        int dev = 0, cus = 0, per_cu = 0;
        if (hipGetDevice(&dev) != hipSuccess || hipDeviceGetAttribute(&cus, hipDeviceAttributeMultiprocessorCount, dev) != hipSuccess) { grid = -1; return; }
        if (hipFuncSetAttribute((const void*)fwd, hipFuncAttributeMaxDynamicSharedMemorySize, LDS_BYTES) != hipSuccess) { fprintf(stderr, "kernel_launch: hipFuncSetAttribute failed\n"); grid = -1; return; }
        if (hipOccupancyMaxActiveBlocksPerMultiprocessor(&per_cu, (const void*)fwd, NWAVES * 64, LDS_BYTES) != hipSuccess || per_cu < 1) { fprintf(stderr, "kernel_launch: occupancy query says %d\n", per_cu); }
        (void)hipGetLastError();
        grid = cus;
    }
    if (grid < 0) return;
    (void)hipMemsetAsync((char*)d_ws + WS_CTL, 0, CTL_ZERO_BYTES, stream);
    Args a{};
    for (int i = 0; i < 28; ++i) a.in[i] = d_in[i];
    a.out = (float*)d_out; a.ws = (unsigned char*)d_ws;
#if ONE_LAUNCH
    a.ph_lo = 0; a.ph_hi = N_PHASES; hipLaunchKernelGGL(fwd, dim3(grid), dim3(NWAVES * 64), LDS_BYTES, stream, a);
#else
    for (int p = 0; p < N_PHASES; ++p) { a.ph_lo = p; a.ph_hi = p + 1; hipLaunchKernelGGL(fwd, dim3(grid), dim3(NWAVES * 64), LDS_BYTES, stream, a); }
#endif
}
```

```cpp
#include <hip/hip_runtime.h>
#include <cstdio>
#include <cstdint>
#include <type_traits>

#define LAS __attribute__((address_space(3)))
#define GAS __attribute__((address_space(1)))
typedef unsigned short bf16_t;
typedef short bf16x8 __attribute__((ext_vector_type(8)));
typedef short s16x4 __attribute__((ext_vector_type(4)));
typedef float f32x2 __attribute__((ext_vector_type(2)));
typedef float f32x4 __attribute__((ext_vector_type(4)));
typedef float f32x16 __attribute__((ext_vector_type(16)));
typedef unsigned u32x2 __attribute__((ext_vector_type(2)));
typedef unsigned u32x4 __attribute__((ext_vector_type(4)));
typedef __bf16 bf16x2_t __attribute__((ext_vector_type(2)));

constexpr int D = 1024, BP = 4, SEQ = 4096, MP = BP * SEQ, BS = 32, TS = 8, MS = BS * TS, M = MP + MS;
constexpr int PAST = 8192, PAGE = 128, NPG = PAST / PAGE;
constexpr int AB_IN = 2560, C_IN = 2608, C_IN_PAD = 2816, FF = 2816, FF2 = 2 * FF;
constexpr int DIL_KEEP = 2048, WIN = 512;
constexpr int NCP = 255, NCS = 511;
constexpr float EPS = 1e-6f;
constexpr float LOG2E = 1.4426950408889634f;
constexpr float C_SCALE2 = 0.125f * LOG2E;

constexpr size_t O_YP = 0, O_YS = O_YP + (size_t)MP * D, O_DILP = O_YS + (size_t)MS * D, O_DILS = O_DILP + (size_t)BP * 2048 * 1024,
                 O_CONVP = O_DILS + (size_t)BS * 2048 * 1024, O_CONVS = O_CONVP + (size_t)BP * 3 * 512, O_RNNP = O_CONVS + (size_t)BS * 3 * 512,
                 O_RNNS = O_RNNP + (size_t)BP * 512, O_WINP = O_RNNS + (size_t)BS * 512, O_WINS = O_WINP + (size_t)BP * 512 * 512,
                 O_CMPP = O_WINS + (size_t)BS * 512 * 512, O_CMPS = O_CMPP + (size_t)BP * SEQ * 512, O_SELP = O_CMPS + (size_t)BS * TS * 512,
                 O_SELS = O_SELP + (size_t)BP * SEQ * 512, O_END = O_SELS + (size_t)BS * TS * 512;
static_assert(O_END == 119087104, "output size");

constexpr size_t al256(size_t x) { return (x + 255) & ~(size_t)255; }
constexpr size_t WS_CTL = 0, CTL_ZERO_BYTES = 1u << 16;
constexpr size_t WS_WIN0 = CTL_ZERO_BYTES;
constexpr size_t WS_WOUT0 = WS_WIN0 + (size_t)AB_IN * D * 2;
constexpr size_t WS_W13_0 = WS_WOUT0 + (size_t)D * D * 2;
constexpr size_t WS_W2_0 = WS_W13_0 + (size_t)FF2 * D * 2;
constexpr size_t WS_WIN1 = WS_W2_0 + (size_t)D * FF * 2;
constexpr size_t WS_WOUT1 = WS_WIN1 + (size_t)C_IN_PAD * D * 2;
constexpr size_t WS_W13_1 = WS_WOUT1 + (size_t)D * D * 2;
constexpr size_t WS_W2_1 = WS_W13_1 + (size_t)FF2 * D * 2;
constexpr size_t WS_WG = WS_W2_1 + (size_t)D * FF * 2;
constexpr size_t WS_WCT = WS_WG + (size_t)2 * 8 * 64 * 64 * 2;
constexpr size_t WS_PET = WS_WCT + (size_t)2 * 64 * 2048 * 2;
constexpr size_t WS_C8 = WS_PET + 512;
constexpr size_t WS_XN = al256(WS_C8 + 2048);
constexpr size_t WS_QD = WS_XN + (size_t)M * D * 2;
constexpr size_t WS_KVD = WS_QD + (size_t)M * 512 * 2;
constexpr size_t WS_XR = WS_KVD + (size_t)M * 1024 * 2;
constexpr size_t WS_GT = WS_XR + (size_t)M * 512 * 4;
constexpr size_t WS_AU = WS_GT + (size_t)M * 512 * 2;
constexpr size_t WS_AGG = WS_AU + (size_t)M * 1024 * 4;
constexpr size_t WS_O = WS_AGG + (size_t)4 * 128 * 1024 * 4;
constexpr size_t WS_H = WS_O + (size_t)M * D * 2;
constexpr size_t WS_SSP = WS_H + (size_t)M * FF * 2;
constexpr size_t WS_Q1 = WS_SSP + (size_t)M * 16 * 4;
constexpr size_t WS_KVSEL = WS_Q1 + (size_t)M * D * 2;
constexpr size_t WS_KVWIN = WS_KVSEL + (size_t)MP * 512 * 2;
constexpr size_t WS_G1 = WS_KVWIN + (size_t)MP * 512 * 2;
constexpr size_t WS_KCP = al256(WS_G1 + (size_t)M * 48 * 4);
constexpr size_t WS_KCS = WS_KCP + (size_t)BP * 256 * 512 * 2;
constexpr size_t WS_SLAB = WS_KCS + (size_t)BS * 512 * 512 * 2;
constexpr size_t WS_XSL = WS_SLAB + (size_t)11 * MS * D * 4;
constexpr size_t WS_PETP = WS_XSL + (size_t)MP * 4 * 4;
constexpr size_t WS_END = WS_PETP + (size_t)2 * 32 * 64 * 4;

constexpr int CW_BAR = 4096;
constexpr int CW_Q2 = 8192, CW_Q9 = 8192 + 1024;
constexpr int CW_PN = 8192 + 2048;
constexpr int CW_SR = 8192 + 2048 + 4096;
constexpr int CW_QBG = 8192 + 2048, CW_DONE = 8192 + 3072;

constexpr int RING_BYTES = 131072;
constexpr int WSCR = 18432;
constexpr int MISC_OFF = 8 * WSCR;
constexpr int LDS_BYTES = MISC_OFF + 1024;

__device__ __forceinline__ unsigned cvtpk(float lo, float hi) { f32x2 v = {lo, hi}; bf16x2_t b = __builtin_convertvector(v, bf16x2_t); return __builtin_bit_cast(unsigned, b); }
__device__ __forceinline__ float bf2f(unsigned short h) { return __uint_as_float((unsigned)h << 16); }
__device__ __forceinline__ bf16x8 pack8(f32x4 a, f32x4 b) { u32x4 w; w.x = cvtpk(a[0], a[1]); w.y = cvtpk(a[2], a[3]); w.z = cvtpk(b[0], b[1]); w.w = cvtpk(b[2], b[3]); return __builtin_bit_cast(bf16x8, w); }
__device__ __forceinline__ float wave_sum(float v) {
#pragma unroll
    for (int o = 1; o < 64; o <<= 1) v += __shfl_xor(v, o);
    return v;
}
#define LDS_WAIT() asm volatile("s_waitcnt lgkmcnt(0)" ::: "memory")
#define VM_WAIT() asm volatile("s_waitcnt vmcnt(0)" ::: "memory")

namespace pg8 {
#define PG8_LAS __attribute__((address_space(3)))
constexpr int BM = 256, BK = 64, HALF = 128, HTB = HALF * BK * 2, STAGE_BYTES = 8 * HTB, NXCD = 8, WGM = 8;
__host__ __device__ __forceinline__ int lds_byte(int r, int c) { const int st = (r >> 4) * 2 + (c >> 5), rr = r & 15, cc = c & 31, ob = rr * 64 + cc * 2; return st * 1024 + (ob ^ (((ob >> 9) & 1) << 5)); }
__host__ __device__ __forceinline__ void stage_rc(int b, int& R, int& C) { const int st = b / 1024, sb = b % 1024, swz = sb ^ (((sb >> 9) & 1) << 5); R = (st >> 1) * 16 + swz / 64; C = (st & 1) * 32 + (swz % 64) / 2; }
__host__ __device__ __forceinline__ int perm32(int rho) { const int n = rho >> 4, i = rho & 15; return 8 * (i >> 2) + 4 * n + (i & 3); }
struct Unit { int pm, pn; };
struct Gemm { const bf16_t* A; const bf16_t* Bt; int M, N, K, ld; };
struct StaticOrder {
    int nM, nN, nwg, G, c;
    __host__ __device__ void init(int M_, int N_, int G_, int c_) { nM = M_ / BM; nN = N_ / BM; nwg = nM * nN; G = G_; c = c_; }
    __host__ __device__ bool next(int i, Unit& u) const {
        const long L = (long)i * G + c; if (L >= nwg) return false;
        int wgid = (int)L; { const int q = nwg / NXCD, r = nwg % NXCD, xcd = wgid % NXCD, off = wgid / NXCD; wgid = (xcd < r ? xcd * (q + 1) : r * (q + 1) + (xcd - r) * q) + off; }
        const int nig = WGM * nN, gid = wgid / nig, fm = gid * WGM, gsz = (nM - fm) < WGM ? (nM - fm) : WGM;
        u.pm = fm + ((wgid % nig) % gsz); u.pn = (wgid % nig) / gsz; return true;
    }
    __device__ __forceinline__ void a_ready(const Unit&) const {}
    __device__ __forceinline__ void done(const Unit&) const {}
};

struct CountingOrder : StaticOrder {
    unsigned* cnt; int lane;
    __device__ __forceinline__ void done(const Unit&) const { if (lane == 0) __hip_atomic_fetch_add(cnt, 1u, __ATOMIC_RELAXED, __HIP_MEMORY_SCOPE_AGENT); }
};
struct OneUnit {
    int pm, pn;
    __host__ __device__ bool next(int i, Unit& u) const { if (i) return false; u.pm = pm; u.pn = pn; return true; }
    __device__ __forceinline__ void a_ready(const Unit&) const {}
    __device__ __forceinline__ void done(const Unit&) const {}
};
template <class Epi, class Sched, bool ALIGN_EPI = false, bool SP2 = false>
__device__ __forceinline__ void gemm_phase(PG8_LAS unsigned char* lds, const Gemm g, const Sched& S, const Epi& E) {
    const int tid = threadIdx.x, wid = __builtin_amdgcn_readfirstlane(tid >> 6), lane = tid & 63, wr = wid >> 2, wc = wid & 3, fr = lane & 15, fq = lane >> 4;
    const int K = g.K, nt = K / BK, LD = g.ld;
    unsigned voffA[2], voffB[2];
#pragma unroll
    for (int i = 0; i < 2; ++i) { int R, C; stage_rc(tid * 16 + i * 8192, R, C); const int Rb = Epi::PERM ? ((R & ~31) + perm32(R & 31)) : R;
        voffA[i] = (unsigned)(R * LD + C) * 2u; voffB[i] = (unsigned)(Rb * LD + C) * 2u; }
    const size_t kstep = (size_t)(BK * 2);
    const size_t hstep = (size_t)HALF * LD * 2;
    const size_t tstep = 2 * hstep;
    const unsigned ldsw = (unsigned)wid * 1024u;
    const int aoff = lds_byte(wr * 64 + fr, fq * 8), boff = lds_byte(wc * 32 + fr, fq * 8);
#define PG8_SA(b, h) (((b) * 2 + (h)) * HTB)
#define PG8_SB(b, h) ((4 + (b) * 2 + (h)) * HTB)
#define PG8_STAGE(bufoff, gbase, voff) do { _Pragma("unroll") for (int _i = 0; _i < 2; ++_i) \
        __builtin_amdgcn_global_load_lds((const unsigned*)((const char*)(gbase) + (voff)[_i]), (PG8_LAS unsigned*)(lds + (bufoff) + ldsw + _i * 8192), 16, 0, 0); } while (0)
#define PG8_LDA(dst, b, h) do { _Pragma("unroll") for (int m = 0; m < 4; ++m) _Pragma("unroll") for (int k = 0; k < 2; ++k) dst[m][k] = *(const PG8_LAS bf16x8*)(lds + PG8_SA(b, h) + aoff + m * 2048 + k * 1024); } while (0)
#define PG8_LDB(dst, b, h) do { _Pragma("unroll") for (int n = 0; n < 2; ++n) _Pragma("unroll") for (int k = 0; k < 2; ++k) dst[n][k] = *(const PG8_LAS bf16x8*)(lds + PG8_SB(b, h) + boff + n * 2048 + k * 1024); } while (0)
#define PG8_MMA(ai, bj, At, Bt) do { __builtin_amdgcn_s_setprio(1); _Pragma("unroll") for (int m = 0; m < 4; ++m) _Pragma("unroll") for (int n = 0; n < 2; ++n) _Pragma("unroll") for (int k = 0; k < 2; ++k) \
        acc[ai][bj][m][n] = __builtin_amdgcn_mfma_f32_16x16x32_bf16(Bt[n][k], At[m][k], acc[ai][bj][m][n], 0, 0, 0); __builtin_amdgcn_s_setprio(0); } while (0)
#define PG8_WAIT_V(n) asm volatile("s_waitcnt vmcnt(" #n ")" ::: "memory")
#define PG8_WAIT_L(n) asm volatile("s_waitcnt lgkmcnt(" #n ")" ::: "memory")
#define PG8_BAR __builtin_amdgcn_s_barrier()
#define PG8_SCHED __builtin_amdgcn_sched_barrier(0)
    Unit cur, nxt; int ui = 0;
    if (!S.next(0, cur)) return;
    f32x4 acc[2][2][4][2];
#pragma unroll
    for (int a = 0; a < 2; ++a)
#pragma unroll
        for (int b = 0; b < 2; ++b)
#pragma unroll
            for (int m = 0; m < 4; ++m)
#pragma unroll
                for (int n = 0; n < 2; ++n) acc[a][b][m][n] = (f32x4){0.f, 0.f, 0.f, 0.f};
    bf16x8 At[4][2], B0[2][2], B1[2][2];
    const char* cA = (const char*)g.A + (size_t)cur.pm * tstep; const char* cB = (const char*)g.Bt + (size_t)cur.pn * tstep;
    S.a_ready(cur);
    if constexpr (SP2) {
        PG8_STAGE(PG8_SB(0, 0), cB, voffB); PG8_STAGE(PG8_SB(0, 1), cB + hstep, voffB); PG8_STAGE(PG8_SA(0, 0), cA, voffA); PG8_STAGE(PG8_SA(0, 1), cA + hstep, voffA);
        if (wr == 1) PG8_BAR;
        PG8_WAIT_V(2); PG8_BAR;
        PG8_STAGE(PG8_SB(1, 0), cB + kstep, voffB); PG8_STAGE(PG8_SA(1, 0), cA + kstep, voffA); PG8_STAGE(PG8_SB(1, 1), cB + hstep + kstep, voffB);
        PG8_WAIT_V(6); PG8_BAR;
    } else {
        PG8_STAGE(PG8_SB(0, 0), cB, voffB); PG8_STAGE(PG8_SA(0, 0), cA, voffA); PG8_STAGE(PG8_SB(0, 1), cB + hstep, voffB); PG8_STAGE(PG8_SA(0, 1), cA + hstep, voffA);
        if (wr == 1) PG8_BAR;
        PG8_WAIT_V(4); PG8_BAR;
        PG8_STAGE(PG8_SB(1, 0), cB + kstep, voffB); PG8_STAGE(PG8_SA(1, 0), cA + kstep, voffA); PG8_STAGE(PG8_SB(1, 1), cB + hstep + kstep, voffB);
        PG8_WAIT_V(6); PG8_BAR;
    }
    for (;;) {
        const bool has_next = S.next(ui + 1, nxt);
        const char* nA = has_next ? (const char*)g.A + (size_t)nxt.pm * tstep : cA; const char* nB = has_next ? (const char*)g.Bt + (size_t)nxt.pn * tstep : cB;
        for (int t = 0; t < nt; t += 2) {
            const bool last = (t == nt - 2);
            const char* a1 = cA + (size_t)(t + 1) * kstep;
            const char* a2 = last ? nA : cA + (size_t)(t + 2) * kstep; const char* b2 = last ? nB : cB + (size_t)(t + 2) * kstep;
            const char* a3 = a2 + kstep; const char* b3 = b2 + kstep;
            if (last && has_next) S.a_ready(nxt);
            if constexpr (SP2) {
            PG8_LDB(B0, 0, 0); PG8_LDB(B1, 0, 1); PG8_SCHED; PG8_LDA(At, 0, 0); PG8_STAGE(PG8_SA(1, 1), a1 + hstep, voffA);
            PG8_WAIT_V(8); PG8_WAIT_L(0); PG8_BAR; PG8_MMA(0, 0, At, B0); PG8_MMA(0, 1, At, B1); PG8_BAR; PG8_SCHED;
            PG8_LDA(At, 0, 1); PG8_STAGE(PG8_SB(0, 0), b2, voffB); PG8_STAGE(PG8_SB(0, 1), b2 + hstep, voffB); PG8_STAGE(PG8_SA(0, 0), a2, voffA);
            PG8_WAIT_V(8); PG8_WAIT_L(0); PG8_BAR; PG8_MMA(1, 0, At, B0); PG8_MMA(1, 1, At, B1); PG8_BAR; PG8_SCHED;
            PG8_LDB(B0, 1, 0); PG8_LDB(B1, 1, 1); PG8_SCHED; PG8_LDA(At, 1, 0); PG8_STAGE(PG8_SA(0, 1), a2 + hstep, voffA);
            PG8_WAIT_V(8); PG8_WAIT_L(0); PG8_BAR; PG8_MMA(0, 0, At, B0); PG8_MMA(0, 1, At, B1); PG8_BAR; PG8_SCHED;
            PG8_LDA(At, 1, 1); PG8_STAGE(PG8_SB(1, 0), b3, voffB); PG8_STAGE(PG8_SB(1, 1), b3 + hstep, voffB); PG8_STAGE(PG8_SA(1, 0), a3, voffA);
            PG8_WAIT_V(8); PG8_WAIT_L(0); PG8_BAR; PG8_MMA(1, 0, At, B0); PG8_MMA(1, 1, At, B1); PG8_BAR; PG8_SCHED;
            } else {
            PG8_LDB(B0, 0, 0); PG8_SCHED; PG8_LDA(At, 0, 0); PG8_STAGE(PG8_SA(1, 1), a1 + hstep, voffA);
            PG8_WAIT_L(8); PG8_BAR; PG8_WAIT_L(0); PG8_MMA(0, 0, At, B0); PG8_BAR; PG8_SCHED;
            PG8_LDB(B1, 0, 1); PG8_STAGE(PG8_SB(0, 0), b2, voffB);
            PG8_BAR; PG8_WAIT_L(0); PG8_MMA(0, 1, At, B1); PG8_BAR;
            PG8_LDA(At, 0, 1); PG8_STAGE(PG8_SA(0, 0), a2, voffA);
            PG8_BAR; PG8_WAIT_L(0); PG8_MMA(1, 0, At, B0); PG8_BAR; PG8_SCHED;
            PG8_STAGE(PG8_SB(0, 1), b2 + hstep, voffB);
            PG8_WAIT_V(6); PG8_BAR; PG8_MMA(1, 1, At, B1); PG8_BAR;
            PG8_LDB(B0, 1, 0); PG8_SCHED; PG8_LDA(At, 1, 0); PG8_STAGE(PG8_SA(0, 1), a2 + hstep, voffA);
            PG8_WAIT_L(8); PG8_BAR; PG8_WAIT_L(0); PG8_MMA(0, 0, At, B0); PG8_BAR; PG8_SCHED;
            PG8_LDB(B1, 1, 1); PG8_STAGE(PG8_SB(1, 0), b3, voffB);
            PG8_BAR; PG8_WAIT_L(0); PG8_MMA(0, 1, At, B1); PG8_BAR;
            PG8_LDA(At, 1, 1); PG8_STAGE(PG8_SA(1, 0), a3, voffA);
            PG8_BAR; PG8_WAIT_L(0); PG8_MMA(1, 0, At, B0); PG8_BAR; PG8_SCHED;
            PG8_STAGE(PG8_SB(1, 1), b3 + hstep, voffB);
            PG8_WAIT_V(6); PG8_BAR; PG8_MMA(1, 1, At, B1); PG8_BAR;
            }
        }
        if constexpr (ALIGN_EPI) { if (wr == 0) PG8_BAR; }
        if constexpr (!Epi::AFTER_DRAIN) { E(acc, cur, wr, wc, fr, fq); S.done(cur); }
        if (!has_next) break;
#pragma unroll
        for (int a = 0; a < 2; ++a)
#pragma unroll
            for (int b = 0; b < 2; ++b)
#pragma unroll
                for (int m = 0; m < 4; ++m)
#pragma unroll
                    for (int n = 0; n < 2; ++n) acc[a][b][m][n] = (f32x4){0.f, 0.f, 0.f, 0.f};
        cur = nxt; cA = nA; cB = nB; ++ui;
        if constexpr (ALIGN_EPI) { if (wr == 1) PG8_BAR; }
    }
    PG8_WAIT_V(0);
    if constexpr (!ALIGN_EPI) { if (wr == 0) PG8_BAR; }
    PG8_BAR;
    if constexpr (Epi::AFTER_DRAIN) { E.fused(acc, cur, wr, wc, fr, fq, lds, wid, lane, tid); S.done(cur); }
#undef PG8_SA
#undef PG8_SB
#undef PG8_STAGE
#undef PG8_LDA
#undef PG8_LDB
#undef PG8_MMA
#undef PG8_WAIT_V
#undef PG8_WAIT_L
#undef PG8_BAR
#undef PG8_SCHED
}

typedef f32x4 Acc[2][2][4][2];

struct EpiIn0 {
    static constexpr bool PERM = true, AFTER_DRAIN = false;
    bf16_t* QD; bf16_t* KVD; float* XR; bf16_t* GT; float* out;
    __device__ __forceinline__ void operator()(const Acc& acc, const Unit& u, int wr, int wc, int fr, int fq) const {
        const int region = u.pn >> 1, cb = (u.pn & 1) * 256 + wc * 32 + 8 * fq;
#pragma unroll
        for (int ai = 0; ai < 2; ++ai)
#pragma unroll
            for (int m = 0; m < 4; ++m) {
                const int row = u.pm * BM + ai * HALF + wr * 64 + m * 16 + fr;
                const bool smp = row >= MP; const int b = smp ? (row - MP) >> 3 : row >> 12, t = smp ? (row - MP) & 7 : row & 4095;
#pragma unroll
                for (int bj = 0; bj < 2; ++bj) {
                    const int col = cb + bj * HALF; const f32x4 v0 = acc[ai][bj][m][0], v1 = acc[ai][bj][m][1];
                    if (region == 0) { *(bf16x8*)(QD + (size_t)row * 512 + col) = pack8(v0 * C_SCALE2, v1 * C_SCALE2); }
                    else if (region <= 2) { const int c = region - 1;
                        *(bf16x8*)(KVD + (size_t)row * 1024 + c * 512 + col) = pack8(v0, v1);
                        float* o = nullptr;
                        if (smp) o = out + O_DILS + ((size_t)(b * 2048 + 2040 + t) * 2 + c) * 512 + col;
                        else if (t >= 2048) o = out + O_DILP + ((size_t)(b * 2048 + t - 2048) * 2 + c) * 512 + col;
                        if (o) { *(f32x4*)o = v0; *(f32x4*)(o + 4) = v1; } }
                    else if (region == 3) { float* x = XR + (size_t)row * 512 + col; *(f32x4*)x = v0; *(f32x4*)(x + 4) = v1;
                        float* o = nullptr;
                        if (smp) { if (t >= 5) o = out + O_CONVS + (size_t)(b * 3 + t - 5) * 512 + col; }
                        else if (t >= SEQ - 3) o = out + O_CONVP + (size_t)(b * 3 + t - (SEQ - 3)) * 512 + col;
                        if (o) { *(f32x4*)o = v0; *(f32x4*)(o + 4) = v1; } }
                    else { *(bf16x8*)(GT + (size_t)row * 512 + col) = pack8(v0, v1); }
                }
            }
    }
};
}

#define XB_TMO      128
#define XB_XCNT(j)  (256  + 64 * (j))
#define XB_XSUB(j)  (1280 + 64 * (j))
#define XB_XGEN(j)  (2304 + 64 * (j))
#define XB_TOP      3328
#define XB_TOPGEN   3392
#define XCD_BAR_WORDS 3456
#define XB_SPIN_CAP (1u << 18)
__device__ __forceinline__ unsigned xb_ld(unsigned* p)              { return __hip_atomic_load(p, __ATOMIC_RELAXED, __HIP_MEMORY_SCOPE_AGENT); }
__device__ __forceinline__ unsigned xb_add(unsigned* p, unsigned v) { return __hip_atomic_fetch_add(p, v, __ATOMIC_RELAXED, __HIP_MEMORY_SCOPE_AGENT); }
__device__ __forceinline__ unsigned xb_xcc_id() { return (unsigned)__builtin_amdgcn_s_getreg((3 << 11) | 20) & 0xFu; }
#define XB_SPIN(cond, bar) do { unsigned _sp = 0; while (cond) { __builtin_amdgcn_s_sleep(1); \
    if ((++_sp & 255u) == 0u) { if (xb_ld(&(bar)[XB_TMO])) break; if (_sp > XB_SPIN_CAP) { atomicAdd(&(bar)[XB_TMO], 1u); break; } } } } while (0)
struct XcdBarrier { unsigned* bar; unsigned x; volatile LAS unsigned* st; };
__device__ __forceinline__ XcdBarrier xcd_barrier_post(unsigned* bar, volatile LAS unsigned* st) {
    XcdBarrier b; b.bar = bar; b.x = xb_xcc_id(); b.st = st;
    if (threadIdx.x == 0) (void)xb_add(&bar[XB_XCNT(b.x)], 1u);
    return b;
}
__device__ __forceinline__ void xcd_barrier_complete(unsigned* bar, unsigned x, unsigned& nloc, unsigned& nx) {
    const unsigned G = gridDim.x * gridDim.y * gridDim.z;
    unsigned sum, cnt, mine, sp = 0u;
    for (;;) {
        sum = 0u; cnt = 0u; mine = 0u;
#pragma unroll
        for (unsigned j = 0; j < 16; ++j) { const unsigned c = xb_ld(&bar[XB_XCNT(j)]); sum += c; cnt += (c > 0u) ? 1u : 0u; mine = (j == x) ? c : mine; }
        if (sum == G) break;
        __builtin_amdgcn_s_sleep(1);
        if ((++sp & 255u) == 0u) { if (xb_ld(&bar[XB_TMO])) break; if (sp > XB_SPIN_CAP) { atomicAdd(&bar[XB_TMO], 1u); break; } }
    }
    nloc = mine > 0u ? mine : 1u; nx = cnt > 0u ? cnt : 1u;
}
__device__ __forceinline__ void xcd_barrier(const XcdBarrier& b) {
    asm volatile("s_waitcnt vmcnt(0)" ::: "memory");
    __syncthreads();
    if (threadIdx.x == 0) {
        unsigned* bar = b.bar;
        __builtin_amdgcn_s_waitcnt(0);
        unsigned nloc = b.st[0], nx = b.st[1];
        if (nloc == 0u) { xcd_barrier_complete(bar, b.x, nloc, nx); b.st[0] = nloc; b.st[1] = nx; }
        const unsigned old = xb_add(&bar[XB_XSUB(b.x)], 1u);
        const unsigned gen = old / nloc;
        if (old + 1u == (gen + 1u) * nloc) {
            __builtin_amdgcn_fence(__ATOMIC_RELEASE, "agent");
            asm volatile("s_waitcnt vmcnt(0)" ::: "memory");
            const unsigned og = xb_add(&bar[XB_TOP], 1u);
            const unsigned tg = og / nx;
            if (og + 1u == (tg + 1u) * nx) xb_add(&bar[XB_TOPGEN], 1u);
            else XB_SPIN(xb_ld(&bar[XB_TOPGEN]) == tg, bar);
            __builtin_amdgcn_fence(__ATOMIC_ACQUIRE, "agent");
            xb_add(&bar[XB_XGEN(b.x)], 1u);
            asm volatile("s_waitcnt vmcnt(0)" ::: "memory");
        } else {
            XB_SPIN(xb_ld(&bar[XB_XGEN(b.x)]) == gen, bar);
            __builtin_amdgcn_fence(__ATOMIC_ACQUIRE, "agent");
            asm volatile("s_waitcnt vmcnt(0)" ::: "memory");
        }
    }
    __syncthreads();
}

__device__ __forceinline__ void subgrid_rendezvous(unsigned* cnt, unsigned n, unsigned* bar) {
    asm volatile("s_waitcnt vmcnt(0)" ::: "memory");
    __syncthreads();
    if (threadIdx.x == 0) {
        __builtin_amdgcn_fence(__ATOMIC_RELEASE, "agent");
        asm volatile("s_waitcnt vmcnt(0)" ::: "memory");
        (void)xb_add(cnt, 1u);
        XB_SPIN(xb_ld(cnt) < n, bar);
        __builtin_amdgcn_fence(__ATOMIC_ACQUIRE, "agent");
        asm volatile("s_waitcnt vmcnt(0)" ::: "memory");
    }
    __syncthreads();
}

struct Args { const void* in[28]; float* out; unsigned char* ws; int ph_lo, ph_hi; };
constexpr int NWAVES = 8;

struct Frame {
    LAS unsigned char* lds; LAS unsigned char* wscr;
    int tid, lane, wave, gw, NGW, G;
    unsigned char* ws; float* out; const Args* a;
};

__device__ __forceinline__ void transpose_item(const float* W, int K, int Nsrc, int Npad, bf16_t* WT, int mode, LAS float* scr, int item, int lane, const float* gk = nullptr) {
    const int nblk = Npad / 32, kb = item / nblk, nb = item % nblk, k0 = 64 * kb, n0 = 32 * nb;
    const int nn = n0 + (lane & 31);
    float v[32];
#pragma unroll
    for (int i = 0; i < 32; ++i) { const int kk = 2 * i + (lane >> 5); v[i] = nn < Nsrc ? __builtin_nontemporal_load(W + (size_t)(k0 + kk) * Nsrc + nn) : 0.f; }
#pragma unroll
    for (int i = 0; i < 32; ++i) { const int kk = 2 * i + (lane >> 5); scr[kk * 33 + (lane & 31)] = v[i]; }
    LDS_WAIT();
    const int c = lane & 7;
    f32x4 ga = {1.f, 1.f, 1.f, 1.f}, gb = ga;
    if (gk) { ga = *(const f32x4*)(gk + k0 + 8 * c); gb = *(const f32x4*)(gk + k0 + 8 * c + 4); }
#pragma unroll
    for (int j = 0; j < 4; ++j) { const int n = (lane >> 3) + 8 * j; const LAS float* s = scr + (8 * c) * 33 + n;
        u32x4 o; o.x = cvtpk(s[0 * 33] * ga.x, s[1 * 33] * ga.y); o.y = cvtpk(s[2 * 33] * ga.z, s[3 * 33] * ga.w); o.z = cvtpk(s[4 * 33] * gb.x, s[5 * 33] * gb.y); o.w = cvtpk(s[6 * 33] * gb.z, s[7 * 33] * gb.w);
        const int ng = n0 + n; const int drow = mode == 0 ? ng : ((ng >> 7) * 256 + (ng & 127) + (mode == 2 ? 128 : 0));
        *(u32x4*)(WT + (size_t)drow * K + k0 + 8 * c) = o; }
    LDS_WAIT();
}
__device__ __forceinline__ void rms_row_to_bf16(const float* xrow, const float* g, bf16_t* orow, int lane) {
    const f32x4* xr = (const f32x4*)xrow + lane; const f32x4* gr = (const f32x4*)g + lane;
    f32x4 v[4]; float s = 0.f;
#pragma unroll
    for (int j = 0; j < 4; ++j) { v[j] = __builtin_nontemporal_load(xr + 64 * j); s += (v[j].x * v[j].x + v[j].y * v[j].y) + (v[j].z * v[j].z + v[j].w * v[j].w); }
    const float rstd = 1.f / sqrtf(wave_sum(s) * (1.f / D) + EPS);
    u32x2* o8 = (u32x2*)orow + lane;
#pragma unroll
    for (int j = 0; j < 4; ++j) { const f32x4 gg = gr[64 * j]; u32x2 w; w.x = cvtpk(v[j].x * rstd * gg.x, v[j].y * rstd * gg.y); w.y = cvtpk(v[j].z * rstd * gg.z, v[j].w * rstd * gg.w); o8[64 * j] = w; }
}

__device__ __forceinline__ void rms_rows4_to_bf16(const float* x0, const float* x1, const float* x2, const float* x3, const float* g, bf16_t* o0, bf16_t* o1, bf16_t* o2, bf16_t* o3, int lane) {
    const float* xs[4] = {x0, x1, x2, x3}; bf16_t* os[4] = {o0, o1, o2, o3};
    f32x4 v[4][4]; float s[4];
#pragma unroll
    for (int q = 0; q < 4; ++q)
#pragma unroll
        for (int j = 0; j < 4; ++j) v[q][j] = __builtin_nontemporal_load((const f32x4*)xs[q] + lane + 64 * j);
    f32x4 gg[4];
#pragma unroll
    for (int j = 0; j < 4; ++j) gg[j] = *((const f32x4*)g + lane + 64 * j);
#pragma unroll
    for (int q = 0; q < 4; ++q) { float t = 0.f;
#pragma unroll
        for (int j = 0; j < 4; ++j) t += (v[q][j].x * v[q][j].x + v[q][j].y * v[q][j].y) + (v[q][j].z * v[q][j].z + v[q][j].w * v[q][j].w);
        s[q] = 1.f / sqrtf(wave_sum(t) * (1.f / D) + EPS); }
#pragma unroll
    for (int q = 0; q < 4; ++q)
#pragma unroll
        for (int j = 0; j < 4; ++j) { const float rstd = s[q]; u32x2 w; w.x = cvtpk(v[q][j].x * rstd * gg[j].x, v[q][j].y * rstd * gg[j].y); w.y = cvtpk(v[q][j].z * rstd * gg[j].z, v[q][j].w * rstd * gg[j].w);
            *((u32x2*)os[q] + lane + 64 * j) = w; }
}

constexpr int WT_IN0 = 16 * (AB_IN / 32), WT_O = 16 * (D / 32), WT_F = 16 * (FF / 32), WT_2 = (FF / 64) * (D / 32), WT_IN1 = 16 * (C_IN_PAD / 32);
constexpr int WT_T0 = WT_IN0, WT_T1 = WT_T0 + WT_O, WT_T2 = WT_T1 + WT_F, WT_T3 = WT_T2 + WT_F, WT_T4 = WT_T3 + WT_2, WT_T5 = WT_T4 + WT_IN1, WT_T6 = WT_T5 + WT_O, WT_T7 = WT_T6 + WT_F, WT_T8 = WT_T7 + WT_F, WT_T9 = WT_T8 + WT_2;
__device__ __forceinline__ void weight_transpose_item(const Frame& F, int it) {
    const Args& A = *F.a; LAS float* scr = (LAS float*)F.wscr; unsigned char* ws = F.ws; const int lane = F.lane;
    constexpr int T0 = WT_T0, T1 = WT_T1, T2 = WT_T2, T3 = WT_T3, T4 = WT_T4, T5 = WT_T5, T6 = WT_T6, T7 = WT_T7, T8 = WT_T8;
    {
        {
            const float* w1_0 = (const float*)A.in[25]; const float* w3_0 = (const float*)A.in[26]; const float* w2_0 = (const float*)A.in[27];
            if (it < T0) transpose_item((const float*)A.in[12], D, AB_IN, AB_IN, (bf16_t*)(ws + WS_WIN0), 0, scr, it, lane);
            else if (it < T1) transpose_item((const float*)A.in[13], D, D, D, (bf16_t*)(ws + WS_WOUT0), 0, scr, it - T0, lane);
            else if (it < T2) transpose_item(w1_0, D, FF, FF, (bf16_t*)(ws + WS_W13_0), 1, scr, it - T1, lane, (const float*)A.in[10]);
            else if (it < T3) transpose_item(w3_0, D, FF, FF, (bf16_t*)(ws + WS_W13_0), 2, scr, it - T2, lane, (const float*)A.in[10]);
            else if (it < T4) transpose_item(w2_0, FF, D, D, (bf16_t*)(ws + WS_W2_0), 0, scr, it - T3, lane);
            else if (it < T5) transpose_item((const float*)A.in[21], D, C_IN, C_IN_PAD, (bf16_t*)(ws + WS_WIN1), 0, scr, it - T4, lane, (const float*)A.in[9] + D);
            else if (it < T6) transpose_item((const float*)A.in[22], D, D, D, (bf16_t*)(ws + WS_WOUT1), 0, scr, it - T5, lane);
            else if (it < T7) transpose_item(w1_0 + (size_t)D * FF, D, FF, FF, (bf16_t*)(ws + WS_W13_1), 1, scr, it - T6, lane, (const float*)A.in[10] + D);
            else if (it < T8) transpose_item(w3_0 + (size_t)D * FF, D, FF, FF, (bf16_t*)(ws + WS_W13_1), 2, scr, it - T7, lane, (const float*)A.in[10] + D);
            else transpose_item(w2_0 + (size_t)FF * D, FF, D, D, (bf16_t*)(ws + WS_W2_1), 0, scr, it - T8, lane);
        }
    }
}
__device__ __forceinline__ void p0_prologue(const Frame& F) {
    const Args& A = *F.a;
    unsigned char* ws = F.ws;
    const int lane = F.lane;
    constexpr int X0 = WT_T4;
    constexpr int NMISC = 16 + 64 + 1;
    constexpr int R0 = X0 + NMISC;
    constexpr int NITEMS = R0 + M;
    for (int it = F.gw; it < NITEMS; it += F.NGW) {
        if (it < WT_T4) { weight_transpose_item(F, it);
        } else if (it < R0) {
            const int mi = it - X0;
            if (mi < 16) {
                const int mat = mi >> 3, n = mi & 7; const float* W = (const float*)A.in[mat ? 18 : 16] + (size_t)n * 4096;
                bf16_t* dst = (bf16_t*)(ws + WS_WG) + ((size_t)(mat * 8 + n) * 64 + lane) * 64;
#pragma unroll
                for (int k8 = 0; k8 < 8; ++k8) { const int d0 = k8 >> 1, h = k8 & 1; float v[8];
#pragma unroll
                    for (int jj = 0; jj < 8; ++jj) { const int i = 16 * d0 + 8 * (jj >> 2) + 4 * h + (jj & 3); v[jj] = W[i * 64 + lane]; }
                    u32x4 o; o.x = cvtpk(v[0], v[1]); o.y = cvtpk(v[2], v[3]); o.z = cvtpk(v[4], v[5]); o.w = cvtpk(v[6], v[7]);
                    *(u32x4*)(dst + 8 * k8) = o; }
            } else if (mi < 16 + 64) {
                const int lc = mi - 16, l = lc >> 1, c = lc & 1; const float* W = (const float*)A.in[23] + (size_t)(l * 2 + c) * 4096;
                bf16_t* dst = (bf16_t*)(ws + WS_WCT) + ((size_t)(c * 32 + l) * 4 * 2) * 512 + lane * 8;
                const int r32 = lane & 31, hi = lane >> 5;
                const float* P = (const float*)A.in[24] + (size_t)(l * 2 + c) * 64 + 8 * hi;
                float pt0 = 0.f, pt1 = 0.f;
#pragma unroll
                for (int k4 = 0; k4 < 4; ++k4) {
                    const f32x4 pa = *(const f32x4*)(P + 16 * k4), pb = *(const f32x4*)(P + 16 * k4 + 4);
#pragma unroll
                    for (int eh = 0; eh < 2; ++eh) { float v[8];
#pragma unroll
                        for (int j = 0; j < 8; ++j) v[j] = W[(16 * k4 + 8 * hi + j) * 64 + r32 + 32 * eh];
                        u32x4 o; o.x = cvtpk(v[0], v[1]); o.y = cvtpk(v[2], v[3]); o.z = cvtpk(v[4], v[5]); o.w = cvtpk(v[6], v[7]);
                        *(u32x4*)(dst + (size_t)(k4 * 2 + eh) * 512) = o;
                        const float t = ((pa.x * v[0] + pa.y * v[1]) + (pa.z * v[2] + pa.w * v[3])) + ((pb.x * v[4] + pb.y * v[5]) + (pb.z * v[6] + pb.w * v[7]));
                        if (eh) pt1 += t; else pt0 += t; }
                }
                pt0 += __shfl_xor(pt0, 32); pt1 += __shfl_xor(pt1, 32);
                ((float*)(ws + WS_PETP))[(size_t)(c * 32 + l) * 64 + lane] = hi ? pt1 : pt0;
            } else {
                const float* L = (const float*)A.in[20];
#pragma unroll
                for (int j = 0; j < 8; ++j) { const float z = -L[j * 64 + lane]; ((float*)(ws + WS_C8))[j * 64 + lane] = 8.f * (fmaxf(z, 0.f) + log1pf(expf(-fabsf(z)))); }
            }
        } else {
            const int r = it - R0;
#define XROW(r_) ((r_) < MP ? (const float*)A.in[0] + (size_t)(r_) * D : (const float*)A.in[1] + (size_t)((r_) - MP) * D)
#define OROW(r_) ((bf16_t*)(ws + WS_XN) + (size_t)(r_) * D)
            if (r + 3 * F.NGW < M) {
                rms_rows4_to_bf16(XROW(r), XROW(r + F.NGW), XROW(r + 2 * F.NGW), XROW(r + 3 * F.NGW), (const float*)A.in[9], OROW(r), OROW(r + F.NGW), OROW(r + 2 * F.NGW), OROW(r + 3 * F.NGW), lane);
                it += 3 * F.NGW;
            } else rms_row_to_bf16(XROW(r), (const float*)A.in[9], OROW(r), lane);
#undef XROW
#undef OROW
        }
    }
}
constexpr int NDC = BS * 255, NWC = BS * 32;
__device__ __forceinline__ void copy_item(const Frame& F, int ci) {
    const float* src; float* dst; const int lane = F.lane; bool half2 = true;
    if (ci < NDC) { const int b = ci / 255, ch = ci % 255; src = (const float*)F.a->in[2] + ((size_t)b * 2048 + 8) * 1024 + (size_t)ch * 8192; dst = F.out + O_DILS + (size_t)b * 2048 * 1024 + (size_t)ch * 8192; }
    else { const int c2 = ci - NDC, b = c2 >> 5, ch = c2 & 31; src = (const float*)F.a->in[5] + ((size_t)b * 512 + 8) * 512 + (size_t)ch * 8192; dst = F.out + O_WINS + (size_t)b * 512 * 512 + (size_t)ch * 8192; half2 = ch < 31; }
    f32x4 v[32];
#pragma unroll
    for (int j = 0; j < 16; ++j) v[j] = __builtin_nontemporal_load((const f32x4*)src + j * 64 + lane);
    if (half2) {
#pragma unroll
        for (int j = 16; j < 32; ++j) v[j] = __builtin_nontemporal_load((const f32x4*)src + j * 64 + lane); }
#pragma unroll
    for (int j = 0; j < 16; ++j) __builtin_nontemporal_store(v[j], (f32x4*)dst + j * 64 + lane);
    if (half2) {
#pragma unroll
        for (int j = 16; j < 32; ++j) __builtin_nontemporal_store(v[j], (f32x4*)dst + j * 64 + lane); }
}

namespace pg8 {
struct GatedOrder : StaticOrder {
    unsigned* flag; unsigned need; unsigned* bar;
    __device__ __forceinline__ void a_ready(const Unit& u) const {
        if (u.pm == MP / BM) {
            XB_SPIN(xb_ld(flag) < need, bar);
            __builtin_amdgcn_fence(__ATOMIC_ACQUIRE, "agent");
            asm volatile("s_waitcnt vmcnt(0)" ::: "memory");
        }
    }
};
__device__ __forceinline__ float row_rstd_q(const float* ssp, int row, int fq) {
    const f32x4 a = *(const f32x4*)(ssp + (size_t)row * 16 + fq * 4);
    float t = (a.x + a.y) + (a.z + a.w);
    { auto rr = __builtin_amdgcn_permlane16_swap(__float_as_uint(t), __float_as_uint(t), false, false); t = __uint_as_float(rr[0]) + __uint_as_float(rr[1]); }
    { auto rr = __builtin_amdgcn_permlane32_swap(__float_as_uint(t), __float_as_uint(t), false, false); t = __uint_as_float(rr[0]) + __uint_as_float(rr[1]); }
    return __builtin_amdgcn_rsqf(t * (1.f / D) + EPS);
}
__device__ __forceinline__ float row_rstd(const float* ssp, int row) {
    const f32x4* p = (const f32x4*)(ssp + (size_t)row * 16);
    const f32x4 a = p[0], b = p[1], c = p[2], d = p[3];
    const float s = ((a.x + a.y) + (a.z + a.w)) + ((b.x + b.y) + (b.z + b.w)) + ((c.x + c.y) + (c.z + c.w)) + ((d.x + d.y) + (d.z + d.w));
    return __builtin_amdgcn_rsqf(s * (1.f / D) + EPS);
}
__device__ __forceinline__ void unpack8(const bf16x8& v, f32x4& a, f32x4& b) {
    const u32x4 w = __builtin_bit_cast(u32x4, v);
    a = (f32x4){__uint_as_float(w.x << 16), __uint_as_float(w.x & 0xffff0000u), __uint_as_float(w.y << 16), __uint_as_float(w.y & 0xffff0000u)};
    b = (f32x4){__uint_as_float(w.z << 16), __uint_as_float(w.z & 0xffff0000u), __uint_as_float(w.w << 16), __uint_as_float(w.w & 0xffff0000u)};
}
template <bool RES_BF16, bool OUT_F32 = false>
struct EpiRes {
    static constexpr bool PERM = true, AFTER_DRAIN = false;
    const float* resF; bf16_t* Yb; float* Yf; float* ssp;
    __device__ __forceinline__ void operator()(const Acc& acc, const Unit& u, int wr, int wc, int fr, int fq) const {
        const int cb = u.pn * BM + wc * 32 + 8 * fq;
#pragma unroll
        for (int ai = 0; ai < 2; ++ai)
#pragma unroll
            for (int m = 0; m < 4; ++m) {
                const int row = u.pm * BM + ai * HALF + wr * 64 + m * 16 + fr;
                float ss = 0.f;
#pragma unroll
                for (int bj = 0; bj < 2; ++bj) {
                    const int col = cb + bj * HALF;
                    f32x4 r0, r1;
                    if (RES_BF16) unpack8(*(const bf16x8*)(Yb + (size_t)row * D + col), r0, r1);
                    else { r0 = *(const f32x4*)(resF + (size_t)row * D + col); r1 = *(const f32x4*)(resF + (size_t)row * D + col + 4); }
                    const f32x4 y0 = acc[ai][bj][m][0] + r0, y1 = acc[ai][bj][m][1] + r1;
                    if (OUT_F32) { float* yp = Yf + (size_t)row * D + col; *(f32x4*)yp = y0; *(f32x4*)(yp + 4) = y1; }
                    else *(bf16x8*)(Yb + (size_t)row * D + col) = pack8(y0, y1);
                    ss += (y0.x * y0.x + y0.y * y0.y) + (y0.z * y0.z + y0.w * y0.w) + (y1.x * y1.x + y1.y * y1.y) + (y1.z * y1.z + y1.w * y1.w);
                }
                ss += __shfl_xor(ss, 16); ss += __shfl_xor(ss, 32);
                if (fq == 0) ssp[(size_t)row * 16 + u.pn * 4 + wc] = ss;
            }
    }
};
struct EpiResNorm {
    static constexpr bool PERM = true, AFTER_DRAIN = true;
    const bf16_t* res; float* out; const float* gain; float* xslot; unsigned* cnt; unsigned* tmo;
    __device__ __forceinline__ void fused(Acc& acc, const Unit& u, int wr, int wc, int fr, int fq, PG8_LAS unsigned char* lds, int wid, int lane, int tid) const {
        PG8_LAS float* P = (PG8_LAS float*)lds;
        PG8_LAS float* S = (PG8_LAS float*)(lds + 4096);
        const int cb = u.pn * BM + wc * 32 + 8 * fq;
#pragma unroll
        for (int am = 0; am < 4; ++am) {
            const int ai = am >> 1, m0 = (am & 1) * 2;
            f32x4 r[2][2][2];
#pragma unroll
            for (int mm = 0; mm < 2; ++mm) { const bf16_t* rp = res + (size_t)(u.pm * BM + ai * HALF + wr * 64 + (m0 + mm) * 16 + fr) * D;
#pragma unroll
                for (int bj = 0; bj < 2; ++bj) unpack8(*(const bf16x8*)(rp + cb + bj * HALF), r[mm][bj][0], r[mm][bj][1]); }
#pragma unroll
            for (int mm = 0; mm < 2; ++mm) { const int m = m0 + mm; float ss = 0.f;
#pragma unroll
                for (int bj = 0; bj < 2; ++bj)
#pragma unroll
                    for (int n = 0; n < 2; ++n) { const f32x4 y = acc[ai][bj][m][n] + r[mm][bj][n]; acc[ai][bj][m][n] = y; ss += (y.x * y.x + y.y * y.y) + (y.z * y.z + y.w * y.w); }
                ss += __shfl_xor(ss, 16); ss += __shfl_xor(ss, 32);
                if (fq == 0) P[(ai * HALF + wr * 64 + m * 16 + fr) * 4 + wc] = ss; }
        }
        asm volatile("s_waitcnt lgkmcnt(0)" ::: "memory"); __builtin_amdgcn_s_barrier(); asm volatile("" ::: "memory");
        if (tid < 256) { const float t = (P[tid * 4 + 0] + P[tid * 4 + 1]) + (P[tid * 4 + 2] + P[tid * 4 + 3]);
            __hip_atomic_store((unsigned*)xslot + ((size_t)(u.pm * BM + tid) * 4 + u.pn), __float_as_uint(t), __ATOMIC_RELAXED, __HIP_MEMORY_SCOPE_AGENT); }
        asm volatile("s_waitcnt vmcnt(0)" ::: "memory");
        if (lane == 0) __hip_atomic_fetch_add(cnt + 64 * u.pm, 1u, __ATOMIC_RELAXED, __HIP_MEMORY_SCOPE_AGENT);
        if (wid == 0) {
            unsigned spins = 0;
            while ((unsigned)__builtin_amdgcn_readfirstlane(__hip_atomic_load(cnt + 64 * u.pm, __ATOMIC_RELAXED, __HIP_MEMORY_SCOPE_AGENT)) < 32u) {
                __builtin_amdgcn_s_sleep(2); if (++spins > (1u << 22)) { if (lane == 0) atomicAdd(tmo, 1u); break; } }
            __builtin_amdgcn_fence(__ATOMIC_ACQUIRE, "agent");
        }
        asm volatile("s_waitcnt vmcnt(0) lgkmcnt(0)" ::: "memory"); __builtin_amdgcn_s_barrier(); asm volatile("" ::: "memory");
        if (tid < 256) { const unsigned* sl = (const unsigned*)xslot + (size_t)(u.pm * BM + tid) * 4; float t = 0.f;
#pragma unroll
            for (int k = 0; k < 4; ++k) t += __uint_as_float(__hip_atomic_load(sl + k, __ATOMIC_RELAXED, __HIP_MEMORY_SCOPE_AGENT));
            S[tid] = __builtin_amdgcn_rsqf(t * (1.f / D) + EPS); }
        asm volatile("s_waitcnt lgkmcnt(0)" ::: "memory"); __builtin_amdgcn_s_barrier(); asm volatile("" ::: "memory");
        f32x4 g[2][2];
#pragma unroll
        for (int bj = 0; bj < 2; ++bj) { g[bj][0] = *(const f32x4*)(gain + cb + bj * HALF); g[bj][1] = *(const f32x4*)(gain + cb + bj * HALF + 4); }
#pragma unroll
        for (int ai = 0; ai < 2; ++ai)
#pragma unroll
            for (int m = 0; m < 4; ++m) { const int rl = ai * HALF + wr * 64 + m * 16 + fr; const float rs = S[rl]; float* op = out + (size_t)(u.pm * BM + rl) * D + cb;
#pragma unroll
                for (int bj = 0; bj < 2; ++bj) { *(f32x4*)(op + bj * HALF) = acc[ai][bj][m][0] * rs * g[bj][0]; *(f32x4*)(op + bj * HALF + 4) = acc[ai][bj][m][1] * rs * g[bj][1]; } }
        asm volatile("s_waitcnt lgkmcnt(0)" ::: "memory"); __builtin_amdgcn_s_barrier(); asm volatile("" ::: "memory");
    }
};
struct EpiSlab {
    static constexpr bool PERM = true, AFTER_DRAIN = false;
    float* slab;
    __device__ __forceinline__ void operator()(const Acc& acc, const Unit& u, int wr, int wc, int fr, int fq) const {
        const int cb = u.pn * BM + wc * 32 + 8 * fq;
#pragma unroll
        for (int ai = 0; ai < 2; ++ai)
#pragma unroll
            for (int m = 0; m < 4; ++m) { float* rp = slab + (size_t)(ai * HALF + wr * 64 + m * 16 + fr) * D;
#pragma unroll
                for (int bj = 0; bj < 2; ++bj) { *(f32x4*)(rp + cb + bj * HALF) = acc[ai][bj][m][0]; *(f32x4*)(rp + cb + bj * HALF + 4) = acc[ai][bj][m][1]; } }
    }
};
struct EpiUp {
    static constexpr bool PERM = true, AFTER_DRAIN = false;
    const float* ssp; bf16_t* H;
    __device__ __forceinline__ void operator()(const Acc& acc, const Unit& u, int wr, int wc, int fr, int fq) const {
        const int col = u.pn * HALF + wc * 32 + 8 * fq;
#pragma unroll
        for (int ai = 0; ai < 2; ++ai)
#pragma unroll
            for (int m = 0; m < 4; ++m) {
                const int row = u.pm * BM + ai * HALF + wr * 64 + m * 16 + fr;
                const float rs = row_rstd_q(ssp, row, fq);
                f32x4 h[2];
#pragma unroll
                for (int n = 0; n < 2; ++n) {
#pragma unroll
                    for (int e = 0; e < 4; ++e) { float a = acc[ai][0][m][n][e] * rs, b = acc[ai][1][m][n][e] * rs;
                        asm volatile("" : "+v"(a), "+v"(b));
                        h[n][e] = a * b * __builtin_amdgcn_rcpf(1.f + __expf(-a)); }
                }
                *(bf16x8*)(H + (size_t)row * FF + col) = pack8(h[0], h[1]);
            }
    }
};
struct EpiIn1 {
    static constexpr bool PERM = true, AFTER_DRAIN = false;
    const float* ssp; bf16_t* Q1; bf16_t* KVSEL; bf16_t* KVWIN; float* G1; float* out;
    __device__ __forceinline__ void operator()(const Acc& acc, const Unit& u, int wr, int wc, int fr, int fq) const {
        const int pn = u.pn;
#pragma unroll
        for (int ai = 0; ai < 2; ++ai)
#pragma unroll
            for (int m = 0; m < 4; ++m) {
                const int row = u.pm * BM + ai * HALF + wr * 64 + m * 16 + fr;
                const float rs = row_rstd_q(ssp, row, fq);
                const bool smp = row >= MP; const int b = smp ? (row - MP) >> 3 : row >> 12, t = smp ? (row - MP) & 7 : row & 4095;
#pragma unroll
                for (int bj = 0; bj < 2; ++bj) {
                    const int lc = bj * HALF + wc * 32 + 8 * fq;
                    const f32x4 v0 = acc[ai][bj][m][0] * rs, v1 = acc[ai][bj][m][1] * rs;
                    if (pn < 4) { *(bf16x8*)(Q1 + (size_t)row * D + pn * 256 + lc) = pack8(v0 * C_SCALE2, v1 * C_SCALE2); }
                    else if (pn < 6) { const int col = (pn - 4) * 256 + lc;
                        float* o = smp ? out + O_CMPS + (size_t)(row - MP) * 512 + col : out + O_CMPP + (size_t)row * 512 + col;
                        *(f32x4*)o = v0; *(f32x4*)(o + 4) = v1; }
                    else if (pn < 8) { const int col = (pn - 6) * 256 + lc;
                        float* o = smp ? out + O_SELS + (size_t)(row - MP) * 512 + col : out + O_SELP + (size_t)row * 512 + col;
                        *(f32x4*)o = v0; *(f32x4*)(o + 4) = v1;
                        if (!smp) *(bf16x8*)(KVSEL + (size_t)row * 512 + col) = pack8(v0, v1); }
                    else if (pn < 10) { const int col = (pn - 8) * 256 + lc;
                        if (!smp) *(bf16x8*)(KVWIN + (size_t)row * 512 + col) = pack8(v0, v1);
                        float* o = nullptr;
                        if (smp) o = out + O_WINS + (size_t)(b * 512 + 504 + t) * 512 + col;
                        else if (t >= SEQ - WIN) o = out + O_WINP + (size_t)(b * 512 + t - (SEQ - WIN)) * 512 + col;
                        if (o) { *(f32x4*)o = v0; *(f32x4*)(o + 4) = v1; } }
                    else { if (lc < 48) { f32x4 s0, s1;
#pragma unroll
                            for (int e = 0; e < 4; ++e) { s0[e] = __builtin_amdgcn_rcpf(1.f + __expf(-v0[e])); s1[e] = __builtin_amdgcn_rcpf(1.f + __expf(-v1[e])); }
                            float* o = G1 + (size_t)row * 48 + lc; *(f32x4*)o = s0; *(f32x4*)(o + 4) = s1; } }
                }
            }
    }
};
}

template <typename T> struct Src;
template <> struct Src<bf16_t> { typedef bf16x8 raw;
    static __device__ __forceinline__ raw ld(const bf16_t* p) { return *(const bf16x8*)p; }
    static __device__ __forceinline__ bf16x8 cv(const raw& r) { return r; } };
template <> struct Src<float> { struct raw { f32x4 a, b; };
    static __device__ __forceinline__ raw ld(const float* p) { raw r; r.a = *(const f32x4*)p; r.b = *(const f32x4*)(p + 4); return r; }
    static __device__ __forceinline__ bf16x8 cv(const raw& r) { return pack8(r.a, r.b); } };

constexpr int VT_MT = 2112;
constexpr float NEG_INF = -__builtin_inff();
struct AttnAcc { f32x16 o0, o1; float m, l; };
__device__ __forceinline__ void acc_init(AttnAcc& A) {
#pragma unroll
    for (int r = 0; r < 16; ++r) { A.o0[r] = 0.f; A.o1[r] = 0.f; }
    A.m = NEG_INF; A.l = 0.f;
}
__device__ __forceinline__ float swap32_max(float v) { auto rr = __builtin_amdgcn_permlane32_swap(__float_as_uint(v), __float_as_uint(v), false, false); return fmaxf(__uint_as_float(rr[0]), __uint_as_float(rr[1])); }
__device__ __forceinline__ float swap32_sum(float v) { auto rr = __builtin_amdgcn_permlane32_swap(__float_as_uint(v), __float_as_uint(v), false, false); return __uint_as_float(rr[0]) + __uint_as_float(rr[1]); }
__device__ __forceinline__ int crow(int r, int hi) { return (r & 3) + 8 * (r >> 2) + 4 * hi; }
typedef short v4i16_t __attribute__((ext_vector_type(4)));
__device__ __forceinline__ s16x4 vtr(const LAS unsigned char* p) { return __builtin_bit_cast(s16x4, __builtin_amdgcn_ds_read_tr16_b64_v4i16((LAS v4i16_t*)p)); }

struct VFrag { s16x4 lo[4], hh[4]; };
__device__ __forceinline__ void vt_read(VFrag& f, const LAS unsigned char* vb) {
#pragma unroll
    for (int mt = 0; mt < 2; ++mt)
#pragma unroll
        for (int ks = 0; ks < 2; ++ks) { f.lo[mt * 2 + ks] = vtr(vb + mt * VT_MT + ks * 1024); f.hh[mt * 2 + ks] = vtr(vb + mt * VT_MT + ks * 1024 + 512); }
}
__device__ __forceinline__ void pv_tile(f32x16& o0, f32x16& o1, const VFrag& f, bf16x8 pf0, bf16x8 pf1) {
#define VFR(i) (bf16x8){f.lo[i][0], f.lo[i][1], f.lo[i][2], f.lo[i][3], f.hh[i][0], f.hh[i][1], f.hh[i][2], f.hh[i][3]}
    __builtin_amdgcn_s_setprio(1);
    o0 = __builtin_amdgcn_mfma_f32_32x32x16_bf16(VFR(0), pf0, o0, 0, 0, 0);
    o0 = __builtin_amdgcn_mfma_f32_32x32x16_bf16(VFR(1), pf1, o0, 0, 0, 0);
    o1 = __builtin_amdgcn_mfma_f32_32x32x16_bf16(VFR(2), pf0, o1, 0, 0, 0);
    o1 = __builtin_amdgcn_mfma_f32_32x32x16_bf16(VFR(3), pf1, o1, 0, 0, 0);
    __builtin_amdgcn_s_setprio(0);
#undef VFR
}
__device__ __forceinline__ bf16x8 pack_p(const f32x16& p, int base) {
    u32x4 w; w.x = cvtpk(p[base + 0], p[base + 1]); w.y = cvtpk(p[base + 2], p[base + 3]); w.z = cvtpk(p[base + 4], p[base + 5]); w.w = cvtpk(p[base + 6], p[base + 7]);
    return __builtin_bit_cast(bf16x8, w);
}

constexpr float RESC_THR = 6.f;
constexpr int KT_OFF = 4352;
struct NoHook { __device__ __forceinline__ void operator()(int, const f32x16&) const {} };
template <typename T, int MODE, int VOFF, int PFD = 1, class RP, class MK, class HK = NoHook>
__device__ __forceinline__ void attn_run(AttnAcc& A, const bf16x8 (&qf)[4], int t_begin, int t_end, LAS unsigned char* vt, int lane, RP rp, MK mk, HK hk = HK()) {
    if (t_begin >= t_end) return;
    const int r32 = lane & 31, hi = lane >> 5, vkey = lane >> 3, vch = lane & 7;
    LAS unsigned char* vdst = vt + (vch >> 2) * VT_MT + vkey * 64 + (vch & 3) * 16;
    const LAS unsigned char* vb = vt + ((lane >> 4) & 1) * 32 + (lane & 3) * 8 + (4 * hi + ((lane & 15) >> 2)) * 64;
    LAS unsigned char* kt = vt + KT_OFF;
    const int kswz_w = (vkey >> 1) & 3;
    const LAS unsigned char* krd = kt + r32 * 128; const int kswz_r = (r32 >> 1) & 7;
    typedef typename Src<T>::raw raw_t;
    auto loads = [&](raw_t (&kr)[4], raw_t (&vr)[4], int tt) {
#pragma unroll
        for (int i = 0; i < 4; ++i) { const T* p_ = rp(tt, vkey + 8 * i) + 8 * vch; kr[i] = Src<T>::ld(p_); if (MODE != 1) vr[i] = Src<T>::ld(p_ + VOFF); } };
    auto tile = [&](int t, raw_t (&kr)[4], raw_t (&vr)[4], int tnext) {
        asm volatile("" ::: "memory");
#pragma unroll
        for (int i = 0; i < 4; ++i) {
            *(LAS bf16x8*)(kt + (vkey + 8 * i) * 128 + ((vch ^ (kswz_w | ((i & 1) << 2))) * 16)) = Src<T>::cv(kr[i]);
            if (MODE != 1) *(LAS bf16x8*)(vdst + i * 512) = Src<T>::cv(vr[i]);
        }
        if (tnext >= t_begin) loads(kr, vr, tnext);
        asm volatile("s_waitcnt lgkmcnt(0)" ::: "memory");
        bf16x8 kf[4];
#pragma unroll
        for (int d0 = 0; d0 < 4; ++d0) kf[d0] = *(const LAS bf16x8*)(krd + (((2 * d0 + hi) ^ kswz_r) * 16));
        VFrag vf;
        if (MODE != 1) { vt_read(vf, vb); __builtin_amdgcn_sched_barrier(0); }
        f32x16 s;
#pragma unroll
        for (int r = 0; r < 16; ++r) s[r] = 0.f;
        __builtin_amdgcn_s_setprio(1);
#pragma unroll
        for (int d0 = 0; d0 < 4; ++d0) s = __builtin_amdgcn_mfma_f32_32x32x16_bf16(kf[d0], qf[d0], s, 0, 0, 0);
        __builtin_amdgcn_s_setprio(0);
        if (MODE == 2) {
            mk(t, s, -A.m);
#pragma unroll
            for (int r = 0; r < 16; ++r) s[r] = __builtin_amdgcn_exp2f(s[r]) * A.l;
            hk(t, s);
        } else {
            const bool first = A.m == NEG_INF;
            mk(t, s, first ? 0.f : -A.m);
            float tm = fmaxf(fmaxf(s[0], s[1]), fmaxf(s[2], s[3]));
#pragma unroll
            for (int r = 4; r < 16; r += 4) tm = fmaxf(tm, fmaxf(fmaxf(s[r], s[r + 1]), fmaxf(s[r + 2], s[r + 3])));
            tm = swap32_max(tm);
            if (__any(first ? tm > NEG_INF : tm > RESC_THR)) {
                const float up = first ? tm : fmaxf(tm, 0.f);
                const float alpha = first ? 0.f : __builtin_amdgcn_exp2f(-up);
                A.l *= alpha; A.m = first ? up : A.m + up;
                const float sh = (up == NEG_INF) ? 0.f : up;
#pragma unroll
                for (int r = 0; r < 16; ++r) s[r] -= sh;
                if (MODE == 0) {
#pragma unroll
                    for (int r = 0; r < 16; ++r) { A.o0[r] *= alpha; A.o1[r] *= alpha; } }
            }
            float ps = 0.f;
#pragma unroll
            for (int r = 0; r < 16; ++r) { s[r] = __builtin_amdgcn_exp2f(s[r]); ps += s[r]; }
            A.l += swap32_sum(ps);
        }
        if (MODE != 1) {
            const bf16x8 pf0 = pack_p(s, 0), pf1 = pack_p(s, 8);
            pv_tile(A.o0, A.o1, vf, pf0, pf1);
        }
        asm volatile("" ::: "memory");
    };
    raw_t krA[4], vrA[4];
    int t = t_end - 1;
    loads(krA, vrA, t);
    if (PFD == 2) {
        raw_t krB[4], vrB[4];
        if (t - 1 >= t_begin) loads(krB, vrB, t - 1);
        while (t >= t_begin) {
            tile(t, krA, vrA, t - 2);
            if (t - 1 < t_begin) break;
            tile(t - 1, krB, vrB, t - 3);
            t -= 2;
        }
    } else {
        for (; t >= t_begin; --t) tile(t, krA, vrA, t - 1);
    }
}
template <int KS, int CHECK>
__device__ __forceinline__ void bias_mask(f32x16& s, float dq, float nslope2, float lo, float hi_, int hi, float base = 0.f) {
    const float dq2 = dq - (float)(KS * 4 * hi);
#pragma unroll
    for (int r = 0; r < 16; ++r) {
        const float d = dq2 - (float)(KS * ((r & 3) + 8 * (r >> 2)));
        float x = __builtin_fmaf(d, nslope2, s[r] + base);
        asm volatile("" : "+v"(x));
        if (CHECK == 1) { const bool ok = (d >= lo) & (d <= hi_); s[r] = ok ? x : NEG_INF; } else if (CHECK == 2) { s[r] = d >= lo ? x : NEG_INF; } else s[r] = x;
    }
}

__device__ __forceinline__ void store_o(bf16_t* orow, const f32x16& o0, const f32x16& o1, float sc, int hi) {
#pragma unroll
    for (int i = 0; i < 4; ++i) {
        u32x2 w; w.x = cvtpk(o0[4 * i] * sc, o0[4 * i + 1] * sc); w.y = cvtpk(o0[4 * i + 2] * sc, o0[4 * i + 3] * sc); *(u32x2*)(orow + 8 * i + 4 * hi) = w;
        u32x2 x; x.x = cvtpk(o1[4 * i] * sc, o1[4 * i + 1] * sc); x.y = cvtpk(o1[4 * i + 2] * sc, o1[4 * i + 3] * sc); *(u32x2*)(orow + 32 + 8 * i + 4 * hi) = x;
    }
}

__device__ __forceinline__ void dil_item_prompt(const Frame& F, int item) {
    const int lane = F.lane, r32 = lane & 31, hi = lane >> 5;
    const int j = item & 7, blk = (item >> 3) & 15, h = (item >> 7) & 7, b = item >> 10;
    const int q0 = blk * 256 + j, q = q0 + 8 * r32;
    const bf16_t* QD = (const bf16_t*)(F.ws + WS_QD); const bf16_t* KVD = (const bf16_t*)(F.ws + WS_KVD);
    const size_t rb = (size_t)b * SEQ;
    bf16x8 qf[4];
#pragma unroll
    for (int d0 = 0; d0 < 4; ++d0) qf[d0] = *(const bf16x8*)(QD + (rb + q) * 512 + h * 64 + 16 * d0 + 8 * hi);
    const float nslope2 = -__builtin_amdgcn_exp2f(-(float)(h + 1)) * LOG2E; const bool par = (r32 & 1) != 0;
    const bf16_t* Kb = KVD + rb * 1024 + h * 64;
    AttnAcc A; acc_init(A);
    LAS unsigned char* vt = F.wscr;
#define DIL_BRANCH(ST, K0, NT, WINDOW, PAR) do { \
        const int need_ = -(K0) - 31 - q0 / (ST); const int tb_ = need_ <= 0 ? 0 : (need_ + 31) >> 5; \
        auto rp = [&](int t, int key) -> const bf16_t* { int pos = q0 + (ST) * ((K0) + 32 * t + key); pos = pos < 0 ? 0 : (pos > SEQ - 1 ? SEQ - 1 : pos); return Kb + (size_t)pos * 1024; }; \
        auto mk = [&](int t, f32x16& s, float sh) { \
            const int tb = q0 + (ST) * ((K0) + 32 * t);                      \
            const float dq = (float)(q - tb); const float lim = fminf((float)(WINDOW), (float)q); \
            bias_mask<(ST), true>(s, dq, nslope2, 0.f, lim, hi, sh); \
            if (PAR) { _Pragma("unroll") for (int r = 0; r < 16; ++r) { const bool keep = (r & 1) ? par : !par; s[r] = keep ? s[r] : NEG_INF; } } }; \
        attn_run<bf16_t, 0, 512, 2>(A, qf, tb_, (NT), vt, lane, rp, mk); } while (0)
    DIL_BRANCH(1, -128, 12, 128, false);
    DIL_BRANCH(4, -128, 6, 512, false);
    DIL_BRANCH(8, -256, 9, 2048, true);
#undef DIL_BRANCH
    const float inv = 1.f / fmaxf(A.l, 1e-30f);
    store_o((bf16_t*)(F.ws + WS_O) + (rb + q) * D + h * 64, A.o0, A.o1, inv, hi);
}
__device__ __forceinline__ void dil_item_sample(const Frame& F, int item) {
    const int lane = F.lane, hi = lane >> 5, qi = lane & 7;
    const int h = item & 7, b = item >> 3;
    const size_t row = (size_t)MP + b * 8 + qi;
    const bf16_t* QD = (const bf16_t*)(F.ws + WS_QD);
    bf16x8 qf[4];
#pragma unroll
    for (int d0 = 0; d0 < 4; ++d0) qf[d0] = *(const bf16x8*)(QD + row * 512 + h * 64 + 16 * d0 + 8 * hi);
    const float slope2 = __builtin_amdgcn_exp2f(-(float)(h + 1)) * LOG2E;
    const float* cache = (const float*)F.a->in[2] + (size_t)b * 2048 * 1024 + h * 64;
    const float* newr = F.out + O_DILS + (size_t)b * 2048 * 1024 + h * 64;
    AttnAcc A; acc_init(A);
    LAS unsigned char* vt = F.wscr;
    auto geom = [&](int t, int& sh, int& pos0, int& tt, int& cls) { if (t < 5) { sh = 0; cls = 0; tt = t; pos0 = 1920; } else if (t < 25) { sh = 2; cls = (t - 5) / 5; tt = (t - 5) - 5 * cls; pos0 = 1536 + cls; } else { sh = 4; cls = (t - 25) / 5; tt = (t - 25) - 5 * cls; pos0 = cls; } };
    auto rowp = [&](int t, int key) -> const float* { int sh, pos0, tt, cls; geom(t, sh, pos0, tt, cls); int c = pos0 + ((32 * tt + key) << sh); c = c > 2055 ? 2055 : c; return c < 2048 ? cache + (size_t)c * 1024 : newr + (size_t)(c - 8) * 1024; };
    auto mk = [&](int t, f32x16& s, float shf) {
        int sh, pos0, tt, cls; geom(t, sh, pos0, tt, cls);
        const bool ok2 = sh == 0 ? true : (sh == 2 ? (qi & 3) == cls : qi == cls);
        const float dq = (float)(((2048 + qi - pos0) >> sh) - 32 * tt);
        bias_mask<1, true>(s, dq, -slope2 * (float)(1 << sh), 0.f, 128.f, hi, ok2 ? shf : NEG_INF); };
    attn_run<float, 0, 512>(A, qf, 0, 65, vt, lane, rowp, mk);
    const float inv = 1.f / fmaxf(A.l, 1e-30f);
    if ((lane & 31) < 8) store_o((bf16_t*)(F.ws + WS_O) + row * D + h * 64, A.o0, A.o1, inv, hi);
}

template <bool SAMPLE>
__device__ __forceinline__ void rglru_gates_item(const Frame& F, int item) {
    const int lane = F.lane, r32 = lane & 31, hi = lane >> 5;
    const int n = item & 7, tile = item >> 3;
    const int b = SAMPLE ? tile : tile >> 7, t = SAMPLE ? (r32 < 8 ? r32 : 7) : ((tile & 127) * 32 + r32);
    const size_t rowbase = SAMPLE ? (size_t)MP + b * 8 : (size_t)b * SEQ;
    const float* XR = (const float*)(F.ws + WS_XR);
    const float* cw = (const float*)F.a->in[14]; const float* cbias = (const float*)F.a->in[15];
    const float* sconv = (const float*)F.a->in[3] + (size_t)b * 3 * 512;
    const int ch0 = 64 * n + 4 * hi;
    f32x4 xc[8];
#pragma unroll
    for (int a = 0; a < 8; ++a) {
        const int ch = ch0 + 8 * a;
        f32x4 acc = *(const f32x4*)(cbias + ch);
#pragma unroll
        for (int k = 0; k < 4; ++k) {
            const int tau = t + k - 3;
            const float* xp = XR + (rowbase + (tau >= 0 ? tau : 0)) * 512 + ch;
            if (SAMPLE) xp = tau >= 0 ? xp : sconv + (3 + tau) * 512 + ch;
            f32x4 x = *(const f32x4*)xp;
            const float keep = (SAMPLE || tau >= 0) ? 1.f : 0.f;
            acc += x * (*(const f32x4*)(cw + k * 512 + ch) * keep);
        }
        xc[a] = acc;
        if ((a & 3) == 3) __builtin_amdgcn_sched_barrier(0);
    }
    bf16x8 xb[4];
#pragma unroll
    for (int d0 = 0; d0 < 4; ++d0) xb[d0] = pack8(xc[2 * d0], xc[2 * d0 + 1]);
    const bf16_t* WG = (const bf16_t*)(F.ws + WS_WG);
    const float* ba = (const float*)F.a->in[17]; const float* bx = (const float*)F.a->in[19]; const float* c8 = (const float*)(F.ws + WS_C8);
    float* AU = (float*)(F.ws + WS_AU) + (rowbase + t) * 1024;
    const bool valid = !SAMPLE || r32 < 8;
#pragma unroll
    for (int mt = 0; mt < 2; ++mt) {
        f32x16 ga, gx;
#pragma unroll
        for (int r = 0; r < 16; ++r) { ga[r] = 0.f; gx[r] = 0.f; }
        f32x4 vba[4], vbx[4], vc8[4];
#pragma unroll
        for (int a4 = 0; a4 < 4; ++a4) { const int ch = ch0 + 8 * (4 * mt + a4); vba[a4] = *(const f32x4*)(ba + ch); vbx[a4] = *(const f32x4*)(bx + ch); vc8[a4] = *(const f32x4*)(c8 + ch); }
#pragma unroll
        for (int d0 = 0; d0 < 4; ++d0) {
            const bf16x8 wa = *(const bf16x8*)(WG + ((size_t)(0 * 8 + n) * 64 + r32 + 32 * mt) * 64 + 16 * d0 + 8 * hi);
            const bf16x8 wx = *(const bf16x8*)(WG + ((size_t)(1 * 8 + n) * 64 + r32 + 32 * mt) * 64 + 16 * d0 + 8 * hi);
            ga = __builtin_amdgcn_mfma_f32_32x32x16_bf16(wa, xb[d0], ga, 0, 0, 0);
            gx = __builtin_amdgcn_mfma_f32_32x32x16_bf16(wx, xb[d0], gx, 0, 0, 0);
        }
        f32x4 av[4], uv[4];
#pragma unroll
        for (int a4 = 0; a4 < 4; ++a4) {
            const int a = 4 * mt + a4, ch = ch0 + 8 * a, rb = a4 * 4;
#pragma unroll
            for (int e = 0; e < 4; ++e) {
                const float rg = __builtin_amdgcn_rcpf(1.f + __expf(-(ga[rb + e] + vba[a4][e])));
                const float ig = __builtin_amdgcn_rcpf(1.f + __expf(-(gx[rb + e] + vbx[a4][e])));
                const float la = -rg * vc8[a4][e];
                av[a4][e] = __expf(la);
                uv[a4][e] = __builtin_amdgcn_sqrtf(fmaxf(1.f - av[a4][e] * av[a4][e], 0.f)) * ig * xc[a][e];
            }
            if (valid) { *(f32x4*)(AU + ch) = av[a4]; *(f32x4*)(AU + 512 + ch) = uv[a4]; }
        }
        if (!SAMPLE) {
#pragma unroll
            for (int sft = 1; sft < 32; sft <<= 1) {
                const bool upper = (r32 & sft) != 0;
#pragma unroll
                for (int a4 = 0; a4 < 4; ++a4)
#pragma unroll
                    for (int e = 0; e < 4; ++e) {
                        const float pa = __shfl_xor(av[a4][e], sft), pu = __shfl_xor(uv[a4][e], sft);
                        const float nu = upper ? av[a4][e] * pu + uv[a4][e] : pa * uv[a4][e] + pu;
                        av[a4][e] = av[a4][e] * pa; uv[a4][e] = nu;
                    }
            }
            if (r32 == 0) { float* ag = (float*)(F.ws + WS_AGG) + (size_t)tile * 1024;
#pragma unroll
                for (int a4 = 0; a4 < 4; ++a4) { const int ch = ch0 + 8 * (4 * mt + a4); *(f32x4*)(ag + ch) = av[a4]; *(f32x4*)(ag + 512 + ch) = uv[a4]; } }
        }
        __builtin_amdgcn_sched_barrier(0);
    }
}
__device__ __forceinline__ float gelu_tanh(float x) { const float z = 0.7978845608028654f * (x + 0.044715f * x * x * x); const float e = __expf(2.f * z); return 0.5f * x * (2.f - 2.f * __builtin_amdgcn_rcpf(e + 1.f)); }
template <bool SAMPLE>
__device__ __forceinline__ void rglru_scan_item(const Frame& F, int item) {
    const int lane = F.lane, n = item & 7, tile = item >> 3;
    const int b = SAMPLE ? tile : tile >> 6, tt = SAMPLE ? 0 : 2 * (tile & 63);
    const int ch = 64 * n + lane;
    constexpr int NT = SAMPLE ? 8 : 32;
    const size_t row0 = SAMPLE ? (size_t)MP + b * 8 : (size_t)b * SEQ + tt * 32;
    const float* AU = (const float*)(F.ws + WS_AU) + row0 * 1024 + ch; const bf16_t* GT = (const bf16_t*)(F.ws + WS_GT) + row0 * 512 + ch;
    bf16_t* O = (bf16_t*)(F.ws + WS_O) + row0 * D + 512 + ch;
    float av[NT], uv[NT], gv[NT];
#pragma unroll
    for (int i = 0; i < NT; ++i) { av[i] = AU[(size_t)i * 1024]; uv[i] = AU[(size_t)i * 1024 + 512]; gv[i] = bf2f(GT[(size_t)i * 512]); }
    float h;
    if (SAMPLE) h = ((const float*)F.a->in[4])[b * 512 + ch];
    else { h = 0.f; const float* ag = (const float*)(F.ws + WS_AGG) + (size_t)(b * 128) * 1024 + ch;
        int c = 0;
        for (; c + 32 <= tt; c += 32) { float pa[32], ph[32];
#pragma unroll
            for (int k = 0; k < 32; ++k) { pa[k] = ag[(size_t)(c + k) * 1024]; ph[k] = ag[(size_t)(c + k) * 1024 + 512]; }
#pragma unroll
            for (int k = 0; k < 32; ++k) h = pa[k] * h + ph[k]; }
        if (c < tt) { float pa[32], ph[32];
#pragma unroll
            for (int k = 0; k < 32; ++k) { const int cc = c + k < tt ? c + k : 0; pa[k] = ag[(size_t)cc * 1024]; ph[k] = ag[(size_t)cc * 1024 + 512]; }
#pragma unroll
            for (int k = 0; k < 32; ++k) { const bool on = c + k < tt; h = on ? pa[k] * h + ph[k] : h; } }
    }
    float y[NT];
#pragma unroll
    for (int i = 0; i < NT; ++i) { h = av[i] * h + uv[i]; y[i] = h * gelu_tanh(gv[i]); }
    if (!SAMPLE) {
        const float* AU2 = AU + (size_t)32 * 1024; const bf16_t* GT2 = GT + (size_t)32 * 512;
#pragma unroll
        for (int i = 0; i < NT; ++i) { av[i] = AU2[(size_t)i * 1024]; uv[i] = AU2[(size_t)i * 1024 + 512]; gv[i] = bf2f(GT2[(size_t)i * 512]); }
#pragma unroll
        for (int i = 0; i < NT; ++i) O[(size_t)i * D] = (bf16_t)(cvtpk(y[i], 0.f) & 0xffffu);
#pragma unroll
        for (int i = 0; i < NT; ++i) { h = av[i] * h + uv[i]; y[i] = h * gelu_tanh(gv[i]); }
        O += (size_t)32 * D;
    }
#pragma unroll
    for (int i = 0; i < NT; ++i) O[(size_t)i * D] = (bf16_t)(cvtpk(y[i], 0.f) & 0xffffu);
    if (SAMPLE) F.out[O_RNNS + b * 512 + ch] = h;
    else if (tt == 126) F.out[O_RNNP + b * 512 + ch] = h;
}

template <bool SAMPLE, bool SPLIT = false>
__device__ __forceinline__ void compress_item(const Frame& F, int item) {
    const int lane = F.lane, r32 = lane & 31, hi = lane >> 5;
    constexpr int NTL = SAMPLE ? 64 : 32, NC = SAMPLE ? NCS : NCP;
    const int c = item & 1, nt = (item >> 1) % NTL, b = (item >> 1) / NTL;
    const int lg = lane >> 4, lch = lane & 15;
    const int* pt = (const int*)F.a->in[8] + b * NPG;
    const float* rbase[9];
#pragma unroll
    for (int j = 0; j < 9; ++j) { int ch = nt * 8 + j; ch = ch < NC ? ch : NC;
        if (SAMPLE) { const int pg = pt[ch >> 3]; rbase[j] = (const float*)F.a->in[6] + ((size_t)pg * PAGE + (ch & 7) * 16) * 512 + c * 256 + lane * 4; }
        else rbase[j] = F.out + O_CMPP + ((size_t)b * SEQ + ch * 16) * 512 + c * 256 + lane * 4; }
    const bf16_t* WF = (const bf16_t*)(F.ws + WS_WCT) + (size_t)c * 32 * 4 * 2 * 512 + lane * 8;
    LAS unsigned char* xt = F.wscr;
    f32x4 xr[9];
#define CMP_LOAD(X, l_) do { _Pragma("unroll") for (int j = 0; j < 9; ++j) X[j] = SAMPLE ? __builtin_nontemporal_load((const f32x4*)(rbase[j] + (size_t)(l_) * 512)) : *(const f32x4*)(rbase[j] + (size_t)(l_) * 512); } while (0)
#define CMP_STEP(X, l_, NEXT_OK, lnext_) do { \
        LAS unsigned char* img = xt + ((l_) & 1) * 4608; \
        bf16x8 wf[4][4];                                    \
        _Pragma("unroll") for (int k4 = 0; k4 < 4; ++k4) { \
            wf[k4][0] = *(const bf16x8*)(WF + (size_t)(((l_) * 4 + k4) * 2 + 0) * 512); wf[k4][1] = *(const bf16x8*)(WF + (size_t)(((l_) * 4 + k4) * 2 + 1) * 512); \
            wf[k4][2] = *(const bf16x8*)(WF + (size_t)((((l_) + 16) * 4 + k4) * 2 + 0) * 512); wf[k4][3] = *(const bf16x8*)(WF + (size_t)((((l_) + 16) * 4 + k4) * 2 + 1) * 512); } \
        _Pragma("unroll") for (int j = 0; j < 9; ++j) { const int q = 4 * j + lg; u32x2 w; w.x = cvtpk(X[j][0], X[j][1]); w.y = cvtpk(X[j][2], X[j][3]); \
            *(LAS u32x2*)(img + q * 128 + (((lch >> 1) ^ ((q >> 1) & 7)) * 16) + (lch & 1) * 8) = w; } \
        if (NEXT_OK) CMP_LOAD(X, lnext_); \
        asm volatile("s_waitcnt lgkmcnt(0)" ::: "memory"); \
        _Pragma("unroll") for (int k4 = 0; k4 < 4; ++k4) { \
            const bf16x8 x0 = *(const LAS bf16x8*)(img + r32 * 128 + (((2 * k4 + hi) ^ ((r32 >> 1) & 7)) * 16)); \
            const bf16x8 x1 = *(const LAS bf16x8*)(img + (r32 + 4) * 128 + (((2 * k4 + hi) ^ (((r32 + 4) >> 1) & 7)) * 16)); \
            const bf16x8 w0 = wf[k4][0], w1 = wf[k4][1], w2 = wf[k4][2], w3 = wf[k4][3]; \
            a0 = __builtin_amdgcn_mfma_f32_32x32x16_bf16(w0, x0, a0, 0, 0, 0); \
            a1 = __builtin_amdgcn_mfma_f32_32x32x16_bf16(w1, x0, a1, 0, 0, 0); \
            a0 = __builtin_amdgcn_mfma_f32_32x32x16_bf16(w2, x1, a0, 0, 0, 0); \
            a1 = __builtin_amdgcn_mfma_f32_32x32x16_bf16(w3, x1, a1, 0, 0, 0); } \
        asm volatile("" ::: "memory"); } while (0)
    f32x16 a0, a1;
#pragma unroll
    for (int r = 0; r < 16; ++r) { a0[r] = 0.f; a1[r] = 0.f; }
    const int l0 = SPLIT ? 2 * F.wave : 0, l1 = SPLIT ? l0 + 2 : 16;
    CMP_LOAD(xr, l0);
    for (int l = l0; l < l1; ++l) CMP_STEP(xr, l, l + 1 < l1, l + 1);
#undef CMP_STEP
#undef CMP_LOAD
    if (SPLIT) {
        constexpr int PART = 9216;
        LAS f32x4* mine = (LAS f32x4*)(F.wscr + PART);
#pragma unroll
        for (int i = 0; i < 4; ++i) { mine[i * 64 + lane] = (f32x4){a0[4 * i], a0[4 * i + 1], a0[4 * i + 2], a0[4 * i + 3]}; mine[(4 + i) * 64 + lane] = (f32x4){a1[4 * i], a1[4 * i + 1], a1[4 * i + 2], a1[4 * i + 3]}; }
        __syncthreads();
        {
            const int me = F.wave;
            for (int w = 0; w < NWAVES; ++w) { if (w == me) continue; const LAS f32x4* p = (const LAS f32x4*)(F.lds + w * WSCR + PART);
#pragma unroll
                for (int i = 0; i < 4; ++i) { const f32x4 u = p[i * 64 + lane], v = p[(4 + i) * 64 + lane];
                    a0[4 * i] += u.x; a0[4 * i + 1] += u.y; a0[4 * i + 2] += u.z; a0[4 * i + 3] += u.w; a1[4 * i] += v.x; a1[4 * i + 1] += v.y; a1[4 * i + 2] += v.z; a1[4 * i + 3] += v.w; } }
        }
        __syncthreads();
    }
    const int n = nt * 8 + (r32 >> 2), g = r32 & 3;
    if (n < NC && (!SPLIT || F.wave == 0)) {
        const float* pe = (const float*)(F.ws + WS_PET) + c * 64;
        bf16_t* o = SAMPLE ? (bf16_t*)(F.ws + WS_KCS) + ((size_t)(b * 512 + n) * 2 + c) * 256 + g * 64 : (bf16_t*)(F.ws + WS_KCP) + ((size_t)(b * 256 + n) * 2 + c) * 256 + g * 64;
#pragma unroll
        for (int i = 0; i < 4; ++i) {
            const int e0 = 8 * i + 4 * hi; const f32x4 p0 = *(const f32x4*)(pe + e0), p1 = *(const f32x4*)(pe + 32 + e0);
            u32x2 w; w.x = cvtpk(a0[4 * i] + p0.x, a0[4 * i + 1] + p0.y); w.y = cvtpk(a0[4 * i + 2] + p0.z, a0[4 * i + 3] + p0.w); *(u32x2*)(o + e0) = w;
            u32x2 x; x.x = cvtpk(a1[4 * i] + p1.x, a1[4 * i + 1] + p1.y); x.y = cvtpk(a1[4 * i + 2] + p1.z, a1[4 * i + 3] + p1.w); *(u32x2*)(o + 32 + e0) = x;
        }
    }
}

constexpr int WS_IMP = 8448, WS_SELM = WS_IMP + 8 * 132 * 4, WS_BLIST = WS_SELM + 8 * 4 * 8, WS_OT = 13568, WS_PT = WS_OT + 4096;
static_assert(KT_OFF + 4096 <= WS_IMP && WS_BLIST + 132 * 4 <= WS_OT && WS_PT + 256 <= WSCR, "per-wave scratch map");
template <bool SAMPLE>
__device__ __forceinline__ void nsa_item(const Frame& F, int item) {
    typedef typename std::conditional<SAMPLE, float, bf16_t>::type KT;
    const int lane = F.lane, r32 = lane & 31, hi = lane >> 5, qi = r32 >> 2, r = r32 & 3;
    const int g = item & 3, qt = SAMPLE ? 0 : (item >> 2) & 511, b = SAMPLE ? item >> 2 : item >> 11;
    const int t0 = 8 * qt, qp = SAMPLE ? PAST + qi : t0 + qi, qp_max = SAMPLE ? PAST + 7 : t0 + 7;
    const size_t row = SAMPLE ? (size_t)MP + b * 8 + qi : (size_t)b * SEQ + t0 + qi;
    const int head = 4 * g + r;
    const float nslope2 = -__builtin_amdgcn_exp2f(-0.5f * (float)(head + 1)) * LOG2E;
    const bf16_t* Q1 = (const bf16_t*)(F.ws + WS_Q1);
    bf16x8 qf[4];
#pragma unroll
    for (int d0 = 0; d0 < 4; ++d0) qf[d0] = *(const bf16x8*)(Q1 + row * D + head * 64 + 16 * d0 + 8 * hi);
    const float* gp = (const float*)(F.ws + WS_G1) + row * 48 + head * 3;
    const float g_cmp = gp[0], g_sel = gp[1], g_win = gp[2];
    LAS unsigned char* vt = F.wscr;
    LAS float* imp = (LAS float*)(F.wscr + WS_IMP);
    LAS unsigned long long* selm = (LAS unsigned long long*)(F.wscr + WS_SELM);
    LAS int* blist = (LAS int*)(F.wscr + WS_BLIST);
    constexpr int NC = SAMPLE ? NCS : NCP, NCH = SAMPLE ? 3 : 1;
    LAS u32x2* otl = (LAS u32x2*)(F.wscr + WS_OT) + lane;
    for (int i = lane; i < 8 * 132; i += 64) imp[i] = 0.f;

    const bf16_t* KC = SAMPLE ? (const bf16_t*)(F.ws + WS_KCS) + (size_t)b * 512 * 512 + g * 64 : (const bf16_t*)(F.ws + WS_KCP) + (size_t)b * 256 * 512 + g * 64;
    const int ncv = qp_max >= 31 ? (((qp_max - 31) >> 4) + 1 < NC ? ((qp_max - 31) >> 4) + 1 : NC) : 0;
    const int nct = (ncv + 31) >> 5;
    auto rpc = [&](int t, int key) -> const bf16_t* { int n = 32 * t + key; n = n < NC ? n : NC - 1; return KC + (size_t)n * 512; };
    auto mkc = [&](int t, f32x16& s, float sh) { bias_mask<16, 2>(s, (float)(qp - 31 - 512 * t), nslope2, 0.f, 1e30f, hi, sh); };
    AttnAcc A; acc_init(A);
    attn_run<bf16_t, 1, 256>(A, qf, 0, nct, vt, lane, rpc, mkc);
    {
        A.m = (A.m == NEG_INF) ? 0.f : A.m; A.l = A.l > 0.f ? 1.f / A.l : 0.f;
        auto hkc = [&](int t, const f32x16& p) {
#pragma unroll
            for (int i = 0; i < 4; ++i) {
                float p3 = p[4 * i + 3]; float a = 2.f * ((p[4 * i] + p[4 * i + 1]) + p[4 * i + 2]) + p3;
                a += __shfl_xor(a, 1); a += __shfl_xor(a, 2); p3 += __shfl_xor(p3, 1); p3 += __shfl_xor(p3, 2);
                if (r == 0) { const int J = 8 * t + 2 * i + hi; __hip_atomic_fetch_add(&imp[J * 8 + qi], a, __ATOMIC_RELAXED, __HIP_MEMORY_SCOPE_WORKGROUP); __hip_atomic_fetch_add(&imp[(J + 1) * 8 + qi], p3, __ATOMIC_RELAXED, __HIP_MEMORY_SCOPE_WORKGROUP); }
            } };
        attn_run<bf16_t, 2, 256>(A, qf, 0, nct, vt, lane, rpc, mkc, hkc);
#pragma unroll
        for (int j = 0; j < 4; ++j) {
            u32x2 w; w.x = cvtpk(A.o0[4 * j] * g_cmp, A.o0[4 * j + 1] * g_cmp); w.y = cvtpk(A.o0[4 * j + 2] * g_cmp, A.o0[4 * j + 3] * g_cmp); otl[64 * j] = w;
            u32x2 x; x.x = cvtpk(A.o1[4 * j] * g_cmp, A.o1[4 * j + 1] * g_cmp); x.y = cvtpk(A.o1[4 * j + 2] * g_cmp, A.o1[4 * j + 3] * g_cmp); otl[64 * (4 + j)] = x; }
    }
    asm volatile("s_waitcnt lgkmcnt(0)" ::: "memory");
    const int cb = qp_max >> 6;
    for (int idx = lane; idx < 8 * (cb + 1); idx += 64) { const int j = idx >> 3; if (j == 0 || j >= cb - 1) imp[idx] += 1000.f; }
    asm volatile("s_waitcnt lgkmcnt(0)" ::: "memory");
    {
        f32x4 sj[NCH][2]; int rank[NCH][8];
#pragma unroll
        for (int c2 = 0; c2 < NCH; ++c2) { int j = lane + 64 * c2; j = j <= cb ? j : cb; sj[c2][0] = *(const LAS f32x4*)(imp + j * 8); sj[c2][1] = *(const LAS f32x4*)(imp + j * 8 + 4);
#pragma unroll
            for (int q = 0; q < 8; ++q) rank[c2][q] = 0; }
#pragma unroll 2
        for (int i = 0; i <= cb; ++i) {
            const f32x4 v0 = *(const LAS f32x4*)(imp + i * 8), v1 = *(const LAS f32x4*)(imp + i * 8 + 4);
#pragma unroll
            for (int c2 = 0; c2 < NCH; ++c2) { const bool lower = i < lane + 64 * c2;
#pragma unroll
                for (int q = 0; q < 8; ++q) { const float vi = q < 4 ? v0[q & 3] : v1[q & 3], vj = q < 4 ? sj[c2][0][q & 3] : sj[c2][1][q & 3];
                    rank[c2][q] += ((vi > vj) | ((vi == vj) & lower)) ? 1 : 0; } }
        }
#pragma unroll
        for (int c2 = 0; c2 < NCH; ++c2) { const bool cand = lane + 64 * c2 <= cb;
#pragma unroll
            for (int q = 0; q < 8; ++q) { const unsigned long long mask = __ballot(cand && rank[c2][q] < 16); if (lane == 0) selm[q * 4 + c2] = mask; } }
    }
    asm volatile("s_waitcnt lgkmcnt(0)" ::: "memory");
    unsigned long long mym0 = 0ull, mym1 = 0ull, mym2 = 0ull; int nblk = 0;
#pragma unroll
    for (int c2 = 0; c2 < NCH; ++c2) { const unsigned long long mine = selm[qi * 4 + c2]; unsigned long long u = 0;
        if (c2 == 0) mym0 = mine; else if (c2 == 1) mym1 = mine; else mym2 = mine;
#pragma unroll
        for (int q = 0; q < 8; ++q) u |= selm[q * 4 + c2];
        const int j = lane + 64 * c2; const bool in = (u >> lane) & 1ull;
        const int pos = nblk + __popcll(u & ((1ull << lane) - 1ull));
        if (in) blist[pos] = j;
        nblk += __popcll(u); }
    asm volatile("s_waitcnt lgkmcnt(0)" ::: "memory");
    nblk = __builtin_amdgcn_readfirstlane(nblk);
    {
        const KT* sbase; LAS int* pt = (LAS int*)(F.wscr + WS_PT);
        if constexpr (SAMPLE) { pt[lane] = ((const int*)F.a->in[8])[b * NPG + lane]; asm volatile("s_waitcnt lgkmcnt(0)" ::: "memory"); }
        if constexpr (SAMPLE) sbase = (const float*)F.a->in[7] + g * 64; else sbase = (const bf16_t*)(F.ws + WS_KVSEL) + (size_t)b * SEQ * 512 + g * 64;
        const float* snew = F.out + O_SELS + (size_t)b * 8 * 512 + g * 64;
        auto rps = [&](int t, int key) -> const KT* {
            const int J = blist[t >> 1]; const int tok = 64 * J + 32 * (t & 1) + key;
            if constexpr (SAMPLE) { const int tk = tok < PAST ? tok : PAST - 1; const int pg = pt[tk >> 7]; const KT* p0 = sbase + ((size_t)pg * PAGE + (tk & 127)) * 512;
                int i2 = tok - PAST; i2 = i2 < 0 ? 0 : (i2 > 7 ? 7 : i2); const KT* p1 = (const KT*)(snew + (size_t)i2 * 512); return tok < PAST ? p0 : p1; }
            else return sbase + (size_t)tok * 512; };
        auto mks = [&](int t, f32x16& s, float sh) {
            const int J = blist[t >> 1]; bool sel = (mym0 >> (J & 63)) & 1ull; if constexpr (SAMPLE) { const bool s1 = (mym1 >> (J & 63)) & 1ull, s2 = (mym2 >> (J & 63)) & 1ull; sel = J < 64 ? sel : (J < 128 ? s1 : s2); } const int tb = 64 * J + 32 * (t & 1);
            const float base = sel ? sh : NEG_INF, dq = (float)(qp - tb);
            if (J < cb) bias_mask<1, false>(s, dq, nslope2, 0.f, 0.f, hi, base);
            else bias_mask<1, 2>(s, dq, nslope2, 0.f, 1e30f, hi, base); };
        acc_init(A);
        attn_run<KT, 0, 256, SAMPLE ? 1 : 2>(A, qf, 0, 2 * nblk, vt, lane, rps, mks);
        const float sc = g_sel / fmaxf(A.l, 1e-30f);
#pragma unroll
        for (int j = 0; j < 4; ++j) {
            const u32x2 a = otl[64 * j], c = otl[64 * (4 + j)];
            u32x2 w; w.x = cvtpk(A.o0[4 * j] * sc + __uint_as_float(a.x << 16), A.o0[4 * j + 1] * sc + __uint_as_float(a.x & 0xffff0000u)); w.y = cvtpk(A.o0[4 * j + 2] * sc + __uint_as_float(a.y << 16), A.o0[4 * j + 3] * sc + __uint_as_float(a.y & 0xffff0000u)); otl[64 * j] = w;
            u32x2 x; x.x = cvtpk(A.o1[4 * j] * sc + __uint_as_float(c.x << 16), A.o1[4 * j + 1] * sc + __uint_as_float(c.x & 0xffff0000u)); x.y = cvtpk(A.o1[4 * j + 2] * sc + __uint_as_float(c.y << 16), A.o1[4 * j + 3] * sc + __uint_as_float(c.y & 0xffff0000u)); otl[64 * (4 + j)] = x; }
    }
    {
        acc_init(A);
        if constexpr (SAMPLE) {
            const float* wc = (const float*)F.a->in[5] + (size_t)b * 512 * 512 + g * 64; const float* wn = F.out + O_WINS + (size_t)b * 512 * 512 + g * 64;
            auto rpw = [&](int t, int key) -> const float* { int c = 32 * t + key; c = c > 519 ? 519 : c; return c < 512 ? wc + (size_t)c * 512 : wn + (size_t)(c - 8) * 512; };
            auto mkw = [&](int t, f32x16& s, float sh) { bias_mask<1, true>(s, (float)(512 + qi - 32 * t), nslope2, 0.f, (float)WIN, hi, sh); };
            attn_run<float, 0, 256>(A, qf, 0, 17, vt, lane, rpw, mkw);
        } else {
            const bf16_t* wb = (const bf16_t*)(F.ws + WS_KVWIN) + (size_t)b * SEQ * 512 + g * 64;
            const int tlo = (t0 - WIN > 0 ? t0 - WIN : 0) >> 5, thi = (t0 + 7) >> 5;
            auto rpw = [&](int t, int key) -> const bf16_t* { return wb + (size_t)(32 * t + key) * 512; };
            auto mkw = [&](int t, f32x16& s, float sh) { const float dq = (float)(qp - 32 * t);
                if (32 * t + 31 <= t0 && 32 * t >= t0 + 7 - WIN) bias_mask<1, false>(s, dq, nslope2, 0.f, 0.f, hi, sh);
                else bias_mask<1, true>(s, dq, nslope2, 0.f, (float)WIN, hi, sh); };
            attn_run<bf16_t, 0, 256, 2>(A, qf, tlo, thi + 1, vt, lane, rpw, mkw);
        }
        const float sc = g_win / fmaxf(A.l, 1e-30f);
#pragma unroll
        for (int j = 0; j < 4; ++j) { const u32x2 a = otl[64 * j], c = otl[64 * (4 + j)];
            A.o0[4 * j] = A.o0[4 * j] * sc + __uint_as_float(a.x << 16); A.o0[4 * j + 1] = A.o0[4 * j + 1] * sc + __uint_as_float(a.x & 0xffff0000u);
            A.o0[4 * j + 2] = A.o0[4 * j + 2] * sc + __uint_as_float(a.y << 16); A.o0[4 * j + 3] = A.o0[4 * j + 3] * sc + __uint_as_float(a.y & 0xffff0000u);
            A.o1[4 * j] = A.o1[4 * j] * sc + __uint_as_float(c.x << 16); A.o1[4 * j + 1] = A.o1[4 * j + 1] * sc + __uint_as_float(c.x & 0xffff0000u);
            A.o1[4 * j + 2] = A.o1[4 * j + 2] * sc + __uint_as_float(c.y << 16); A.o1[4 * j + 3] = A.o1[4 * j + 3] * sc + __uint_as_float(c.y & 0xffff0000u); }
    }
    store_o((bf16_t*)(F.ws + WS_O) + row * D + head * 64, A.o0, A.o1, 1.f, hi);
}

__device__ __forceinline__ void final_norm_row(float* y, const float* ssp, const float* g, int row, int lane) {
    const float rs = pg8::row_rstd(ssp, row);
    f32x4* yr = (f32x4*)(y + (size_t)row * D) + lane; const f32x4* gr = (const f32x4*)g + lane;
#pragma unroll
    for (int j = 0; j < 4; ++j) { const f32x4 v = yr[64 * j], gg = gr[64 * j]; yr[64 * j] = v * rs * gg; }
}

template <bool FINAL>
__device__ __forceinline__ void sample_finalize_row(const float* slab, int ns, const float* res, float* Y, bf16_t* Aout, const float* gain, float* ssp, int r, int lane) {
    f32x4 y[4]; float ss = 0.f;
#pragma unroll
    for (int j = 0; j < 4; ++j) y[j] = *((const f32x4*)(res + (size_t)r * D) + lane + 64 * j);
#pragma unroll 4
    for (int sl = 0; sl < ns; ++sl) {
#pragma unroll
        for (int j = 0; j < 4; ++j) y[j] += *((const f32x4*)(slab + ((size_t)sl * MS + r) * D) + lane + 64 * j); }
#pragma unroll
    for (int j = 0; j < 4; ++j) ss += (y[j].x * y[j].x + y[j].y * y[j].y) + (y[j].z * y[j].z + y[j].w * y[j].w);
    ss = wave_sum(ss);
    if (FINAL) { const float rs = 1.f / sqrtf(ss * (1.f / D) + EPS);
#pragma unroll
        for (int j = 0; j < 4; ++j) *((f32x4*)(Y + (size_t)r * D) + lane + 64 * j) = y[j] * rs * *((const f32x4*)gain + lane + 64 * j); }
    else {
#pragma unroll
        for (int j = 0; j < 4; ++j) { *((f32x4*)(Y + (size_t)r * D) + lane + 64 * j) = y[j];
            u32x2 w; w.x = cvtpk(y[j].x, y[j].y); w.y = cvtpk(y[j].z, y[j].w); *((u32x2*)(Aout + (size_t)r * D) + lane + 64 * j) = w; }
        if (lane < 16) ssp[(size_t)(MP + r) * 16 + lane] = lane == 0 ? ss : 0.f; }
}
__device__ __forceinline__ unsigned q_issue(unsigned* ctr, int lane) { unsigned v = 0u; if (lane == 0) v = __hip_atomic_fetch_add(ctr, 1u, __ATOMIC_RELAXED, __HIP_MEMORY_SCOPE_AGENT); return v; }
__device__ __forceinline__ int q_item(unsigned tk, int shard) { return (int)__builtin_amdgcn_readfirstlane(tk) * 8 + shard; }
constexpr int N_PHASES = 17;
#ifndef ONE_LAUNCH
#define ONE_LAUNCH 1
#endif
#define PH_BEGIN \
    const Args* ap_ = &args; size_t z_ = 0; asm volatile("" : "+s"(z_)); \
    Frame F; F.lds = (LAS unsigned char*)lds_raw; F.tid = threadIdx.x; F.lane = F.tid & 63; F.wave = __builtin_amdgcn_readfirstlane(F.tid >> 6); \
    F.G = gridDim.x; { const int vcu_ = (F.G % 8 == 0) ? ((int)blockIdx.x % 8) * (F.G / 8) + (int)blockIdx.x / 8 : (int)blockIdx.x; F.gw = vcu_ * NWAVES + F.wave; } F.NGW = F.G * NWAVES; \
    F.wscr = F.lds + F.wave * WSCR; F.ws = ap_->ws + z_; F.out = ap_->out + z_; F.a = ap_; \
    unsigned char* ws = F.ws; float* out = F.out; unsigned* ctl = (unsigned*)(ws + WS_CTL); float* ssp = (float*)(ws + WS_SSP); \
    const float* norm_mix = (const float*)ap_->in[9] + z_; const float* norm_ffn = (const float*)ap_->in[10] + z_; const float* norm_out = (const float*)ap_->in[11] + z_; \
    (void)ctl; (void)ssp; (void)norm_mix; (void)norm_ffn; (void)norm_out; (void)out;
__global__ void __launch_bounds__(NWAVES * 64, 2) fwd(Args args) {
    extern __shared__ __attribute__((aligned(16))) unsigned char lds_raw[];
    volatile LAS unsigned* MISC = (volatile LAS unsigned*)((LAS unsigned char*)lds_raw + MISC_OFF);
    if (threadIdx.x < 16) MISC[threadIdx.x] = 0u;
    __syncthreads();
    const int lo = args.ph_lo, hi = args.ph_hi;
    const bool multi = (hi - lo) > 1;
    if (multi) (void)xcd_barrier_post((unsigned*)(args.ws + WS_CTL) + CW_BAR, MISC);
#ifndef ONLY_PHASE
#define ONLY_PHASE -1
#endif
#define IN(k) ((ONLY_PHASE < 0 || ONLY_PHASE == (k)) && lo <= (k) && (k) < hi)
#define SEAM(k) do { if (IN(k) && IN((k) + 1)) { XcdBarrier bar_; bar_.bar = (unsigned*)(args.ws + WS_CTL) + CW_BAR; bar_.x = xb_xcc_id(); bar_.st = MISC; xcd_barrier(bar_); } } while (0)

#define GEMM_N1024(Aptr, Wptr, KFULL, RESF, RBF16) do { \
        { pg8::Gemm g{(const bf16_t*)(Aptr), (const bf16_t*)(Wptr), MP, D, (KFULL), (KFULL)}; \
          pg8::StaticOrder S; S.init(MP, D, F.G, (int)blockIdx.x); \
          pg8::EpiRes<RBF16> E{(RESF), (bf16_t*)(ws + WS_XN), nullptr, ssp}; \
          pg8::gemm_phase<pg8::EpiRes<RBF16>, pg8::StaticOrder, true, true>(F.lds, g, S, E); } } while (0)
#define DEFERRED_SAMPLE(Aptr, Wptr, KFULL, RESS, AOUT, GAIN, INST) do { \
        constexpr int ns_ = (KFULL) / 256; const int mu = (int)blockIdx.x - (F.G - 4 * ns_); \
        if (mu >= 0) { const int sl = mu >> 2; int ks_ = 256; asm volatile("" : "+s"(ks_)); \
          pg8::Gemm g{(const bf16_t*)(Aptr) + sl * 256, (const bf16_t*)(Wptr) + sl * 256, M, D, ks_, (KFULL)}; \
          pg8::OneUnit S{MP / 256, mu & 3}; \
          pg8::EpiSlab E{(float*)(ws + WS_SLAB) + (size_t)sl * MS * D}; \
          pg8::gemm_phase<pg8::EpiSlab, pg8::OneUnit, true, true>(F.lds, g, S, E); \
          subgrid_rendezvous(ctl + CW_SR + 64 * (INST), 4 * ns_, ctl + CW_BAR); \
          for (int r = mu * NWAVES + F.wave; r < MS; r += 4 * ns_ * NWAVES) \
              sample_finalize_row<false>((const float*)(ws + WS_SLAB), ns_, (RESS), out + O_YS, (AOUT) + (size_t)MP * D, (GAIN), ssp, r, F.lane); \
          asm volatile("s_waitcnt vmcnt(0)" ::: "memory"); \
          __syncthreads(); \
          if (threadIdx.x == 0) { __builtin_amdgcn_fence(__ATOMIC_RELEASE, "agent"); asm volatile("s_waitcnt vmcnt(0)" ::: "memory"); (void)xb_add(ctl + CW_SR + 64 * (4 + (INST)), 1u); } } } while (0)
#define GATED_ORDER(S, MROWS, NCOLS, KFULL, INST) pg8::GatedOrder S; S.init((MROWS), (NCOLS), F.G, (int)blockIdx.x); S.flag = ctl + CW_SR + 64 * (4 + (INST)); S.need = 4 * ((KFULL) / 256); S.bar = ctl + CW_BAR

    if (IN(0)) { PH_BEGIN p0_prologue(F); }
    SEAM(0);
    if (IN(1)) { PH_BEGIN
        pg8::Gemm g{(const bf16_t*)(ws + WS_XN), (const bf16_t*)(ws + WS_WIN0), M, AB_IN, D, D};
        pg8::StaticOrder S; S.init(M, AB_IN, F.G, (int)blockIdx.x);
        pg8::EpiIn0 E{(bf16_t*)(ws + WS_QD), (bf16_t*)(ws + WS_KVD), (float*)(ws + WS_XR), (bf16_t*)(ws + WS_GT), out};
        pg8::gemm_phase<pg8::EpiIn0, pg8::StaticOrder, true, true>(F.lds, g, S, E);
        {
            constexpr int units = (M / 256) * (AB_IN / 256); const int nfull = units % F.G, nbg = nfull ? F.G - nfull : F.G;
            const int me = (int)blockIdx.x - (F.G - nbg);
            if (me >= 0) { __syncthreads(); for (int it = WT_T4 + me * NWAVES + F.wave; it < WT_T9; it += nbg * NWAVES) weight_transpose_item(F, it); }
        }
        if ((int)blockIdx.x == F.G - 1 && F.wave < 2) {
            const float* pp = (const float*)(ws + WS_PETP) + (size_t)F.wave * 32 * 64 + F.lane; float acc = 0.f;
#pragma unroll
            for (int l = 0; l < 32; ++l) acc += pp[l * 64];
            ((float*)(ws + WS_PET))[F.wave * 64 + F.lane] = acc;
        }
    }
    SEAM(1);
    if (IN(2)) { PH_BEGIN
        constexpr int ND = 32, NGL = 256, NL = ND + NGL * 6 + 32;
        unsigned* qc = ctl + CW_Q2 + 64 * ((int)blockIdx.x & 7); const int shard = (int)blockIdx.x & 7;
        for (int k = (int)__builtin_amdgcn_readfirstlane(q_issue(qc, F.lane)); k < NL; ) {
            const unsigned tk = q_issue(qc, F.lane);
            Frame Fi = F; { size_t zz = 0; asm volatile("" : "+s"(zz)); Fi.ws += zz; Fi.out += zz; }
            if (k < ND) dil_item_sample(Fi, k * 8 + shard);
            else if (k >= ND + NGL * 6) rglru_gates_item<true>(Fi, (k - ND - NGL * 6) * 8 + shard);
            else { const int i2 = k - ND, gl = i2 / 6, slot = i2 - gl * 6;
                if (slot < 2) compress_item<true>(Fi, (2 * gl + slot) * 8 + shard);
                else { const int kd = 2 * gl + (slot & 1);
                    const int item = (((kd >> 3) * 8 + shard) << 3) | (kd & 7);
                    if (slot < 4) dil_item_prompt(Fi, item); else rglru_gates_item<false>(Fi, item); } }
            k = (int)__builtin_amdgcn_readfirstlane(tk);
        }
    }
    SEAM(2);
    if (IN(3)) { PH_BEGIN
        for (int it = F.gw; it < 2048 + 256; it += F.NGW) { if (it < 2048) rglru_scan_item<false>(F, it); else rglru_scan_item<true>(F, it - 2048); }
    }
    SEAM(3);
    if (IN(4)) { PH_BEGIN GEMM_N1024(ws + WS_O, ws + WS_WOUT0, D, (const float*)args.in[0], false); }
    SEAM(4);
    if (IN(6)) { PH_BEGIN
        DEFERRED_SAMPLE(ws + WS_O, ws + WS_WOUT0, D, (const float*)args.in[1], (bf16_t*)(ws + WS_XN), norm_ffn, 0);
        pg8::Gemm g{(const bf16_t*)(ws + WS_XN), (const bf16_t*)(ws + WS_W13_0), M, FF2, D, D};
        GATED_ORDER(S, M, FF2, D, 0);
        pg8::EpiUp E{ssp, (bf16_t*)(ws + WS_H)};
        pg8::gemm_phase<pg8::EpiUp, pg8::GatedOrder, true, true>(F.lds, g, S, E);
    }
    SEAM(6);
    if (IN(7)) { PH_BEGIN GEMM_N1024(ws + WS_H, ws + WS_W2_0, FF, nullptr, true); }
    SEAM(7);
    if (IN(9)) { PH_BEGIN
        DEFERRED_SAMPLE(ws + WS_H, ws + WS_W2_0, FF, out + O_YS, (bf16_t*)(ws + WS_XN), norm_mix + D, 1);
        pg8::Gemm g{(const bf16_t*)(ws + WS_XN), (const bf16_t*)(ws + WS_WIN1), M, C_IN_PAD, D, D};
        GATED_ORDER(S, M, C_IN_PAD, FF, 1);
        pg8::EpiIn1 E{ssp, (bf16_t*)(ws + WS_Q1), (bf16_t*)(ws + WS_KVSEL), (bf16_t*)(ws + WS_KVWIN), (float*)(ws + WS_G1), out};
        pg8::gemm_phase<pg8::EpiIn1, pg8::GatedOrder, true, true>(F.lds, g, S, E);
    }
    SEAM(9);
    if (IN(10)) { PH_BEGIN
        for (int it = (int)blockIdx.x; it < 4 * 8 * 8; it += F.G) compress_item<false, true>(F, it);
    }
    SEAM(10);
    if (IN(11)) { PH_BEGIN
        unsigned* qc = ctl + CW_Q9 + 64 * ((int)blockIdx.x & 7); const int shard = (int)blockIdx.x & 7;
        if (F.wave == 7) for (int it = (int)blockIdx.x; it < NDC + NWC; it += F.G) copy_item(F, it);
        for (int it = q_item(q_issue(qc, F.lane), shard); it < 128 + 8192; ) {
            const unsigned tk = q_issue(qc, F.lane);
            if (it < 128) nsa_item<true>(F, it);
            else { const int p = it - 128, qt = 511 - (p >> 4), bg = p & 15; nsa_item<false>(F, ((bg >> 2) << 11) | (qt << 2) | (bg & 3)); }
            it = q_item(tk, shard);
        }
    }
    SEAM(11);
    if (IN(12)) { PH_BEGIN GEMM_N1024(ws + WS_O, ws + WS_WOUT1, D, nullptr, true); }
    SEAM(12);
    if (IN(14)) { PH_BEGIN
        DEFERRED_SAMPLE(ws + WS_O, ws + WS_WOUT1, D, out + O_YS, (bf16_t*)(ws + WS_XN), norm_ffn + D, 2);
        pg8::Gemm g{(const bf16_t*)(ws + WS_XN), (const bf16_t*)(ws + WS_W13_1), M, FF2, D, D};
        GATED_ORDER(S, M, FF2, D, 2);
        pg8::EpiUp E{ssp, (bf16_t*)(ws + WS_H)};
        pg8::gemm_phase<pg8::EpiUp, pg8::GatedOrder, true, true>(F.lds, g, S, E);
    }
    SEAM(14);
    if (IN(15)) { PH_BEGIN
        if (F.G == MP / 256 * 4) {
            pg8::Gemm g{(const bf16_t*)(ws + WS_H), (const bf16_t*)(ws + WS_W2_1), MP, D, FF, FF};
            pg8::StaticOrder S; S.init(MP, D, F.G, (int)blockIdx.x);
            pg8::EpiResNorm E{(const bf16_t*)(ws + WS_XN), out + O_YP, norm_out, (float*)(ws + WS_XSL), ctl + CW_PN, ctl + CW_BAR + XB_TMO};
            pg8::gemm_phase<pg8::EpiResNorm, pg8::StaticOrder, true, true>(F.lds, g, S, E);
        } else {
            pg8::Gemm g{(const bf16_t*)(ws + WS_H), (const bf16_t*)(ws + WS_W2_1), MP, D, FF, FF};
            pg8::StaticOrder S; S.init(MP, D, F.G, (int)blockIdx.x);
            pg8::EpiRes<true, true> E{nullptr, (bf16_t*)(ws + WS_XN), out + O_YP, ssp};
            pg8::gemm_phase<pg8::EpiRes<true, true>, pg8::StaticOrder, true, true>(F.lds, g, S, E);
        }
        if ((int)blockIdx.x < 4 * (FF / 256)) { const int mu = (int)blockIdx.x; const int sl = mu >> 2;
            pg8::Gemm g{(const bf16_t*)(ws + WS_H) + sl * 256, (const bf16_t*)(ws + WS_W2_1) + sl * 256, M, D, 256, FF};
            pg8::OneUnit S{MP / 256, mu & 3};
            pg8::EpiSlab E{(float*)(ws + WS_SLAB) + (size_t)sl * MS * D};
            pg8::gemm_phase<pg8::EpiSlab, pg8::OneUnit, true, true>(F.lds, g, S, E);
            subgrid_rendezvous(ctl + CW_SR + 64 * 3, 4 * (FF / 256), ctl + CW_BAR);
            for (int r = mu * NWAVES + F.wave; r < MS; r += 4 * (FF / 256) * NWAVES)
                sample_finalize_row<true>((const float*)(ws + WS_SLAB), FF / 256, out + O_YS, out + O_YS, nullptr, norm_out, ssp, r, F.lane); }
    }
    if (gridDim.x != MP / 256 * 4) {
        SEAM(15);
        if (IN(16)) { PH_BEGIN
            for (int r = F.gw; r < MP; r += F.NGW) final_norm_row(out, ssp, norm_out, r, F.lane);
        }
    }
#undef GEMM_N1024
#undef DEFERRED_SAMPLE
#undef GATED_ORDER
#undef IN
#undef SEAM
}

extern "C" void kernel_launch(void* const* d_in, const int* in_sizes, int n_in, void* d_out, int out_size, void* d_ws, size_t ws_size, hipStream_t stream) {
    static int grid = 0;
    if (grid == 0) {
        if (n_in != 28 || (size_t)out_size != O_END || ws_size < WS_END) { fprintf(stderr, "kernel_launch: unexpected shapes (n_in %d out %d ws %zu need %zu)\n", n_in, out_size, ws_size, (size_t)WS_END); grid = -1; return; }
        int dev = 0, cus = 0, per_cu = 0;
        if (hipGetDevice(&dev) != hipSuccess || hipDeviceGetAttribute(&cus, hipDeviceAttributeMultiprocessorCount, dev) != hipSuccess) { grid = -1; return; }
        if (hipFuncSetAttribute((const void*)fwd, hipFuncAttributeMaxDynamicSharedMemorySize, LDS_BYTES) != hipSuccess) { fprintf(stderr, "kernel_launch: hipFuncSetAttribute failed\n"); grid = -1; return; }
        if (hipOccupancyMaxActiveBlocksPerMultiprocessor(&per_cu, (const void*)fwd, NWAVES * 64, LDS_BYTES) != hipSuccess || per_cu < 1) { fprintf(stderr, "kernel_launch: occupancy query says %d\n", per_cu); }
        (void)hipGetLastError();
        grid = cus;
    }
    if (grid < 0) return;
    (void)hipMemsetAsync((char*)d_ws + WS_CTL, 0, CTL_ZERO_BYTES, stream);
    Args a{};
    for (int i = 0; i < 28; ++i) a.in[i] = d_in[i];
    a.out = (float*)d_out; a.ws = (unsigned char*)d_ws;
#if ONE_LAUNCH
    a.ph_lo = 0; a.ph_hi = N_PHASES; hipLaunchKernelGGL(fwd, dim3(grid), dim3(NWAVES * 64), LDS_BYTES, stream, a);
#else
    for (int p = 0; p < N_PHASES; ++p) { a.ph_lo = p; a.ph_hi = p + 1; hipLaunchKernelGGL(fwd, dim3(grid), dim3(NWAVES * 64), LDS_BYTES, stream, a); }
#endif
}
```
